# Optimizing an MI355X kernel written in HIP

```python
import math
import jax
import jax.numpy as jnp
from jax import lax
import numpy as np

D_MODEL = 1024
BATCH = 1
SEQ = 16384
DEPTH = 4
DEC_BATCH = 8
DEC_SEQ = 64
PAST_LEN = 2048

CHUNK = 64
N_MIXERS = 2
N_GDN_LAYERS = (DEPTH + 1) // 2
N_SB_LAYERS = DEPTH // 2
MEM_TOKENS = 256
MEM_HEADS = 4
MEM_HEAD_DIM = 64
MEM_WIDTH = MEM_HEADS * MEM_HEAD_DIM
GDN_HEAD_DIM = 128
GDN_HEADS = 6
GDN_WIDTH = GDN_HEADS * GDN_HEAD_DIM
GDN_CONV = 4
GDN_CONV_CH = 3 * GDN_WIDTH
GDN_TOK_IN = 4 * GDN_WIDTH + 2 * GDN_HEADS
GDN_IN = GDN_TOK_IN + MEM_WIDTH
GDN_MIX = GDN_WIDTH + MEM_WIDTH
SB_HEAD_DIM = 128
SB_HEADS = 4
SB_WIDTH = SB_HEADS * SB_HEAD_DIM
SB_TOK_IN = 3 * SB_WIDTH
SB_IN = SB_TOK_IN + MEM_WIDTH
SB_MIX = SB_WIDTH + MEM_WIDTH
SB_BLOCK = 128
D_FF = 4 * D_MODEL
NORM_EPS = 1e-6

kernel_name = 'hybrid_gdn_stickbreak_stream_step'


def rms_norm(x, gain):
    xf = x.astype(jnp.float32)
    y = xf * lax.rsqrt(jnp.mean(xf * xf, axis=-1, keepdims=True) + NORM_EPS)
    return (y * gain.astype(jnp.float32)).astype(x.dtype)


def l2_norm(x):
    xf = x.astype(jnp.float32)
    return (xf * lax.rsqrt(jnp.sum(xf * xf, axis=-1, keepdims=True) + NORM_EPS)).astype(x.dtype)


def causal_conv_silu(x, buf, w):
    t = x.shape[1]
    xp = jnp.concatenate([buf.astype(x.dtype), x], axis=1)
    y = xp[:, 0:t] * w[0]
    for j in range(1, GDN_CONV):
        y = y + xp[:, j:j + t] * w[j]
    return jax.nn.silu(y), xp[:, -(GDN_CONV - 1):]


def gdn_chunked(q, k, v, beta, g, s0, chunk):
    f32 = jnp.float32
    b, t, h, dk = q.shape
    dv = v.shape[-1]
    n = t // chunk

    def blocks(a):
        a = a.astype(f32).reshape((b, n, chunk, h) + a.shape[3:])
        return jnp.swapaxes(jnp.moveaxis(a, 2, 3), 0, 1)

    qc, kc, vc = blocks(q), blocks(k), blocks(v)
    bc = blocks(beta)
    gc = jnp.cumsum(blocks(g), axis=-1)
    idx = jnp.arange(chunk)
    causal = idx[:, None] >= idx[None, :]
    strict = idx[:, None] > idx[None, :]
    diff = gc[..., :, None] - gc[..., None, :]
    decay = jnp.where(causal, jnp.exp(jnp.where(causal, diff, 0.0)), 0.0)
    kb = kc * bc[..., None]
    lower = jnp.einsum('nbhid,nbhjd->nbhij', kb, kc) * jnp.where(strict, decay, 0.0)
    lhs = lower + jnp.eye(chunk, dtype=f32)
    rhs = jnp.concatenate([vc * bc[..., None], kb * jnp.exp(gc)[..., None]], axis=-1)
    sol = lax.linalg.triangular_solve(lhs, rhs, left_side=True, lower=True, unit_diagonal=True)
    u, w = sol[..., :dv], sol[..., dv:]
    a_intra = jnp.einsum('nbhid,nbhjd->nbhij', qc, kc) * decay
    q_dec = qc * jnp.exp(gc)[..., None]
    k_dec = kc * jnp.exp(gc[..., -1:] - gc)[..., None]
    g_last = jnp.exp(gc[..., -1])[..., None, None]

    def step(s, inp):
        u_c, w_c, a_c, qd_c, kd_c, gl_c = inp
        v_new = u_c - jnp.einsum('bhck,bhkv->bhcv', w_c, s)
        o_c = jnp.einsum('bhck,bhkv->bhcv', qd_c, s) + jnp.einsum('bhij,bhjv->bhiv', a_c, v_new)
        s = s * gl_c + jnp.einsum('bhck,bhcv->bhkv', kd_c, v_new)
        return s, o_c

    s_fin, o = lax.scan(step, s0.astype(f32), (u, w, a_intra, q_dec, k_dec, g_last))
    o = jnp.moveaxis(jnp.swapaxes(o, 0, 1), 2, 3).reshape(b, t, h, dv)
    return o, s_fin


def gdn_mixer(tok, conv_buf, s0, conv_w, a_log, dt_bias, o_gain):
    b, t, _ = tok.shape
    tw = GDN_WIDTH
    qkv_raw = tok[..., :3 * tw]
    z = tok[..., 3 * tw:4 * tw]
    b_raw = tok[..., 4 * tw:4 * tw + GDN_HEADS]
    a_raw = tok[..., 4 * tw + GDN_HEADS:]
    qkv, new_buf = causal_conv_silu(qkv_raw, conv_buf, conv_w)
    q, k, v = (u.reshape(b, t, GDN_HEADS, GDN_HEAD_DIM) for u in jnp.split(qkv, 3, axis=-1))
    q = l2_norm(q) * (GDN_HEAD_DIM ** -0.5)
    k = l2_norm(k)
    beta = jax.nn.sigmoid(b_raw.astype(jnp.float32))
    g = -jnp.exp(a_log.astype(jnp.float32)) * jax.nn.softplus(a_raw.astype(jnp.float32) + dt_bias.astype(jnp.float32))
    o, s_new = gdn_chunked(q, k, v, beta, g, s0, min(CHUNK, t))
    o = rms_norm(o.astype(tok.dtype), o_gain) * jax.nn.silu(z.reshape(b, t, GDN_HEADS, GDN_HEAD_DIM))
    return o.reshape(b, t, tw), new_buf, s_new.astype(tok.dtype)


def sb_qkv(tok, q_gain, k_gain):
    b, t, _ = tok.shape
    q, k, v = (u.reshape(b, t, SB_HEADS, SB_HEAD_DIM) for u in jnp.split(tok, 3, axis=-1))
    return rms_norm(q, q_gain) * (SB_HEAD_DIM ** -0.5), rms_norm(k, k_gain), v


def sb_attend(q, k_dg, v_dg, k_off, v_off):
    f32 = jnp.float32
    qn = q.shape[1]
    idx = jnp.arange(qn)
    strict = idx[:, None] > idx[None, :]
    incl = (idx[:, None] >= idx[None, :]).astype(f32)
    z_d = jnp.einsum('bqhd,bshd->bhqs', q, k_dg).astype(f32)
    m_d = jnp.where(strict, jnp.log1p(jnp.exp(z_d)), 0.0)
    c_d = jnp.einsum('bhqj,js->bhqs', m_d, incl)
    a_d = jnp.where(strict, jnp.exp(z_d - c_d), 0.0)
    out = jnp.einsum('bhqs,bshd->bqhd', a_d.astype(v_dg.dtype), v_dg)
    if k_off is not None:
        nb = k_off.shape[1]
        bi = jnp.arange(SB_BLOCK)
        incl_b = (bi[:, None] >= bi[None, :]).astype(f32)
        ni = jnp.arange(nb)
        later = (ni[:, None] > ni[None, :]).astype(f32)
        z_o = jnp.einsum('bqhd,bnshd->bhqns', q, k_off).astype(f32)
        m_o = jnp.log1p(jnp.exp(z_o))
        c_o = jnp.einsum('bhqnj,js->bhqns', m_o, incl_b)
        suf = jnp.einsum('bhqm,mn->bhqn', c_o[..., 0], later) + c_d[..., 0:1]
        a_o = jnp.exp(z_o - c_o - suf[..., None])
        out = out + jnp.einsum('bhqns,bnshd->bqhd', a_o.astype(v_off.dtype), v_off)
    return out


def sb_prompt(q, k, v):
    b, t, h, d = q.shape
    nb = t // SB_BLOCK
    outs = []
    for i in range(nb):
        lo, hi = i * SB_BLOCK, (i + 1) * SB_BLOCK
        if i == 0:
            k_off, v_off = None, None
        else:
            k_off = k[:, :lo].reshape(b, i, SB_BLOCK, h, d)
            v_off = v[:, :lo].reshape(b, i, SB_BLOCK, h, d)
        outs.append(sb_attend(q[:, lo:hi], k[:, lo:hi], v[:, lo:hi], k_off, v_off))
    return jnp.concatenate(outs, axis=1).reshape(b, t, h * d)


def memory_kv(mem, norm_g, w_kv, k_gain):
    b, m, _ = mem.shape
    kv = rms_norm(mem, norm_g) @ w_kv
    k, v = jnp.split(kv, 2, axis=-1)
    k = rms_norm(k.reshape(b, m, MEM_HEADS, MEM_HEAD_DIM), k_gain)
    return k, v.reshape(b, m, MEM_HEADS, MEM_HEAD_DIM)


def memory_attend(mq, mk, mv, q_gain):
    b, t, _ = mq.shape
    q = rms_norm(mq.reshape(b, t, MEM_HEADS, MEM_HEAD_DIM), q_gain)
    s = jnp.einsum('bthd,bmhd->bhtm', q, mk.astype(q.dtype)).astype(jnp.float32) * (MEM_HEAD_DIM ** -0.5)
    p = jax.nn.softmax(s, axis=-1).astype(q.dtype)
    return jnp.einsum('bhtm,bmhd->bthd', p, mv.astype(q.dtype)).reshape(b, t, MEM_WIDTH)


def sq_relu_mlp(h, w_up, w_down):
    a = jax.nn.relu(h @ w_up)
    return (a * a) @ w_down


def setup_inputs(seed: int = 0) -> dict:
    key = jax.random.key(seed)
    ks = jax.random.split(key, 27)
    f32 = jnp.float32
    nrm = lambda k, shape, s=1.0: s * jax.random.normal(k, shape, f32)
    gain = lambda k, shape: 1.0 + 0.02 * jax.random.normal(k, shape, f32)
    dt = jnp.exp(jax.random.uniform(ks[19], (N_GDN_LAYERS, GDN_HEADS), f32) * (math.log(0.1) - math.log(0.001)) + math.log(0.001))
    return {
        'x_prompt': nrm(ks[0], (BATCH, SEQ, D_MODEL)),
        'x_sample': nrm(ks[1], (DEC_BATCH, DEC_SEQ, D_MODEL)),
        'state_gdn_conv': nrm(ks[2], (N_GDN_LAYERS, DEC_BATCH, GDN_CONV - 1, GDN_CONV_CH)),
        'state_gdn_s': nrm(ks[3], (N_GDN_LAYERS, DEC_BATCH, GDN_HEADS, GDN_HEAD_DIM, GDN_HEAD_DIM), 0.1),
        'cache_sb_k': nrm(ks[4], (N_SB_LAYERS, DEC_BATCH, PAST_LEN, SB_HEADS, SB_HEAD_DIM)),
        'cache_sb_v': nrm(ks[5], (N_SB_LAYERS, DEC_BATCH, PAST_LEN, SB_HEADS, SB_HEAD_DIM)),
        'cache_mem_k': nrm(ks[6], (DEPTH, DEC_BATCH, MEM_TOKENS, MEM_HEADS, MEM_HEAD_DIM)),
        'cache_mem_v': nrm(ks[7], (DEPTH, DEC_BATCH, MEM_TOKENS, MEM_HEADS, MEM_HEAD_DIM)),
        'mem_prompt': nrm(ks[8], (BATCH, MEM_TOKENS, D_MODEL)),
        'norm_mix': gain(ks[9], (DEPTH, D_MODEL)),
        'norm_mem': gain(ks[10], (DEPTH, D_MODEL)),
        'norm_ffn': gain(ks[11], (DEPTH, D_MODEL)),
        'w_in_gdn': nrm(ks[12], (N_GDN_LAYERS, D_MODEL, GDN_IN), D_MODEL ** -0.5),
        'w_in_sb': nrm(ks[13], (N_SB_LAYERS, D_MODEL, SB_IN), D_MODEL ** -0.5),
        'w_mem_kv': nrm(ks[14], (DEPTH, D_MODEL, 2 * MEM_WIDTH), D_MODEL ** -0.5),
        'mem_q_gain': gain(ks[15], (DEPTH, MEM_HEAD_DIM)),
        'mem_k_gain': gain(ks[16], (DEPTH, MEM_HEAD_DIM)),
        'gdn_conv_w': nrm(ks[17], (N_GDN_LAYERS, GDN_CONV, GDN_CONV_CH), GDN_CONV ** -0.5),
        'gdn_a_log': jnp.log(jax.random.uniform(ks[18], (N_GDN_LAYERS, GDN_HEADS), f32, 1.0, 16.0)),
        'gdn_dt_bias': dt + jnp.log(-jnp.expm1(-dt)),
        'gdn_o_gain': gain(ks[20], (N_GDN_LAYERS, GDN_HEAD_DIM)),
        'sb_q_gain': gain(ks[21], (N_SB_LAYERS, SB_HEAD_DIM)),
        'sb_k_gain': gain(ks[22], (N_SB_LAYERS, SB_HEAD_DIM)),
        'w_out_gdn': nrm(ks[23], (N_GDN_LAYERS, GDN_MIX, D_MODEL), GDN_MIX ** -0.5),
        'w_out_sb': nrm(ks[26], (N_SB_LAYERS, SB_MIX, D_MODEL), SB_MIX ** -0.5),
        'w_up': nrm(ks[24], (DEPTH, D_MODEL, D_FF), D_MODEL ** -0.5),
        'w_down': nrm(ks[25], (DEPTH, D_FF, D_MODEL), D_FF ** -0.5),
    }


def reference(x_prompt, x_sample, state_gdn_conv, state_gdn_s, cache_sb_k, cache_sb_v, cache_mem_k, cache_mem_v,
              mem_prompt, norm_mix, norm_mem, norm_ffn, w_in_gdn, w_in_sb, w_mem_kv, mem_q_gain, mem_k_gain,
              gdn_conv_w, gdn_a_log, gdn_dt_bias, gdn_o_gain, sb_q_gain, sb_k_gain, w_out_gdn, w_out_sb, w_up, w_down):
    yp, ys = x_prompt, x_sample
    bp = x_prompt.shape[0]
    bs, t_new = x_sample.shape[0], x_sample.shape[1]
    past = cache_sb_k.shape[2]
    n_past_blk = past // SB_BLOCK
    pc, pst, pk, pv, pmk, pmv = [], [], [], [], [], []
    sc, sst, sk, sv = [], [], [], []
    for i in range(DEPTH):
        j = i // N_MIXERS
        mk, mv = memory_kv(mem_prompt, norm_mem[i], w_mem_kv[i], mem_k_gain[i])
        pmk.append(mk)
        pmv.append(mv)
        hp = rms_norm(yp, norm_mix[i])
        hs = rms_norm(ys, norm_mix[i])
        if i % N_MIXERS == 0:
            pp = hp @ w_in_gdn[j]
            ps = hs @ w_in_gdn[j]
            tok_p, mq_p = pp[..., :GDN_TOK_IN], pp[..., GDN_TOK_IN:]
            tok_s, mq_s = ps[..., :GDN_TOK_IN], ps[..., GDN_TOK_IN:]
            buf0 = jnp.zeros((bp, GDN_CONV - 1, GDN_CONV_CH), tok_p.dtype)
            st0 = jnp.zeros((bp, GDN_HEADS, GDN_HEAD_DIM, GDN_HEAD_DIM), jnp.float32)
            op, bufp, stp = gdn_mixer(tok_p, buf0, st0, gdn_conv_w[j], gdn_a_log[j], gdn_dt_bias[j], gdn_o_gain[j])
            osm, bufs, sts = gdn_mixer(tok_s, state_gdn_conv[j], state_gdn_s[j], gdn_conv_w[j], gdn_a_log[j], gdn_dt_bias[j], gdn_o_gain[j])
            pc.append(bufp)
            pst.append(stp)
            sc.append(bufs)
            sst.append(sts)
            w_o = w_out_gdn[j]
        else:
            pp = hp @ w_in_sb[j]
            ps = hs @ w_in_sb[j]
            tok_p, mq_p = pp[..., :SB_TOK_IN], pp[..., SB_TOK_IN:]
            tok_s, mq_s = ps[..., :SB_TOK_IN], ps[..., SB_TOK_IN:]
            qp, kp, vp = sb_qkv(tok_p, sb_q_gain[j], sb_k_gain[j])
            op = sb_prompt(qp, kp, vp)
            qs, ks_, vs = sb_qkv(tok_s, sb_q_gain[j], sb_k_gain[j])
            k_past = cache_sb_k[j].astype(ks_.dtype).reshape(bs, n_past_blk, SB_BLOCK, SB_HEADS, SB_HEAD_DIM)
            v_past = cache_sb_v[j].astype(vs.dtype).reshape(bs, n_past_blk, SB_BLOCK, SB_HEADS, SB_HEAD_DIM)
            osm = sb_attend(qs, ks_, vs, k_past, v_past).reshape(bs, t_new, SB_WIDTH)
            pk.append(kp)
            pv.append(vp)
            sk.append(ks_)
            sv.append(vs)
            w_o = w_out_sb[j]
        mp = memory_attend(mq_p, mk, mv, mem_q_gain[i])
        ms = memory_attend(mq_s, cache_mem_k[i], cache_mem_v[i], mem_q_gain[i])
        yp = yp + jnp.concatenate([op, mp], axis=-1) @ w_o
        ys = ys + jnp.concatenate([osm, ms], axis=-1) @ w_o
        yp = yp + sq_relu_mlp(rms_norm(yp, norm_ffn[i]), w_up[i], w_down[i])
        ys = ys + sq_relu_mlp(rms_norm(ys, norm_ffn[i]), w_up[i], w_down[i])
    p_gdn_conv = jnp.stack(pc)
    p_gdn_s = jnp.stack(pst)
    p_sb_k = jnp.stack(pk)
    p_sb_v = jnp.stack(pv)
    p_mem_k = jnp.stack(pmk)
    p_mem_v = jnp.stack(pmv)
    s_gdn_conv = jnp.stack(sc)
    s_gdn_s = jnp.stack(sst)
    s_sb_k = jnp.stack(sk)
    s_sb_v = jnp.stack(sv)
    return (yp, ys, p_gdn_conv, p_gdn_s, p_sb_k, p_sb_v, p_mem_k, p_mem_v, s_gdn_conv, s_gdn_s, s_sb_k, s_sb_v)
```

```cpp
#include <hip/hip_runtime.h>
#include <hip/hip_cooperative_groups.h>
#include <cstdio>
#include <cstdint>
namespace cg = cooperative_groups;

typedef unsigned short bf16_t;
typedef short bf16x8 __attribute__((ext_vector_type(8)));
typedef float f32x16 __attribute__((ext_vector_type(16)));
typedef float f32x4 __attribute__((ext_vector_type(4)));
typedef unsigned u4 __attribute__((ext_vector_type(4)));
typedef unsigned u2 __attribute__((ext_vector_type(2)));
#define DEVI __device__ __forceinline__
__device__ __forceinline__ u4 mk4(unsigned a, unsigned b, unsigned c, unsigned d) { u4 r; r.x = a; r.y = b; r.z = c; r.w = d; return r; }
__device__ __forceinline__ u2 mk2(unsigned a, unsigned b) { u2 r; r.x = a; r.y = b; return r; }
#define MFMA32(a, b, c) __builtin_amdgcn_mfma_f32_32x32x16_bf16((a), (b), (c), 0, 0, 0)
#define MFMA16(a, b, c) __builtin_amdgcn_mfma_f32_16x16x32_bf16((a), (b), (c), 0, 0, 0)

constexpr int DM = 1024, TP = 16384, TS = 512, TA = TP + TS, DFF = 4096;
constexpr int NP_GDN = 3456, NP_SB = 1792, MQ_GDN = 3200, MQ_SB = 1536;
constexpr int NCHUNK = 264, NITEM = NCHUNK * 6;
constexpr float EPS = 1e-6f;
constexpr float LOG2E = 1.4426950408889634f;
constexpr size_t O_YP = 0, O_PGC = 17301504, O_PGS = 17315328, O_PSK = 17511936, O_PSV = 34289152, O_PMK = 51066368, O_PMV = 51328512,
                 O_SGC = 51590656, O_SGS = 51701248, O_SSK = 53274112, O_SSV = 53798400;
constexpr size_t WS_CTR = 0;
constexpr size_t WS_WIG = 4096;
constexpr size_t WS_WIS = WS_WIG + 2ull * 3456 * 1024 * 2;
constexpr size_t WS_WKV = WS_WIS + 2ull * 1792 * 1024 * 2;
constexpr size_t WS_WOG = WS_WKV + 4ull * 512 * 1024 * 2;
constexpr size_t WS_WOS = WS_WOG + 2ull * 1024 * 1024 * 2;
constexpr size_t WS_WUP = WS_WOS + 2ull * 1024 * 768 * 2;
constexpr size_t WS_WDN = WS_WUP + 4ull * 4096 * 1024 * 2;
constexpr size_t WS_XN = WS_WDN + 4ull * 4096 * 1024 * 2;
constexpr size_t WS_MIX = WS_XN + (size_t)TA * 1024 * 2;
constexpr size_t WS_MEMN = WS_MIX + (size_t)TA * 1024 * 2;
constexpr size_t WS_MEMKV = WS_MEMN + 4ull * 256 * 1024 * 2;
constexpr size_t WS_BIG = WS_MEMKV + 4ull * 256 * 512 * 4;
constexpr size_t WS_P = WS_BIG;
constexpr size_t WS_G = WS_P + (size_t)TA * 3456 * 2;
constexpr size_t G_ITEM = 73728;
constexpr size_t WS_GL = WS_G + (size_t)NITEM * G_ITEM;
constexpr size_t WS_H = WS_BIG;
constexpr size_t WS_END = WS_GL + 8192;

struct KP { const float* in[27]; float* out; unsigned char* ws; int ph_lo, ph_hi; };

DEVI int get_tid() { int t = __builtin_amdgcn_workitem_id_x(); asm volatile("" : "+v"(t)); return t; }
DEVI float bf2f(bf16_t b) { return __uint_as_float(((unsigned)b) << 16); }
DEVI unsigned pk2(float lo, float hi) { unsigned r; asm("v_cvt_pk_bf16_f32 %0, %1, %2" : "=v"(r) : "v"(lo), "v"(hi)); return r; }
DEVI bf16_t f2bf(float f) { return (bf16_t)(pk2(f, 0.f) & 0xffffu); }
DEVI float lo2f(unsigned u) { return __uint_as_float(u << 16); }
DEVI float hi2f(unsigned u) { return __uint_as_float(u & 0xffff0000u); }
DEVI float ex2(float x) { return __builtin_amdgcn_exp2f(x); }
DEVI float lg2(float x) { return __builtin_amdgcn_logf(x); }
DEVI float wave_sum(float v) {
#pragma unroll
  for (int o = 32; o >= 1; o >>= 1) v += __shfl_xor(v, o);
  return v;
}
DEVI bf16x8 as_frag(u4 u) { return __builtin_bit_cast(bf16x8, u); }
DEVI float silu(float y) { return y / (1.f + __expf(-y)); }

struct EpiArgs { bf16_t* cb; float* cf; int ldc; const float* res0; const float* res1; float* yout; };
template <int EPI>
DEVI void gemm_tile(const bf16_t* __restrict__ A, int lda, const bf16_t* __restrict__ Bt, int ldb, int K, int m0, int n0, const EpiArgs& ea, unsigned char* smem) {
  const int tid = get_tid(), lane = tid & 63, wave = tid >> 6;
  const int wm = wave >> 1, wn = wave & 1, l31 = lane & 31, lh = lane >> 5;
  bf16_t* sA = (bf16_t*)smem;
  bf16_t* sB = sA + 2 * 128 * 72;
  f32x16 acc[2][2];
#pragma unroll
  for (int i = 0; i < 2; ++i)
#pragma unroll
    for (int j = 0; j < 2; ++j)
#pragma unroll
      for (int r = 0; r < 16; ++r) acc[i][j][r] = 0.f;
  const int lr = tid >> 3, lc = (tid & 7) * 8;
  const bf16_t* gA = A + (size_t)(m0 + lr) * lda + lc;
  const bf16_t* gB = Bt + (size_t)(n0 + lr) * ldb + lc;
  u4 ra[4], rb[4];
#pragma unroll
  for (int i = 0; i < 4; ++i) { ra[i] = *(const u4*)(gA + (size_t)i * 32 * lda); rb[i] = *(const u4*)(gB + (size_t)i * 32 * ldb); }
  __syncthreads();
#pragma unroll
  for (int i = 0; i < 4; ++i) { *(u4*)(sA + (lr + i * 32) * 72 + lc) = ra[i]; *(u4*)(sB + (lr + i * 32) * 72 + lc) = rb[i]; }
  __syncthreads();
  const int nk = K >> 6;
  for (int kt = 0; kt < nk; ++kt) {
    const int cur = kt & 1;
    if (kt + 1 < nk) {
      const int k0 = (kt + 1) << 6;
#pragma unroll
      for (int i = 0; i < 4; ++i) { ra[i] = *(const u4*)(gA + (size_t)i * 32 * lda + k0); rb[i] = *(const u4*)(gB + (size_t)i * 32 * ldb + k0); }
    }
    const bf16_t* cA = sA + cur * 128 * 72 + (wm * 64 + l31) * 72 + lh * 8;
    const bf16_t* cB = sB + cur * 128 * 72 + (wn * 64 + l31) * 72 + lh * 8;
#pragma unroll
    for (int ks = 0; ks < 4; ++ks) {
      bf16x8 a0 = *(const bf16x8*)(cA + ks * 16), a1 = *(const bf16x8*)(cA + 32 * 72 + ks * 16);
      bf16x8 b0 = *(const bf16x8*)(cB + ks * 16), b1 = *(const bf16x8*)(cB + 32 * 72 + ks * 16);
      acc[0][0] = MFMA32(a0, b0, acc[0][0]); acc[0][1] = MFMA32(a0, b1, acc[0][1]);
      acc[1][0] = MFMA32(a1, b0, acc[1][0]); acc[1][1] = MFMA32(a1, b1, acc[1][1]);
    }
    if (kt + 1 < nk) {
      const int nx = cur ^ 1;
#pragma unroll
      for (int i = 0; i < 4; ++i) { *(u4*)(sA + nx * 128 * 72 + (lr + i * 32) * 72 + lc) = ra[i]; *(u4*)(sB + nx * 128 * 72 + (lr + i * 32) * 72 + lc) = rb[i]; }
    }
    __syncthreads();
  }
#pragma unroll
  for (int i = 0; i < 2; ++i)
#pragma unroll
    for (int r = 0; r < 16; ++r) {
      const int row = m0 + wm * 64 + i * 32 + (r >> 2) * 8 + lh * 4 + (r & 3);
#pragma unroll
      for (int j = 0; j < 2; ++j) {
        const int col = n0 + wn * 64 + j * 32 + l31;
        const float v = acc[i][j][r];
        if (EPI == 0) ea.cb[(size_t)row * ea.ldc + col] = f2bf(v);
        else if (EPI == 1) {
          const float* rp = ea.res1 ? (row < TP ? ea.res0 + (size_t)row * DM : ea.res1 + (size_t)(row - TP) * DM) : ea.res0 + (size_t)row * DM;
          ea.yout[(size_t)row * DM + col] = rp[col] + v;
        } else if (EPI == 2) { const float rl = v > 0.f ? v : 0.f; ea.cb[(size_t)row * ea.ldc + col] = f2bf(rl * rl); }
        else ea.cf[(size_t)row * ea.ldc + col] = v;
      }
    }
}
template <int EPI>
DEVI void gemm_phase(const bf16_t* A, int lda, const bf16_t* Bt, int K, int M, int N, const EpiArgs& ea, unsigned char* smem) {
  const int ntn = N >> 7, nt = (M >> 7) * ntn;
  for (int t = blockIdx.x; t < nt; t += gridDim.x) gemm_tile<EPI>(A, lda, Bt, K, K, (t / ntn) << 7, (t % ntn) << 7, ea, smem);
}

DEVI void convert_tile(const float* __restrict__ W, bf16_t* __restrict__ Wt, int K, int N, int k0, int n0, int thr, int shift, unsigned char* smem) {
  float* tile = (float*)smem;
  const int tid = get_tid();
  __syncthreads();
#pragma unroll
  for (int i = 0; i < 4; ++i) {
    const int r = (tid >> 4) + 16 * i, c = (tid & 15) * 4;
    float4 v = make_float4(0.f, 0.f, 0.f, 0.f);
    if (n0 + c < N) v = *(const float4*)(W + (size_t)(k0 + r) * N + n0 + c);
    tile[r * 65 + c] = v.x; tile[r * 65 + c + 1] = v.y; tile[r * 65 + c + 2] = v.z; tile[r * 65 + c + 3] = v.w;
  }
  __syncthreads();
  const int n = tid >> 2, kc = (tid & 3) * 16;
  if (n0 + n < N) {
    const int nn = n0 + n, nd = nn + (nn >= thr ? shift : 0);
    unsigned o[8];
#pragma unroll
    for (int e = 0; e < 8; ++e) o[e] = pk2(tile[(kc + 2 * e) * 65 + n], tile[(kc + 2 * e + 1) * 65 + n]);
    u4* dst = (u4*)(Wt + (size_t)nd * K + k0 + kc);
    dst[0] = mk4(o[0], o[1], o[2], o[3]); dst[1] = mk4(o[4], o[5], o[6], o[7]);
  }
}
DEVI void convert_group(int& base, int bid, int nb, const float* W, bf16_t* Wt, int nl, int K, int N, int NPAD, int thr, int shift, unsigned char* smem) {
  const int tk = K >> 6, tn = (N + 63) >> 6, per = tk * tn, tot = per * nl;
  int first = ((bid - base) % nb + nb) % nb;
  for (int t = first; t < tot; t += nb) {
    const int l = t / per, r = t % per;
    convert_tile(W + (size_t)l * K * N, Wt + (size_t)l * NPAD * K, K, N, (r / tn) << 6, (r % tn) << 6, thr, shift, smem);
  }
  base += tot;
}

DEVI void norm_row(const float* __restrict__ src, const float* __restrict__ gain, bf16_t* __restrict__ dst, int lane) {
  float4 v[4]; float ss = 0.f;
#pragma unroll
  for (int i = 0; i < 4; ++i) { v[i] = *(const float4*)(src + lane * 4 + 256 * i); ss += v[i].x * v[i].x + v[i].y * v[i].y + v[i].z * v[i].z + v[i].w * v[i].w; }
  ss = wave_sum(ss);
  const float sc = rsqrtf(ss * (1.f / 1024.f) + EPS);
#pragma unroll
  for (int i = 0; i < 4; ++i) {
    const float4 g = *(const float4*)(gain + lane * 4 + 256 * i);
    u2 o; o.x = pk2(v[i].x * sc * g.x, v[i].y * sc * g.y); o.y = pk2(v[i].z * sc * g.z, v[i].w * sc * g.w);
    *(u2*)(dst + lane * 4 + 256 * i) = o;
  }
}

struct KVSrc { const void* k; const void* v; int kpitch, vpitch, f32; };
template <int D>
DEVI void attn_load(const KVSrc& s, int r0, u4 (&kr)[D / 32], u4 (&vr)[D / 32]) {
  const int tid = get_tid();
#pragma unroll
  for (int i = 0; i < D / 32; ++i) {
    const int c = tid + 256 * i, key = c / (D / 8), dch = c % (D / 8);
    if (s.f32) {
      const float* kp = (const float*)s.k + (size_t)(r0 + key) * s.kpitch + dch * 8;
      const float* vp = (const float*)s.v + (size_t)(r0 + key) * s.vpitch + dch * 8;
      const float4 a = *(const float4*)kp, b = *(const float4*)(kp + 4), c2 = *(const float4*)vp, d2 = *(const float4*)(vp + 4);
      kr[i] = mk4(pk2(a.x, a.y), pk2(a.z, a.w), pk2(b.x, b.y), pk2(b.z, b.w));
      vr[i] = mk4(pk2(c2.x, c2.y), pk2(c2.z, c2.w), pk2(d2.x, d2.y), pk2(d2.z, d2.w));
    } else {
      kr[i] = *(const u4*)((const bf16_t*)s.k + (size_t)(r0 + key) * s.kpitch + dch * 8);
      vr[i] = *(const u4*)((const bf16_t*)s.v + (size_t)(r0 + key) * s.vpitch + dch * 8);
    }
  }
}
template <int D>
DEVI void attn_store(bf16_t* Ks, bf16_t* Vt, const u4 (&kr)[D / 32], const u4 (&vr)[D / 32]) {
  const int tid = get_tid();
#pragma unroll
  for (int i = 0; i < D / 32; ++i) {
    const int c = tid + 256 * i, key = c / (D / 8), dch = c % (D / 8);
    *(u4*)(Ks + key * (D + 8) + dch * 8) = kr[i];
    const int kx = key ^ ((dch & 15) << 2);
    const unsigned w[4] = {vr[i].x, vr[i].y, vr[i].z, vr[i].w};
#pragma unroll
    for (int e = 0; e < 8; ++e) Vt[(dch * 8 + e) * 72 + kx] = (bf16_t)((w[e >> 1] >> (16 * (e & 1))) & 0xffffu);
  }
}

template <int D, int MODE>
DEVI void attn_item(const bf16_t* __restrict__ qsrc, int qpitch, int nq, const float* __restrict__ qgain, float qscale,
                    const KVSrc& segA, int nA, int qposA0, int maskA, const KVSrc& segB, int nB,
                    bf16_t* __restrict__ out, int opitch, unsigned char* smem) {
  constexpr int KPT = D + 8, NKS = D / 16, NDB = D / 32, NCH = D / 32;
  constexpr int STAGE = 64 * KPT + D * 72;
  const int tid = get_tid(), lane = tid & 63, wave = tid >> 6, l31 = lane & 31, lh = lane >> 5;
  bf16_t* sbase = (bf16_t*)smem;
  const bool active = wave * 32 < nq;
  bf16x8 qf[NKS];
  {
    float qv[NKS][8]; float ss = 0.f;
    const bf16_t* qp = qsrc + (size_t)(wave * 32 + l31) * qpitch + lh * 8;
#pragma unroll
    for (int ks = 0; ks < NKS; ++ks) {
      u4 u = mk4(0, 0, 0, 0);
      if (active) u = *(const u4*)(qp + ks * 16);
      const unsigned w[4] = {u.x, u.y, u.z, u.w};
#pragma unroll
      for (int e = 0; e < 4; ++e) { qv[ks][2 * e] = lo2f(w[e]); qv[ks][2 * e + 1] = hi2f(w[e]); }
#pragma unroll
      for (int e = 0; e < 8; ++e) ss += qv[ks][e] * qv[ks][e];
    }
    ss += __shfl_xor(ss, 32);
    const float sc = rsqrtf(ss * (1.f / D) + EPS) * qscale;
#pragma unroll
    for (int ks = 0; ks < NKS; ++ks) {
      const float4 g0 = *(const float4*)(qgain + ks * 16 + lh * 8), g1 = *(const float4*)(qgain + ks * 16 + lh * 8 + 4);
      u4 u;
      u.x = pk2(qv[ks][0] * sc * g0.x, qv[ks][1] * sc * g0.y); u.y = pk2(qv[ks][2] * sc * g0.z, qv[ks][3] * sc * g0.w);
      u.z = pk2(qv[ks][4] * sc * g1.x, qv[ks][5] * sc * g1.y); u.w = pk2(qv[ks][6] * sc * g1.z, qv[ks][7] * sc * g1.w);
      qf[ks] = as_frag(u);
    }
  }
  f32x16 oacc[NDB];
#pragma unroll
  for (int db = 0; db < NDB; ++db)
#pragma unroll
    for (int r = 0; r < 16; ++r) oacc[db][r] = 0.f;
  float carry = 0.f, mx = -1e30f, lsum = 0.f;
  const int ntot = nA + nB;
  const int qpos = qposA0 + wave * 32 + l31;
  u4 kr[NCH], vr[NCH];
  {
    const bool inA = 0 < nA; const int tix = inA ? nA - 1 : nB - 1;
    attn_load<D>(inA ? segA : segB, tix * 64, kr, vr);
    __syncthreads();
    attn_store<D>(sbase, sbase + 64 * KPT, kr, vr);
    __syncthreads();
  }
  for (int it = 0; it < ntot; ++it) {
    const int cur = it & 1;
    if (it + 1 < ntot) {
      const bool nInA = (it + 1) < nA; const int tix = nInA ? nA - 2 - it : nB - 1 - (it + 1 - nA);
      attn_load<D>(nInA ? segA : segB, tix * 64, kr, vr);
    }
    const bool inA = it < nA;
    const int kbase = inA ? (nA - 1 - it) * 64 : 0;
    const bf16_t* Ks = sbase + cur * STAGE;
    const bf16_t* Vt = Ks + 64 * KPT;
    const bool mneed = inA && maskA && (kbase + 63 >= qposA0 + wave * 32);
    const bool skip = !active || (inA && maskA && (kbase > qposA0 + wave * 32 + 31));
    if (!skip) {
      bf16x8 pf[2][2];
      if (MODE == 0) {
        float after = carry;
#pragma unroll
        for (int rt = 1; rt >= 0; --rt) {
          f32x16 z;
#pragma unroll
          for (int r = 0; r < 16; ++r) z[r] = 0.f;
#pragma unroll
          for (int ks = 0; ks < NKS; ++ks) {
            const bf16x8 a = *(const bf16x8*)(Ks + (rt * 32 + l31) * KPT + ks * 16 + lh * 8);
            z = MFMA32(a, qf[ks], z);
          }
          float m[16];
#pragma unroll
          for (int i = 0; i < 16; ++i) {
            float mm = lg2(1.f + ex2(z[i]));
            if (mneed) { const int key = kbase + rt * 32 + (i >> 2) * 8 + lh * 4 + (i & 3); if (key >= qpos) mm = 0.f; }
            m[i] = mm;
          }
          float a_[16];
#pragma unroll
          for (int g = 3; g >= 0; --g) {
            const float s4 = (m[g * 4] + m[g * 4 + 1]) + (m[g * 4 + 2] + m[g * 4 + 3]);
            const float p4 = __shfl_xor(s4, 32);
            float c = after + (lh == 0 ? p4 : 0.f);
            after += s4 + p4;
#pragma unroll
            for (int e = 3; e >= 0; --e) {
              c += m[g * 4 + e];
              float av = ex2(z[g * 4 + e] - c);
              if (mneed) { const int key = kbase + rt * 32 + g * 8 + lh * 4 + e; if (key >= qpos) av = 0.f; }
              a_[g * 4 + e] = av;
            }
          }
#pragma unroll
          for (int s2 = 0; s2 < 2; ++s2)
            pf[rt][s2] = as_frag(mk4(pk2(a_[8 * s2 + 0], a_[8 * s2 + 1]), pk2(a_[8 * s2 + 2], a_[8 * s2 + 3]), pk2(a_[8 * s2 + 4], a_[8 * s2 + 5]), pk2(a_[8 * s2 + 6], a_[8 * s2 + 7])));
        }
        carry = after;
      } else {
        f32x16 z[2];
#pragma unroll
        for (int rt = 0; rt < 2; ++rt) {
          f32x16 zt;
#pragma unroll
          for (int r = 0; r < 16; ++r) zt[r] = 0.f;
#pragma unroll
          for (int ks = 0; ks < NKS; ++ks) {
            const bf16x8 a = *(const bf16x8*)(Ks + (rt * 32 + l31) * KPT + ks * 16 + lh * 8);
            zt = MFMA32(a, qf[ks], zt);
          }
          z[rt] = zt;
        }
        float tm = z[0][0];
#pragma unroll
        for (int rt = 0; rt < 2; ++rt)
#pragma unroll
          for (int i = 0; i < 16; ++i) tm = fmaxf(tm, z[rt][i]);
        tm = fmaxf(tm, __shfl_xor(tm, 32));
        const float nm = fmaxf(mx, tm);
        const float alpha = ex2(mx - nm);
        mx = nm;
        float ps = 0.f;
        float a_[2][16];
#pragma unroll
        for (int rt = 0; rt < 2; ++rt)
#pragma unroll
          for (int i = 0; i < 16; ++i) { a_[rt][i] = ex2(z[rt][i] - nm); ps += a_[rt][i]; }
        lsum = lsum * alpha + ps;
#pragma unroll
        for (int db = 0; db < NDB; ++db)
#pragma unroll
          for (int r = 0; r < 16; ++r) oacc[db][r] *= alpha;
#pragma unroll
        for (int rt = 0; rt < 2; ++rt)
#pragma unroll
          for (int s2 = 0; s2 < 2; ++s2)
            pf[rt][s2] = as_frag(mk4(pk2(a_[rt][8 * s2 + 0], a_[rt][8 * s2 + 1]), pk2(a_[rt][8 * s2 + 2], a_[rt][8 * s2 + 3]), pk2(a_[rt][8 * s2 + 4], a_[rt][8 * s2 + 5]), pk2(a_[rt][8 * s2 + 6], a_[rt][8 * s2 + 7])));
      }
#pragma unroll
      for (int db = 0; db < NDB; ++db) {
        const int d = db * 32 + l31, sw = ((d >> 3) & 15) << 2;
#pragma unroll
        for (int rt = 0; rt < 2; ++rt)
#pragma unroll
          for (int s = 0; s < 2; ++s) {
            const int kb0 = rt * 32 + 16 * s + 4 * lh;
            const u2 lo = *(const u2*)(Vt + d * 72 + (kb0 ^ sw));
            const u2 hi = *(const u2*)(Vt + d * 72 + ((kb0 + 8) ^ sw));
            oacc[db] = MFMA32(as_frag(mk4(lo.x, lo.y, hi.x, hi.y)), pf[rt][s], oacc[db]);
          }
      }
    }
    if (it + 1 < ntot) { bf16_t* nK = sbase + (cur ^ 1) * STAGE; attn_store<D>(nK, nK + 64 * KPT, kr, vr); }
    __syncthreads();
  }
  if (active) {
    float inv = 1.f;
    if (MODE == 1) { const float l = lsum + __shfl_xor(lsum, 32); inv = 1.f / l; }
    bf16_t* op = out + (size_t)(wave * 32 + l31) * opitch + lh * 4;
#pragma unroll
    for (int db = 0; db < NDB; ++db)
#pragma unroll
      for (int g = 0; g < 4; ++g) {
        u2 o; o.x = pk2(oacc[db][g * 4] * inv, oacc[db][g * 4 + 1] * inv); o.y = pk2(oacc[db][g * 4 + 2] * inv, oacc[db][g * 4 + 3] * inv);
        *(u2*)(op + db * 32 + g * 8) = o;
      }
  }
}

DEVI void mem_attn_item(const KP& p, int layer, int item, const bf16_t* P, int np, int mqoff, bf16_t* mix, int mixp, int mixoff, unsigned char* smem) {
  const int h = item & 3;
  int t0, nq; const float *kk, *vv;
  if (item < 512) { t0 = (item >> 2) * 128; nq = 128; kk = p.out + O_PMK + (size_t)layer * 65536; vv = p.out + O_PMV + (size_t)layer * 65536; }
  else { const int b = (item - 512) >> 2; t0 = TP + b * 64; nq = 64; kk = p.in[6] + ((size_t)layer * 8 + b) * 65536; vv = p.in[7] + ((size_t)layer * 8 + b) * 65536; }
  KVSrc s; s.k = kk + h * 64; s.v = vv + h * 64; s.kpitch = 256; s.vpitch = 256; s.f32 = 1;
  attn_item<64, 1>(P + (size_t)t0 * np + mqoff + h * 64, np, nq, p.in[15] + layer * 64, 0.125f * LOG2E, s, 4, 0, 0, s, 0,
                   mix + (size_t)t0 * mixp + mixoff + h * 64, mixp, smem);
}

DEVI void gdn_prep_item(const KP& p, int j, int ci, int h, const bf16_t* P, unsigned char* smem) {
  constexpr int NP = NP_GDN;
  const int tid = get_tid(), lane = tid & 63, wave = tid >> 6;
  const int item = ci * 6 + h;
  const bool samp = ci >= 256;
  const int b = ci - 256;
  const int t0 = samp ? TP + b * 64 : ci * 64;
  float* stage = (float*)smem;
  float* sL = (float*)smem;
  bf16_t* qn = (bf16_t*)(smem + 33280);
  bf16_t* kn = qn + 64 * 136;
  float* sgc = (float*)(smem + 33280 + 2 * 64 * 136 * 2);
  float* sbeta = sgc + 64;
  float* segc = sbeta + 64;
  unsigned char* gi = p.ws + WS_G + (size_t)item * G_ITEM;
  bf16_t* gU = (bf16_t*)gi; bf16_t* gW = gU + 8192; bf16_t* gQD = gW + 8192; bf16_t* gKDT = gQD + 8192; bf16_t* gAI = gKDT + 8192;
  const float* convw = p.in[17] + (size_t)j * 4 * 2304;
  const float* cstate = p.in[2] + ((size_t)j * 8 + (samp ? b : 0)) * 3 * 2304;
  const bf16_t* Pc = P + (size_t)t0 * NP;
  __syncthreads();
  if (wave == 0) {
    const float braw = bf2f(Pc[(size_t)lane * NP + 3072 + h]), araw = bf2f(Pc[(size_t)lane * NP + 3078 + h]);
    const float beta = 1.f / (1.f + expf(-braw));
    const float xx = araw + p.in[19][j * 6 + h];
    const float sp = xx > 20.f ? xx : log1pf(expf(xx));
    float g = -expf(p.in[18][j * 6 + h]) * sp;
#pragma unroll
    for (int d = 1; d < 64; d <<= 1) { const float v = __shfl_up(g, d); if (lane >= d) g += v; }
    sgc[lane] = g; sbeta[lane] = beta; segc[lane] = expf(g);
    if (lane == 63) ((float*)(p.ws + WS_GL))[item] = expf(g);
  }
  if (samp || ci == 255) {
    float* dst = samp ? p.out + O_SGC + ((size_t)j * 8 + b) * 3 * 2304 : p.out + O_PGC + (size_t)j * 3 * 2304;
    for (int idx = tid; idx < 1152; idx += 256) {
      const int r = idx / 384, cc = idx % 384, ch = (cc >> 7) * 768 + h * 128 + (cc & 127);
      dst[r * 2304 + ch] = bf2f(Pc[(size_t)(61 + r) * NP + ch]);
    }
  }
  const float gcl_dummy = 0.f; (void)gcl_dummy;
#pragma unroll 1
  for (int which = 0; which < 2; ++which) {
    {
      const int c = tid & 127, th = tid >> 7, ch = which * 768 + h * 128 + c;
      const float w0 = convw[ch], w1 = convw[2304 + ch], w2 = convw[2 * 2304 + ch], w3 = convw[3 * 2304 + ch];
      float xm3, xm2, xm1;
      if (th == 1) { xm3 = bf2f(Pc[(size_t)29 * NP + ch]); xm2 = bf2f(Pc[(size_t)30 * NP + ch]); xm1 = bf2f(Pc[(size_t)31 * NP + ch]); }
      else if (samp) { xm3 = cstate[ch]; xm2 = cstate[2304 + ch]; xm1 = cstate[2 * 2304 + ch]; }
      else if (ci == 0) { xm3 = xm2 = xm1 = 0.f; }
      else { xm3 = bf2f(Pc[-(ptrdiff_t)3 * NP + ch]); xm2 = bf2f(Pc[-(ptrdiff_t)2 * NP + ch]); xm1 = bf2f(Pc[-(ptrdiff_t)NP + ch]); }
      const bf16_t* pp = Pc + (size_t)(th * 32) * NP + ch;
#pragma unroll 8
      for (int tt = 0; tt < 32; ++tt) {
        const float x0 = bf2f(pp[(size_t)tt * NP]);
        const float y = w0 * xm3 + w1 * xm2 + w2 * xm1 + w3 * x0;
        stage[(th * 32 + tt) * 129 + c] = silu(y);
        xm3 = xm2; xm2 = xm1; xm1 = x0;
      }
    }
    __syncthreads();
    {
      const int tt = tid >> 2, part = tid & 3;
      float v[32]; float ss = 0.f;
#pragma unroll
      for (int e = 0; e < 32; ++e) { v[e] = stage[tt * 129 + part * 32 + e]; ss += v[e] * v[e]; }
      ss += __shfl_xor(ss, 1); ss += __shfl_xor(ss, 2);
      float rinv = rsqrtf(ss + EPS);
      if (which == 0) rinv *= 0.08838834764831845f;
      bf16_t* dn = (which == 0 ? qn : kn) + tt * 136 + part * 32;
      const float eg = segc[tt];
#pragma unroll
      for (int e = 0; e < 32; e += 8) {
        u4 u; u.x = pk2(v[e] * rinv, v[e + 1] * rinv); u.y = pk2(v[e + 2] * rinv, v[e + 3] * rinv); u.z = pk2(v[e + 4] * rinv, v[e + 5] * rinv); u.w = pk2(v[e + 6] * rinv, v[e + 7] * rinv);
        *(u4*)(dn + e) = u;
        if (which == 0) {
          const float s2 = rinv * eg;
          u4 w; w.x = pk2(v[e] * s2, v[e + 1] * s2); w.y = pk2(v[e + 2] * s2, v[e + 3] * s2); w.z = pk2(v[e + 4] * s2, v[e + 5] * s2); w.w = pk2(v[e + 6] * s2, v[e + 7] * s2);
          *(u4*)(gQD + tt * 128 + part * 32 + e) = w;
        }
      }
    }
    __syncthreads();
  }
  {
    const int d = tid & 127, th = tid >> 7;
    const float gcl = sgc[63];
#pragma unroll
    for (int q8 = 0; q8 < 4; ++q8) {
      float f[8];
#pragma unroll
      for (int e = 0; e < 8; ++e) { const int tt = th * 32 + q8 * 8 + e; f[e] = bf2f(kn[tt * 136 + d]) * expf(gcl - sgc[tt]); }
      *(u4*)(gKDT + d * 64 + th * 32 + q8 * 8) = mk4(pk2(f[0], f[1]), pk2(f[2], f[3]), pk2(f[4], f[5]), pk2(f[6], f[7]));
    }
  }
  {
    const int l31 = lane & 31, lh = lane >> 5, ri = wave >> 1, cj = wave & 1;
    f32x16 kk, qk;
#pragma unroll
    for (int r = 0; r < 16; ++r) { kk[r] = 0.f; qk[r] = 0.f; }
#pragma unroll
    for (int ks = 0; ks < 8; ++ks) {
      const bf16x8 ak = *(const bf16x8*)(kn + (ri * 32 + l31) * 136 + ks * 16 + lh * 8);
      const bf16x8 aq = *(const bf16x8*)(qn + (ri * 32 + l31) * 136 + ks * 16 + lh * 8);
      const bf16x8 bk = *(const bf16x8*)(kn + (cj * 32 + l31) * 136 + ks * 16 + lh * 8);
      kk = MFMA32(ak, bk, kk); qk = MFMA32(aq, bk, qk);
    }
    const int jj = cj * 32 + l31; const float gj = sgc[jj];
#pragma unroll
    for (int r = 0; r < 16; ++r) {
      const int ii = ri * 32 + (r >> 2) * 8 + lh * 4 + (r & 3);
      const float dec = ii >= jj ? expf(sgc[ii] - gj) : 0.f;
      sL[ii * 64 + jj] = ii > jj ? sbeta[ii] * kk[r] * dec : 0.f;
      gAI[ii * 64 + jj] = f2bf(qk[r] * dec);
    }
  }
  __syncthreads();
  {
    float x[64];
    if (tid < 128) {
      const int ch = 1536 + h * 128 + tid;
      const float w0 = convw[ch], w1 = convw[2304 + ch], w2 = convw[2 * 2304 + ch], w3 = convw[3 * 2304 + ch];
      float xm3, xm2, xm1;
      if (samp) { xm3 = cstate[ch]; xm2 = cstate[2304 + ch]; xm1 = cstate[2 * 2304 + ch]; }
      else if (ci == 0) { xm3 = xm2 = xm1 = 0.f; }
      else { xm3 = bf2f(Pc[-(ptrdiff_t)3 * NP + ch]); xm2 = bf2f(Pc[-(ptrdiff_t)2 * NP + ch]); xm1 = bf2f(Pc[-(ptrdiff_t)NP + ch]); }
#pragma unroll
      for (int tt = 0; tt < 64; ++tt) {
        const float x0 = bf2f(Pc[(size_t)tt * NP + ch]);
        const float y = w0 * xm3 + w1 * xm2 + w2 * xm1 + w3 * x0;
        x[tt] = silu(y) * sbeta[tt];
        xm3 = xm2; xm2 = xm1; xm1 = x0;
        if ((tt & 7) == 7) __builtin_amdgcn_sched_barrier(0);
      }
    } else {
#pragma unroll
      for (int tt = 0; tt < 64; ++tt) { x[tt] = bf2f(kn[tt * 136 + tid - 128]) * sbeta[tt] * segc[tt]; if ((tt & 7) == 7) __builtin_amdgcn_sched_barrier(0); }
    }
#pragma unroll
    for (int i = 1; i < 64; ++i) {
      float a = x[i];
#pragma unroll
      for (int jx = 0; jx < i; ++jx) a -= sL[i * 64 + jx] * x[jx];
      x[i] = a;
      __builtin_amdgcn_sched_barrier(0);
    }
    bf16_t* dst = (tid < 128 ? gU : gW) + (tid & 127);
#pragma unroll
    for (int tt = 0; tt < 64; ++tt) { dst[tt * 128] = f2bf(x[tt]); if ((tt & 7) == 7) __builtin_amdgcn_sched_barrier(0); }
  }
}

struct ScanFrags { u4 w[4], qd[4], ai[2], kdt[2][2]; unsigned u01, u23; float gl; };
DEVI void scan_load(const KP& p, int item, int wave, int lane, int sl, ScanFrags& f) {
  const int n = lane & 15, g = lane >> 4;
  const unsigned char* gi = p.ws + WS_G + (size_t)item * G_ITEM;
  const bf16_t* gU = (const bf16_t*)gi; const bf16_t* gW = gU + 8192; const bf16_t* gQD = gW + 8192; const bf16_t* gKDT = gQD + 8192; const bf16_t* gAI = gKDT + 8192;
#pragma unroll
  for (int s = 0; s < 4; ++s) { f.w[s] = *(const u4*)(gW + (16 * wave + n) * 128 + 32 * s + 8 * g); f.qd[s] = *(const u4*)(gQD + (16 * wave + n) * 128 + 32 * s + 8 * g); }
#pragma unroll
  for (int s = 0; s < 2; ++s) {
    f.ai[s] = *(const u4*)(gAI + (16 * wave + n) * 64 + 32 * s + 8 * g);
#pragma unroll
    for (int tt = 0; tt < 2; ++tt) f.kdt[tt][s] = *(const u4*)(gKDT + (32 * wave + 16 * tt + n) * 64 + 32 * s + 8 * g);
  }
  const bf16_t* up = gU + (16 * wave + 4 * g) * 128 + sl * 16 + n;
  f.u01 = (unsigned)up[0] | ((unsigned)up[128] << 16);
  f.u23 = (unsigned)up[256] | ((unsigned)up[384] << 16);
  f.gl = ((const float*)(p.ws + WS_GL))[item];
}
DEVI void gdn_scan_stream(const KP& p, int j, int ci0, int nch, int h, int sl, const float* s0, float* sout, bf16_t* O, unsigned char* smem) {
  const int tid = get_tid(), lane = tid & 63, wave = tid >> 6, n = lane & 15, g = lane >> 4;
  bf16_t* St = (bf16_t*)smem;
  bf16_t* Vnt = St + 16 * 136;
  f32x4 sacc[2];
#pragma unroll
  for (int tt = 0; tt < 2; ++tt)
#pragma unroll
    for (int r = 0; r < 4; ++r) sacc[tt][r] = s0 ? s0[(size_t)(32 * wave + 16 * tt + 4 * g + r) * 128 + sl * 16 + n] : 0.f;
  __syncthreads();
#pragma unroll
  for (int tt = 0; tt < 2; ++tt) { u2 o; o.x = pk2(sacc[tt][0], sacc[tt][1]); o.y = pk2(sacc[tt][2], sacc[tt][3]); *(u2*)(St + n * 136 + 32 * wave + 16 * tt + 4 * g) = o; }
  ScanFrags f;
  scan_load(p, ci0 * 6 + h, wave, lane, sl, f);
  __syncthreads();
  for (int c = 0; c < nch; ++c) {
    ScanFrags fn;
    if (c + 1 < nch) scan_load(p, (ci0 + c + 1) * 6 + h, wave, lane, sl, fn); else fn = f;
    const int t0 = (ci0 + c) >= 256 ? TP + (ci0 + c - 256) * 64 : (ci0 + c) * 64;
    bf16x8 sf[4];
#pragma unroll
    for (int s = 0; s < 4; ++s) sf[s] = *(const bf16x8*)(St + n * 136 + 32 * s + 8 * g);
    f32x4 wsa = {0.f, 0.f, 0.f, 0.f}, oa = {0.f, 0.f, 0.f, 0.f};
#pragma unroll
    for (int s = 0; s < 4; ++s) wsa = MFMA16(as_frag(f.w[s]), sf[s], wsa);
    float vn[4];
    vn[0] = lo2f(f.u01) - wsa[0]; vn[1] = hi2f(f.u01) - wsa[1]; vn[2] = lo2f(f.u23) - wsa[2]; vn[3] = hi2f(f.u23) - wsa[3];
    { u2 o; o.x = pk2(vn[0], vn[1]); o.y = pk2(vn[2], vn[3]); *(u2*)(Vnt + n * 72 + 16 * wave + 4 * g) = o; }
#pragma unroll
    for (int s = 0; s < 4; ++s) oa = MFMA16(as_frag(f.qd[s]), sf[s], oa);
    __syncthreads();
    bf16x8 vf[2];
#pragma unroll
    for (int s = 0; s < 2; ++s) vf[s] = *(const bf16x8*)(Vnt + n * 72 + 32 * s + 8 * g);
#pragma unroll
    for (int s = 0; s < 2; ++s) oa = MFMA16(as_frag(f.ai[s]), vf[s], oa);
#pragma unroll
    for (int r = 0; r < 4; ++r) O[(size_t)(t0 + 16 * wave + 4 * g + r) * 768 + h * 128 + sl * 16 + n] = f2bf(oa[r]);
#pragma unroll
    for (int tt = 0; tt < 2; ++tt) {
#pragma unroll
      for (int r = 0; r < 4; ++r) sacc[tt][r] *= f.gl;
#pragma unroll
      for (int s = 0; s < 2; ++s) sacc[tt] = MFMA16(as_frag(f.kdt[tt][s]), vf[s], sacc[tt]);
      u2 o; o.x = pk2(sacc[tt][0], sacc[tt][1]); o.y = pk2(sacc[tt][2], sacc[tt][3]);
      *(u2*)(St + n * 136 + 32 * wave + 16 * tt + 4 * g) = o;
    }
    __syncthreads();
    f = fn;
  }
#pragma unroll
  for (int tt = 0; tt < 2; ++tt)
#pragma unroll
    for (int r = 0; r < 4; ++r) sout[(size_t)(32 * wave + 16 * tt + 4 * g + r) * 128 + sl * 16 + n] = sacc[tt][r];
}

DEVI int next_item(unsigned* ctr) {
  __shared__ int s_item;
  __syncthreads();
  if (get_tid() == 0) s_item = (int)atomicAdd(ctr, 1u);
  __syncthreads();
  return s_item;
}

DEVI void gbar(unsigned* bar, unsigned nb, unsigned& gen) {
  asm volatile("s_waitcnt vmcnt(0)" ::: "memory");
  __syncthreads();
  gen++;
  if (get_tid() == 0) {
    __builtin_amdgcn_fence(__ATOMIC_RELEASE, "agent");
    asm volatile("s_waitcnt vmcnt(0)" ::: "memory");
    __hip_atomic_fetch_add(bar, 1u, __ATOMIC_RELAXED, __HIP_MEMORY_SCOPE_AGENT);
    while (__hip_atomic_load(bar, __ATOMIC_RELAXED, __HIP_MEMORY_SCOPE_AGENT) < gen * nb) __builtin_amdgcn_s_sleep(2);
    __builtin_amdgcn_fence(__ATOMIC_ACQUIRE, "agent");
    asm volatile("s_waitcnt vmcnt(0)" ::: "memory");
  }
  __syncthreads();
}
#ifndef ONLY
#define ENAB(k) true
#else
#define ENAB(k) ((ONLY) == (k))
#endif
__global__ void __launch_bounds__(256, 1) mk_fwd(KP p) {
  __shared__ __attribute__((aligned(16))) unsigned char smem[73728];
  cg::grid_group grid = cg::this_grid();
  const int tid = get_tid(), lane = tid & 63, wave = tid >> 6;
  const int bid = blockIdx.x, nb = gridDim.x;
  const int gw = bid * 4 + wave, ngw = nb * 4;
  unsigned char* ws = p.ws;
  unsigned* ctr = (unsigned*)(ws + WS_CTR);
  float* Y = p.out + O_YP;
  bf16_t* XN = (bf16_t*)(ws + WS_XN);
  bf16_t* MIX = (bf16_t*)(ws + WS_MIX);
  bf16_t* Pb = (bf16_t*)(ws + WS_P);
  bf16_t* Hb = (bf16_t*)(ws + WS_H);
  bool did = false;
  unsigned bgen = 0;
  grid.sync();
  for (int ph = p.ph_lo; ph < p.ph_hi; ++ph) {
    const int layer = ph == 0 ? 0 : (ph - 1) / 9, sub = ph == 0 ? -1 : (ph - 1) % 9;
    const int kind = layer & 1, j = layer >> 1;
    if (sub == 3 && kind == 1) continue;
    if (sub == 8 && layer == 3) continue;
    if (did) gbar(ctr + 512, nb, bgen);
    did = true;
    const int np = kind ? NP_SB : NP_GDN, mqoff = kind ? MQ_SB : MQ_GDN, mixp = kind ? 768 : 1024, mixoff = kind ? 512 : 768;
    if (ph == 0 && ENAB(0)) {
      int base = 0;
      convert_group(base, bid, nb, p.in[12], (bf16_t*)(ws + WS_WIG), 2, 1024, 3340, 3456, 3084, 116, smem);
      convert_group(base, bid, nb, p.in[13], (bf16_t*)(ws + WS_WIS), 2, 1024, 1792, 1792, 1 << 30, 0, smem);
      convert_group(base, bid, nb, p.in[14], (bf16_t*)(ws + WS_WKV), 4, 1024, 512, 512, 1 << 30, 0, smem);
      convert_group(base, bid, nb, p.in[23], (bf16_t*)(ws + WS_WOG), 2, 1024, 1024, 1024, 1 << 30, 0, smem);
      convert_group(base, bid, nb, p.in[24], (bf16_t*)(ws + WS_WOS), 2, 768, 1024, 1024, 1 << 30, 0, smem);
      convert_group(base, bid, nb, p.in[25], (bf16_t*)(ws + WS_WUP), 4, 1024, 4096, 4096, 1 << 30, 0, smem);
      convert_group(base, bid, nb, p.in[26], (bf16_t*)(ws + WS_WDN), 4, 4096, 1024, 1024, 1 << 30, 0, smem);
      for (int r = gw; r < TA; r += ngw) norm_row(r < TP ? p.in[0] + (size_t)r * DM : p.in[1] + (size_t)(r - TP) * DM, p.in[9], XN + (size_t)r * DM, lane);
      for (int r = gw; r < 1024; r += ngw) norm_row(p.in[8] + (size_t)(r & 255) * DM, p.in[10] + (r >> 8) * DM, (bf16_t*)(ws + WS_MEMN) + (size_t)r * DM, lane);
    } else if (sub == 0 && ENAB(1)) {
      EpiArgs ea{}; ea.cb = Pb; ea.ldc = np;
      const bf16_t* wt = kind ? (const bf16_t*)(ws + WS_WIS) + (size_t)j * 1792 * 1024 : (const bf16_t*)(ws + WS_WIG) + (size_t)j * 3456 * 1024;
      gemm_phase<0>(XN, DM, wt, 1024, TA, np, ea, smem);
      if (layer == 0) {
        for (int t = bid; t < 32; t += nb) {
          const int l = t >> 3, r = t & 7;
          EpiArgs e2{}; e2.cf = (float*)(ws + WS_MEMKV) + (size_t)l * 256 * 512; e2.ldc = 512;
          gemm_tile<3>((const bf16_t*)(ws + WS_MEMN) + (size_t)l * 256 * DM, DM, (const bf16_t*)(ws + WS_WKV) + (size_t)l * 512 * DM, DM, 1024, (r >> 2) << 7, (r & 3) << 7, e2, smem);
        }
      }
    } else if (sub == 1 && ENAB(2)) {
      if (layer == 0) {
        const float* kv = (const float*)(ws + WS_MEMKV);
        for (int it = gw; it < 4096; it += ngw) {
          const int l = it >> 10, m = (it >> 2) & 255, hh = it & 3;
          const float kx = kv[((size_t)l * 256 + m) * 512 + hh * 64 + lane], vx = kv[((size_t)l * 256 + m) * 512 + 256 + hh * 64 + lane];
          const float ss = wave_sum(kx * kx);
          p.out[O_PMK + ((size_t)l * 256 + m) * 256 + hh * 64 + lane] = kx * rsqrtf(ss * (1.f / 64.f) + EPS) * p.in[16][l * 64 + lane];
          p.out[O_PMV + ((size_t)l * 256 + m) * 256 + hh * 64 + lane] = vx;
        }
      }
      if (kind == 0) {
        for (int it = bid; it < NITEM; it += nb) gdn_prep_item(p, j, it / 6, it % 6, Pb, smem);
      } else {
        bf16_t* Kb = (bf16_t*)(ws + WS_G);
        const float* kg = p.in[22] + j * 128;
        for (int t = gw; t < TA; t += ngw) {
          const bf16_t* pr = Pb + (size_t)t * np;
          const u4 ku = *(const u4*)(pr + 512 + lane * 8), vu = *(const u4*)(pr + 1024 + lane * 8);
          float kf[8] = {lo2f(ku.x), hi2f(ku.x), lo2f(ku.y), hi2f(ku.y), lo2f(ku.z), hi2f(ku.z), lo2f(ku.w), hi2f(ku.w)};
          float ss = 0.f;
#pragma unroll
          for (int e = 0; e < 8; ++e) ss += kf[e] * kf[e];
          ss += __shfl_xor(ss, 1); ss += __shfl_xor(ss, 2); ss += __shfl_xor(ss, 4); ss += __shfl_xor(ss, 8);
          const float sc = rsqrtf(ss * (1.f / 128.f) + EPS);
          const int c0 = (lane & 15) * 8;
#pragma unroll
          for (int e = 0; e < 8; ++e) kf[e] *= sc * kg[c0 + e];
          float* ok = t < TP ? p.out + O_PSK + ((size_t)j * TP + t) * 512 : p.out + O_SSK + ((size_t)j * TS + (t - TP)) * 512;
          float* ov = t < TP ? p.out + O_PSV + ((size_t)j * TP + t) * 512 : p.out + O_SSV + ((size_t)j * TS + (t - TP)) * 512;
          *(float4*)(ok + lane * 8) = make_float4(kf[0], kf[1], kf[2], kf[3]); *(float4*)(ok + lane * 8 + 4) = make_float4(kf[4], kf[5], kf[6], kf[7]);
          *(float4*)(ov + lane * 8) = make_float4(lo2f(vu.x), hi2f(vu.x), lo2f(vu.y), hi2f(vu.y)); *(float4*)(ov + lane * 8 + 4) = make_float4(lo2f(vu.z), hi2f(vu.z), lo2f(vu.w), hi2f(vu.w));
          *(u4*)(Kb + (size_t)t * 512 + lane * 8) = mk4(pk2(kf[0], kf[1]), pk2(kf[2], kf[3]), pk2(kf[4], kf[5]), pk2(kf[6], kf[7]));
        }
      }
    } else if (sub == 2 && ENAB(3)) {
      unsigned* c = ctr + layer * 4;
      if (kind == 0) {
        bf16_t* O = XN;
        if (bid < 64 && (bid & 7) < 6) {
          const int h = bid & 7, sl = bid >> 3;
          gdn_scan_stream(p, j, 0, 256, h, sl, nullptr, p.out + O_PGS + ((size_t)j * 6 + h) * 16384, O, smem);
        }
        for (;;) {
          const int it = next_item(c);
          if (it >= 384 + 544) break;
          if (it < 384) { const int b = it / 48, r = it % 48, h = r >> 3, sl = r & 7;
            gdn_scan_stream(p, j, 256 + b, 1, h, sl, p.in[3] + (((size_t)j * 8 + b) * 6 + h) * 16384, p.out + O_SGS + (((size_t)j * 8 + b) * 6 + h) * 16384, O, smem);
          } else mem_attn_item(p, layer, it - 384, Pb, np, mqoff, MIX, mixp, mixoff, smem);
        }
      } else {
        const bf16_t* Kb = (const bf16_t*)(ws + WS_G);
        const float qs = 0.08838834764831845f * LOG2E;
        for (;;) {
          const int it = next_item(c);
          if (it >= 512 + 32 + 544) break;
          if (it < 512) {
            const int qb = 127 - (it >> 2), h = it & 3;
            KVSrc s; s.k = Kb + h * 128; s.v = Pb + 1024 + h * 128; s.kpitch = 512; s.vpitch = np; s.f32 = 0;
            attn_item<128, 0>(Pb + (size_t)(qb * 128) * np + h * 128, np, 128, p.in[21] + j * 128, qs, s, 2 * qb + 2, qb * 128, 1, s, 0,
                              MIX + (size_t)(qb * 128) * mixp + h * 128, mixp, smem);
          } else if (it < 544) {
            const int b = (it - 512) >> 2, h = it & 3, t0 = TP + b * 64;
            KVSrc sa; sa.k = Kb + (size_t)t0 * 512 + h * 128; sa.v = Pb + (size_t)t0 * np + 1024 + h * 128; sa.kpitch = 512; sa.vpitch = np; sa.f32 = 0;
            KVSrc sb; sb.k = p.in[4] + ((size_t)j * 8 + b) * 2048 * 512 + h * 128; sb.v = p.in[5] + ((size_t)j * 8 + b) * 2048 * 512 + h * 128; sb.kpitch = 512; sb.vpitch = 512; sb.f32 = 1;
            attn_item<128, 0>(Pb + (size_t)t0 * np + h * 128, np, 64, p.in[21] + j * 128, qs, sa, 1, 0, 1, sb, 32,
                              MIX + (size_t)t0 * mixp + h * 128, mixp, smem);
          } else mem_attn_item(p, layer, it - 544, Pb, np, mqoff, MIX, mixp, mixoff, smem);
        }
      }
    } else if (sub == 3 && ENAB(4)) {
      const bf16_t* O = XN;
      const float* og = p.in[20] + j * 128;
      for (int it = gw; it < TA * 6; it += ngw) {
        const int t = it / 6, h = it % 6;
        const unsigned ou = *(const unsigned*)(O + (size_t)t * 768 + h * 128 + lane * 2);
        const unsigned zu = *(const unsigned*)(Pb + (size_t)t * np + 2304 + h * 128 + lane * 2);
        const float o0 = lo2f(ou), o1 = hi2f(ou), z0 = lo2f(zu), z1 = hi2f(zu);
        const float ss = wave_sum(o0 * o0 + o1 * o1);
        const float sc = rsqrtf(ss * (1.f / 128.f) + EPS);
        *(unsigned*)(MIX + (size_t)t * 1024 + h * 128 + lane * 2) = pk2(o0 * sc * og[lane * 2] * silu(z0), o1 * sc * og[lane * 2 + 1] * silu(z1));
      }
    } else if (sub == 4 && ENAB(5)) {
      EpiArgs ea{}; ea.yout = Y;
      if (layer == 0) { ea.res0 = p.in[0]; ea.res1 = p.in[1]; } else { ea.res0 = Y; ea.res1 = nullptr; }
      const bf16_t* wt = kind ? (const bf16_t*)(ws + WS_WOS) + (size_t)j * 1024 * 768 : (const bf16_t*)(ws + WS_WOG) + (size_t)j * 1024 * 1024;
      gemm_phase<1>(MIX, mixp, wt, mixp, TA, 1024, ea, smem);
    } else if (sub == 5) {
      for (int r = gw; r < TA; r += ngw) norm_row(Y + (size_t)r * DM, p.in[11] + layer * DM, XN + (size_t)r * DM, lane);
    } else if (sub == 6 && ENAB(6)) {
      EpiArgs ea{}; ea.cb = Hb; ea.ldc = DFF;
      gemm_phase<2>(XN, DM, (const bf16_t*)(ws + WS_WUP) + (size_t)layer * 4096 * 1024, 1024, TA, 4096, ea, smem);
    } else if (sub == 7 && ENAB(7)) {
      EpiArgs ea{}; ea.yout = Y; ea.res0 = Y; ea.res1 = nullptr;
      gemm_phase<1>(Hb, DFF, (const bf16_t*)(ws + WS_WDN) + (size_t)layer * 1024 * 4096, 4096, TA, 1024, ea, smem);
    } else if (sub == 8) {
      for (int r = gw; r < TA; r += ngw) norm_row(Y + (size_t)r * DM, p.in[9] + (layer + 1) * DM, XN + (size_t)r * DM, lane);
    }
  }
}

extern "C" void kernel_launch(void* const* d_in, const int* in_sizes, int n_in, void* d_out, int out_size, void* d_ws, size_t ws_size, hipStream_t stream) {
  static int grid_blocks = 0;
  if (!grid_blocks) {
    int dev = 0, cus = 0, per_cu = 0;
    (void)hipGetDevice(&dev);
    (void)hipDeviceGetAttribute(&cus, hipDeviceAttributeMultiprocessorCount, dev);
    (void)hipOccupancyMaxActiveBlocksPerMultiprocessor(&per_cu, mk_fwd, 256, 0);
    if (per_cu > 2) per_cu = 2;
    if (per_cu < 1) per_cu = 1;
    grid_blocks = cus * per_cu;
    if (ws_size < WS_END) fprintf(stderr, "kernel_launch: workspace too small: %zu < %zu\n", ws_size, (size_t)WS_END);
  }
  (void)hipMemsetAsync((char*)d_ws + WS_CTR, 0, 4096, stream);
  KP p{};
  for (int i = 0; i < 27; ++i) p.in[i] = (const float*)d_in[i];
  p.out = (float*)d_out; p.ws = (unsigned char*)d_ws; p.ph_lo = 0; p.ph_hi = 37;
  void* args[] = {&p};
  hipError_t e = hipLaunchCooperativeKernel((void*)mk_fwd, dim3(grid_blocks), dim3(256), args, 0, stream);
  if (e != hipSuccess) fprintf(stderr, "cooperative launch failed: %s (grid %d)\n", hipGetErrorString(e), grid_blocks);
}
```

```cpp
#include <hip/hip_runtime.h>
#include <hip/hip_cooperative_groups.h>
#include <cstdio>
#include <cstdint>
namespace cg = cooperative_groups;

typedef unsigned short bf16_t;
typedef short bf16x8 __attribute__((ext_vector_type(8)));
typedef float f32x16 __attribute__((ext_vector_type(16)));
typedef float f32x4 __attribute__((ext_vector_type(4)));
typedef unsigned u4 __attribute__((ext_vector_type(4)));
typedef unsigned u2 __attribute__((ext_vector_type(2)));
#define DEVI __device__ __forceinline__
__device__ __forceinline__ u4 mk4(unsigned a, unsigned b, unsigned c, unsigned d) { u4 r; r.x = a; r.y = b; r.z = c; r.w = d; return r; }
__device__ __forceinline__ u2 mk2(unsigned a, unsigned b) { u2 r; r.x = a; r.y = b; return r; }
#define MFMA32(a, b, c) __builtin_amdgcn_mfma_f32_32x32x16_bf16((a), (b), (c), 0, 0, 0)
#define MFMA16(a, b, c) __builtin_amdgcn_mfma_f32_16x16x32_bf16((a), (b), (c), 0, 0, 0)

constexpr int DM = 1024, TP = 16384, TS = 512, TA = TP + TS, DFF = 4096;
constexpr int NP_GDN = 3456, NP_SB = 1792, MQ_GDN = 3200, MQ_SB = 1536;
constexpr int NCHUNK = 264, NITEM = NCHUNK * 6;
constexpr float EPS = 1e-6f;
constexpr float LOG2E = 1.4426950408889634f;
constexpr size_t O_YP = 0, O_PGC = 17301504, O_PGS = 17315328, O_PSK = 17511936, O_PSV = 34289152, O_PMK = 51066368, O_PMV = 51328512,
                 O_SGC = 51590656, O_SGS = 51701248, O_SSK = 53274112, O_SSV = 53798400;
constexpr size_t WS_CTR = 0;
constexpr size_t WS_WIG = 4096;
constexpr size_t WS_WIS = WS_WIG + 2ull * 3456 * 1024 * 2;
constexpr size_t WS_WKV = WS_WIS + 2ull * 1792 * 1024 * 2;
constexpr size_t WS_WOG = WS_WKV + 4ull * 512 * 1024 * 2;
constexpr size_t WS_WOS = WS_WOG + 2ull * 1024 * 1024 * 2;
constexpr size_t WS_WUP = WS_WOS + 2ull * 1024 * 768 * 2;
constexpr size_t WS_WDN = WS_WUP + 4ull * 4096 * 1024 * 2;
constexpr size_t WS_XN = WS_WDN + 4ull * 4096 * 1024 * 2;
constexpr size_t WS_MIX = WS_XN + (size_t)TA * 1024 * 2;
constexpr size_t WS_MEMN = WS_MIX + (size_t)TA * 1024 * 2;
constexpr size_t WS_MEMKV = WS_MEMN + 4ull * 256 * 1024 * 2;
constexpr size_t WS_BIG = WS_MEMKV + 4ull * 256 * 512 * 4;
constexpr size_t WS_P = WS_BIG;
constexpr size_t WS_G = WS_P + (size_t)TA * 3456 * 2;
constexpr size_t G_ITEM = 73728;
constexpr size_t WS_GL = WS_G + (size_t)NITEM * G_ITEM;
constexpr size_t WS_H = WS_BIG;
constexpr size_t WS_END = WS_GL + 8192;

struct KP { const float* in[27]; float* out; unsigned char* ws; int ph_lo, ph_hi; };

DEVI int get_tid() { int t = __builtin_amdgcn_workitem_id_x(); asm volatile("" : "+v"(t)); return t; }
DEVI float bf2f(bf16_t b) { return __uint_as_float(((unsigned)b) << 16); }
typedef float f32x2_t __attribute__((ext_vector_type(2)));
typedef __bf16 bf16x2_t __attribute__((ext_vector_type(2)));
DEVI unsigned pk2(float lo, float hi) { f32x2_t v = {lo, hi}; return __builtin_bit_cast(unsigned, __builtin_convertvector(v, bf16x2_t)); }
DEVI bf16_t f2bf(float f) { return (bf16_t)(pk2(f, 0.f) & 0xffffu); }
DEVI float lo2f(unsigned u) { return __uint_as_float(u << 16); }
DEVI float hi2f(unsigned u) { return __uint_as_float(u & 0xffff0000u); }
DEVI float ex2(float x) { return __builtin_amdgcn_exp2f(x); }
DEVI float lg2(float x) { return __builtin_amdgcn_logf(x); }
DEVI float wave_sum(float v) {
#pragma unroll
  for (int o = 32; o >= 1; o >>= 1) v += __shfl_xor(v, o);
  return v;
}
DEVI bf16x8 as_frag(u4 u) { return __builtin_bit_cast(bf16x8, u); }
DEVI float silu(float y) { return y / (1.f + __expf(-y)); }

struct EpiArgs { bf16_t* cb; float* cf; int ldc; const float* res0; const float* res1; float* yout; };
template <int EPI>
DEVI void gemm_tile(const bf16_t* __restrict__ A, int lda, const bf16_t* __restrict__ Bt, int ldb, int K, int m0, int n0, const EpiArgs& ea, unsigned char* smem) {
  const int tid = get_tid(), lane = tid & 63, wave = tid >> 6;
  const int wm = wave >> 1, wn = wave & 1, l31 = lane & 31, lh = lane >> 5;
  bf16_t* sA = (bf16_t*)smem;
  bf16_t* sB = sA + 2 * 128 * 72;
  f32x16 acc[2][2];
#pragma unroll
  for (int i = 0; i < 2; ++i)
#pragma unroll
    for (int j = 0; j < 2; ++j)
#pragma unroll
      for (int r = 0; r < 16; ++r) acc[i][j][r] = 0.f;
  const int lr = tid >> 3, lc = (tid & 7) * 8;
  const bf16_t* gA = A + (size_t)(m0 + lr) * lda + lc;
  const bf16_t* gB = Bt + (size_t)(n0 + lr) * ldb + lc;
  u4 ra[4], rb[4];
#pragma unroll
  for (int i = 0; i < 4; ++i) { ra[i] = *(const u4*)(gA + (size_t)i * 32 * lda); rb[i] = *(const u4*)(gB + (size_t)i * 32 * ldb); }
  __syncthreads();
#pragma unroll
  for (int i = 0; i < 4; ++i) { *(u4*)(sA + (lr + i * 32) * 72 + lc) = ra[i]; *(u4*)(sB + (lr + i * 32) * 72 + lc) = rb[i]; }
  __syncthreads();
  const int nk = K >> 6;
  for (int kt = 0; kt < nk; ++kt) {
    const int cur = kt & 1;
    if (kt + 1 < nk) {
      const int k0 = (kt + 1) << 6;
#pragma unroll
      for (int i = 0; i < 4; ++i) { ra[i] = *(const u4*)(gA + (size_t)i * 32 * lda + k0); rb[i] = *(const u4*)(gB + (size_t)i * 32 * ldb + k0); }
    }
    const bf16_t* cA = sA + cur * 128 * 72 + (wm * 64 + l31) * 72 + lh * 8;
    const bf16_t* cB = sB + cur * 128 * 72 + (wn * 64 + l31) * 72 + lh * 8;
#pragma unroll
    for (int ks = 0; ks < 4; ++ks) {
      bf16x8 a0 = *(const bf16x8*)(cA + ks * 16), a1 = *(const bf16x8*)(cA + 32 * 72 + ks * 16);
      bf16x8 b0 = *(const bf16x8*)(cB + ks * 16), b1 = *(const bf16x8*)(cB + 32 * 72 + ks * 16);
      acc[0][0] = MFMA32(a0, b0, acc[0][0]); acc[0][1] = MFMA32(a0, b1, acc[0][1]);
      acc[1][0] = MFMA32(a1, b0, acc[1][0]); acc[1][1] = MFMA32(a1, b1, acc[1][1]);
    }
    if (kt + 1 < nk) {
      const int nx = cur ^ 1;
#pragma unroll
      for (int i = 0; i < 4; ++i) { *(u4*)(sA + nx * 128 * 72 + (lr + i * 32) * 72 + lc) = ra[i]; *(u4*)(sB + nx * 128 * 72 + (lr + i * 32) * 72 + lc) = rb[i]; }
    }
    __syncthreads();
  }
#pragma unroll
  for (int i = 0; i < 2; ++i)
#pragma unroll
    for (int r = 0; r < 16; ++r) {
      const int row = m0 + wm * 64 + i * 32 + (r >> 2) * 8 + lh * 4 + (r & 3);
#pragma unroll
      for (int j = 0; j < 2; ++j) {
        const int col = n0 + wn * 64 + j * 32 + l31;
        const float v = acc[i][j][r];
        if (EPI == 0) ea.cb[(size_t)row * ea.ldc + col] = f2bf(v);
        else if (EPI == 1) {
          const float* rp = ea.res1 ? (row < TP ? ea.res0 + (size_t)row * DM : ea.res1 + (size_t)(row - TP) * DM) : ea.res0 + (size_t)row * DM;
          ea.yout[(size_t)row * DM + col] = rp[col] + v;
        } else if (EPI == 2) { const float rl = v > 0.f ? v : 0.f; ea.cb[(size_t)row * ea.ldc + col] = f2bf(rl * rl); }
        else ea.cf[(size_t)row * ea.ldc + col] = v;
      }
    }
}
template <int EPI>
DEVI void gemm_phase(const bf16_t* A, int lda, const bf16_t* Bt, int K, int M, int N, const EpiArgs& ea, unsigned char* smem) {
  const int ntn = N >> 7, nt = (M >> 7) * ntn;
  for (int t = blockIdx.x; t < nt; t += gridDim.x) gemm_tile<EPI>(A, lda, Bt, K, K, (t / ntn) << 7, (t % ntn) << 7, ea, smem);
}

DEVI void convert_tile(const float* __restrict__ W, bf16_t* __restrict__ Wt, int K, int N, int k0, int n0, int thr, int shift, unsigned char* smem) {
  float* tile = (float*)smem;
  const int tid = get_tid();
  __syncthreads();
#pragma unroll
  for (int i = 0; i < 4; ++i) {
    const int r = (tid >> 4) + 16 * i, c = (tid & 15) * 4;
    float4 v = make_float4(0.f, 0.f, 0.f, 0.f);
    if (n0 + c < N) v = *(const float4*)(W + (size_t)(k0 + r) * N + n0 + c);
    tile[r * 65 + c] = v.x; tile[r * 65 + c + 1] = v.y; tile[r * 65 + c + 2] = v.z; tile[r * 65 + c + 3] = v.w;
  }
  __syncthreads();
  const int n = tid >> 2, kc = (tid & 3) * 16;
  if (n0 + n < N) {
    const int nn = n0 + n, nd = nn + (nn >= thr ? shift : 0);
    unsigned o[8];
#pragma unroll
    for (int e = 0; e < 8; ++e) o[e] = pk2(tile[(kc + 2 * e) * 65 + n], tile[(kc + 2 * e + 1) * 65 + n]);
    u4* dst = (u4*)(Wt + (size_t)nd * K + k0 + kc);
    dst[0] = mk4(o[0], o[1], o[2], o[3]); dst[1] = mk4(o[4], o[5], o[6], o[7]);
  }
}
DEVI void convert_group(int& base, int bid, int nb, const float* W, bf16_t* Wt, int nl, int K, int N, int NPAD, int thr, int shift, unsigned char* smem) {
  const int tk = K >> 6, tn = (N + 63) >> 6, per = tk * tn, tot = per * nl;
  int first = ((bid - base) % nb + nb) % nb;
  for (int t = first; t < tot; t += nb) {
    const int l = t / per, r = t % per;
    convert_tile(W + (size_t)l * K * N, Wt + (size_t)l * NPAD * K, K, N, (r / tn) << 6, (r % tn) << 6, thr, shift, smem);
  }
  base += tot;
}

DEVI void norm_row(const float* __restrict__ src, const float* __restrict__ gain, bf16_t* __restrict__ dst, int lane) {
  float4 v[4]; float ss = 0.f;
#pragma unroll
  for (int i = 0; i < 4; ++i) { v[i] = *(const float4*)(src + lane * 4 + 256 * i); ss += v[i].x * v[i].x + v[i].y * v[i].y + v[i].z * v[i].z + v[i].w * v[i].w; }
  ss = wave_sum(ss);
  const float sc = rsqrtf(ss * (1.f / 1024.f) + EPS);
#pragma unroll
  for (int i = 0; i < 4; ++i) {
    const float4 g = *(const float4*)(gain + lane * 4 + 256 * i);
    u2 o; o.x = pk2(v[i].x * sc * g.x, v[i].y * sc * g.y); o.y = pk2(v[i].z * sc * g.z, v[i].w * sc * g.w);
    *(u2*)(dst + lane * 4 + 256 * i) = o;
  }
}

struct KVSrc { const void* k; const void* v; int kpitch, vpitch, f32; };
template <int D>
DEVI void attn_load(const KVSrc& s, int r0, u4 (&kr)[D / 32], u4 (&vr)[D / 32]) {
  const int tid = get_tid();
#pragma unroll
  for (int i = 0; i < D / 32; ++i) {
    const int c = tid + 256 * i, key = c / (D / 8), dch = c % (D / 8);
    if (s.f32) {
      const float* kp = (const float*)s.k + (size_t)(r0 + key) * s.kpitch + dch * 8;
      const float* vp = (const float*)s.v + (size_t)(r0 + key) * s.vpitch + dch * 8;
      const float4 a = *(const float4*)kp, b = *(const float4*)(kp + 4), c2 = *(const float4*)vp, d2 = *(const float4*)(vp + 4);
      kr[i] = mk4(pk2(a.x, a.y), pk2(a.z, a.w), pk2(b.x, b.y), pk2(b.z, b.w));
      vr[i] = mk4(pk2(c2.x, c2.y), pk2(c2.z, c2.w), pk2(d2.x, d2.y), pk2(d2.z, d2.w));
    } else {
      kr[i] = *(const u4*)((const bf16_t*)s.k + (size_t)(r0 + key) * s.kpitch + dch * 8);
      vr[i] = *(const u4*)((const bf16_t*)s.v + (size_t)(r0 + key) * s.vpitch + dch * 8);
    }
  }
}
template <int D>
DEVI void attn_store(bf16_t* Ks, bf16_t* Vt, const u4 (&kr)[D / 32], const u4 (&vr)[D / 32]) {
  const int tid = get_tid();
#pragma unroll
  for (int i = 0; i < D / 32; ++i) {
    const int c = tid + 256 * i, key = c / (D / 8), dch = c % (D / 8);
    *(u4*)(Ks + key * (D + 8) + dch * 8) = kr[i];
    const int kx = key ^ ((dch & 15) << 2);
    const unsigned w[4] = {vr[i].x, vr[i].y, vr[i].z, vr[i].w};
#pragma unroll
    for (int e = 0; e < 8; ++e) Vt[(dch * 8 + e) * 72 + kx] = (bf16_t)((w[e >> 1] >> (16 * (e & 1))) & 0xffffu);
  }
}

template <int D, int MODE>
DEVI void attn_item(const bf16_t* __restrict__ qsrc, int qpitch, int nq, const float* __restrict__ qgain, float qscale,
                    const KVSrc& segA, int nA, int qposA0, int maskA, const KVSrc& segB, int nB,
                    bf16_t* __restrict__ out, int opitch, unsigned char* smem) {
  constexpr int KPT = D + 8, NKS = D / 16, NDB = D / 32, NCH = D / 32;
  constexpr int STAGE = 64 * KPT + D * 72;
  const int tid = get_tid(), lane = tid & 63, wave = tid >> 6, l31 = lane & 31, lh = lane >> 5;
  bf16_t* sbase = (bf16_t*)smem;
  const bool active = wave * 32 < nq;
  bf16x8 qf[NKS];
  {
    float qv[NKS][8]; float ss = 0.f;
    const bf16_t* qp = qsrc + (size_t)(wave * 32 + l31) * qpitch + lh * 8;
#pragma unroll
    for (int ks = 0; ks < NKS; ++ks) {
      u4 u = mk4(0, 0, 0, 0);
      if (active) u = *(const u4*)(qp + ks * 16);
      const unsigned w[4] = {u.x, u.y, u.z, u.w};
#pragma unroll
      for (int e = 0; e < 4; ++e) { qv[ks][2 * e] = lo2f(w[e]); qv[ks][2 * e + 1] = hi2f(w[e]); }
#pragma unroll
      for (int e = 0; e < 8; ++e) ss += qv[ks][e] * qv[ks][e];
    }
    ss += __shfl_xor(ss, 32);
    const float sc = rsqrtf(ss * (1.f / D) + EPS) * qscale;
#pragma unroll
    for (int ks = 0; ks < NKS; ++ks) {
      const float4 g0 = *(const float4*)(qgain + ks * 16 + lh * 8), g1 = *(const float4*)(qgain + ks * 16 + lh * 8 + 4);
      u4 u;
      u.x = pk2(qv[ks][0] * sc * g0.x, qv[ks][1] * sc * g0.y); u.y = pk2(qv[ks][2] * sc * g0.z, qv[ks][3] * sc * g0.w);
      u.z = pk2(qv[ks][4] * sc * g1.x, qv[ks][5] * sc * g1.y); u.w = pk2(qv[ks][6] * sc * g1.z, qv[ks][7] * sc * g1.w);
      qf[ks] = as_frag(u);
    }
  }
  f32x16 oacc[NDB];
#pragma unroll
  for (int db = 0; db < NDB; ++db)
#pragma unroll
    for (int r = 0; r < 16; ++r) oacc[db][r] = 0.f;
  float carry = 0.f, mx = -1e30f, lsum = 0.f;
  const int ntot = nA + nB;
  const int qpos = qposA0 + wave * 32 + l31;
  u4 kr[NCH], vr[NCH];
  {
    const bool inA = 0 < nA; const int tix = inA ? nA - 1 : nB - 1;
    attn_load<D>(inA ? segA : segB, tix * 64, kr, vr);
    __syncthreads();
    attn_store<D>(sbase, sbase + 64 * KPT, kr, vr);
    __syncthreads();
  }
  for (int it = 0; it < ntot; ++it) {
    const int cur = it & 1;
    if (it + 1 < ntot) {
      const bool nInA = (it + 1) < nA; const int tix = nInA ? nA - 2 - it : nB - 1 - (it + 1 - nA);
      attn_load<D>(nInA ? segA : segB, tix * 64, kr, vr);
    }
    const bool inA = it < nA;
    const int kbase = inA ? (nA - 1 - it) * 64 : 0;
    const bf16_t* Ks = sbase + cur * STAGE;
    const bf16_t* Vt = Ks + 64 * KPT;
    const bool mneed = inA && maskA && (kbase + 63 >= qposA0 + wave * 32);
    const bool skip = !active || (inA && maskA && (kbase > qposA0 + wave * 32 + 31));
    if (!skip) {
      bf16x8 pf[2][2];
      if (MODE == 0) {
        float after = carry;
#pragma unroll
        for (int rt = 1; rt >= 0; --rt) {
          f32x16 z;
#pragma unroll
          for (int r = 0; r < 16; ++r) z[r] = 0.f;
#pragma unroll
          for (int ks = 0; ks < NKS; ++ks) {
            const bf16x8 a = *(const bf16x8*)(Ks + (rt * 32 + l31) * KPT + ks * 16 + lh * 8);
            z = MFMA32(a, qf[ks], z);
          }
          float m[16];
#pragma unroll
          for (int i = 0; i < 16; ++i) {
            float mm = lg2(1.f + ex2(z[i]));
            if (mneed) { const int key = kbase + rt * 32 + (i >> 2) * 8 + lh * 4 + (i & 3); if (key >= qpos) mm = 0.f; }
            m[i] = mm;
          }
          float a_[16];
#pragma unroll
          for (int g = 3; g >= 0; --g) {
            const float s4 = (m[g * 4] + m[g * 4 + 1]) + (m[g * 4 + 2] + m[g * 4 + 3]);
            const float p4 = __shfl_xor(s4, 32);
            float c = after + (lh == 0 ? p4 : 0.f);
            after += s4 + p4;
#pragma unroll
            for (int e = 3; e >= 0; --e) {
              c += m[g * 4 + e];
              float av = ex2(z[g * 4 + e] - c);
              if (mneed) { const int key = kbase + rt * 32 + g * 8 + lh * 4 + e; if (key >= qpos) av = 0.f; }
              a_[g * 4 + e] = av;
            }
          }
#pragma unroll
          for (int s2 = 0; s2 < 2; ++s2)
            pf[rt][s2] = as_frag(mk4(pk2(a_[8 * s2 + 0], a_[8 * s2 + 1]), pk2(a_[8 * s2 + 2], a_[8 * s2 + 3]), pk2(a_[8 * s2 + 4], a_[8 * s2 + 5]), pk2(a_[8 * s2 + 6], a_[8 * s2 + 7])));
        }
        carry = after;
      } else {
        f32x16 z[2];
#pragma unroll
        for (int rt = 0; rt < 2; ++rt) {
          f32x16 zt;
#pragma unroll
          for (int r = 0; r < 16; ++r) zt[r] = 0.f;
#pragma unroll
          for (int ks = 0; ks < NKS; ++ks) {
            const bf16x8 a = *(const bf16x8*)(Ks + (rt * 32 + l31) * KPT + ks * 16 + lh * 8);
            zt = MFMA32(a, qf[ks], zt);
          }
          z[rt] = zt;
        }
        float tm = z[0][0];
#pragma unroll
        for (int rt = 0; rt < 2; ++rt)
#pragma unroll
          for (int i = 0; i < 16; ++i) tm = fmaxf(tm, z[rt][i]);
        tm = fmaxf(tm, __shfl_xor(tm, 32));
        const float nm = fmaxf(mx, tm);
        const float alpha = ex2(mx - nm);
        mx = nm;
        float ps = 0.f;
        float a_[2][16];
#pragma unroll
        for (int rt = 0; rt < 2; ++rt)
#pragma unroll
          for (int i = 0; i < 16; ++i) { a_[rt][i] = ex2(z[rt][i] - nm); ps += a_[rt][i]; }
        lsum = lsum * alpha + ps;
#pragma unroll
        for (int db = 0; db < NDB; ++db)
#pragma unroll
          for (int r = 0; r < 16; ++r) oacc[db][r] *= alpha;
#pragma unroll
        for (int rt = 0; rt < 2; ++rt)
#pragma unroll
          for (int s2 = 0; s2 < 2; ++s2)
            pf[rt][s2] = as_frag(mk4(pk2(a_[rt][8 * s2 + 0], a_[rt][8 * s2 + 1]), pk2(a_[rt][8 * s2 + 2], a_[rt][8 * s2 + 3]), pk2(a_[rt][8 * s2 + 4], a_[rt][8 * s2 + 5]), pk2(a_[rt][8 * s2 + 6], a_[rt][8 * s2 + 7])));
      }
#pragma unroll
      for (int db = 0; db < NDB; ++db) {
        const int d = db * 32 + l31, sw = ((d >> 3) & 15) << 2;
#pragma unroll
        for (int rt = 0; rt < 2; ++rt)
#pragma unroll
          for (int s = 0; s < 2; ++s) {
            const int kb0 = rt * 32 + 16 * s + 4 * lh;
            const u2 lo = *(const u2*)(Vt + d * 72 + (kb0 ^ sw));
            const u2 hi = *(const u2*)(Vt + d * 72 + ((kb0 + 8) ^ sw));
            oacc[db] = MFMA32(as_frag(mk4(lo.x, lo.y, hi.x, hi.y)), pf[rt][s], oacc[db]);
          }
      }
    }
    if (it + 1 < ntot) { bf16_t* nK = sbase + (cur ^ 1) * STAGE; attn_store<D>(nK, nK + 64 * KPT, kr, vr); }
    __syncthreads();
  }
  if (active) {
    float inv = 1.f;
    if (MODE == 1) { const float l = lsum + __shfl_xor(lsum, 32); inv = 1.f / l; }
    bf16_t* op = out + (size_t)(wave * 32 + l31) * opitch + lh * 4;
#pragma unroll
    for (int db = 0; db < NDB; ++db)
#pragma unroll
      for (int g = 0; g < 4; ++g) {
        u2 o; o.x = pk2(oacc[db][g * 4] * inv, oacc[db][g * 4 + 1] * inv); o.y = pk2(oacc[db][g * 4 + 2] * inv, oacc[db][g * 4 + 3] * inv);
        *(u2*)(op + db * 32 + g * 8) = o;
      }
  }
}

DEVI void mem_attn_item(const KP& p, int layer, int item, const bf16_t* P, int np, int mqoff, bf16_t* mix, int mixp, int mixoff, unsigned char* smem) {
  const int h = item & 3;
  int t0, nq; const float *kk, *vv;
  if (item < 512) { t0 = (item >> 2) * 128; nq = 128; kk = p.out + O_PMK + (size_t)layer * 65536; vv = p.out + O_PMV + (size_t)layer * 65536; }
  else { const int b = (item - 512) >> 2; t0 = TP + b * 64; nq = 64; kk = p.in[6] + ((size_t)layer * 8 + b) * 65536; vv = p.in[7] + ((size_t)layer * 8 + b) * 65536; }
  KVSrc s; s.k = kk + h * 64; s.v = vv + h * 64; s.kpitch = 256; s.vpitch = 256; s.f32 = 1;
  attn_item<64, 1>(P + (size_t)t0 * np + mqoff + h * 64, np, nq, p.in[15] + layer * 64, 0.125f * LOG2E, s, 4, 0, 0, s, 0,
                   mix + (size_t)t0 * mixp + mixoff + h * 64, mixp, smem);
}

DEVI void gdn_prep_item(const KP& p, int j, int ci, int h, const bf16_t* P, unsigned char* smem) {
  constexpr int NP = NP_GDN;
  const int tid = get_tid(), lane = tid & 63, wave = tid >> 6;
  const int item = ci * 6 + h;
  const bool samp = ci >= 256;
  const int b = ci - 256;
  const int t0 = samp ? TP + b * 64 : ci * 64;
  float* stage = (float*)smem;
  float* sL = (float*)smem;
  bf16_t* qn = (bf16_t*)(smem + 33280);
  bf16_t* kn = qn + 64 * 136;
  float* sgc = (float*)(smem + 33280 + 2 * 64 * 136 * 2);
  float* sbeta = sgc + 64;
  float* segc = sbeta + 64;
  unsigned char* gi = p.ws + WS_G + (size_t)item * G_ITEM;
  bf16_t* gU = (bf16_t*)gi; bf16_t* gW = gU + 8192; bf16_t* gQD = gW + 8192; bf16_t* gKDT = gQD + 8192; bf16_t* gAI = gKDT + 8192;
  const float* convw = p.in[17] + (size_t)j * 4 * 2304;
  const float* cstate = p.in[2] + ((size_t)j * 8 + (samp ? b : 0)) * 3 * 2304;
  const bf16_t* Pc = P + (size_t)t0 * NP;
  __syncthreads();
  if (wave == 0) {
    const float braw = bf2f(Pc[(size_t)lane * NP + 3072 + h]), araw = bf2f(Pc[(size_t)lane * NP + 3078 + h]);
    const float beta = 1.f / (1.f + expf(-braw));
    const float xx = araw + p.in[19][j * 6 + h];
    const float sp = xx > 20.f ? xx : log1pf(expf(xx));
    float g = -expf(p.in[18][j * 6 + h]) * sp;
#pragma unroll
    for (int d = 1; d < 64; d <<= 1) { const float v = __shfl_up(g, d); if (lane >= d) g += v; }
    sgc[lane] = g; sbeta[lane] = beta; segc[lane] = expf(g);
    if (lane == 63) ((float*)(p.ws + WS_GL))[item] = expf(g);
  }
  if (samp || ci == 255) {
    float* dst = samp ? p.out + O_SGC + ((size_t)j * 8 + b) * 3 * 2304 : p.out + O_PGC + (size_t)j * 3 * 2304;
    for (int idx = tid; idx < 1152; idx += 256) {
      const int r = idx / 384, cc = idx % 384, ch = (cc >> 7) * 768 + h * 128 + (cc & 127);
      dst[r * 2304 + ch] = bf2f(Pc[(size_t)(61 + r) * NP + ch]);
    }
  }
  const float gcl_dummy = 0.f; (void)gcl_dummy;
#pragma unroll 1
  for (int which = 0; which < 2; ++which) {
    {
      const int c = tid & 127, th = tid >> 7, ch = which * 768 + h * 128 + c;
      const float w0 = convw[ch], w1 = convw[2304 + ch], w2 = convw[2 * 2304 + ch], w3 = convw[3 * 2304 + ch];
      float xm3, xm2, xm1;
      if (th == 1) { xm3 = bf2f(Pc[(size_t)29 * NP + ch]); xm2 = bf2f(Pc[(size_t)30 * NP + ch]); xm1 = bf2f(Pc[(size_t)31 * NP + ch]); }
      else if (samp) { xm3 = cstate[ch]; xm2 = cstate[2304 + ch]; xm1 = cstate[2 * 2304 + ch]; }
      else if (ci == 0) { xm3 = xm2 = xm1 = 0.f; }
      else { xm3 = bf2f(Pc[-(ptrdiff_t)3 * NP + ch]); xm2 = bf2f(Pc[-(ptrdiff_t)2 * NP + ch]); xm1 = bf2f(Pc[-(ptrdiff_t)NP + ch]); }
      const bf16_t* pp = Pc + (size_t)(th * 32) * NP + ch;
#pragma unroll 8
      for (int tt = 0; tt < 32; ++tt) {
        const float x0 = bf2f(pp[(size_t)tt * NP]);
        const float y = w0 * xm3 + w1 * xm2 + w2 * xm1 + w3 * x0;
        stage[(th * 32 + tt) * 129 + c] = silu(y);
        xm3 = xm2; xm2 = xm1; xm1 = x0;
      }
    }
    __syncthreads();
    {
      const int tt = tid >> 2, part = tid & 3;
      float v[32]; float ss = 0.f;
#pragma unroll
      for (int e = 0; e < 32; ++e) { v[e] = stage[tt * 129 + part * 32 + e]; ss += v[e] * v[e]; }
      ss += __shfl_xor(ss, 1); ss += __shfl_xor(ss, 2);
      float rinv = rsqrtf(ss + EPS);
      if (which == 0) rinv *= 0.08838834764831845f;
      bf16_t* dn = (which == 0 ? qn : kn) + tt * 136 + part * 32;
      const float eg = segc[tt];
#pragma unroll
      for (int e = 0; e < 32; e += 8) {
        u4 u; u.x = pk2(v[e] * rinv, v[e + 1] * rinv); u.y = pk2(v[e + 2] * rinv, v[e + 3] * rinv); u.z = pk2(v[e + 4] * rinv, v[e + 5] * rinv); u.w = pk2(v[e + 6] * rinv, v[e + 7] * rinv);
        *(u4*)(dn + e) = u;
        if (which == 0) {
          const float s2 = rinv * eg;
          u4 w; w.x = pk2(v[e] * s2, v[e + 1] * s2); w.y = pk2(v[e + 2] * s2, v[e + 3] * s2); w.z = pk2(v[e + 4] * s2, v[e + 5] * s2); w.w = pk2(v[e + 6] * s2, v[e + 7] * s2);
          *(u4*)(gQD + tt * 128 + part * 32 + e) = w;
        }
      }
    }
    __syncthreads();
  }
  {
    const int d = tid & 127, th = tid >> 7;
    const float gcl = sgc[63];
#pragma unroll
    for (int q8 = 0; q8 < 4; ++q8) {
      float f[8];
#pragma unroll
      for (int e = 0; e < 8; ++e) { const int tt = th * 32 + q8 * 8 + e; f[e] = bf2f(kn[tt * 136 + d]) * expf(gcl - sgc[tt]); }
      *(u4*)(gKDT + d * 64 + th * 32 + q8 * 8) = mk4(pk2(f[0], f[1]), pk2(f[2], f[3]), pk2(f[4], f[5]), pk2(f[6], f[7]));
    }
  }
  {
    const int l31 = lane & 31, lh = lane >> 5, ri = wave >> 1, cj = wave & 1;
    f32x16 kk, qk;
#pragma unroll
    for (int r = 0; r < 16; ++r) { kk[r] = 0.f; qk[r] = 0.f; }
#pragma unroll
    for (int ks = 0; ks < 8; ++ks) {
      const bf16x8 ak = *(const bf16x8*)(kn + (ri * 32 + l31) * 136 + ks * 16 + lh * 8);
      const bf16x8 aq = *(const bf16x8*)(qn + (ri * 32 + l31) * 136 + ks * 16 + lh * 8);
      const bf16x8 bk = *(const bf16x8*)(kn + (cj * 32 + l31) * 136 + ks * 16 + lh * 8);
      kk = MFMA32(ak, bk, kk); qk = MFMA32(aq, bk, qk);
    }
    const int jj = cj * 32 + l31; const float gj = sgc[jj];
#pragma unroll
    for (int r = 0; r < 16; ++r) {
      const int ii = ri * 32 + (r >> 2) * 8 + lh * 4 + (r & 3);
      const float dec = ii >= jj ? expf(sgc[ii] - gj) : 0.f;
      sL[ii * 64 + jj] = ii > jj ? sbeta[ii] * kk[r] * dec : 0.f;
      gAI[ii * 64 + jj] = f2bf(qk[r] * dec);
    }
  }
  __syncthreads();
  {
    float x[64];
    if (tid < 128) {
      const int ch = 1536 + h * 128 + tid;
      const float w0 = convw[ch], w1 = convw[2304 + ch], w2 = convw[2 * 2304 + ch], w3 = convw[3 * 2304 + ch];
      float xm3, xm2, xm1;
      if (samp) { xm3 = cstate[ch]; xm2 = cstate[2304 + ch]; xm1 = cstate[2 * 2304 + ch]; }
      else if (ci == 0) { xm3 = xm2 = xm1 = 0.f; }
      else { xm3 = bf2f(Pc[-(ptrdiff_t)3 * NP + ch]); xm2 = bf2f(Pc[-(ptrdiff_t)2 * NP + ch]); xm1 = bf2f(Pc[-(ptrdiff_t)NP + ch]); }
#pragma unroll
      for (int tt = 0; tt < 64; ++tt) {
        const float x0 = bf2f(Pc[(size_t)tt * NP + ch]);
        const float y = w0 * xm3 + w1 * xm2 + w2 * xm1 + w3 * x0;
        x[tt] = silu(y) * sbeta[tt];
        xm3 = xm2; xm2 = xm1; xm1 = x0;
        if ((tt & 7) == 7) __builtin_amdgcn_sched_barrier(0);
      }
    } else {
#pragma unroll
      for (int tt = 0; tt < 64; ++tt) { x[tt] = bf2f(kn[tt * 136 + tid - 128]) * sbeta[tt] * segc[tt]; if ((tt & 7) == 7) __builtin_amdgcn_sched_barrier(0); }
    }
#pragma unroll
    for (int i = 1; i < 64; ++i) {
      float a = x[i];
#pragma unroll
      for (int jx = 0; jx < i; ++jx) a -= sL[i * 64 + jx] * x[jx];
      x[i] = a;
      __builtin_amdgcn_sched_barrier(0);
    }
    bf16_t* dst = (tid < 128 ? gU : gW) + (tid & 127);
#pragma unroll
    for (int tt = 0; tt < 64; ++tt) { dst[tt * 128] = f2bf(x[tt]); if ((tt & 7) == 7) __builtin_amdgcn_sched_barrier(0); }
  }
}

struct ScanFrags { u4 w[4], qd[4], ai[2], kdt[2][2]; unsigned u01, u23; float gl; };
DEVI void scan_load(const KP& p, int item, int wave, int lane, int sl, ScanFrags& f) {
  const int n = lane & 15, g = lane >> 4;
  const unsigned char* gi = p.ws + WS_G + (size_t)item * G_ITEM;
  const bf16_t* gU = (const bf16_t*)gi; const bf16_t* gW = gU + 8192; const bf16_t* gQD = gW + 8192; const bf16_t* gKDT = gQD + 8192; const bf16_t* gAI = gKDT + 8192;
#pragma unroll
  for (int s = 0; s < 4; ++s) { f.w[s] = *(const u4*)(gW + (16 * wave + n) * 128 + 32 * s + 8 * g); f.qd[s] = *(const u4*)(gQD + (16 * wave + n) * 128 + 32 * s + 8 * g); }
#pragma unroll
  for (int s = 0; s < 2; ++s) {
    f.ai[s] = *(const u4*)(gAI + (16 * wave + n) * 64 + 32 * s + 8 * g);
#pragma unroll
    for (int tt = 0; tt < 2; ++tt) f.kdt[tt][s] = *(const u4*)(gKDT + (32 * wave + 16 * tt + n) * 64 + 32 * s + 8 * g);
  }
  const bf16_t* up = gU + (16 * wave + 4 * g) * 128 + sl * 16 + n;
  f.u01 = (unsigned)up[0] | ((unsigned)up[128] << 16);
  f.u23 = (unsigned)up[256] | ((unsigned)up[384] << 16);
  f.gl = ((const float*)(p.ws + WS_GL))[item];
}
DEVI void gdn_scan_stream(const KP& p, int j, int ci0, int nch, int h, int sl, const float* s0, float* sout, bf16_t* O, unsigned char* smem) {
  const int tid = get_tid(), lane = tid & 63, wave = tid >> 6, n = lane & 15, g = lane >> 4;
  bf16_t* St = (bf16_t*)smem;
  bf16_t* Vnt = St + 16 * 136;
  f32x4 sacc[2];
#pragma unroll
  for (int tt = 0; tt < 2; ++tt)
#pragma unroll
    for (int r = 0; r < 4; ++r) sacc[tt][r] = s0 ? s0[(size_t)(32 * wave + 16 * tt + 4 * g + r) * 128 + sl * 16 + n] : 0.f;
  __syncthreads();
#pragma unroll
  for (int tt = 0; tt < 2; ++tt) { u2 o; o.x = pk2(sacc[tt][0], sacc[tt][1]); o.y = pk2(sacc[tt][2], sacc[tt][3]); *(u2*)(St + n * 136 + 32 * wave + 16 * tt + 4 * g) = o; }
  ScanFrags f;
  scan_load(p, ci0 * 6 + h, wave, lane, sl, f);
  __syncthreads();
  for (int c = 0; c < nch; ++c) {
    ScanFrags fn;
    if (c + 1 < nch) scan_load(p, (ci0 + c + 1) * 6 + h, wave, lane, sl, fn); else fn = f;
    const int t0 = (ci0 + c) >= 256 ? TP + (ci0 + c - 256) * 64 : (ci0 + c) * 64;
    bf16x8 sf[4];
#pragma unroll
    for (int s = 0; s < 4; ++s) sf[s] = *(const bf16x8*)(St + n * 136 + 32 * s + 8 * g);
    f32x4 wsa = {0.f, 0.f, 0.f, 0.f}, oa = {0.f, 0.f, 0.f, 0.f};
#pragma unroll
    for (int s = 0; s < 4; ++s) wsa = MFMA16(as_frag(f.w[s]), sf[s], wsa);
    float vn[4];
    vn[0] = lo2f(f.u01) - wsa[0]; vn[1] = hi2f(f.u01) - wsa[1]; vn[2] = lo2f(f.u23) - wsa[2]; vn[3] = hi2f(f.u23) - wsa[3];
    { u2 o; o.x = pk2(vn[0], vn[1]); o.y = pk2(vn[2], vn[3]); *(u2*)(Vnt + n * 72 + 16 * wave + 4 * g) = o; }
#pragma unroll
    for (int s = 0; s < 4; ++s) oa = MFMA16(as_frag(f.qd[s]), sf[s], oa);
    __syncthreads();
    bf16x8 vf[2];
#pragma unroll
    for (int s = 0; s < 2; ++s) vf[s] = *(const bf16x8*)(Vnt + n * 72 + 32 * s + 8 * g);
#pragma unroll
    for (int s = 0; s < 2; ++s) oa = MFMA16(as_frag(f.ai[s]), vf[s], oa);
#pragma unroll
    for (int r = 0; r < 4; ++r) O[(size_t)(t0 + 16 * wave + 4 * g + r) * 768 + h * 128 + sl * 16 + n] = f2bf(oa[r]);
#pragma unroll
    for (int tt = 0; tt < 2; ++tt) {
#pragma unroll
      for (int r = 0; r < 4; ++r) sacc[tt][r] *= f.gl;
#pragma unroll
      for (int s = 0; s < 2; ++s) sacc[tt] = MFMA16(as_frag(f.kdt[tt][s]), vf[s], sacc[tt]);
      u2 o; o.x = pk2(sacc[tt][0], sacc[tt][1]); o.y = pk2(sacc[tt][2], sacc[tt][3]);
      *(u2*)(St + n * 136 + 32 * wave + 16 * tt + 4 * g) = o;
    }
    __syncthreads();
    f = fn;
  }
#pragma unroll
  for (int tt = 0; tt < 2; ++tt)
#pragma unroll
    for (int r = 0; r < 4; ++r) sout[(size_t)(32 * wave + 16 * tt + 4 * g + r) * 128 + sl * 16 + n] = sacc[tt][r];
}

DEVI int next_item(unsigned* ctr) {
  __shared__ int s_item;
  __syncthreads();
  if (get_tid() == 0) s_item = (int)atomicAdd(ctr, 1u);
  __syncthreads();
  return s_item;
}

DEVI void gbar(unsigned* bar, unsigned nb, unsigned& gen) {
  asm volatile("s_waitcnt vmcnt(0)" ::: "memory");
  __syncthreads();
  gen++;
  if (get_tid() == 0) {
    __builtin_amdgcn_fence(__ATOMIC_RELEASE, "agent");
    asm volatile("s_waitcnt vmcnt(0)" ::: "memory");
    __hip_atomic_fetch_add(bar, 1u, __ATOMIC_RELAXED, __HIP_MEMORY_SCOPE_AGENT);
    while (__hip_atomic_load(bar, __ATOMIC_RELAXED, __HIP_MEMORY_SCOPE_AGENT) < gen * nb) __builtin_amdgcn_s_sleep(2);
    __builtin_amdgcn_fence(__ATOMIC_ACQUIRE, "agent");
    asm volatile("s_waitcnt vmcnt(0)" ::: "memory");
  }
  __syncthreads();
}
#ifndef ONLY
#define ENAB(k) true
#else
#define ENAB(k) ((ONLY) == (k))
#endif
__global__ void __launch_bounds__(256, 2) mk_fwd(KP p) {
  __shared__ __attribute__((aligned(16))) unsigned char smem[73728];
  cg::grid_group grid = cg::this_grid();
  const int bid = blockIdx.x, nb = gridDim.x;
  const int ngw = nb * 4;
  unsigned char* ws = p.ws;
  unsigned* ctr = (unsigned*)(ws + WS_CTR);
  float* Y = p.out + O_YP;
  bf16_t* XN = (bf16_t*)(ws + WS_XN);
  bf16_t* MIX = (bf16_t*)(ws + WS_MIX);
  bf16_t* Pb = (bf16_t*)(ws + WS_P);
  bf16_t* Hb = (bf16_t*)(ws + WS_H);
  bool did = false;
  unsigned bgen = 0;
  grid.sync();
  for (int ph = p.ph_lo; ph < p.ph_hi; ++ph) {
    const int layer = ph == 0 ? 0 : (ph - 1) / 9, sub = ph == 0 ? -1 : (ph - 1) % 9;
    const int kind = layer & 1, j = layer >> 1;
    if (sub == 3 && kind == 1) continue;
    if (sub == 8 && layer == 3) continue;
    if (did) gbar(ctr + 512, nb, bgen);
    did = true;
    const int tid = get_tid(), lane = tid & 63, wave = tid >> 6, gw = bid * 4 + wave;
    (void)tid;
    const int np = kind ? NP_SB : NP_GDN, mqoff = kind ? MQ_SB : MQ_GDN, mixp = kind ? 768 : 1024, mixoff = kind ? 512 : 768;
    if (ph == 0 && ENAB(0)) {
      int base = 0;
      convert_group(base, bid, nb, p.in[12], (bf16_t*)(ws + WS_WIG), 2, 1024, 3340, 3456, 3084, 116, smem);
      convert_group(base, bid, nb, p.in[13], (bf16_t*)(ws + WS_WIS), 2, 1024, 1792, 1792, 1 << 30, 0, smem);
      convert_group(base, bid, nb, p.in[14], (bf16_t*)(ws + WS_WKV), 4, 1024, 512, 512, 1 << 30, 0, smem);
      convert_group(base, bid, nb, p.in[23], (bf16_t*)(ws + WS_WOG), 2, 1024, 1024, 1024, 1 << 30, 0, smem);
      convert_group(base, bid, nb, p.in[24], (bf16_t*)(ws + WS_WOS), 2, 768, 1024, 1024, 1 << 30, 0, smem);
      convert_group(base, bid, nb, p.in[25], (bf16_t*)(ws + WS_WUP), 4, 1024, 4096, 4096, 1 << 30, 0, smem);
      convert_group(base, bid, nb, p.in[26], (bf16_t*)(ws + WS_WDN), 4, 4096, 1024, 1024, 1 << 30, 0, smem);
      for (int r = gw; r < TA; r += ngw) norm_row(r < TP ? p.in[0] + (size_t)r * DM : p.in[1] + (size_t)(r - TP) * DM, p.in[9], XN + (size_t)r * DM, lane);
      for (int r = gw; r < 1024; r += ngw) norm_row(p.in[8] + (size_t)(r & 255) * DM, p.in[10] + (r >> 8) * DM, (bf16_t*)(ws + WS_MEMN) + (size_t)r * DM, lane);
    } else if (sub == 0 && ENAB(1)) {
      EpiArgs ea{}; ea.cb = Pb; ea.ldc = np;
      const bf16_t* wt = kind ? (const bf16_t*)(ws + WS_WIS) + (size_t)j * 1792 * 1024 : (const bf16_t*)(ws + WS_WIG) + (size_t)j * 3456 * 1024;
      gemm_phase<0>(XN, DM, wt, 1024, TA, np, ea, smem);
      if (layer == 0) {
        for (int t = bid; t < 32; t += nb) {
          const int l = t >> 3, r = t & 7;
          EpiArgs e2{}; e2.cf = (float*)(ws + WS_MEMKV) + (size_t)l * 256 * 512; e2.ldc = 512;
          gemm_tile<3>((const bf16_t*)(ws + WS_MEMN) + (size_t)l * 256 * DM, DM, (const bf16_t*)(ws + WS_WKV) + (size_t)l * 512 * DM, DM, 1024, (r >> 2) << 7, (r & 3) << 7, e2, smem);
        }
      }
    } else if (sub == 1 && ENAB(2)) {
      if (layer == 0) {
        const float* kv = (const float*)(ws + WS_MEMKV);
        for (int it = gw; it < 4096; it += ngw) {
          const int l = it >> 10, m = (it >> 2) & 255, hh = it & 3;
          const float kx = kv[((size_t)l * 256 + m) * 512 + hh * 64 + lane], vx = kv[((size_t)l * 256 + m) * 512 + 256 + hh * 64 + lane];
          const float ss = wave_sum(kx * kx);
          p.out[O_PMK + ((size_t)l * 256 + m) * 256 + hh * 64 + lane] = kx * rsqrtf(ss * (1.f / 64.f) + EPS) * p.in[16][l * 64 + lane];
          p.out[O_PMV + ((size_t)l * 256 + m) * 256 + hh * 64 + lane] = vx;
        }
      }
      if (kind == 0) {
        for (int it = bid; it < NITEM; it += nb) gdn_prep_item(p, j, it / 6, it % 6, Pb, smem);
      } else {
        bf16_t* Kb = (bf16_t*)(ws + WS_G);
        const float* kg = p.in[22] + j * 128;
        for (int t = gw; t < TA; t += ngw) {
          const bf16_t* pr = Pb + (size_t)t * np;
          const u4 ku = *(const u4*)(pr + 512 + lane * 8), vu = *(const u4*)(pr + 1024 + lane * 8);
          float kf[8] = {lo2f(ku.x), hi2f(ku.x), lo2f(ku.y), hi2f(ku.y), lo2f(ku.z), hi2f(ku.z), lo2f(ku.w), hi2f(ku.w)};
          float ss = 0.f;
#pragma unroll
          for (int e = 0; e < 8; ++e) ss += kf[e] * kf[e];
          ss += __shfl_xor(ss, 1); ss += __shfl_xor(ss, 2); ss += __shfl_xor(ss, 4); ss += __shfl_xor(ss, 8);
          const float sc = rsqrtf(ss * (1.f / 128.f) + EPS);
          const int c0 = (lane & 15) * 8;
#pragma unroll
          for (int e = 0; e < 8; ++e) kf[e] *= sc * kg[c0 + e];
          float* ok = t < TP ? p.out + O_PSK + ((size_t)j * TP + t) * 512 : p.out + O_SSK + ((size_t)j * TS + (t - TP)) * 512;
          float* ov = t < TP ? p.out + O_PSV + ((size_t)j * TP + t) * 512 : p.out + O_SSV + ((size_t)j * TS + (t - TP)) * 512;
          *(float4*)(ok + lane * 8) = make_float4(kf[0], kf[1], kf[2], kf[3]); *(float4*)(ok + lane * 8 + 4) = make_float4(kf[4], kf[5], kf[6], kf[7]);
          *(float4*)(ov + lane * 8) = make_float4(lo2f(vu.x), hi2f(vu.x), lo2f(vu.y), hi2f(vu.y)); *(float4*)(ov + lane * 8 + 4) = make_float4(lo2f(vu.z), hi2f(vu.z), lo2f(vu.w), hi2f(vu.w));
          *(u4*)(Kb + (size_t)t * 512 + lane * 8) = mk4(pk2(kf[0], kf[1]), pk2(kf[2], kf[3]), pk2(kf[4], kf[5]), pk2(kf[6], kf[7]));
        }
      }
    } else if (sub == 2 && ENAB(3)) {
      unsigned* c = ctr + layer * 4;
      if (kind == 0) {
        bf16_t* O = XN;
        if (bid < 64 && (bid & 7) < 6) {
          const int h = bid & 7, sl = bid >> 3;
          gdn_scan_stream(p, j, 0, 256, h, sl, nullptr, p.out + O_PGS + ((size_t)j * 6 + h) * 16384, O, smem);
        }
        for (;;) {
          const int it = next_item(c);
          if (it >= 384 + 544) break;
          if (it < 384) { const int b = it / 48, r = it % 48, h = r >> 3, sl = r & 7;
            gdn_scan_stream(p, j, 256 + b, 1, h, sl, p.in[3] + (((size_t)j * 8 + b) * 6 + h) * 16384, p.out + O_SGS + (((size_t)j * 8 + b) * 6 + h) * 16384, O, smem);
          } else mem_attn_item(p, layer, it - 384, Pb, np, mqoff, MIX, mixp, mixoff, smem);
        }
      } else {
        const bf16_t* Kb = (const bf16_t*)(ws + WS_G);
        const float qs = 0.08838834764831845f * LOG2E;
        for (;;) {
          const int it = next_item(c);
          if (it >= 512 + 32 + 544) break;
          if (it < 512) {
            const int qb = 127 - (it >> 2), h = it & 3;
            KVSrc s; s.k = Kb + h * 128; s.v = Pb + 1024 + h * 128; s.kpitch = 512; s.vpitch = np; s.f32 = 0;
            attn_item<128, 0>(Pb + (size_t)(qb * 128) * np + h * 128, np, 128, p.in[21] + j * 128, qs, s, 2 * qb + 2, qb * 128, 1, s, 0,
                              MIX + (size_t)(qb * 128) * mixp + h * 128, mixp, smem);
          } else if (it < 544) {
            const int b = (it - 512) >> 2, h = it & 3, t0 = TP + b * 64;
            KVSrc sa; sa.k = Kb + (size_t)t0 * 512 + h * 128; sa.v = Pb + (size_t)t0 * np + 1024 + h * 128; sa.kpitch = 512; sa.vpitch = np; sa.f32 = 0;
            KVSrc sb; sb.k = p.in[4] + ((size_t)j * 8 + b) * 2048 * 512 + h * 128; sb.v = p.in[5] + ((size_t)j * 8 + b) * 2048 * 512 + h * 128; sb.kpitch = 512; sb.vpitch = 512; sb.f32 = 1;
            attn_item<128, 0>(Pb + (size_t)t0 * np + h * 128, np, 64, p.in[21] + j * 128, qs, sa, 1, 0, 1, sb, 32,
                              MIX + (size_t)t0 * mixp + h * 128, mixp, smem);
          } else mem_attn_item(p, layer, it - 544, Pb, np, mqoff, MIX, mixp, mixoff, smem);
        }
      }
    } else if (sub == 3 && ENAB(4)) {
      const bf16_t* O = XN;
      const float* og = p.in[20] + j * 128;
      for (int it = gw; it < TA * 6; it += ngw) {
        const int t = it / 6, h = it % 6;
        const unsigned ou = *(const unsigned*)(O + (size_t)t * 768 + h * 128 + lane * 2);
        const unsigned zu = *(const unsigned*)(Pb + (size_t)t * np + 2304 + h * 128 + lane * 2);
        const float o0 = lo2f(ou), o1 = hi2f(ou), z0 = lo2f(zu), z1 = hi2f(zu);
        const float ss = wave_sum(o0 * o0 + o1 * o1);
        const float sc = rsqrtf(ss * (1.f / 128.f) + EPS);
        *(unsigned*)(MIX + (size_t)t * 1024 + h * 128 + lane * 2) = pk2(o0 * sc * og[lane * 2] * silu(z0), o1 * sc * og[lane * 2 + 1] * silu(z1));
      }
    } else if (sub == 4 && ENAB(5)) {
      EpiArgs ea{}; ea.yout = Y;
      if (layer == 0) { ea.res0 = p.in[0]; ea.res1 = p.in[1]; } else { ea.res0 = Y; ea.res1 = nullptr; }
      const bf16_t* wt = kind ? (const bf16_t*)(ws + WS_WOS) + (size_t)j * 1024 * 768 : (const bf16_t*)(ws + WS_WOG) + (size_t)j * 1024 * 1024;
      gemm_phase<1>(MIX, mixp, wt, mixp, TA, 1024, ea, smem);
    } else if (sub == 5) {
      for (int r = gw; r < TA; r += ngw) norm_row(Y + (size_t)r * DM, p.in[11] + layer * DM, XN + (size_t)r * DM, lane);
    } else if (sub == 6 && ENAB(6)) {
      EpiArgs ea{}; ea.cb = Hb; ea.ldc = DFF;
      gemm_phase<2>(XN, DM, (const bf16_t*)(ws + WS_WUP) + (size_t)layer * 4096 * 1024, 1024, TA, 4096, ea, smem);
    } else if (sub == 7 && ENAB(7)) {
      EpiArgs ea{}; ea.yout = Y; ea.res0 = Y; ea.res1 = nullptr;
      gemm_phase<1>(Hb, DFF, (const bf16_t*)(ws + WS_WDN) + (size_t)layer * 1024 * 4096, 4096, TA, 1024, ea, smem);
    } else if (sub == 8) {
      for (int r = gw; r < TA; r += ngw) norm_row(Y + (size_t)r * DM, p.in[9] + (layer + 1) * DM, XN + (size_t)r * DM, lane);
    }
  }
}

extern "C" void kernel_launch(void* const* d_in, const int* in_sizes, int n_in, void* d_out, int out_size, void* d_ws, size_t ws_size, hipStream_t stream) {
  static int grid_blocks = 0;
  if (!grid_blocks) {
    int dev = 0, cus = 0, per_cu = 0;
    (void)hipGetDevice(&dev);
    (void)hipDeviceGetAttribute(&cus, hipDeviceAttributeMultiprocessorCount, dev);
    (void)hipOccupancyMaxActiveBlocksPerMultiprocessor(&per_cu, mk_fwd, 256, 0);
    if (per_cu > 2) per_cu = 2;
    if (per_cu < 1) per_cu = 1;
    grid_blocks = cus * per_cu;
    if (ws_size < WS_END) fprintf(stderr, "kernel_launch: workspace too small: %zu < %zu\n", ws_size, (size_t)WS_END);
  }
  (void)hipMemsetAsync((char*)d_ws + WS_CTR, 0, 4096, stream);
  KP p{};
  for (int i = 0; i < 27; ++i) p.in[i] = (const float*)d_in[i];
  p.out = (float*)d_out; p.ws = (unsigned char*)d_ws; p.ph_lo = 0; p.ph_hi = 37;
  void* args[] = {&p};
  hipError_t e = hipLaunchCooperativeKernel((void*)mk_fwd, dim3(grid_blocks), dim3(256), args, 0, stream);
  if (e != hipSuccess) fprintf(stderr, "cooperative launch failed: %s (grid %d)\n", hipGetErrorString(e), grid_blocks);
}
```

```cpp
#include <hip/hip_runtime.h>
#include <hip/hip_cooperative_groups.h>
#include <cstdio>
#include <cstdint>
namespace cg = cooperative_groups;

typedef unsigned short bf16_t;
typedef short bf16x8 __attribute__((ext_vector_type(8)));
typedef float f32x16 __attribute__((ext_vector_type(16)));
typedef float f32x4 __attribute__((ext_vector_type(4)));
typedef unsigned u4 __attribute__((ext_vector_type(4)));
typedef unsigned u2 __attribute__((ext_vector_type(2)));
#define DEVI __device__ __forceinline__
__device__ __forceinline__ u4 mk4(unsigned a, unsigned b, unsigned c, unsigned d) { u4 r; r.x = a; r.y = b; r.z = c; r.w = d; return r; }
__device__ __forceinline__ u2 mk2(unsigned a, unsigned b) { u2 r; r.x = a; r.y = b; return r; }
#define MFMA32(a, b, c) __builtin_amdgcn_mfma_f32_32x32x16_bf16((a), (b), (c), 0, 0, 0)
#define LDS_BARRIER() do { asm volatile("s_waitcnt lgkmcnt(0)" ::: "memory"); __builtin_amdgcn_s_barrier(); } while (0)
#define GLOAD16(dst, ptr) asm volatile("global_load_dwordx4 %0, %1, off" : "=&v"(dst) : "v"(ptr) : "memory")
#define VMWAIT(n) asm volatile("s_waitcnt vmcnt(" #n ")" ::: "memory")
#define MFMA16(a, b, c) __builtin_amdgcn_mfma_f32_16x16x32_bf16((a), (b), (c), 0, 0, 0)

constexpr int DM = 1024, TP = 16384, TS = 512, TA = TP + TS, DFF = 4096;
constexpr int NP_GDN = 3456, NP_SB = 1792, MQ_GDN = 3200, MQ_SB = 1536;
constexpr int NCHUNK = 264, NITEM = NCHUNK * 6;
constexpr float EPS = 1e-6f;
constexpr float LOG2E = 1.4426950408889634f;
constexpr size_t O_YP = 0, O_PGC = 17301504, O_PGS = 17315328, O_PSK = 17511936, O_PSV = 34289152, O_PMK = 51066368, O_PMV = 51328512,
                 O_SGC = 51590656, O_SGS = 51701248, O_SSK = 53274112, O_SSV = 53798400;
constexpr size_t WS_CTR = 0;
constexpr size_t WS_WIG = 4096;
constexpr size_t WS_WIS = WS_WIG + 2ull * 3456 * 1024 * 2;
constexpr size_t WS_WKV = WS_WIS + 2ull * 1792 * 1024 * 2;
constexpr size_t WS_WOG = WS_WKV + 4ull * 512 * 1024 * 2;
constexpr size_t WS_WOS = WS_WOG + 2ull * 1024 * 1024 * 2;
constexpr size_t WS_WUP = WS_WOS + 2ull * 1024 * 768 * 2;
constexpr size_t WS_WDN = WS_WUP + 4ull * 4096 * 1024 * 2;
constexpr size_t WS_XN = WS_WDN + 4ull * 4096 * 1024 * 2;
constexpr size_t WS_MIX = WS_XN + (size_t)TA * 1024 * 2;
constexpr size_t WS_MEMN = WS_MIX + (size_t)TA * 1024 * 2;
constexpr size_t WS_MEMKV = WS_MEMN + 4ull * 256 * 1024 * 2;
constexpr size_t WS_BIG = WS_MEMKV + 4ull * 256 * 512 * 4;
constexpr size_t WS_P = WS_BIG;
constexpr size_t WS_G = WS_P + (size_t)TA * 3456 * 2;
constexpr size_t G_ITEM = 73728;
constexpr size_t WS_GL = WS_G + (size_t)NITEM * G_ITEM;
constexpr size_t WS_H = WS_BIG;
constexpr size_t WS_END = WS_GL + 8192;

struct KP { const float* in[27]; float* out; unsigned char* ws; int ph_lo, ph_hi; };

DEVI int get_tid() { int t = __builtin_amdgcn_workitem_id_x(); asm volatile("" : "+v"(t)); return t; }
DEVI float bf2f(bf16_t b) { return __uint_as_float(((unsigned)b) << 16); }
typedef float f32x2_t __attribute__((ext_vector_type(2)));
typedef __bf16 bf16x2_t __attribute__((ext_vector_type(2)));
DEVI unsigned pk2(float lo, float hi) { f32x2_t v = {lo, hi}; return __builtin_bit_cast(unsigned, __builtin_convertvector(v, bf16x2_t)); }
DEVI bf16_t f2bf(float f) { return (bf16_t)(pk2(f, 0.f) & 0xffffu); }
DEVI float lo2f(unsigned u) { return __uint_as_float(u << 16); }
DEVI float hi2f(unsigned u) { return __uint_as_float(u & 0xffff0000u); }
DEVI float ex2(float x) { return __builtin_amdgcn_exp2f(x); }
DEVI float lg2(float x) { return __builtin_amdgcn_logf(x); }
DEVI float wave_sum(float v) {
#pragma unroll
  for (int o = 32; o >= 1; o >>= 1) v += __shfl_xor(v, o);
  return v;
}
DEVI bf16x8 as_frag(u4 u) { return __builtin_bit_cast(bf16x8, u); }
DEVI float silu(float y) { return y / (1.f + __expf(-y)); }

struct EpiArgs { bf16_t* cb; float* cf; int ldc; const float* res0; const float* res1; float* yout; };
template <int EPI>
DEVI void gemm_tile(const bf16_t* __restrict__ A, int lda, const bf16_t* __restrict__ Bt, int ldb, int K, int m0, int n0, const EpiArgs& ea, unsigned char* smem) {
  const int tid = get_tid(), lane = tid & 63, wave = tid >> 6;
  const int wm = wave >> 1, wn = wave & 1, l31 = lane & 31, lh = lane >> 5;
  bf16_t* sA = (bf16_t*)smem;
  bf16_t* sB = sA + 2 * 128 * 72;
  f32x16 acc[2][2];
#pragma unroll
  for (int i = 0; i < 2; ++i)
#pragma unroll
    for (int j = 0; j < 2; ++j)
#pragma unroll
      for (int r = 0; r < 16; ++r) acc[i][j][r] = 0.f;
  const int lr = tid >> 3, lc = (tid & 7) * 8;
  const bf16_t* gA = A + (size_t)(m0 + lr) * lda + lc;
  const bf16_t* gB = Bt + (size_t)(n0 + lr) * ldb + lc;
  u4 ra0[4], rb0[4], ra1[4], rb1[4];
#define G_ISSUE(RA, RB, K0) { _Pragma("unroll") for (int i = 0; i < 4; ++i) { GLOAD16(RA[i], gA + (size_t)i * 32 * lda + (K0)); GLOAD16(RB[i], gB + (size_t)i * 32 * ldb + (K0)); } }
#define G_STASH(RA, RB, BUF) { _Pragma("unroll") for (int i = 0; i < 4; ++i) { *(u4*)(sA + (BUF) * 128 * 72 + (lr + i * 32) * 72 + lc) = RA[i]; *(u4*)(sB + (BUF) * 128 * 72 + (lr + i * 32) * 72 + lc) = RB[i]; } }
#define G_COMPUTE(BUF) { const bf16_t* cA = sA + (BUF) * 128 * 72 + (wm * 64 + l31) * 72 + lh * 8; const bf16_t* cB = sB + (BUF) * 128 * 72 + (wn * 64 + l31) * 72 + lh * 8; \
    _Pragma("unroll") for (int ks = 0; ks < 4; ++ks) { \
      bf16x8 a0 = *(const bf16x8*)(cA + ks * 16), a1 = *(const bf16x8*)(cA + 32 * 72 + ks * 16); \
      bf16x8 b0 = *(const bf16x8*)(cB + ks * 16), b1 = *(const bf16x8*)(cB + 32 * 72 + ks * 16); \
      acc[0][0] = MFMA32(a0, b0, acc[0][0]); acc[0][1] = MFMA32(a0, b1, acc[0][1]); \
      acc[1][0] = MFMA32(a1, b0, acc[1][0]); acc[1][1] = MFMA32(a1, b1, acc[1][1]); } }
  const int nk = K >> 6;
  VMWAIT(0);
  G_ISSUE(ra0, rb0, 0);
  G_ISSUE(ra1, rb1, 64);
  __syncthreads();
  VMWAIT(8);
  G_STASH(ra0, rb0, 0);
  LDS_BARRIER();
  for (int kt = 0; kt < nk; kt += 2) {
    G_ISSUE(ra0, rb0, ((kt + 2 < nk) ? kt + 2 : nk - 1) << 6);
    G_COMPUTE(0);
    VMWAIT(8);
    G_STASH(ra1, rb1, 1);
    LDS_BARRIER();
    G_ISSUE(ra1, rb1, ((kt + 3 < nk) ? kt + 3 : nk - 1) << 6);
    G_COMPUTE(1);
    VMWAIT(8);
    if (kt + 2 < nk) G_STASH(ra0, rb0, 0);
    LDS_BARRIER();
  }
  VMWAIT(0);
#pragma unroll
  for (int i = 0; i < 4; ++i) asm volatile("" :: "v"(ra0[i]), "v"(rb0[i]), "v"(ra1[i]), "v"(rb1[i]));
#undef G_ISSUE
#undef G_STASH
#undef G_COMPUTE
#pragma unroll
  for (int i = 0; i < 2; ++i)
#pragma unroll
    for (int r = 0; r < 16; ++r) {
      const int row = m0 + wm * 64 + i * 32 + (r >> 2) * 8 + lh * 4 + (r & 3);
#pragma unroll
      for (int j = 0; j < 2; ++j) {
        const int col = n0 + wn * 64 + j * 32 + l31;
        const float v = acc[i][j][r];
        if (EPI == 0) ea.cb[(size_t)row * ea.ldc + col] = f2bf(v);
        else if (EPI == 1) {
          const float* rp = ea.res1 ? (row < TP ? ea.res0 + (size_t)row * DM : ea.res1 + (size_t)(row - TP) * DM) : ea.res0 + (size_t)row * DM;
          ea.yout[(size_t)row * DM + col] = rp[col] + v;
        } else if (EPI == 2) { const float rl = v > 0.f ? v : 0.f; ea.cb[(size_t)row * ea.ldc + col] = f2bf(rl * rl); }
        else ea.cf[(size_t)row * ea.ldc + col] = v;
      }
    }
}
template <int EPI>
DEVI void gemm_phase(const bf16_t* A, int lda, const bf16_t* Bt, int K, int M, int N, const EpiArgs& ea, unsigned char* smem) {
  const int nM = M >> 7, nN = N >> 7, nwg = nM * nN;
  const int q = nwg >> 3, r = nwg & 7;
  for (int L = blockIdx.x; L < nwg; L += gridDim.x) {
    const int xcd = L & 7, off = L >> 3;
    const int wg = (xcd < r ? xcd * (q + 1) : r * (q + 1) + (xcd - r) * q) + off;
    const int nig = 8 * nN, gid = wg / nig, fm = gid * 8, gsz = (nM - fm) < 8 ? (nM - fm) : 8;
    const int pm = fm + ((wg % nig) % gsz), pn = (wg % nig) / gsz;
    gemm_tile<EPI>(A, lda, Bt, K, K, pm << 7, pn << 7, ea, smem);
  }
}

DEVI void convert_tile(const float* __restrict__ W, bf16_t* __restrict__ Wt, int K, int N, int k0, int n0, int thr, int shift, unsigned char* smem) {
  float* tile = (float*)smem;
  const int tid = get_tid();
  __syncthreads();
#pragma unroll
  for (int i = 0; i < 4; ++i) {
    const int r = (tid >> 4) + 16 * i, c = (tid & 15) * 4;
    float4 v = make_float4(0.f, 0.f, 0.f, 0.f);
    if (n0 + c < N) v = *(const float4*)(W + (size_t)(k0 + r) * N + n0 + c);
    tile[r * 65 + c] = v.x; tile[r * 65 + c + 1] = v.y; tile[r * 65 + c + 2] = v.z; tile[r * 65 + c + 3] = v.w;
  }
  __syncthreads();
  const int n = tid >> 2, kc = (tid & 3) * 16;
  if (n0 + n < N) {
    const int nn = n0 + n, nd = nn + (nn >= thr ? shift : 0);
    unsigned o[8];
#pragma unroll
    for (int e = 0; e < 8; ++e) o[e] = pk2(tile[(kc + 2 * e) * 65 + n], tile[(kc + 2 * e + 1) * 65 + n]);
    u4* dst = (u4*)(Wt + (size_t)nd * K + k0 + kc);
    dst[0] = mk4(o[0], o[1], o[2], o[3]); dst[1] = mk4(o[4], o[5], o[6], o[7]);
  }
}
DEVI void convert_group(int& base, int bid, int nb, const float* W, bf16_t* Wt, int nl, int K, int N, int NPAD, int thr, int shift, unsigned char* smem) {
  const int tk = K >> 6, tn = (N + 63) >> 6, per = tk * tn, tot = per * nl;
  int first = ((bid - base) % nb + nb) % nb;
  for (int t = first; t < tot; t += nb) {
    const int l = t / per, r = t % per;
    convert_tile(W + (size_t)l * K * N, Wt + (size_t)l * NPAD * K, K, N, (r / tn) << 6, (r % tn) << 6, thr, shift, smem);
  }
  base += tot;
}

DEVI void norm_row(const float* __restrict__ src, const float* __restrict__ gain, bf16_t* __restrict__ dst, int lane) {
  float4 v[4]; float ss = 0.f;
#pragma unroll
  for (int i = 0; i < 4; ++i) { v[i] = *(const float4*)(src + lane * 4 + 256 * i); ss += v[i].x * v[i].x + v[i].y * v[i].y + v[i].z * v[i].z + v[i].w * v[i].w; }
  ss = wave_sum(ss);
  const float sc = rsqrtf(ss * (1.f / 1024.f) + EPS);
#pragma unroll
  for (int i = 0; i < 4; ++i) {
    const float4 g = *(const float4*)(gain + lane * 4 + 256 * i);
    u2 o; o.x = pk2(v[i].x * sc * g.x, v[i].y * sc * g.y); o.y = pk2(v[i].z * sc * g.z, v[i].w * sc * g.w);
    *(u2*)(dst + lane * 4 + 256 * i) = o;
  }
}

DEVI void norm_row2(const float* __restrict__ s0, const float* __restrict__ s1, const float* __restrict__ gain, bf16_t* __restrict__ d0, bf16_t* __restrict__ d1, int lane) {
  float4 v[4], w[4]; float ss = 0.f, tt = 0.f;
#pragma unroll
  for (int i = 0; i < 4; ++i) { v[i] = *(const float4*)(s0 + lane * 4 + 256 * i); w[i] = *(const float4*)(s1 + lane * 4 + 256 * i); }
#pragma unroll
  for (int i = 0; i < 4; ++i) { ss += v[i].x * v[i].x + v[i].y * v[i].y + v[i].z * v[i].z + v[i].w * v[i].w; tt += w[i].x * w[i].x + w[i].y * w[i].y + w[i].z * w[i].z + w[i].w * w[i].w; }
#pragma unroll
  for (int o = 32; o >= 1; o >>= 1) { ss += __shfl_xor(ss, o); tt += __shfl_xor(tt, o); }
  const float sc = rsqrtf(ss * (1.f / 1024.f) + EPS), tc = rsqrtf(tt * (1.f / 1024.f) + EPS);
#pragma unroll
  for (int i = 0; i < 4; ++i) {
    const float4 g = *(const float4*)(gain + lane * 4 + 256 * i);
    u2 o; o.x = pk2(v[i].x * sc * g.x, v[i].y * sc * g.y); o.y = pk2(v[i].z * sc * g.z, v[i].w * sc * g.w);
    *(u2*)(d0 + lane * 4 + 256 * i) = o;
    u2 q; q.x = pk2(w[i].x * tc * g.x, w[i].y * tc * g.y); q.y = pk2(w[i].z * tc * g.z, w[i].w * tc * g.w);
    *(u2*)(d1 + lane * 4 + 256 * i) = q;
  }
}
DEVI void norm_all(const float* __restrict__ Y, const float* __restrict__ gain, bf16_t* __restrict__ XN, int gw, int ngw, int lane) {
  for (int r = gw; r < TA; r += ngw) norm_row(Y + (size_t)r * DM, gain, XN + (size_t)r * DM, lane);
}

struct KVSrc { const void* k; const void* v; int kpitch, vpitch, f32; };
template <int D>
DEVI void attn_load(const KVSrc& s, int r0, u4 (&kr)[D / 32], u4 (&vr)[D / 32]) {
  const int tid = get_tid();
#pragma unroll
  for (int i = 0; i < D / 32; ++i) {
    const int c = tid + 256 * i, key = c / (D / 8), dch = c % (D / 8);
    if (s.f32) {
      const float* kp = (const float*)s.k + (size_t)(r0 + key) * s.kpitch + dch * 8;
      const float* vp = (const float*)s.v + (size_t)(r0 + key) * s.vpitch + dch * 8;
      const float4 a = *(const float4*)kp, b = *(const float4*)(kp + 4), c2 = *(const float4*)vp, d2 = *(const float4*)(vp + 4);
      kr[i] = mk4(pk2(a.x, a.y), pk2(a.z, a.w), pk2(b.x, b.y), pk2(b.z, b.w));
      vr[i] = mk4(pk2(c2.x, c2.y), pk2(c2.z, c2.w), pk2(d2.x, d2.y), pk2(d2.z, d2.w));
    } else {
      kr[i] = *(const u4*)((const bf16_t*)s.k + (size_t)(r0 + key) * s.kpitch + dch * 8);
      vr[i] = *(const u4*)((const bf16_t*)s.v + (size_t)(r0 + key) * s.vpitch + dch * 8);
    }
  }
}
template <int D>
DEVI void attn_store(bf16_t* Ks, bf16_t* Vt, const u4 (&kr)[D / 32], const u4 (&vr)[D / 32]) {
  const int tid = get_tid();
#pragma unroll
  for (int i = 0; i < D / 32; ++i) {
    const int c = tid + 256 * i, key = c / (D / 8), dch = c % (D / 8);
    *(u4*)(Ks + key * (D + 8) + dch * 8) = kr[i];
    const int kx = key ^ ((dch & 15) << 2);
    const unsigned w[4] = {vr[i].x, vr[i].y, vr[i].z, vr[i].w};
#pragma unroll
    for (int e = 0; e < 8; ++e) Vt[(dch * 8 + e) * 72 + kx] = (bf16_t)((w[e >> 1] >> (16 * (e & 1))) & 0xffffu);
  }
}

template <int D, int MODE>
DEVI void attn_item(const bf16_t* __restrict__ qsrc, int qpitch, int nq, const float* __restrict__ qgain, float qscale,
                    const KVSrc& segA, int nA, int qposA0, int maskA, const KVSrc& segB, int nB,
                    bf16_t* __restrict__ out, int opitch, unsigned char* smem) {
  constexpr int KPT = D + 8, NKS = D / 16, NDB = D / 32, NCH = D / 32;
  constexpr int STAGE = 64 * KPT + D * 72;
  const int tid = get_tid(), lane = tid & 63, wave = tid >> 6, l31 = lane & 31, lh = lane >> 5;
  bf16_t* sbase = (bf16_t*)smem;
  const bool active = wave * 32 < nq;
  bf16x8 qf[NKS];
  {
    float qv[NKS][8]; float ss = 0.f;
    const bf16_t* qp = qsrc + (size_t)(wave * 32 + l31) * qpitch + lh * 8;
#pragma unroll
    for (int ks = 0; ks < NKS; ++ks) {
      u4 u = mk4(0, 0, 0, 0);
      if (active) u = *(const u4*)(qp + ks * 16);
      const unsigned w[4] = {u.x, u.y, u.z, u.w};
#pragma unroll
      for (int e = 0; e < 4; ++e) { qv[ks][2 * e] = lo2f(w[e]); qv[ks][2 * e + 1] = hi2f(w[e]); }
#pragma unroll
      for (int e = 0; e < 8; ++e) ss += qv[ks][e] * qv[ks][e];
    }
    ss += __shfl_xor(ss, 32);
    const float sc = rsqrtf(ss * (1.f / D) + EPS) * qscale;
#pragma unroll
    for (int ks = 0; ks < NKS; ++ks) {
      const float4 g0 = *(const float4*)(qgain + ks * 16 + lh * 8), g1 = *(const float4*)(qgain + ks * 16 + lh * 8 + 4);
      u4 u;
      u.x = pk2(qv[ks][0] * sc * g0.x, qv[ks][1] * sc * g0.y); u.y = pk2(qv[ks][2] * sc * g0.z, qv[ks][3] * sc * g0.w);
      u.z = pk2(qv[ks][4] * sc * g1.x, qv[ks][5] * sc * g1.y); u.w = pk2(qv[ks][6] * sc * g1.z, qv[ks][7] * sc * g1.w);
      qf[ks] = as_frag(u);
    }
  }
  f32x16 oacc[NDB];
#pragma unroll
  for (int db = 0; db < NDB; ++db)
#pragma unroll
    for (int r = 0; r < 16; ++r) oacc[db][r] = 0.f;
  float carry = 0.f, mx = -1e30f, lsum = 0.f;
  const int ntot = nA + nB;
  const int qpos = qposA0 + wave * 32 + l31;
  u4 kr[NCH], vr[NCH];
  {
    const bool inA = 0 < nA; const int tix = inA ? nA - 1 : nB - 1;
    attn_load<D>(inA ? segA : segB, tix * 64, kr, vr);
    __syncthreads();
    attn_store<D>(sbase, sbase + 64 * KPT, kr, vr);
    __syncthreads();
  }
  for (int it = 0; it < ntot; ++it) {
    const int cur = it & 1;
    if (it + 1 < ntot) {
      const bool nInA = (it + 1) < nA; const int tix = nInA ? nA - 2 - it : nB - 1 - (it + 1 - nA);
      attn_load<D>(nInA ? segA : segB, tix * 64, kr, vr);
    }
    const bool inA = it < nA;
    const int kbase = inA ? (nA - 1 - it) * 64 : 0;
    const bf16_t* Ks = sbase + cur * STAGE;
    const bf16_t* Vt = Ks + 64 * KPT;
    const bool mneed = inA && maskA && (kbase + 63 >= qposA0 + wave * 32);
    const bool skip = !active || (inA && maskA && (kbase > qposA0 + wave * 32 + 31));
    if (!skip) {
      bf16x8 pf[2][2];
      if (MODE == 0) {
        float after = carry;
#pragma unroll
        for (int rt = 1; rt >= 0; --rt) {
          f32x16 z;
#pragma unroll
          for (int r = 0; r < 16; ++r) z[r] = 0.f;
#pragma unroll
          for (int ks = 0; ks < NKS; ++ks) {
            const bf16x8 a = *(const bf16x8*)(Ks + (rt * 32 + l31) * KPT + ks * 16 + lh * 8);
            z = MFMA32(a, qf[ks], z);
          }
          float m[16];
#pragma unroll
          for (int i = 0; i < 16; ++i) {
            float mm = lg2(1.f + ex2(z[i]));
            if (mneed) { const int key = kbase + rt * 32 + (i >> 2) * 8 + lh * 4 + (i & 3); if (key >= qpos) mm = 0.f; }
            m[i] = mm;
          }
          float a_[16];
#pragma unroll
          for (int g = 3; g >= 0; --g) {
            const float s4 = (m[g * 4] + m[g * 4 + 1]) + (m[g * 4 + 2] + m[g * 4 + 3]);
            const float p4 = __shfl_xor(s4, 32);
            float c = after + (lh == 0 ? p4 : 0.f);
            after += s4 + p4;
#pragma unroll
            for (int e = 3; e >= 0; --e) {
              c += m[g * 4 + e];
              float av = ex2(z[g * 4 + e] - c);
              if (mneed) { const int key = kbase + rt * 32 + g * 8 + lh * 4 + e; if (key >= qpos) av = 0.f; }
              a_[g * 4 + e] = av;
            }
          }
#pragma unroll
          for (int s2 = 0; s2 < 2; ++s2)
            pf[rt][s2] = as_frag(mk4(pk2(a_[8 * s2 + 0], a_[8 * s2 + 1]), pk2(a_[8 * s2 + 2], a_[8 * s2 + 3]), pk2(a_[8 * s2 + 4], a_[8 * s2 + 5]), pk2(a_[8 * s2 + 6], a_[8 * s2 + 7])));
        }
        carry = after;
      } else {
        f32x16 z[2];
#pragma unroll
        for (int rt = 0; rt < 2; ++rt) {
          f32x16 zt;
#pragma unroll
          for (int r = 0; r < 16; ++r) zt[r] = 0.f;
#pragma unroll
          for (int ks = 0; ks < NKS; ++ks) {
            const bf16x8 a = *(const bf16x8*)(Ks + (rt * 32 + l31) * KPT + ks * 16 + lh * 8);
            zt = MFMA32(a, qf[ks], zt);
          }
          z[rt] = zt;
        }
        float tm = z[0][0];
#pragma unroll
        for (int rt = 0; rt < 2; ++rt)
#pragma unroll
          for (int i = 0; i < 16; ++i) tm = fmaxf(tm, z[rt][i]);
        tm = fmaxf(tm, __shfl_xor(tm, 32));
        const float nm = fmaxf(mx, tm);
        const float alpha = ex2(mx - nm);
        mx = nm;
        float ps = 0.f;
        float a_[2][16];
#pragma unroll
        for (int rt = 0; rt < 2; ++rt)
#pragma unroll
          for (int i = 0; i < 16; ++i) { a_[rt][i] = ex2(z[rt][i] - nm); ps += a_[rt][i]; }
        lsum = lsum * alpha + ps;
#pragma unroll
        for (int db = 0; db < NDB; ++db)
#pragma unroll
          for (int r = 0; r < 16; ++r) oacc[db][r] *= alpha;
#pragma unroll
        for (int rt = 0; rt < 2; ++rt)
#pragma unroll
          for (int s2 = 0; s2 < 2; ++s2)
            pf[rt][s2] = as_frag(mk4(pk2(a_[rt][8 * s2 + 0], a_[rt][8 * s2 + 1]), pk2(a_[rt][8 * s2 + 2], a_[rt][8 * s2 + 3]), pk2(a_[rt][8 * s2 + 4], a_[rt][8 * s2 + 5]), pk2(a_[rt][8 * s2 + 6], a_[rt][8 * s2 + 7])));
      }
#pragma unroll
      for (int db = 0; db < NDB; ++db) {
        const int d = db * 32 + l31, sw = ((d >> 3) & 15) << 2;
#pragma unroll
        for (int rt = 0; rt < 2; ++rt)
#pragma unroll
          for (int s = 0; s < 2; ++s) {
            const int kb0 = rt * 32 + 16 * s + 4 * lh;
            const u2 lo = *(const u2*)(Vt + d * 72 + (kb0 ^ sw));
            const u2 hi = *(const u2*)(Vt + d * 72 + ((kb0 + 8) ^ sw));
            oacc[db] = MFMA32(as_frag(mk4(lo.x, lo.y, hi.x, hi.y)), pf[rt][s], oacc[db]);
          }
      }
    }
    if (it + 1 < ntot) { bf16_t* nK = sbase + (cur ^ 1) * STAGE; attn_store<D>(nK, nK + 64 * KPT, kr, vr); }
    LDS_BARRIER();
  }
  if (active) {
    float inv = 1.f;
    if (MODE == 1) { const float l = lsum + __shfl_xor(lsum, 32); inv = 1.f / l; }
    bf16_t* op = out + (size_t)(wave * 32 + l31) * opitch + lh * 4;
#pragma unroll
    for (int db = 0; db < NDB; ++db)
#pragma unroll
      for (int g = 0; g < 4; ++g) {
        u2 o; o.x = pk2(oacc[db][g * 4] * inv, oacc[db][g * 4 + 1] * inv); o.y = pk2(oacc[db][g * 4 + 2] * inv, oacc[db][g * 4 + 3] * inv);
        *(u2*)(op + db * 32 + g * 8) = o;
      }
  }
}

DEVI void mem_attn_item(const KP& p, int layer, int item, const bf16_t* P, int np, int mqoff, bf16_t* mix, int mixp, int mixoff, unsigned char* smem) {
  const int h = item & 3;
  int t0, nq; const float *kk, *vv;
  if (item < 512) { t0 = (item >> 2) * 128; nq = 128; kk = p.out + O_PMK + (size_t)layer * 65536; vv = p.out + O_PMV + (size_t)layer * 65536; }
  else { const int b = (item - 512) >> 2; t0 = TP + b * 64; nq = 64; kk = p.in[6] + ((size_t)layer * 8 + b) * 65536; vv = p.in[7] + ((size_t)layer * 8 + b) * 65536; }
  KVSrc s; s.k = kk + h * 64; s.v = vv + h * 64; s.kpitch = 256; s.vpitch = 256; s.f32 = 1;
  attn_item<64, 1>(P + (size_t)t0 * np + mqoff + h * 64, np, nq, p.in[15] + layer * 64, 0.125f * LOG2E, s, 4, 0, 0, s, 0,
                   mix + (size_t)t0 * mixp + mixoff + h * 64, mixp, smem);
}

DEVI void gdn_prep_item(const KP& p, int j, int ci, int h, const bf16_t* P, unsigned char* smem) {
  constexpr int NP = NP_GDN;
  const int tid = get_tid(), lane = tid & 63, wave = tid >> 6;
  const int item = ci * 6 + h;
  const bool samp = ci >= 256;
  const int b = ci - 256;
  const int t0 = samp ? TP + b * 64 : ci * 64;
  float* stage = (float*)smem;
  float* sL = (float*)smem;
  bf16_t* qn = (bf16_t*)(smem + 33280);
  bf16_t* kn = qn + 64 * 136;
  float* sgc = (float*)(smem + 33280 + 2 * 64 * 136 * 2);
  float* sbeta = sgc + 64;
  float* segc = sbeta + 64;
  unsigned char* gi = p.ws + WS_G + (size_t)item * G_ITEM;
  bf16_t* gU = (bf16_t*)gi; bf16_t* gW = gU + 8192; bf16_t* gQD = gW + 8192; bf16_t* gKDT = gQD + 8192; bf16_t* gAI = gKDT + 8192;
  const float* convw = p.in[17] + (size_t)j * 4 * 2304;
  const float* cstate = p.in[2] + ((size_t)j * 8 + (samp ? b : 0)) * 3 * 2304;
  const bf16_t* Pc = P + (size_t)t0 * NP;
  __syncthreads();
  if (wave == 0) {
    const float braw = bf2f(Pc[(size_t)lane * NP + 3072 + h]), araw = bf2f(Pc[(size_t)lane * NP + 3078 + h]);
    const float beta = 1.f / (1.f + expf(-braw));
    const float xx = araw + p.in[19][j * 6 + h];
    const float sp = xx > 20.f ? xx : log1pf(expf(xx));
    float g = -expf(p.in[18][j * 6 + h]) * sp;
#pragma unroll
    for (int d = 1; d < 64; d <<= 1) { const float v = __shfl_up(g, d); if (lane >= d) g += v; }
    sgc[lane] = g; sbeta[lane] = beta; segc[lane] = expf(g);
    if (lane == 63) ((float*)(p.ws + WS_GL))[item] = expf(g);
  }
  if (samp || ci == 255) {
    float* dst = samp ? p.out + O_SGC + ((size_t)j * 8 + b) * 3 * 2304 : p.out + O_PGC + (size_t)j * 3 * 2304;
    for (int idx = tid; idx < 1152; idx += 256) {
      const int r = idx / 384, cc = idx % 384, ch = (cc >> 7) * 768 + h * 128 + (cc & 127);
      dst[r * 2304 + ch] = bf2f(Pc[(size_t)(61 + r) * NP + ch]);
    }
  }
  const float gcl_dummy = 0.f; (void)gcl_dummy;
#pragma unroll 1
  for (int which = 0; which < 2; ++which) {
    {
      const int c = tid & 127, th = tid >> 7, ch = which * 768 + h * 128 + c;
      const float w0 = convw[ch], w1 = convw[2304 + ch], w2 = convw[2 * 2304 + ch], w3 = convw[3 * 2304 + ch];
      float xm3, xm2, xm1;
      if (th == 1) { xm3 = bf2f(Pc[(size_t)29 * NP + ch]); xm2 = bf2f(Pc[(size_t)30 * NP + ch]); xm1 = bf2f(Pc[(size_t)31 * NP + ch]); }
      else if (samp) { xm3 = cstate[ch]; xm2 = cstate[2304 + ch]; xm1 = cstate[2 * 2304 + ch]; }
      else if (ci == 0) { xm3 = xm2 = xm1 = 0.f; }
      else { xm3 = bf2f(Pc[-(ptrdiff_t)3 * NP + ch]); xm2 = bf2f(Pc[-(ptrdiff_t)2 * NP + ch]); xm1 = bf2f(Pc[-(ptrdiff_t)NP + ch]); }
      const bf16_t* pp = Pc + (size_t)(th * 32) * NP + ch;
#pragma unroll 8
      for (int tt = 0; tt < 32; ++tt) {
        const float x0 = bf2f(pp[(size_t)tt * NP]);
        const float y = w0 * xm3 + w1 * xm2 + w2 * xm1 + w3 * x0;
        stage[(th * 32 + tt) * 129 + c] = silu(y);
        xm3 = xm2; xm2 = xm1; xm1 = x0;
      }
    }
    __syncthreads();
    {
      const int tt = tid >> 2, part = tid & 3;
      float v[32]; float ss = 0.f;
#pragma unroll
      for (int e = 0; e < 32; ++e) { v[e] = stage[tt * 129 + part * 32 + e]; ss += v[e] * v[e]; }
      ss += __shfl_xor(ss, 1); ss += __shfl_xor(ss, 2);
      float rinv = rsqrtf(ss + EPS);
      if (which == 0) rinv *= 0.08838834764831845f;
      bf16_t* dn = (which == 0 ? qn : kn) + tt * 136 + part * 32;
      const float eg = segc[tt];
#pragma unroll
      for (int e = 0; e < 32; e += 8) {
        u4 u; u.x = pk2(v[e] * rinv, v[e + 1] * rinv); u.y = pk2(v[e + 2] * rinv, v[e + 3] * rinv); u.z = pk2(v[e + 4] * rinv, v[e + 5] * rinv); u.w = pk2(v[e + 6] * rinv, v[e + 7] * rinv);
        *(u4*)(dn + e) = u;
        if (which == 0) {
          const float s2 = rinv * eg;
          u4 w; w.x = pk2(v[e] * s2, v[e + 1] * s2); w.y = pk2(v[e + 2] * s2, v[e + 3] * s2); w.z = pk2(v[e + 4] * s2, v[e + 5] * s2); w.w = pk2(v[e + 6] * s2, v[e + 7] * s2);
          *(u4*)(gQD + tt * 128 + part * 32 + e) = w;
        }
      }
    }
    __syncthreads();
  }
  {
    const int d = tid & 127, th = tid >> 7;
    const float gcl = sgc[63];
#pragma unroll
    for (int q8 = 0; q8 < 4; ++q8) {
      float f[8];
#pragma unroll
      for (int e = 0; e < 8; ++e) { const int tt = th * 32 + q8 * 8 + e; f[e] = bf2f(kn[tt * 136 + d]) * expf(gcl - sgc[tt]); }
      *(u4*)(gKDT + d * 64 + th * 32 + q8 * 8) = mk4(pk2(f[0], f[1]), pk2(f[2], f[3]), pk2(f[4], f[5]), pk2(f[6], f[7]));
    }
  }
  {
    const int l31 = lane & 31, lh = lane >> 5, ri = wave >> 1, cj = wave & 1;
    f32x16 kk, qk;
#pragma unroll
    for (int r = 0; r < 16; ++r) { kk[r] = 0.f; qk[r] = 0.f; }
#pragma unroll
    for (int ks = 0; ks < 8; ++ks) {
      const bf16x8 ak = *(const bf16x8*)(kn + (ri * 32 + l31) * 136 + ks * 16 + lh * 8);
      const bf16x8 aq = *(const bf16x8*)(qn + (ri * 32 + l31) * 136 + ks * 16 + lh * 8);
      const bf16x8 bk = *(const bf16x8*)(kn + (cj * 32 + l31) * 136 + ks * 16 + lh * 8);
      kk = MFMA32(ak, bk, kk); qk = MFMA32(aq, bk, qk);
    }
    const int jj = cj * 32 + l31; const float gj = sgc[jj];
#pragma unroll
    for (int r = 0; r < 16; ++r) {
      const int ii = ri * 32 + (r >> 2) * 8 + lh * 4 + (r & 3);
      const float dec = ii >= jj ? expf(sgc[ii] - gj) : 0.f;
      sL[ii * 64 + jj] = ii > jj ? sbeta[ii] * kk[r] * dec : 0.f;
      gAI[ii * 64 + jj] = f2bf(qk[r] * dec);
    }
  }
  __syncthreads();
  {
    float x[64];
    if (tid < 128) {
      const int ch = 1536 + h * 128 + tid;
      const float w0 = convw[ch], w1 = convw[2304 + ch], w2 = convw[2 * 2304 + ch], w3 = convw[3 * 2304 + ch];
      float xm3, xm2, xm1;
      if (samp) { xm3 = cstate[ch]; xm2 = cstate[2304 + ch]; xm1 = cstate[2 * 2304 + ch]; }
      else if (ci == 0) { xm3 = xm2 = xm1 = 0.f; }
      else { xm3 = bf2f(Pc[-(ptrdiff_t)3 * NP + ch]); xm2 = bf2f(Pc[-(ptrdiff_t)2 * NP + ch]); xm1 = bf2f(Pc[-(ptrdiff_t)NP + ch]); }
#pragma unroll
      for (int tt = 0; tt < 64; ++tt) {
        const float x0 = bf2f(Pc[(size_t)tt * NP + ch]);
        const float y = w0 * xm3 + w1 * xm2 + w2 * xm1 + w3 * x0;
        x[tt] = silu(y) * sbeta[tt];
        xm3 = xm2; xm2 = xm1; xm1 = x0;
        if ((tt & 7) == 7) __builtin_amdgcn_sched_barrier(0);
      }
    } else {
#pragma unroll
      for (int tt = 0; tt < 64; ++tt) { x[tt] = bf2f(kn[tt * 136 + tid - 128]) * sbeta[tt] * segc[tt]; if ((tt & 7) == 7) __builtin_amdgcn_sched_barrier(0); }
    }
#pragma unroll
    for (int i = 1; i < 64; ++i) {
      float a = x[i];
#pragma unroll
      for (int jx = 0; jx < i; ++jx) a -= sL[i * 64 + jx] * x[jx];
      x[i] = a;
      __builtin_amdgcn_sched_barrier(0);
    }
    bf16_t* dst = (tid < 128 ? gU : gW) + (tid & 127);
#pragma unroll
    for (int tt = 0; tt < 64; ++tt) { dst[tt * 128] = f2bf(x[tt]); if ((tt & 7) == 7) __builtin_amdgcn_sched_barrier(0); }
  }
}

struct ScanFrags { u4 w[4], qd[4], ai[2], kdt[2][2]; unsigned u01, u23; float gl; };
DEVI void scan_load(const KP& p, int item, int wave, int lane, int sl, ScanFrags& f) {
  const int n = lane & 15, g = lane >> 4;
  const unsigned char* gi = p.ws + WS_G + (size_t)item * G_ITEM;
  const bf16_t* gU = (const bf16_t*)gi; const bf16_t* gW = gU + 8192; const bf16_t* gQD = gW + 8192; const bf16_t* gKDT = gQD + 8192; const bf16_t* gAI = gKDT + 8192;
#pragma unroll
  for (int s = 0; s < 4; ++s) { f.w[s] = *(const u4*)(gW + (16 * wave + n) * 128 + 32 * s + 8 * g); f.qd[s] = *(const u4*)(gQD + (16 * wave + n) * 128 + 32 * s + 8 * g); }
#pragma unroll
  for (int s = 0; s < 2; ++s) {
    f.ai[s] = *(const u4*)(gAI + (16 * wave + n) * 64 + 32 * s + 8 * g);
#pragma unroll
    for (int tt = 0; tt < 2; ++tt) f.kdt[tt][s] = *(const u4*)(gKDT + (32 * wave + 16 * tt + n) * 64 + 32 * s + 8 * g);
  }
  const bf16_t* up = gU + (16 * wave + 4 * g) * 128 + sl * 16 + n;
  f.u01 = (unsigned)up[0] | ((unsigned)up[128] << 16);
  f.u23 = (unsigned)up[256] | ((unsigned)up[384] << 16);
  f.gl = ((const float*)(p.ws + WS_GL))[item];
}
DEVI void scan_step(const ScanFrags& f, f32x4 (&sacc)[2], bf16_t* St, bf16_t* Vnt, bf16_t* O, int t0, int h, int sl, int wave, int n, int g) {
  bf16x8 sf[4];
#pragma unroll
  for (int s = 0; s < 4; ++s) sf[s] = *(const bf16x8*)(St + n * 136 + 32 * s + 8 * g);
  f32x4 wsa = {0.f, 0.f, 0.f, 0.f}, oa = {0.f, 0.f, 0.f, 0.f};
#pragma unroll
  for (int s = 0; s < 4; ++s) wsa = MFMA16(as_frag(f.w[s]), sf[s], wsa);
  float vn[4];
  vn[0] = lo2f(f.u01) - wsa[0]; vn[1] = hi2f(f.u01) - wsa[1]; vn[2] = lo2f(f.u23) - wsa[2]; vn[3] = hi2f(f.u23) - wsa[3];
  { u2 o; o.x = pk2(vn[0], vn[1]); o.y = pk2(vn[2], vn[3]); *(u2*)(Vnt + n * 72 + 16 * wave + 4 * g) = o; }
#pragma unroll
  for (int s = 0; s < 4; ++s) oa = MFMA16(as_frag(f.qd[s]), sf[s], oa);
  LDS_BARRIER();
  bf16x8 vf[2];
#pragma unroll
  for (int s = 0; s < 2; ++s) vf[s] = *(const bf16x8*)(Vnt + n * 72 + 32 * s + 8 * g);
#pragma unroll
  for (int s = 0; s < 2; ++s) oa = MFMA16(as_frag(f.ai[s]), vf[s], oa);
#pragma unroll
  for (int r = 0; r < 4; ++r) O[(size_t)(t0 + 16 * wave + 4 * g + r) * 768 + h * 128 + sl * 16 + n] = f2bf(oa[r]);
#pragma unroll
  for (int tt = 0; tt < 2; ++tt) {
#pragma unroll
    for (int r = 0; r < 4; ++r) sacc[tt][r] *= f.gl;
#pragma unroll
    for (int s = 0; s < 2; ++s) sacc[tt] = MFMA16(as_frag(f.kdt[tt][s]), vf[s], sacc[tt]);
    u2 o; o.x = pk2(sacc[tt][0], sacc[tt][1]); o.y = pk2(sacc[tt][2], sacc[tt][3]);
    *(u2*)(St + n * 136 + 32 * wave + 16 * tt + 4 * g) = o;
  }
  LDS_BARRIER();
}
DEVI void gdn_scan_stream(const KP& p, int j, int ci0, int nch, int h, int sl, const float* s0, float* sout, bf16_t* O, unsigned char* smem) {
  const int tid = get_tid(), lane = tid & 63, wave = tid >> 6, n = lane & 15, g = lane >> 4;
  bf16_t* St = (bf16_t*)smem;
  bf16_t* Vnt = St + 16 * 136;
  f32x4 sacc[2];
#pragma unroll
  for (int tt = 0; tt < 2; ++tt)
#pragma unroll
    for (int r = 0; r < 4; ++r) sacc[tt][r] = s0 ? s0[(size_t)(32 * wave + 16 * tt + 4 * g + r) * 128 + sl * 16 + n] : 0.f;
  __syncthreads();
#pragma unroll
  for (int tt = 0; tt < 2; ++tt) { u2 o; o.x = pk2(sacc[tt][0], sacc[tt][1]); o.y = pk2(sacc[tt][2], sacc[tt][3]); *(u2*)(St + n * 136 + 32 * wave + 16 * tt + 4 * g) = o; }
  ScanFrags f0, f1;
  scan_load(p, ci0 * 6 + h, wave, lane, sl, f0);
  __syncthreads();
#define T0(c) (((ci0 + (c)) >= 256) ? TP + (ci0 + (c) - 256) * 64 : (ci0 + (c)) * 64)
  for (int c = 0; c < nch; c += 2) {
    if (c + 1 < nch) scan_load(p, (ci0 + c + 1) * 6 + h, wave, lane, sl, f1);
    scan_step(f0, sacc, St, Vnt, O, T0(c), h, sl, wave, n, g);
    if (c + 1 < nch) {
      if (c + 2 < nch) scan_load(p, (ci0 + c + 2) * 6 + h, wave, lane, sl, f0);
      scan_step(f1, sacc, St, Vnt, O, T0(c + 1), h, sl, wave, n, g);
    }
  }
#undef T0
#pragma unroll
  for (int tt = 0; tt < 2; ++tt)
#pragma unroll
    for (int r = 0; r < 4; ++r) sout[(size_t)(32 * wave + 16 * tt + 4 * g + r) * 128 + sl * 16 + n] = sacc[tt][r];
}

DEVI int next_item(unsigned* ctr) {
  __shared__ int s_item;
  __syncthreads();
  if (get_tid() == 0) s_item = (int)atomicAdd(ctr, 1u);
  __syncthreads();
  return s_item;
}

DEVI void gbar(unsigned* bar, unsigned nb, unsigned& gen) {
  asm volatile("s_waitcnt vmcnt(0)" ::: "memory");
  __syncthreads();
  gen++;
  if (get_tid() == 0) {
    __builtin_amdgcn_fence(__ATOMIC_RELEASE, "agent");
    asm volatile("s_waitcnt vmcnt(0)" ::: "memory");
    __hip_atomic_fetch_add(bar, 1u, __ATOMIC_RELAXED, __HIP_MEMORY_SCOPE_AGENT);
    while (__hip_atomic_load(bar, __ATOMIC_RELAXED, __HIP_MEMORY_SCOPE_AGENT) < gen * nb) __builtin_amdgcn_s_sleep(2);
    __builtin_amdgcn_fence(__ATOMIC_ACQUIRE, "agent");
    asm volatile("s_waitcnt vmcnt(0)" ::: "memory");
  }
  __syncthreads();
}
#ifndef ONLY
#define ENAB(k) true
#else
#define ENAB(k) ((ONLY) == (k))
#endif
__global__ void __launch_bounds__(256, 2) mk_fwd(KP p) {
  __shared__ __attribute__((aligned(16))) unsigned char smem[73728];
  cg::grid_group grid = cg::this_grid();
  const int bid = blockIdx.x, nb = gridDim.x;
  const int ngw = nb * 4;
  unsigned char* ws = p.ws;
  unsigned* ctr = (unsigned*)(ws + WS_CTR);
  float* Y = p.out + O_YP;
  bf16_t* XN = (bf16_t*)(ws + WS_XN);
  bf16_t* MIX = (bf16_t*)(ws + WS_MIX);
  bf16_t* Pb = (bf16_t*)(ws + WS_P);
  bf16_t* Hb = (bf16_t*)(ws + WS_H);
  bool did = false;
  unsigned bgen = 0;
  grid.sync();
  for (int ph = p.ph_lo; ph < p.ph_hi; ++ph) {
    const int layer = ph == 0 ? 0 : (ph - 1) / 9, sub = ph == 0 ? -1 : (ph - 1) % 9;
    const int kind = layer & 1, j = layer >> 1;
    if (sub == 3 && kind == 1) continue;
    if (sub == 8 && layer == 3) continue;
    if (did) gbar(ctr + 512, nb, bgen);
    did = true;
    const int tid = get_tid(), lane = tid & 63, wave = tid >> 6, gw = bid * 4 + wave;
    (void)tid;
    const int np = kind ? NP_SB : NP_GDN, mqoff = kind ? MQ_SB : MQ_GDN, mixp = kind ? 768 : 1024, mixoff = kind ? 512 : 768;
    if (ph == 0 && ENAB(0)) {
      int base = 0;
      convert_group(base, bid, nb, p.in[12], (bf16_t*)(ws + WS_WIG), 2, 1024, 3340, 3456, 3084, 116, smem);
      convert_group(base, bid, nb, p.in[13], (bf16_t*)(ws + WS_WIS), 2, 1024, 1792, 1792, 1 << 30, 0, smem);
      convert_group(base, bid, nb, p.in[14], (bf16_t*)(ws + WS_WKV), 4, 1024, 512, 512, 1 << 30, 0, smem);
      convert_group(base, bid, nb, p.in[23], (bf16_t*)(ws + WS_WOG), 2, 1024, 1024, 1024, 1 << 30, 0, smem);
      convert_group(base, bid, nb, p.in[24], (bf16_t*)(ws + WS_WOS), 2, 768, 1024, 1024, 1 << 30, 0, smem);
      convert_group(base, bid, nb, p.in[25], (bf16_t*)(ws + WS_WUP), 4, 1024, 4096, 4096, 1 << 30, 0, smem);
      convert_group(base, bid, nb, p.in[26], (bf16_t*)(ws + WS_WDN), 4, 4096, 1024, 1024, 1 << 30, 0, smem);
      for (int r = gw; r < TA; r += ngw) norm_row(r < TP ? p.in[0] + (size_t)r * DM : p.in[1] + (size_t)(r - TP) * DM, p.in[9], XN + (size_t)r * DM, lane);
      for (int r = gw; r < 1024; r += ngw) norm_row(p.in[8] + (size_t)(r & 255) * DM, p.in[10] + (r >> 8) * DM, (bf16_t*)(ws + WS_MEMN) + (size_t)r * DM, lane);
    } else if (sub == 0 && ENAB(1)) {
      EpiArgs ea{}; ea.cb = Pb; ea.ldc = np;
      const bf16_t* wt = kind ? (const bf16_t*)(ws + WS_WIS) + (size_t)j * 1792 * 1024 : (const bf16_t*)(ws + WS_WIG) + (size_t)j * 3456 * 1024;
      gemm_phase<0>(XN, DM, wt, 1024, TA, np, ea, smem);
      if (layer == 0) {
        for (int t = bid; t < 32; t += nb) {
          const int l = t >> 3, r = t & 7;
          EpiArgs e2{}; e2.cf = (float*)(ws + WS_MEMKV) + (size_t)l * 256 * 512; e2.ldc = 512;
          gemm_tile<3>((const bf16_t*)(ws + WS_MEMN) + (size_t)l * 256 * DM, DM, (const bf16_t*)(ws + WS_WKV) + (size_t)l * 512 * DM, DM, 1024, (r >> 2) << 7, (r & 3) << 7, e2, smem);
        }
      }
    } else if (sub == 1 && ENAB(2)) {
      if (layer == 0) {
        const float* kv = (const float*)(ws + WS_MEMKV);
        for (int it = gw; it < 4096; it += ngw) {
          const int l = it >> 10, m = (it >> 2) & 255, hh = it & 3;
          const float kx = kv[((size_t)l * 256 + m) * 512 + hh * 64 + lane], vx = kv[((size_t)l * 256 + m) * 512 + 256 + hh * 64 + lane];
          const float ss = wave_sum(kx * kx);
          p.out[O_PMK + ((size_t)l * 256 + m) * 256 + hh * 64 + lane] = kx * rsqrtf(ss * (1.f / 64.f) + EPS) * p.in[16][l * 64 + lane];
          p.out[O_PMV + ((size_t)l * 256 + m) * 256 + hh * 64 + lane] = vx;
        }
      }
      if (kind == 0) {
        for (int it = bid; it < NITEM; it += nb) gdn_prep_item(p, j, it / 6, it % 6, Pb, smem);
      } else {
        bf16_t* Kb = (bf16_t*)(ws + WS_G);
        const float* kg = p.in[22] + j * 128;
        for (int t = gw; t < TA; t += ngw) {
          const bf16_t* pr = Pb + (size_t)t * np;
          const u4 ku = *(const u4*)(pr + 512 + lane * 8), vu = *(const u4*)(pr + 1024 + lane * 8);
          float kf[8] = {lo2f(ku.x), hi2f(ku.x), lo2f(ku.y), hi2f(ku.y), lo2f(ku.z), hi2f(ku.z), lo2f(ku.w), hi2f(ku.w)};
          float ss = 0.f;
#pragma unroll
          for (int e = 0; e < 8; ++e) ss += kf[e] * kf[e];
          ss += __shfl_xor(ss, 1); ss += __shfl_xor(ss, 2); ss += __shfl_xor(ss, 4); ss += __shfl_xor(ss, 8);
          const float sc = rsqrtf(ss * (1.f / 128.f) + EPS);
          const int c0 = (lane & 15) * 8;
#pragma unroll
          for (int e = 0; e < 8; ++e) kf[e] *= sc * kg[c0 + e];
          float* ok = t < TP ? p.out + O_PSK + ((size_t)j * TP + t) * 512 : p.out + O_SSK + ((size_t)j * TS + (t - TP)) * 512;
          float* ov = t < TP ? p.out + O_PSV + ((size_t)j * TP + t) * 512 : p.out + O_SSV + ((size_t)j * TS + (t - TP)) * 512;
          *(float4*)(ok + lane * 8) = make_float4(kf[0], kf[1], kf[2], kf[3]); *(float4*)(ok + lane * 8 + 4) = make_float4(kf[4], kf[5], kf[6], kf[7]);
          *(float4*)(ov + lane * 8) = make_float4(lo2f(vu.x), hi2f(vu.x), lo2f(vu.y), hi2f(vu.y)); *(float4*)(ov + lane * 8 + 4) = make_float4(lo2f(vu.z), hi2f(vu.z), lo2f(vu.w), hi2f(vu.w));
          *(u4*)(Kb + (size_t)t * 512 + lane * 8) = mk4(pk2(kf[0], kf[1]), pk2(kf[2], kf[3]), pk2(kf[4], kf[5]), pk2(kf[6], kf[7]));
        }
      }
    } else if (sub == 2 && ENAB(3)) {
      unsigned* c = ctr + layer * 4;
      if (kind == 0) {
        bf16_t* O = XN;
        if (bid < 64 && (bid & 7) < 6) {
          const int h = bid & 7, sl = bid >> 3;
          gdn_scan_stream(p, j, 0, 256, h, sl, nullptr, p.out + O_PGS + ((size_t)j * 6 + h) * 16384, O, smem);
        }
        for (;;) {
          const int it = next_item(c);
          if (it >= 384 + 544) break;
          if (it < 384) { const int b = it / 48, r = it % 48, h = r >> 3, sl = r & 7;
            gdn_scan_stream(p, j, 256 + b, 1, h, sl, p.in[3] + (((size_t)j * 8 + b) * 6 + h) * 16384, p.out + O_SGS + (((size_t)j * 8 + b) * 6 + h) * 16384, O, smem);
          } else mem_attn_item(p, layer, it - 384, Pb, np, mqoff, MIX, mixp, mixoff, smem);
        }
      } else {
        const bf16_t* Kb = (const bf16_t*)(ws + WS_G);
        const float qs = 0.08838834764831845f * LOG2E;
        for (;;) {
          const int it = next_item(c);
          if (it >= 512 + 32 + 544) break;
          if (it < 512) {
            const int qb = 127 - (it >> 2), h = it & 3;
            KVSrc s; s.k = Kb + h * 128; s.v = Pb + 1024 + h * 128; s.kpitch = 512; s.vpitch = np; s.f32 = 0;
            attn_item<128, 0>(Pb + (size_t)(qb * 128) * np + h * 128, np, 128, p.in[21] + j * 128, qs, s, 2 * qb + 2, qb * 128, 1, s, 0,
                              MIX + (size_t)(qb * 128) * mixp + h * 128, mixp, smem);
          } else if (it < 544) {
            const int b = (it - 512) >> 2, h = it & 3, t0 = TP + b * 64;
            KVSrc sa; sa.k = Kb + (size_t)t0 * 512 + h * 128; sa.v = Pb + (size_t)t0 * np + 1024 + h * 128; sa.kpitch = 512; sa.vpitch = np; sa.f32 = 0;
            KVSrc sb; sb.k = p.in[4] + ((size_t)j * 8 + b) * 2048 * 512 + h * 128; sb.v = p.in[5] + ((size_t)j * 8 + b) * 2048 * 512 + h * 128; sb.kpitch = 512; sb.vpitch = 512; sb.f32 = 1;
            attn_item<128, 0>(Pb + (size_t)t0 * np + h * 128, np, 64, p.in[21] + j * 128, qs, sa, 1, 0, 1, sb, 32,
                              MIX + (size_t)t0 * mixp + h * 128, mixp, smem);
          } else mem_attn_item(p, layer, it - 544, Pb, np, mqoff, MIX, mixp, mixoff, smem);
        }
      }
    } else if (sub == 3 && ENAB(4)) {
      const bf16_t* O = XN;
      const float* og = p.in[20] + j * 128;
      for (int it = gw; it < TA * 6; it += ngw) {
        const int t = it / 6, h = it % 6;
        const unsigned ou = *(const unsigned*)(O + (size_t)t * 768 + h * 128 + lane * 2);
        const unsigned zu = *(const unsigned*)(Pb + (size_t)t * np + 2304 + h * 128 + lane * 2);
        const float o0 = lo2f(ou), o1 = hi2f(ou), z0 = lo2f(zu), z1 = hi2f(zu);
        const float ss = wave_sum(o0 * o0 + o1 * o1);
        const float sc = rsqrtf(ss * (1.f / 128.f) + EPS);
        *(unsigned*)(MIX + (size_t)t * 1024 + h * 128 + lane * 2) = pk2(o0 * sc * og[lane * 2] * silu(z0), o1 * sc * og[lane * 2 + 1] * silu(z1));
      }
    } else if (sub == 4 && ENAB(5)) {
      EpiArgs ea{}; ea.yout = Y;
      if (layer == 0) { ea.res0 = p.in[0]; ea.res1 = p.in[1]; } else { ea.res0 = Y; ea.res1 = nullptr; }
      const bf16_t* wt = kind ? (const bf16_t*)(ws + WS_WOS) + (size_t)j * 1024 * 768 : (const bf16_t*)(ws + WS_WOG) + (size_t)j * 1024 * 1024;
      gemm_phase<1>(MIX, mixp, wt, mixp, TA, 1024, ea, smem);
    } else if (sub == 5) {
      norm_all(Y, p.in[11] + layer * DM, XN, gw, ngw, lane);
    } else if (sub == 6 && ENAB(6)) {
      EpiArgs ea{}; ea.cb = Hb; ea.ldc = DFF;
      gemm_phase<2>(XN, DM, (const bf16_t*)(ws + WS_WUP) + (size_t)layer * 4096 * 1024, 1024, TA, 4096, ea, smem);
    } else if (sub == 7 && ENAB(7)) {
      EpiArgs ea{}; ea.yout = Y; ea.res0 = Y; ea.res1 = nullptr;
      gemm_phase<1>(Hb, DFF, (const bf16_t*)(ws + WS_WDN) + (size_t)layer * 1024 * 4096, 4096, TA, 1024, ea, smem);
    } else if (sub == 8) {
      norm_all(Y, p.in[9] + (layer + 1) * DM, XN, gw, ngw, lane);
    }
  }
}

extern "C" void kernel_launch(void* const* d_in, const int* in_sizes, int n_in, void* d_out, int out_size, void* d_ws, size_t ws_size, hipStream_t stream) {
  static int grid_blocks = 0;
  if (!grid_blocks) {
    int dev = 0, cus = 0, per_cu = 0;
    (void)hipGetDevice(&dev);
    (void)hipDeviceGetAttribute(&cus, hipDeviceAttributeMultiprocessorCount, dev);
    (void)hipOccupancyMaxActiveBlocksPerMultiprocessor(&per_cu, mk_fwd, 256, 0);
    if (per_cu > 2) per_cu = 2;
    if (per_cu < 1) per_cu = 1;
    grid_blocks = cus * per_cu;
    if (ws_size < WS_END) fprintf(stderr, "kernel_launch: workspace too small: %zu < %zu\n", ws_size, (size_t)WS_END);
  }
  (void)hipMemsetAsync((char*)d_ws + WS_CTR, 0, 4096, stream);
  KP p{};
  for (int i = 0; i < 27; ++i) p.in[i] = (const float*)d_in[i];
  p.out = (float*)d_out; p.ws = (unsigned char*)d_ws; p.ph_lo = 0; p.ph_hi = 37;
  void* args[] = {&p};
  hipError_t e = hipLaunchCooperativeKernel((void*)mk_fwd, dim3(grid_blocks), dim3(256), args, 0, stream);
  if (e != hipSuccess) fprintf(stderr, "cooperative launch failed: %s (grid %d)\n", hipGetErrorString(e), grid_blocks);
}
```

```cpp
#include <hip/hip_runtime.h>
#include <hip/hip_cooperative_groups.h>
#include <cstdio>
#include <cstdint>
namespace cg = cooperative_groups;

typedef unsigned short bf16_t;
typedef short bf16x8 __attribute__((ext_vector_type(8)));
typedef float f32x16 __attribute__((ext_vector_type(16)));
typedef float f32x4 __attribute__((ext_vector_type(4)));
typedef unsigned u4 __attribute__((ext_vector_type(4)));
typedef unsigned u2 __attribute__((ext_vector_type(2)));
#define DEVI __device__ __forceinline__
__device__ __forceinline__ u4 mk4(unsigned a, unsigned b, unsigned c, unsigned d) { u4 r; r.x = a; r.y = b; r.z = c; r.w = d; return r; }
__device__ __forceinline__ u2 mk2(unsigned a, unsigned b) { u2 r; r.x = a; r.y = b; return r; }
#define MFMA32(a, b, c) __builtin_amdgcn_mfma_f32_32x32x16_bf16((a), (b), (c), 0, 0, 0)
#define LDS_BARRIER() do { asm volatile("s_waitcnt lgkmcnt(0)" ::: "memory"); __builtin_amdgcn_s_barrier(); } while (0)
#define GLOAD16(dst, ptr) asm volatile("global_load_dwordx4 %0, %1, off" : "=&v"(dst) : "v"(ptr) : "memory")
#define VMWAIT(n) asm volatile("s_waitcnt vmcnt(" #n ")" ::: "memory")
#define MFMA16(a, b, c) __builtin_amdgcn_mfma_f32_16x16x32_bf16((a), (b), (c), 0, 0, 0)

constexpr int DM = 1024, TP = 16384, TS = 512, TA = TP + TS, DFF = 4096;
constexpr int NP_GDN = 3456, NP_SB = 1792, MQ_GDN = 3200, MQ_SB = 1536;
constexpr int NCHUNK = 264, NITEM = NCHUNK * 6;
constexpr float EPS = 1e-6f;
constexpr float LOG2E = 1.4426950408889634f;
constexpr size_t O_YP = 0, O_PGC = 17301504, O_PGS = 17315328, O_PSK = 17511936, O_PSV = 34289152, O_PMK = 51066368, O_PMV = 51328512,
                 O_SGC = 51590656, O_SGS = 51701248, O_SSK = 53274112, O_SSV = 53798400;
constexpr size_t WS_CTR = 0;
constexpr size_t WS_WIG = 4096;
constexpr size_t WS_WIS = WS_WIG + 2ull * 3456 * 1024 * 2;
constexpr size_t WS_WKV = WS_WIS + 2ull * 1792 * 1024 * 2;
constexpr size_t WS_WOG = WS_WKV + 4ull * 512 * 1024 * 2;
constexpr size_t WS_WOS = WS_WOG + 2ull * 1024 * 1024 * 2;
constexpr size_t WS_WUP = WS_WOS + 2ull * 1024 * 768 * 2;
constexpr size_t WS_WDN = WS_WUP + 4ull * 4096 * 1024 * 2;
constexpr size_t WS_XN = WS_WDN + 4ull * 4096 * 1024 * 2;
constexpr size_t WS_MIX = WS_XN + (size_t)TA * 1024 * 2;
constexpr size_t WS_MEMN = WS_MIX + (size_t)TA * 1024 * 2;
constexpr size_t WS_MEMKV = WS_MEMN + 4ull * 256 * 1024 * 2;
constexpr size_t WS_BIG = WS_MEMKV + 4ull * 256 * 512 * 4;
constexpr size_t WS_P = WS_BIG;
constexpr size_t WS_G = WS_P + (size_t)TA * 3456 * 2;
constexpr size_t G_ITEM = 73728;
constexpr size_t WS_GL = WS_G + (size_t)NITEM * G_ITEM;
constexpr size_t WS_H = WS_BIG;
constexpr size_t WS_END = WS_GL + 8192;

struct KP { const float* in[27]; float* out; unsigned char* ws; int ph_lo, ph_hi; };

DEVI int get_tid() { int t = __builtin_amdgcn_workitem_id_x(); asm volatile("" : "+v"(t)); return t; }
DEVI float bf2f(bf16_t b) { return __uint_as_float(((unsigned)b) << 16); }
typedef float f32x2_t __attribute__((ext_vector_type(2)));
typedef __bf16 bf16x2_t __attribute__((ext_vector_type(2)));
DEVI unsigned pk2(float lo, float hi) { f32x2_t v = {lo, hi}; return __builtin_bit_cast(unsigned, __builtin_convertvector(v, bf16x2_t)); }
DEVI bf16_t f2bf(float f) { return (bf16_t)(pk2(f, 0.f) & 0xffffu); }
DEVI float lo2f(unsigned u) { return __uint_as_float(u << 16); }
DEVI float hi2f(unsigned u) { return __uint_as_float(u & 0xffff0000u); }
DEVI float ex2(float x) { return __builtin_amdgcn_exp2f(x); }
DEVI float lg2(float x) { return __builtin_amdgcn_logf(x); }
DEVI float wave_sum(float v) {
#pragma unroll
  for (int o = 32; o >= 1; o >>= 1) v += __shfl_xor(v, o);
  return v;
}
DEVI bf16x8 as_frag(u4 u) { return __builtin_bit_cast(bf16x8, u); }
DEVI float silu(float y) { return y / (1.f + __expf(-y)); }

struct EpiArgs { bf16_t* cb; float* cf; int ldc; const float* res0; const float* res1; float* yout; };
template <int EPI>
DEVI void gemm_tile(const bf16_t* __restrict__ A, int lda, const bf16_t* __restrict__ Bt, int ldb, int K, int m0, int n0, const EpiArgs& ea, unsigned char* smem) {
  const int tid = get_tid(), lane = tid & 63, wave = tid >> 6;
  const int wm = wave >> 1, wn = wave & 1, l31 = lane & 31, lh = lane >> 5;
  bf16_t* sA = (bf16_t*)smem;
  bf16_t* sB = sA + 2 * 128 * 72;
  f32x16 acc[2][2];
#pragma unroll
  for (int i = 0; i < 2; ++i)
#pragma unroll
    for (int j = 0; j < 2; ++j)
#pragma unroll
      for (int r = 0; r < 16; ++r) acc[i][j][r] = 0.f;
  const int lr = tid >> 3, lc = (tid & 7) * 8;
  const bf16_t* gA = A + (size_t)(m0 + lr) * lda + lc;
  const bf16_t* gB = Bt + (size_t)(n0 + lr) * ldb + lc;
  u4 ra0[4], rb0[4], ra1[4], rb1[4];
#define G_ISSUE(RA, RB, K0) { _Pragma("unroll") for (int i = 0; i < 4; ++i) { GLOAD16(RA[i], gA + (size_t)i * 32 * lda + (K0)); GLOAD16(RB[i], gB + (size_t)i * 32 * ldb + (K0)); } }
#define G_STASH(RA, RB, BUF) { _Pragma("unroll") for (int i = 0; i < 4; ++i) { *(u4*)(sA + (BUF) * 128 * 72 + (lr + i * 32) * 72 + lc) = RA[i]; *(u4*)(sB + (BUF) * 128 * 72 + (lr + i * 32) * 72 + lc) = RB[i]; } }
#define G_COMPUTE(BUF) { const bf16_t* cA = sA + (BUF) * 128 * 72 + (wm * 64 + l31) * 72 + lh * 8; const bf16_t* cB = sB + (BUF) * 128 * 72 + (wn * 64 + l31) * 72 + lh * 8; \
    _Pragma("unroll") for (int ks = 0; ks < 4; ++ks) { \
      bf16x8 a0 = *(const bf16x8*)(cA + ks * 16), a1 = *(const bf16x8*)(cA + 32 * 72 + ks * 16); \
      bf16x8 b0 = *(const bf16x8*)(cB + ks * 16), b1 = *(const bf16x8*)(cB + 32 * 72 + ks * 16); \
      acc[0][0] = MFMA32(a0, b0, acc[0][0]); acc[0][1] = MFMA32(a0, b1, acc[0][1]); \
      acc[1][0] = MFMA32(a1, b0, acc[1][0]); acc[1][1] = MFMA32(a1, b1, acc[1][1]); } }
  const int nk = K >> 6;
  VMWAIT(0);
  G_ISSUE(ra0, rb0, 0);
  G_ISSUE(ra1, rb1, 64);
  __syncthreads();
  VMWAIT(8);
  G_STASH(ra0, rb0, 0);
  LDS_BARRIER();
  for (int kt = 0; kt < nk; kt += 2) {
    G_ISSUE(ra0, rb0, ((kt + 2 < nk) ? kt + 2 : nk - 1) << 6);
    G_COMPUTE(0);
    VMWAIT(8);
    G_STASH(ra1, rb1, 1);
    LDS_BARRIER();
    G_ISSUE(ra1, rb1, ((kt + 3 < nk) ? kt + 3 : nk - 1) << 6);
    G_COMPUTE(1);
    VMWAIT(8);
    if (kt + 2 < nk) G_STASH(ra0, rb0, 0);
    LDS_BARRIER();
  }
  VMWAIT(0);
#pragma unroll
  for (int i = 0; i < 4; ++i) asm volatile("" :: "v"(ra0[i]), "v"(rb0[i]), "v"(ra1[i]), "v"(rb1[i]));
#undef G_ISSUE
#undef G_STASH
#undef G_COMPUTE
#pragma unroll
  for (int i = 0; i < 2; ++i)
#pragma unroll
    for (int r = 0; r < 16; ++r) {
      const int row = m0 + wm * 64 + i * 32 + (r >> 2) * 8 + lh * 4 + (r & 3);
#pragma unroll
      for (int j = 0; j < 2; ++j) {
        const int col = n0 + wn * 64 + j * 32 + l31;
        const float v = acc[i][j][r];
        if (EPI == 0) ea.cb[(size_t)row * ea.ldc + col] = f2bf(v);
        else if (EPI == 1) {
          const float* rp = ea.res1 ? (row < TP ? ea.res0 + (size_t)row * DM : ea.res1 + (size_t)(row - TP) * DM) : ea.res0 + (size_t)row * DM;
          ea.yout[(size_t)row * DM + col] = rp[col] + v;
        } else if (EPI == 4) { unsafeAtomicAdd(ea.yout + (size_t)row * DM + col, v); }
        else if (EPI == 2) { const float rl = v > 0.f ? v : 0.f; ea.cb[(size_t)row * ea.ldc + col] = f2bf(rl * rl); }
        else ea.cf[(size_t)row * ea.ldc + col] = v;
      }
    }
}
template <int EPI>
DEVI void gemm_phase(const bf16_t* A, int lda, const bf16_t* Bt, int K, int M, int N, const EpiArgs& ea, unsigned char* smem) {
  const int nM = M >> 7, nN = N >> 7, nwg = nM * nN;
  const int q = nwg >> 3, r = nwg & 7;
  for (int L = blockIdx.x; L < nwg; L += gridDim.x) {
    const int xcd = L & 7, off = L >> 3;
    const int wg = (xcd < r ? xcd * (q + 1) : r * (q + 1) + (xcd - r) * q) + off;
    const int nig = 8 * nN, gid = wg / nig, fm = gid * 8, gsz = (nM - fm) < 8 ? (nM - fm) : 8;
    const int pm = fm + ((wg % nig) % gsz), pn = (wg % nig) / gsz;
    gemm_tile<EPI>(A, lda, Bt, K, K, pm << 7, pn << 7, ea, smem);
  }
}

DEVI void gemm_phase_res(const bf16_t* A, int lda, const bf16_t* Bt, int K, const EpiArgs& ea, unsigned char* smem) {
  gemm_phase<1>(A, lda, Bt, K, TP, 1024, ea, smem);
  const int S = (K == 4096) ? 16 : (K >> 7), klen = K / S;
  for (int it = blockIdx.x; it < 32 * S; it += gridDim.x) {
    const int tile = it / S, ks = it % S;
    gemm_tile<4>(A + (size_t)ks * klen, lda, Bt + (size_t)ks * klen, K, klen, TP + ((tile >> 3) << 7), (tile & 7) << 7, ea, smem);
  }
}

DEVI void convert_tile(const float* __restrict__ W, bf16_t* __restrict__ Wt, int K, int N, int k0, int n0, int thr, int shift, unsigned char* smem) {
  float* tile = (float*)smem;
  const int tid = get_tid();
  __syncthreads();
#pragma unroll
  for (int i = 0; i < 4; ++i) {
    const int r = (tid >> 4) + 16 * i, c = (tid & 15) * 4;
    float4 v = make_float4(0.f, 0.f, 0.f, 0.f);
    if (n0 + c < N) v = *(const float4*)(W + (size_t)(k0 + r) * N + n0 + c);
    tile[r * 65 + c] = v.x; tile[r * 65 + c + 1] = v.y; tile[r * 65 + c + 2] = v.z; tile[r * 65 + c + 3] = v.w;
  }
  __syncthreads();
  const int n = tid >> 2, kc = (tid & 3) * 16;
  if (n0 + n < N) {
    const int nn = n0 + n, nd = nn + (nn >= thr ? shift : 0);
    unsigned o[8];
#pragma unroll
    for (int e = 0; e < 8; ++e) o[e] = pk2(tile[(kc + 2 * e) * 65 + n], tile[(kc + 2 * e + 1) * 65 + n]);
    u4* dst = (u4*)(Wt + (size_t)nd * K + k0 + kc);
    dst[0] = mk4(o[0], o[1], o[2], o[3]); dst[1] = mk4(o[4], o[5], o[6], o[7]);
  }
}
DEVI void convert_group(int& base, int bid, int nb, const float* W, bf16_t* Wt, int nl, int K, int N, int NPAD, int thr, int shift, unsigned char* smem) {
  const int tk = K >> 6, tn = (N + 63) >> 6, per = tk * tn, tot = per * nl;
  int first = ((bid - base) % nb + nb) % nb;
  for (int t = first; t < tot; t += nb) {
    const int l = t / per, r = t % per;
    convert_tile(W + (size_t)l * K * N, Wt + (size_t)l * NPAD * K, K, N, (r / tn) << 6, (r % tn) << 6, thr, shift, smem);
  }
  base += tot;
}

DEVI void norm_row(const float* __restrict__ src, const float* __restrict__ gain, bf16_t* __restrict__ dst, int lane) {
  float4 v[4]; float ss = 0.f;
#pragma unroll
  for (int i = 0; i < 4; ++i) { v[i] = *(const float4*)(src + lane * 4 + 256 * i); ss += v[i].x * v[i].x + v[i].y * v[i].y + v[i].z * v[i].z + v[i].w * v[i].w; }
  ss = wave_sum(ss);
  const float sc = rsqrtf(ss * (1.f / 1024.f) + EPS);
#pragma unroll
  for (int i = 0; i < 4; ++i) {
    const float4 g = *(const float4*)(gain + lane * 4 + 256 * i);
    u2 o; o.x = pk2(v[i].x * sc * g.x, v[i].y * sc * g.y); o.y = pk2(v[i].z * sc * g.z, v[i].w * sc * g.w);
    *(u2*)(dst + lane * 4 + 256 * i) = o;
  }
}

DEVI void norm_row2(const float* __restrict__ s0, const float* __restrict__ s1, const float* __restrict__ gain, bf16_t* __restrict__ d0, bf16_t* __restrict__ d1, int lane) {
  float4 v[4], w[4]; float ss = 0.f, tt = 0.f;
#pragma unroll
  for (int i = 0; i < 4; ++i) { v[i] = *(const float4*)(s0 + lane * 4 + 256 * i); w[i] = *(const float4*)(s1 + lane * 4 + 256 * i); }
#pragma unroll
  for (int i = 0; i < 4; ++i) { ss += v[i].x * v[i].x + v[i].y * v[i].y + v[i].z * v[i].z + v[i].w * v[i].w; tt += w[i].x * w[i].x + w[i].y * w[i].y + w[i].z * w[i].z + w[i].w * w[i].w; }
#pragma unroll
  for (int o = 32; o >= 1; o >>= 1) { ss += __shfl_xor(ss, o); tt += __shfl_xor(tt, o); }
  const float sc = rsqrtf(ss * (1.f / 1024.f) + EPS), tc = rsqrtf(tt * (1.f / 1024.f) + EPS);
#pragma unroll
  for (int i = 0; i < 4; ++i) {
    const float4 g = *(const float4*)(gain + lane * 4 + 256 * i);
    u2 o; o.x = pk2(v[i].x * sc * g.x, v[i].y * sc * g.y); o.y = pk2(v[i].z * sc * g.z, v[i].w * sc * g.w);
    *(u2*)(d0 + lane * 4 + 256 * i) = o;
    u2 q; q.x = pk2(w[i].x * tc * g.x, w[i].y * tc * g.y); q.y = pk2(w[i].z * tc * g.z, w[i].w * tc * g.w);
    *(u2*)(d1 + lane * 4 + 256 * i) = q;
  }
}
DEVI void norm_all(const float* __restrict__ Y, const float* __restrict__ gain, bf16_t* __restrict__ XN, int gw, int ngw, int lane) {
  for (int r = gw; r < TA; r += ngw) norm_row(Y + (size_t)r * DM, gain, XN + (size_t)r * DM, lane);
}

struct KVSrc { const void* k; const void* v; int kpitch, vpitch, f32; };
template <int D>
DEVI void attn_load(const KVSrc& s, int r0, u4 (&kr)[D / 32], u4 (&vr)[D / 32]) {
  const int tid = get_tid();
#pragma unroll
  for (int i = 0; i < D / 32; ++i) {
    const int c = tid + 256 * i, key = c / (D / 8), dch = c % (D / 8);
    if (s.f32) {
      const float* kp = (const float*)s.k + (size_t)(r0 + key) * s.kpitch + dch * 8;
      const float* vp = (const float*)s.v + (size_t)(r0 + key) * s.vpitch + dch * 8;
      const float4 a = *(const float4*)kp, b = *(const float4*)(kp + 4), c2 = *(const float4*)vp, d2 = *(const float4*)(vp + 4);
      kr[i] = mk4(pk2(a.x, a.y), pk2(a.z, a.w), pk2(b.x, b.y), pk2(b.z, b.w));
      vr[i] = mk4(pk2(c2.x, c2.y), pk2(c2.z, c2.w), pk2(d2.x, d2.y), pk2(d2.z, d2.w));
    } else {
      kr[i] = *(const u4*)((const bf16_t*)s.k + (size_t)(r0 + key) * s.kpitch + dch * 8);
      vr[i] = *(const u4*)((const bf16_t*)s.v + (size_t)(r0 + key) * s.vpitch + dch * 8);
    }
  }
}
template <int D>
DEVI void attn_store(bf16_t* Ks, bf16_t* Vt, const u4 (&kr)[D / 32], const u4 (&vr)[D / 32]) {
  const int tid = get_tid();
#pragma unroll
  for (int i = 0; i < D / 32; ++i) {
    const int c = tid + 256 * i, key = c / (D / 8), dch = c % (D / 8);
    *(u4*)(Ks + key * (D + 8) + dch * 8) = kr[i];
    const int kx = key ^ ((dch & 15) << 2);
    const unsigned w[4] = {vr[i].x, vr[i].y, vr[i].z, vr[i].w};
#pragma unroll
    for (int e = 0; e < 8; ++e) Vt[(dch * 8 + e) * 72 + kx] = (bf16_t)((w[e >> 1] >> (16 * (e & 1))) & 0xffffu);
  }
}

template <int D, int MODE>
DEVI void attn_item(const bf16_t* __restrict__ qsrc, int qpitch, int nq, const float* __restrict__ qgain, float qscale,
                    const KVSrc& segA, int nA, int qposA0, int maskA, const KVSrc& segB, int nB,
                    bf16_t* __restrict__ out, int opitch, unsigned char* smem) {
  constexpr int KPT = D + 8, NKS = D / 16, NDB = D / 32, NCH = D / 32;
  constexpr int STAGE = 64 * KPT + D * 72;
  const int tid = get_tid(), lane = tid & 63, wave = tid >> 6, l31 = lane & 31, lh = lane >> 5;
  bf16_t* sbase = (bf16_t*)smem;
  const bool active = wave * 32 < nq;
  bf16x8 qf[NKS];
  {
    float qv[NKS][8]; float ss = 0.f;
    const bf16_t* qp = qsrc + (size_t)(wave * 32 + l31) * qpitch + lh * 8;
#pragma unroll
    for (int ks = 0; ks < NKS; ++ks) {
      u4 u = mk4(0, 0, 0, 0);
      if (active) u = *(const u4*)(qp + ks * 16);
      const unsigned w[4] = {u.x, u.y, u.z, u.w};
#pragma unroll
      for (int e = 0; e < 4; ++e) { qv[ks][2 * e] = lo2f(w[e]); qv[ks][2 * e + 1] = hi2f(w[e]); }
#pragma unroll
      for (int e = 0; e < 8; ++e) ss += qv[ks][e] * qv[ks][e];
    }
    ss += __shfl_xor(ss, 32);
    const float sc = rsqrtf(ss * (1.f / D) + EPS) * qscale;
#pragma unroll
    for (int ks = 0; ks < NKS; ++ks) {
      const float4 g0 = *(const float4*)(qgain + ks * 16 + lh * 8), g1 = *(const float4*)(qgain + ks * 16 + lh * 8 + 4);
      u4 u;
      u.x = pk2(qv[ks][0] * sc * g0.x, qv[ks][1] * sc * g0.y); u.y = pk2(qv[ks][2] * sc * g0.z, qv[ks][3] * sc * g0.w);
      u.z = pk2(qv[ks][4] * sc * g1.x, qv[ks][5] * sc * g1.y); u.w = pk2(qv[ks][6] * sc * g1.z, qv[ks][7] * sc * g1.w);
      qf[ks] = as_frag(u);
    }
  }
  f32x16 oacc[NDB];
#pragma unroll
  for (int db = 0; db < NDB; ++db)
#pragma unroll
    for (int r = 0; r < 16; ++r) oacc[db][r] = 0.f;
  float carry = 0.f, mx = -1e30f, lsum = 0.f;
  const int ntot = nA + nB;
  const int qpos = qposA0 + wave * 32 + l31;
  u4 kr[NCH], vr[NCH];
  {
    const bool inA = 0 < nA; const int tix = inA ? nA - 1 : nB - 1;
    attn_load<D>(inA ? segA : segB, tix * 64, kr, vr);
    __syncthreads();
    attn_store<D>(sbase, sbase + 64 * KPT, kr, vr);
    __syncthreads();
  }
  for (int it = 0; it < ntot; ++it) {
    const int cur = it & 1;
    if (it + 1 < ntot) {
      const bool nInA = (it + 1) < nA; const int tix = nInA ? nA - 2 - it : nB - 1 - (it + 1 - nA);
      attn_load<D>(nInA ? segA : segB, tix * 64, kr, vr);
    }
    const bool inA = it < nA;
    const int kbase = inA ? (nA - 1 - it) * 64 : 0;
    const bf16_t* Ks = sbase + cur * STAGE;
    const bf16_t* Vt = Ks + 64 * KPT;
    const bool mneed = inA && maskA && (kbase + 63 >= qposA0 + wave * 32);
    const bool skip = !active || (inA && maskA && (kbase > qposA0 + wave * 32 + 31));
    if (!skip) {
      bf16x8 pf[2][2];
      if (MODE == 0) {
        float after = carry;
#pragma unroll
        for (int rt = 1; rt >= 0; --rt) {
          f32x16 z;
#pragma unroll
          for (int r = 0; r < 16; ++r) z[r] = 0.f;
#pragma unroll
          for (int ks = 0; ks < NKS; ++ks) {
            const bf16x8 a = *(const bf16x8*)(Ks + (rt * 32 + l31) * KPT + ks * 16 + lh * 8);
            z = MFMA32(a, qf[ks], z);
          }
          float m[16];
#pragma unroll
          for (int i = 0; i < 16; ++i) {
            float mm = lg2(1.f + ex2(z[i]));
            if (mneed) { const int key = kbase + rt * 32 + (i >> 2) * 8 + lh * 4 + (i & 3); if (key >= qpos) mm = 0.f; }
            m[i] = mm;
          }
          float a_[16];
#pragma unroll
          for (int g = 3; g >= 0; --g) {
            const float s4 = (m[g * 4] + m[g * 4 + 1]) + (m[g * 4 + 2] + m[g * 4 + 3]);
            const float p4 = __shfl_xor(s4, 32);
            float c = after + (lh == 0 ? p4 : 0.f);
            after += s4 + p4;
#pragma unroll
            for (int e = 3; e >= 0; --e) {
              c += m[g * 4 + e];
              float av = ex2(z[g * 4 + e] - c);
              if (mneed) { const int key = kbase + rt * 32 + g * 8 + lh * 4 + e; if (key >= qpos) av = 0.f; }
              a_[g * 4 + e] = av;
            }
          }
#pragma unroll
          for (int s2 = 0; s2 < 2; ++s2)
            pf[rt][s2] = as_frag(mk4(pk2(a_[8 * s2 + 0], a_[8 * s2 + 1]), pk2(a_[8 * s2 + 2], a_[8 * s2 + 3]), pk2(a_[8 * s2 + 4], a_[8 * s2 + 5]), pk2(a_[8 * s2 + 6], a_[8 * s2 + 7])));
        }
        carry = after;
      } else {
        f32x16 z[2];
#pragma unroll
        for (int rt = 0; rt < 2; ++rt) {
          f32x16 zt;
#pragma unroll
          for (int r = 0; r < 16; ++r) zt[r] = 0.f;
#pragma unroll
          for (int ks = 0; ks < NKS; ++ks) {
            const bf16x8 a = *(const bf16x8*)(Ks + (rt * 32 + l31) * KPT + ks * 16 + lh * 8);
            zt = MFMA32(a, qf[ks], zt);
          }
          z[rt] = zt;
        }
        float tm = z[0][0];
#pragma unroll
        for (int rt = 0; rt < 2; ++rt)
#pragma unroll
          for (int i = 0; i < 16; ++i) tm = fmaxf(tm, z[rt][i]);
        tm = fmaxf(tm, __shfl_xor(tm, 32));
        const float nm = fmaxf(mx, tm);
        const float alpha = ex2(mx - nm);
        mx = nm;
        float ps = 0.f;
        float a_[2][16];
#pragma unroll
        for (int rt = 0; rt < 2; ++rt)
#pragma unroll
          for (int i = 0; i < 16; ++i) { a_[rt][i] = ex2(z[rt][i] - nm); ps += a_[rt][i]; }
        lsum = lsum * alpha + ps;
#pragma unroll
        for (int db = 0; db < NDB; ++db)
#pragma unroll
          for (int r = 0; r < 16; ++r) oacc[db][r] *= alpha;
#pragma unroll
        for (int rt = 0; rt < 2; ++rt)
#pragma unroll
          for (int s2 = 0; s2 < 2; ++s2)
            pf[rt][s2] = as_frag(mk4(pk2(a_[rt][8 * s2 + 0], a_[rt][8 * s2 + 1]), pk2(a_[rt][8 * s2 + 2], a_[rt][8 * s2 + 3]), pk2(a_[rt][8 * s2 + 4], a_[rt][8 * s2 + 5]), pk2(a_[rt][8 * s2 + 6], a_[rt][8 * s2 + 7])));
      }
#pragma unroll
      for (int db = 0; db < NDB; ++db) {
        const int d = db * 32 + l31, sw = ((d >> 3) & 15) << 2;
#pragma unroll
        for (int rt = 0; rt < 2; ++rt)
#pragma unroll
          for (int s = 0; s < 2; ++s) {
            const int kb0 = rt * 32 + 16 * s + 4 * lh;
            const u2 lo = *(const u2*)(Vt + d * 72 + (kb0 ^ sw));
            const u2 hi = *(const u2*)(Vt + d * 72 + ((kb0 + 8) ^ sw));
            oacc[db] = MFMA32(as_frag(mk4(lo.x, lo.y, hi.x, hi.y)), pf[rt][s], oacc[db]);
          }
      }
    }
    if (it + 1 < ntot) { bf16_t* nK = sbase + (cur ^ 1) * STAGE; attn_store<D>(nK, nK + 64 * KPT, kr, vr); }
    LDS_BARRIER();
  }
  if (active) {
    float inv = 1.f;
    if (MODE == 1) { const float l = lsum + __shfl_xor(lsum, 32); inv = 1.f / l; }
    bf16_t* op = out + (size_t)(wave * 32 + l31) * opitch + lh * 4;
#pragma unroll
    for (int db = 0; db < NDB; ++db)
#pragma unroll
      for (int g = 0; g < 4; ++g) {
        u2 o; o.x = pk2(oacc[db][g * 4] * inv, oacc[db][g * 4 + 1] * inv); o.y = pk2(oacc[db][g * 4 + 2] * inv, oacc[db][g * 4 + 3] * inv);
        *(u2*)(op + db * 32 + g * 8) = o;
      }
  }
}

DEVI void mem_attn_item(const KP& p, int layer, int item, const bf16_t* P, int np, int mqoff, bf16_t* mix, int mixp, int mixoff, unsigned char* smem) {
  const int h = item & 3;
  int t0, nq; const float *kk, *vv;
  if (item < 512) { t0 = (item >> 2) * 128; nq = 128; kk = p.out + O_PMK + (size_t)layer * 65536; vv = p.out + O_PMV + (size_t)layer * 65536; }
  else { const int b = (item - 512) >> 2; t0 = TP + b * 64; nq = 64; kk = p.in[6] + ((size_t)layer * 8 + b) * 65536; vv = p.in[7] + ((size_t)layer * 8 + b) * 65536; }
  KVSrc s; s.k = kk + h * 64; s.v = vv + h * 64; s.kpitch = 256; s.vpitch = 256; s.f32 = 1;
  attn_item<64, 1>(P + (size_t)t0 * np + mqoff + h * 64, np, nq, p.in[15] + layer * 64, 0.125f * LOG2E, s, 4, 0, 0, s, 0,
                   mix + (size_t)t0 * mixp + mixoff + h * 64, mixp, smem);
}

DEVI void gdn_prep_item(const KP& p, int j, int ci, int h, const bf16_t* P, unsigned char* smem) {
  constexpr int NP = NP_GDN;
  const int tid = get_tid(), lane = tid & 63, wave = tid >> 6;
  const int item = ci * 6 + h;
  const bool samp = ci >= 256;
  const int b = ci - 256;
  const int t0 = samp ? TP + b * 64 : ci * 64;
  float* stage = (float*)smem;
  float* sL = (float*)smem;
  bf16_t* qn = (bf16_t*)(smem + 33280);
  bf16_t* kn = qn + 64 * 136;
  float* sgc = (float*)(smem + 33280 + 2 * 64 * 136 * 2);
  float* sbeta = sgc + 64;
  float* segc = sbeta + 64;
  unsigned char* gi = p.ws + WS_G + (size_t)item * G_ITEM;
  bf16_t* gU = (bf16_t*)gi; bf16_t* gW = gU + 8192; bf16_t* gQD = gW + 8192; bf16_t* gKDT = gQD + 8192; bf16_t* gAI = gKDT + 8192;
  const float* convw = p.in[17] + (size_t)j * 4 * 2304;
  const float* cstate = p.in[2] + ((size_t)j * 8 + (samp ? b : 0)) * 3 * 2304;
  const bf16_t* Pc = P + (size_t)t0 * NP;
  __syncthreads();
  if (wave == 0) {
    const float braw = bf2f(Pc[(size_t)lane * NP + 3072 + h]), araw = bf2f(Pc[(size_t)lane * NP + 3078 + h]);
    const float beta = 1.f / (1.f + expf(-braw));
    const float xx = araw + p.in[19][j * 6 + h];
    const float sp = xx > 20.f ? xx : log1pf(expf(xx));
    float g = -expf(p.in[18][j * 6 + h]) * sp;
#pragma unroll
    for (int d = 1; d < 64; d <<= 1) { const float v = __shfl_up(g, d); if (lane >= d) g += v; }
    sgc[lane] = g; sbeta[lane] = beta; segc[lane] = expf(g);
    if (lane == 63) ((float*)(p.ws + WS_GL))[item] = expf(g);
  }
  if (samp || ci == 255) {
    float* dst = samp ? p.out + O_SGC + ((size_t)j * 8 + b) * 3 * 2304 : p.out + O_PGC + (size_t)j * 3 * 2304;
    for (int idx = tid; idx < 1152; idx += 256) {
      const int r = idx / 384, cc = idx % 384, ch = (cc >> 7) * 768 + h * 128 + (cc & 127);
      dst[r * 2304 + ch] = bf2f(Pc[(size_t)(61 + r) * NP + ch]);
    }
  }
  const float gcl_dummy = 0.f; (void)gcl_dummy;
#pragma unroll 1
  for (int which = 0; which < 2; ++which) {
    {
      const int c = tid & 127, th = tid >> 7, ch = which * 768 + h * 128 + c;
      const float w0 = convw[ch], w1 = convw[2304 + ch], w2 = convw[2 * 2304 + ch], w3 = convw[3 * 2304 + ch];
      float xm3, xm2, xm1;
      if (th == 1) { xm3 = bf2f(Pc[(size_t)29 * NP + ch]); xm2 = bf2f(Pc[(size_t)30 * NP + ch]); xm1 = bf2f(Pc[(size_t)31 * NP + ch]); }
      else if (samp) { xm3 = cstate[ch]; xm2 = cstate[2304 + ch]; xm1 = cstate[2 * 2304 + ch]; }
      else if (ci == 0) { xm3 = xm2 = xm1 = 0.f; }
      else { xm3 = bf2f(Pc[-(ptrdiff_t)3 * NP + ch]); xm2 = bf2f(Pc[-(ptrdiff_t)2 * NP + ch]); xm1 = bf2f(Pc[-(ptrdiff_t)NP + ch]); }
      const bf16_t* pp = Pc + (size_t)(th * 32) * NP + ch;
#pragma unroll 8
      for (int tt = 0; tt < 32; ++tt) {
        const float x0 = bf2f(pp[(size_t)tt * NP]);
        const float y = w0 * xm3 + w1 * xm2 + w2 * xm1 + w3 * x0;
        stage[(th * 32 + tt) * 129 + c] = silu(y);
        xm3 = xm2; xm2 = xm1; xm1 = x0;
      }
    }
    __syncthreads();
    {
      const int tt = tid >> 2, part = tid & 3;
      float v[32]; float ss = 0.f;
#pragma unroll
      for (int e = 0; e < 32; ++e) { v[e] = stage[tt * 129 + part * 32 + e]; ss += v[e] * v[e]; }
      ss += __shfl_xor(ss, 1); ss += __shfl_xor(ss, 2);
      float rinv = rsqrtf(ss + EPS);
      if (which == 0) rinv *= 0.08838834764831845f;
      bf16_t* dn = (which == 0 ? qn : kn) + tt * 136 + part * 32;
      const float eg = segc[tt];
#pragma unroll
      for (int e = 0; e < 32; e += 8) {
        u4 u; u.x = pk2(v[e] * rinv, v[e + 1] * rinv); u.y = pk2(v[e + 2] * rinv, v[e + 3] * rinv); u.z = pk2(v[e + 4] * rinv, v[e + 5] * rinv); u.w = pk2(v[e + 6] * rinv, v[e + 7] * rinv);
        *(u4*)(dn + e) = u;
        if (which == 0) {
          const float s2 = rinv * eg;
          u4 w; w.x = pk2(v[e] * s2, v[e + 1] * s2); w.y = pk2(v[e + 2] * s2, v[e + 3] * s2); w.z = pk2(v[e + 4] * s2, v[e + 5] * s2); w.w = pk2(v[e + 6] * s2, v[e + 7] * s2);
          *(u4*)(gQD + tt * 128 + part * 32 + e) = w;
        }
      }
    }
    __syncthreads();
  }
  {
    const int d = tid & 127, th = tid >> 7;
    const float gcl = sgc[63];
#pragma unroll
    for (int q8 = 0; q8 < 4; ++q8) {
      float f[8];
#pragma unroll
      for (int e = 0; e < 8; ++e) { const int tt = th * 32 + q8 * 8 + e; f[e] = bf2f(kn[tt * 136 + d]) * expf(gcl - sgc[tt]); }
      *(u4*)(gKDT + d * 64 + th * 32 + q8 * 8) = mk4(pk2(f[0], f[1]), pk2(f[2], f[3]), pk2(f[4], f[5]), pk2(f[6], f[7]));
    }
  }
  {
    const int l31 = lane & 31, lh = lane >> 5, ri = wave >> 1, cj = wave & 1;
    f32x16 kk, qk;
#pragma unroll
    for (int r = 0; r < 16; ++r) { kk[r] = 0.f; qk[r] = 0.f; }
#pragma unroll
    for (int ks = 0; ks < 8; ++ks) {
      const bf16x8 ak = *(const bf16x8*)(kn + (ri * 32 + l31) * 136 + ks * 16 + lh * 8);
      const bf16x8 aq = *(const bf16x8*)(qn + (ri * 32 + l31) * 136 + ks * 16 + lh * 8);
      const bf16x8 bk = *(const bf16x8*)(kn + (cj * 32 + l31) * 136 + ks * 16 + lh * 8);
      kk = MFMA32(ak, bk, kk); qk = MFMA32(aq, bk, qk);
    }
    const int jj = cj * 32 + l31; const float gj = sgc[jj];
#pragma unroll
    for (int r = 0; r < 16; ++r) {
      const int ii = ri * 32 + (r >> 2) * 8 + lh * 4 + (r & 3);
      const float dec = ii >= jj ? expf(sgc[ii] - gj) : 0.f;
      sL[ii * 64 + jj] = ii > jj ? sbeta[ii] * kk[r] * dec : 0.f;
      gAI[ii * 64 + jj] = f2bf(qk[r] * dec);
    }
  }
  __syncthreads();
  {
    float x[64];
    if (tid < 128) {
      const int ch = 1536 + h * 128 + tid;
      const float w0 = convw[ch], w1 = convw[2304 + ch], w2 = convw[2 * 2304 + ch], w3 = convw[3 * 2304 + ch];
      float xm3, xm2, xm1;
      if (samp) { xm3 = cstate[ch]; xm2 = cstate[2304 + ch]; xm1 = cstate[2 * 2304 + ch]; }
      else if (ci == 0) { xm3 = xm2 = xm1 = 0.f; }
      else { xm3 = bf2f(Pc[-(ptrdiff_t)3 * NP + ch]); xm2 = bf2f(Pc[-(ptrdiff_t)2 * NP + ch]); xm1 = bf2f(Pc[-(ptrdiff_t)NP + ch]); }
#pragma unroll
      for (int tt = 0; tt < 64; ++tt) {
        const float x0 = bf2f(Pc[(size_t)tt * NP + ch]);
        const float y = w0 * xm3 + w1 * xm2 + w2 * xm1 + w3 * x0;
        x[tt] = silu(y) * sbeta[tt];
        xm3 = xm2; xm2 = xm1; xm1 = x0;
        if ((tt & 7) == 7) __builtin_amdgcn_sched_barrier(0);
      }
    } else {
#pragma unroll
      for (int tt = 0; tt < 64; ++tt) { x[tt] = bf2f(kn[tt * 136 + tid - 128]) * sbeta[tt] * segc[tt]; if ((tt & 7) == 7) __builtin_amdgcn_sched_barrier(0); }
    }
#pragma unroll
    for (int i = 1; i < 64; ++i) {
      float a = x[i];
#pragma unroll
      for (int jx = 0; jx < i; ++jx) a -= sL[i * 64 + jx] * x[jx];
      x[i] = a;
      __builtin_amdgcn_sched_barrier(0);
    }
    bf16_t* dst = (tid < 128 ? gU : gW) + (tid & 127);
#pragma unroll
    for (int tt = 0; tt < 64; ++tt) { dst[tt * 128] = f2bf(x[tt]); if ((tt & 7) == 7) __builtin_amdgcn_sched_barrier(0); }
  }
}

struct ScanFrags { u4 w[4], qd[4], ai[2], kdt[2][2]; unsigned u01, u23; float gl; };
DEVI void scan_load(const KP& p, int item, int wave, int lane, int sl, ScanFrags& f) {
  const int n = lane & 15, g = lane >> 4;
  const unsigned char* gi = p.ws + WS_G + (size_t)item * G_ITEM;
  const bf16_t* gU = (const bf16_t*)gi; const bf16_t* gW = gU + 8192; const bf16_t* gQD = gW + 8192; const bf16_t* gKDT = gQD + 8192; const bf16_t* gAI = gKDT + 8192;
#pragma unroll
  for (int s = 0; s < 4; ++s) { f.w[s] = *(const u4*)(gW + (16 * wave + n) * 128 + 32 * s + 8 * g); f.qd[s] = *(const u4*)(gQD + (16 * wave + n) * 128 + 32 * s + 8 * g); }
#pragma unroll
  for (int s = 0; s < 2; ++s) {
    f.ai[s] = *(const u4*)(gAI + (16 * wave + n) * 64 + 32 * s + 8 * g);
#pragma unroll
    for (int tt = 0; tt < 2; ++tt) f.kdt[tt][s] = *(const u4*)(gKDT + (32 * wave + 16 * tt + n) * 64 + 32 * s + 8 * g);
  }
  const bf16_t* up = gU + (16 * wave + 4 * g) * 128 + sl * 16 + n;
  f.u01 = (unsigned)up[0] | ((unsigned)up[128] << 16);
  f.u23 = (unsigned)up[256] | ((unsigned)up[384] << 16);
  f.gl = ((const float*)(p.ws + WS_GL))[item];
}
DEVI void scan_step(const ScanFrags& f, f32x4 (&sacc)[2], bf16_t* St, bf16_t* Vnt, bf16_t* O, int t0, int h, int sl, int wave, int n, int g) {
  bf16x8 sf[4];
#pragma unroll
  for (int s = 0; s < 4; ++s) sf[s] = *(const bf16x8*)(St + n * 136 + 32 * s + 8 * g);
  f32x4 wsa = {0.f, 0.f, 0.f, 0.f}, oa = {0.f, 0.f, 0.f, 0.f};
#pragma unroll
  for (int s = 0; s < 4; ++s) wsa = MFMA16(as_frag(f.w[s]), sf[s], wsa);
  float vn[4];
  vn[0] = lo2f(f.u01) - wsa[0]; vn[1] = hi2f(f.u01) - wsa[1]; vn[2] = lo2f(f.u23) - wsa[2]; vn[3] = hi2f(f.u23) - wsa[3];
  { u2 o; o.x = pk2(vn[0], vn[1]); o.y = pk2(vn[2], vn[3]); *(u2*)(Vnt + n * 72 + 16 * wave + 4 * g) = o; }
#pragma unroll
  for (int s = 0; s < 4; ++s) oa = MFMA16(as_frag(f.qd[s]), sf[s], oa);
  LDS_BARRIER();
  bf16x8 vf[2];
#pragma unroll
  for (int s = 0; s < 2; ++s) vf[s] = *(const bf16x8*)(Vnt + n * 72 + 32 * s + 8 * g);
#pragma unroll
  for (int s = 0; s < 2; ++s) oa = MFMA16(as_frag(f.ai[s]), vf[s], oa);
#pragma unroll
  for (int r = 0; r < 4; ++r) O[(size_t)(t0 + 16 * wave + 4 * g + r) * 768 + h * 128 + sl * 16 + n] = f2bf(oa[r]);
#pragma unroll
  for (int tt = 0; tt < 2; ++tt) {
#pragma unroll
    for (int r = 0; r < 4; ++r) sacc[tt][r] *= f.gl;
#pragma unroll
    for (int s = 0; s < 2; ++s) sacc[tt] = MFMA16(as_frag(f.kdt[tt][s]), vf[s], sacc[tt]);
    u2 o; o.x = pk2(sacc[tt][0], sacc[tt][1]); o.y = pk2(sacc[tt][2], sacc[tt][3]);
    *(u2*)(St + n * 136 + 32 * wave + 16 * tt + 4 * g) = o;
  }
  LDS_BARRIER();
}
DEVI void gdn_scan_stream(const KP& p, int j, int ci0, int nch, int h, int sl, const float* s0, float* sout, bf16_t* O, unsigned char* smem) {
  const int tid = get_tid(), lane = tid & 63, wave = tid >> 6, n = lane & 15, g = lane >> 4;
  bf16_t* St = (bf16_t*)smem;
  bf16_t* Vnt = St + 16 * 136;
  f32x4 sacc[2];
#pragma unroll
  for (int tt = 0; tt < 2; ++tt)
#pragma unroll
    for (int r = 0; r < 4; ++r) sacc[tt][r] = s0 ? s0[(size_t)(32 * wave + 16 * tt + 4 * g + r) * 128 + sl * 16 + n] : 0.f;
  __syncthreads();
#pragma unroll
  for (int tt = 0; tt < 2; ++tt) { u2 o; o.x = pk2(sacc[tt][0], sacc[tt][1]); o.y = pk2(sacc[tt][2], sacc[tt][3]); *(u2*)(St + n * 136 + 32 * wave + 16 * tt + 4 * g) = o; }
  ScanFrags f0, f1;
  scan_load(p, ci0 * 6 + h, wave, lane, sl, f0);
  __syncthreads();
#define T0(c) (((ci0 + (c)) >= 256) ? TP + (ci0 + (c) - 256) * 64 : (ci0 + (c)) * 64)
  for (int c = 0; c < nch; c += 2) {
    if (c + 1 < nch) scan_load(p, (ci0 + c + 1) * 6 + h, wave, lane, sl, f1);
    scan_step(f0, sacc, St, Vnt, O, T0(c), h, sl, wave, n, g);
    if (c + 1 < nch) {
      if (c + 2 < nch) scan_load(p, (ci0 + c + 2) * 6 + h, wave, lane, sl, f0);
      scan_step(f1, sacc, St, Vnt, O, T0(c + 1), h, sl, wave, n, g);
    }
  }
#undef T0
#pragma unroll
  for (int tt = 0; tt < 2; ++tt)
#pragma unroll
    for (int r = 0; r < 4; ++r) sout[(size_t)(32 * wave + 16 * tt + 4 * g + r) * 128 + sl * 16 + n] = sacc[tt][r];
}

DEVI int next_item(unsigned* ctr) {
  __shared__ int s_item;
  __syncthreads();
  if (get_tid() == 0) s_item = (int)atomicAdd(ctr, 1u);
  __syncthreads();
  return s_item;
}

DEVI unsigned xcc_id() { return (unsigned)__builtin_amdgcn_s_getreg((3 << 11) | 20) & 0xFu; }
DEVI unsigned ld_relaxed(unsigned* p) { return __hip_atomic_load(p, __ATOMIC_RELAXED, __HIP_MEMORY_SCOPE_AGENT); }
DEVI void gbar_setup(unsigned* ctr, unsigned nb, unsigned* sb) {
  if (get_tid() == 0) {
    const unsigned x = xcc_id();
    __hip_atomic_fetch_add(ctr + 544 + 8 * x, 1u, __ATOMIC_RELAXED, __HIP_MEMORY_SCOPE_AGENT);
    unsigned nx, mine;
    for (;;) {
      unsigned sum = 0; nx = 0; mine = 0;
      for (unsigned j = 0; j < 16; ++j) { const unsigned c = ld_relaxed(ctr + 544 + 8 * j); sum += c; nx += c ? 1u : 0u; mine = (j == x) ? c : mine; }
      if (sum == nb) break;
      __builtin_amdgcn_s_sleep(2);
    }
    sb[0] = x; sb[1] = mine; sb[2] = nx;
  }
  __syncthreads();
}
DEVI void gbar(unsigned* ctr, unsigned* sb, unsigned& gen) {
  asm volatile("s_waitcnt vmcnt(0)" ::: "memory");
  __syncthreads();
  gen++;
  if (get_tid() == 0) {
    const unsigned x = sb[0], nloc = sb[1], nx = sb[2];
    const unsigned old = __hip_atomic_fetch_add(ctr + 704 + 8 * x, 1u, __ATOMIC_RELAXED, __HIP_MEMORY_SCOPE_AGENT);
    if (old + 1u == gen * nloc) {
      __builtin_amdgcn_fence(__ATOMIC_RELEASE, "agent");
      asm volatile("s_waitcnt vmcnt(0)" ::: "memory");
      __hip_atomic_fetch_add(ctr + 528, 1u, __ATOMIC_RELAXED, __HIP_MEMORY_SCOPE_AGENT);
    }
    while (ld_relaxed(ctr + 528) < gen * nx) __builtin_amdgcn_s_sleep(2);
    __builtin_amdgcn_fence(__ATOMIC_ACQUIRE, "agent");
    asm volatile("s_waitcnt vmcnt(0)" ::: "memory");
  }
  __syncthreads();
}
#ifndef ONLY
#define ENAB(k) true
#else
#define ENAB(k) ((ONLY) == (k))
#endif
__global__ void __launch_bounds__(256, 2) mk_fwd(KP p) {
  __shared__ __attribute__((aligned(16))) unsigned char smem[73728];
  cg::grid_group grid = cg::this_grid();
  const int bid = blockIdx.x, nb = gridDim.x;
  const int ngw = nb * 4;
  unsigned char* ws = p.ws;
  unsigned* ctr = (unsigned*)(ws + WS_CTR);
  float* Y = p.out + O_YP;
  bf16_t* XN = (bf16_t*)(ws + WS_XN);
  bf16_t* MIX = (bf16_t*)(ws + WS_MIX);
  bf16_t* Pb = (bf16_t*)(ws + WS_P);
  bf16_t* Hb = (bf16_t*)(ws + WS_H);
  bool did = false;
  unsigned bgen = 0;
  __shared__ unsigned s_bar[4];
  gbar_setup(ctr, nb, s_bar);
  grid.sync();
  for (int ph = p.ph_lo; ph < p.ph_hi; ++ph) {
    const int layer = ph == 0 ? 0 : (ph - 1) / 9, sub = ph == 0 ? -1 : (ph - 1) % 9;
    const int kind = layer & 1, j = layer >> 1;
    if (sub == 3 && kind == 1) continue;
    if (sub == 8 && layer == 3) continue;
    if (did) gbar(ctr, s_bar, bgen);
    did = true;
    const int tid = get_tid(), lane = tid & 63, wave = tid >> 6, gw = bid * 4 + wave;
    (void)tid;
    const int np = kind ? NP_SB : NP_GDN, mqoff = kind ? MQ_SB : MQ_GDN, mixp = kind ? 768 : 1024, mixoff = kind ? 512 : 768;
    if (ph == 0 && ENAB(0)) {
      int base = 0;
      convert_group(base, bid, nb, p.in[12], (bf16_t*)(ws + WS_WIG), 2, 1024, 3340, 3456, 3084, 116, smem);
      convert_group(base, bid, nb, p.in[13], (bf16_t*)(ws + WS_WIS), 2, 1024, 1792, 1792, 1 << 30, 0, smem);
      convert_group(base, bid, nb, p.in[14], (bf16_t*)(ws + WS_WKV), 4, 1024, 512, 512, 1 << 30, 0, smem);
      convert_group(base, bid, nb, p.in[23], (bf16_t*)(ws + WS_WOG), 2, 1024, 1024, 1024, 1 << 30, 0, smem);
      convert_group(base, bid, nb, p.in[24], (bf16_t*)(ws + WS_WOS), 2, 768, 1024, 1024, 1 << 30, 0, smem);
      convert_group(base, bid, nb, p.in[25], (bf16_t*)(ws + WS_WUP), 4, 1024, 4096, 4096, 1 << 30, 0, smem);
      convert_group(base, bid, nb, p.in[26], (bf16_t*)(ws + WS_WDN), 4, 4096, 1024, 1024, 1 << 30, 0, smem);
      for (int r = gw; r < TA; r += ngw) norm_row(r < TP ? p.in[0] + (size_t)r * DM : p.in[1] + (size_t)(r - TP) * DM, p.in[9], XN + (size_t)r * DM, lane);
      for (int i = bid * 256 + tid; i < TS * DM / 4; i += nb * 256) ((float4*)(Y + (size_t)TP * DM))[i] = ((const float4*)p.in[1])[i];
      for (int r = gw; r < 1024; r += ngw) norm_row(p.in[8] + (size_t)(r & 255) * DM, p.in[10] + (r >> 8) * DM, (bf16_t*)(ws + WS_MEMN) + (size_t)r * DM, lane);
    } else if (sub == 0 && ENAB(1)) {
      EpiArgs ea{}; ea.cb = Pb; ea.ldc = np;
      const bf16_t* wt = kind ? (const bf16_t*)(ws + WS_WIS) + (size_t)j * 1792 * 1024 : (const bf16_t*)(ws + WS_WIG) + (size_t)j * 3456 * 1024;
      gemm_phase<0>(XN, DM, wt, 1024, TA, np, ea, smem);
      if (layer == 0) {
        for (int t = bid; t < 32; t += nb) {
          const int l = t >> 3, r = t & 7;
          EpiArgs e2{}; e2.cf = (float*)(ws + WS_MEMKV) + (size_t)l * 256 * 512; e2.ldc = 512;
          gemm_tile<3>((const bf16_t*)(ws + WS_MEMN) + (size_t)l * 256 * DM, DM, (const bf16_t*)(ws + WS_WKV) + (size_t)l * 512 * DM, DM, 1024, (r >> 2) << 7, (r & 3) << 7, e2, smem);
        }
      }
    } else if (sub == 1 && ENAB(2)) {
      if (layer == 0) {
        const float* kv = (const float*)(ws + WS_MEMKV);
        for (int it = gw; it < 4096; it += ngw) {
          const int l = it >> 10, m = (it >> 2) & 255, hh = it & 3;
          const float kx = kv[((size_t)l * 256 + m) * 512 + hh * 64 + lane], vx = kv[((size_t)l * 256 + m) * 512 + 256 + hh * 64 + lane];
          const float ss = wave_sum(kx * kx);
          p.out[O_PMK + ((size_t)l * 256 + m) * 256 + hh * 64 + lane] = kx * rsqrtf(ss * (1.f / 64.f) + EPS) * p.in[16][l * 64 + lane];
          p.out[O_PMV + ((size_t)l * 256 + m) * 256 + hh * 64 + lane] = vx;
        }
      }
      if (kind == 0) {
        for (int it = bid; it < NITEM; it += nb) gdn_prep_item(p, j, it / 6, it % 6, Pb, smem);
      } else {
        bf16_t* Kb = (bf16_t*)(ws + WS_G);
        const float* kg = p.in[22] + j * 128;
        for (int t = gw; t < TA; t += ngw) {
          const bf16_t* pr = Pb + (size_t)t * np;
          const u4 ku = *(const u4*)(pr + 512 + lane * 8), vu = *(const u4*)(pr + 1024 + lane * 8);
          float kf[8] = {lo2f(ku.x), hi2f(ku.x), lo2f(ku.y), hi2f(ku.y), lo2f(ku.z), hi2f(ku.z), lo2f(ku.w), hi2f(ku.w)};
          float ss = 0.f;
#pragma unroll
          for (int e = 0; e < 8; ++e) ss += kf[e] * kf[e];
          ss += __shfl_xor(ss, 1); ss += __shfl_xor(ss, 2); ss += __shfl_xor(ss, 4); ss += __shfl_xor(ss, 8);
          const float sc = rsqrtf(ss * (1.f / 128.f) + EPS);
          const int c0 = (lane & 15) * 8;
#pragma unroll
          for (int e = 0; e < 8; ++e) kf[e] *= sc * kg[c0 + e];
          float* ok = t < TP ? p.out + O_PSK + ((size_t)j * TP + t) * 512 : p.out + O_SSK + ((size_t)j * TS + (t - TP)) * 512;
          float* ov = t < TP ? p.out + O_PSV + ((size_t)j * TP + t) * 512 : p.out + O_SSV + ((size_t)j * TS + (t - TP)) * 512;
          *(float4*)(ok + lane * 8) = make_float4(kf[0], kf[1], kf[2], kf[3]); *(float4*)(ok + lane * 8 + 4) = make_float4(kf[4], kf[5], kf[6], kf[7]);
          *(float4*)(ov + lane * 8) = make_float4(lo2f(vu.x), hi2f(vu.x), lo2f(vu.y), hi2f(vu.y)); *(float4*)(ov + lane * 8 + 4) = make_float4(lo2f(vu.z), hi2f(vu.z), lo2f(vu.w), hi2f(vu.w));
          *(u4*)(Kb + (size_t)t * 512 + lane * 8) = mk4(pk2(kf[0], kf[1]), pk2(kf[2], kf[3]), pk2(kf[4], kf[5]), pk2(kf[6], kf[7]));
        }
      }
    } else if (sub == 2 && ENAB(3)) {
      unsigned* c = ctr + layer * 4;
      if (kind == 0) {
        bf16_t* O = XN;
        if (bid < 64 && (bid & 7) < 6) {
          const int h = bid & 7, sl = bid >> 3;
          gdn_scan_stream(p, j, 0, 256, h, sl, nullptr, p.out + O_PGS + ((size_t)j * 6 + h) * 16384, O, smem);
        }
        for (;;) {
          const int it = next_item(c);
          if (it >= 384 + 544) break;
          if (it < 384) { const int b = it / 48, r = it % 48, h = r >> 3, sl = r & 7;
            gdn_scan_stream(p, j, 256 + b, 1, h, sl, p.in[3] + (((size_t)j * 8 + b) * 6 + h) * 16384, p.out + O_SGS + (((size_t)j * 8 + b) * 6 + h) * 16384, O, smem);
          } else mem_attn_item(p, layer, it - 384, Pb, np, mqoff, MIX, mixp, mixoff, smem);
        }
      } else {
        const bf16_t* Kb = (const bf16_t*)(ws + WS_G);
        const float qs = 0.08838834764831845f * LOG2E;
        for (;;) {
          const int it = next_item(c);
          if (it >= 512 + 32 + 544) break;
          if (it < 512) {
            const int qb = 127 - (it >> 2), h = it & 3;
            KVSrc s; s.k = Kb + h * 128; s.v = Pb + 1024 + h * 128; s.kpitch = 512; s.vpitch = np; s.f32 = 0;
            attn_item<128, 0>(Pb + (size_t)(qb * 128) * np + h * 128, np, 128, p.in[21] + j * 128, qs, s, 2 * qb + 2, qb * 128, 1, s, 0,
                              MIX + (size_t)(qb * 128) * mixp + h * 128, mixp, smem);
          } else if (it < 544) {
            const int b = (it - 512) >> 2, h = it & 3, t0 = TP + b * 64;
            KVSrc sa; sa.k = Kb + (size_t)t0 * 512 + h * 128; sa.v = Pb + (size_t)t0 * np + 1024 + h * 128; sa.kpitch = 512; sa.vpitch = np; sa.f32 = 0;
            KVSrc sb; sb.k = p.in[4] + ((size_t)j * 8 + b) * 2048 * 512 + h * 128; sb.v = p.in[5] + ((size_t)j * 8 + b) * 2048 * 512 + h * 128; sb.kpitch = 512; sb.vpitch = 512; sb.f32 = 1;
            attn_item<128, 0>(Pb + (size_t)t0 * np + h * 128, np, 64, p.in[21] + j * 128, qs, sa, 1, 0, 1, sb, 32,
                              MIX + (size_t)t0 * mixp + h * 128, mixp, smem);
          } else mem_attn_item(p, layer, it - 544, Pb, np, mqoff, MIX, mixp, mixoff, smem);
        }
      }
    } else if (sub == 3 && ENAB(4)) {
      const bf16_t* O = XN;
      const float* og = p.in[20] + j * 128;
      for (int it = gw; it < TA * 6; it += ngw) {
        const int t = it / 6, h = it % 6;
        const unsigned ou = *(const unsigned*)(O + (size_t)t * 768 + h * 128 + lane * 2);
        const unsigned zu = *(const unsigned*)(Pb + (size_t)t * np + 2304 + h * 128 + lane * 2);
        const float o0 = lo2f(ou), o1 = hi2f(ou), z0 = lo2f(zu), z1 = hi2f(zu);
        const float ss = wave_sum(o0 * o0 + o1 * o1);
        const float sc = rsqrtf(ss * (1.f / 128.f) + EPS);
        *(unsigned*)(MIX + (size_t)t * 1024 + h * 128 + lane * 2) = pk2(o0 * sc * og[lane * 2] * silu(z0), o1 * sc * og[lane * 2 + 1] * silu(z1));
      }
    } else if (sub == 4 && ENAB(5)) {
      EpiArgs ea{}; ea.yout = Y;
      if (layer == 0) { ea.res0 = p.in[0]; ea.res1 = p.in[1]; } else { ea.res0 = Y; ea.res1 = nullptr; }
      const bf16_t* wt = kind ? (const bf16_t*)(ws + WS_WOS) + (size_t)j * 1024 * 768 : (const bf16_t*)(ws + WS_WOG) + (size_t)j * 1024 * 1024;
      gemm_phase_res(MIX, mixp, wt, mixp, ea, smem);
    } else if (sub == 5) {
      norm_all(Y, p.in[11] + layer * DM, XN, gw, ngw, lane);
    } else if (sub == 6 && ENAB(6)) {
      EpiArgs ea{}; ea.cb = Hb; ea.ldc = DFF;
      gemm_phase<2>(XN, DM, (const bf16_t*)(ws + WS_WUP) + (size_t)layer * 4096 * 1024, 1024, TA, 4096, ea, smem);
    } else if (sub == 7 && ENAB(7)) {
      EpiArgs ea{}; ea.yout = Y; ea.res0 = Y; ea.res1 = nullptr;
      gemm_phase_res(Hb, DFF, (const bf16_t*)(ws + WS_WDN) + (size_t)layer * 1024 * 4096, 4096, ea, smem);
    } else if (sub == 8) {
      norm_all(Y, p.in[9] + (layer + 1) * DM, XN, gw, ngw, lane);
    }
  }
}

extern "C" void kernel_launch(void* const* d_in, const int* in_sizes, int n_in, void* d_out, int out_size, void* d_ws, size_t ws_size, hipStream_t stream) {
  static int grid_blocks = 0;
  if (!grid_blocks) {
    int dev = 0, cus = 0, per_cu = 0;
    (void)hipGetDevice(&dev);
    (void)hipDeviceGetAttribute(&cus, hipDeviceAttributeMultiprocessorCount, dev);
    (void)hipOccupancyMaxActiveBlocksPerMultiprocessor(&per_cu, mk_fwd, 256, 0);
    if (per_cu > 2) per_cu = 2;
    if (per_cu < 1) per_cu = 1;
    grid_blocks = cus * per_cu;
    if (ws_size < WS_END) fprintf(stderr, "kernel_launch: workspace too small: %zu < %zu\n", ws_size, (size_t)WS_END);
  }
  (void)hipMemsetAsync((char*)d_ws + WS_CTR, 0, 4096, stream);
  KP p{};
  for (int i = 0; i < 27; ++i) p.in[i] = (const float*)d_in[i];
  p.out = (float*)d_out; p.ws = (unsigned char*)d_ws; p.ph_lo = 0; p.ph_hi = 37;
  void* args[] = {&p};
  hipError_t e = hipLaunchCooperativeKernel((void*)mk_fwd, dim3(grid_blocks), dim3(256), args, 0, stream);
  if (e != hipSuccess) fprintf(stderr, "cooperative launch failed: %s (grid %d)\n", hipGetErrorString(e), grid_blocks);
}
```

```cpp
#include <hip/hip_runtime.h>
#include <hip/hip_cooperative_groups.h>
#include <cstdio>
#include <cstdint>
namespace cg = cooperative_groups;

typedef unsigned short bf16_t;
typedef short bf16x8 __attribute__((ext_vector_type(8)));
typedef float f32x16 __attribute__((ext_vector_type(16)));
typedef float f32x4 __attribute__((ext_vector_type(4)));
typedef unsigned u4 __attribute__((ext_vector_type(4)));
typedef unsigned u2 __attribute__((ext_vector_type(2)));
#define DEVI __device__ __forceinline__
__device__ __forceinline__ u4 mk4(unsigned a, unsigned b, unsigned c, unsigned d) { u4 r; r.x = a; r.y = b; r.z = c; r.w = d; return r; }
__device__ __forceinline__ u2 mk2(unsigned a, unsigned b) { u2 r; r.x = a; r.y = b; return r; }
#define MFMA32(a, b, c) __builtin_amdgcn_mfma_f32_32x32x16_bf16((a), (b), (c), 0, 0, 0)
#define LDS_BARRIER() do { asm volatile("s_waitcnt lgkmcnt(0)" ::: "memory"); __builtin_amdgcn_s_barrier(); } while (0)
#define GLOAD16(dst, ptr) asm volatile("global_load_dwordx4 %0, %1, off" : "=&v"(dst) : "v"(ptr) : "memory")
#define VMWAIT(n) asm volatile("s_waitcnt vmcnt(" #n ")" ::: "memory")
#define MFMA16(a, b, c) __builtin_amdgcn_mfma_f32_16x16x32_bf16((a), (b), (c), 0, 0, 0)

constexpr int DM = 1024, TP = 16384, TS = 512, TA = TP + TS, DFF = 4096;
constexpr int NP_GDN = 3456, NP_SB = 1792, MQ_GDN = 3200, MQ_SB = 1536;
constexpr int NCHUNK = 264, NITEM = NCHUNK * 6;
constexpr float EPS = 1e-6f;
constexpr float LOG2E = 1.4426950408889634f;
constexpr size_t O_YP = 0, O_PGC = 17301504, O_PGS = 17315328, O_PSK = 17511936, O_PSV = 34289152, O_PMK = 51066368, O_PMV = 51328512,
                 O_SGC = 51590656, O_SGS = 51701248, O_SSK = 53274112, O_SSV = 53798400;
constexpr size_t WS_CTR = 0;
constexpr size_t WS_WIG = 4096;
constexpr size_t WS_WIS = WS_WIG + 2ull * 3456 * 1024 * 2;
constexpr size_t WS_WKV = WS_WIS + 2ull * 1792 * 1024 * 2;
constexpr size_t WS_WOG = WS_WKV + 4ull * 512 * 1024 * 2;
constexpr size_t WS_WOS = WS_WOG + 2ull * 1024 * 1024 * 2;
constexpr size_t WS_WUP = WS_WOS + 2ull * 1024 * 768 * 2;
constexpr size_t WS_WDN = WS_WUP + 4ull * 4096 * 1024 * 2;
constexpr size_t WS_XN = WS_WDN + 4ull * 4096 * 1024 * 2;
constexpr size_t WS_MIX = WS_XN + (size_t)TA * 1024 * 2;
constexpr size_t WS_MEMN = WS_MIX + (size_t)TA * 1024 * 2;
constexpr size_t WS_MEMKV = WS_MEMN + 4ull * 256 * 1024 * 2;
constexpr size_t WS_BIG = WS_MEMKV + 4ull * 256 * 512 * 4;
constexpr size_t WS_P = WS_BIG;
constexpr size_t WS_G = WS_P + (size_t)TA * 3456 * 2;
constexpr size_t G_ITEM = 73728;
constexpr size_t WS_GL = WS_G + (size_t)NITEM * G_ITEM;
constexpr size_t WS_H = WS_BIG;
constexpr size_t WS_END = WS_GL + 8192;

struct KP { const float* in[27]; float* out; unsigned char* ws; int ph_lo, ph_hi; };

DEVI int get_tid() { int t = __builtin_amdgcn_workitem_id_x(); asm volatile("" : "+v"(t)); return t; }
DEVI float bf2f(bf16_t b) { return __uint_as_float(((unsigned)b) << 16); }
typedef float f32x2_t __attribute__((ext_vector_type(2)));
typedef __bf16 bf16x2_t __attribute__((ext_vector_type(2)));
DEVI unsigned pk2(float lo, float hi) { f32x2_t v = {lo, hi}; return __builtin_bit_cast(unsigned, __builtin_convertvector(v, bf16x2_t)); }
DEVI bf16_t f2bf(float f) { return (bf16_t)(pk2(f, 0.f) & 0xffffu); }
DEVI float lo2f(unsigned u) { return __uint_as_float(u << 16); }
DEVI float hi2f(unsigned u) { return __uint_as_float(u & 0xffff0000u); }
DEVI float ex2(float x) { return __builtin_amdgcn_exp2f(x); }
DEVI float lg2(float x) { return __builtin_amdgcn_logf(x); }
DEVI float wave_sum(float v) {
#pragma unroll
  for (int o = 32; o >= 1; o >>= 1) v += __shfl_xor(v, o);
  return v;
}
DEVI bf16x8 as_frag(u4 u) { return __builtin_bit_cast(bf16x8, u); }
DEVI float silu(float y) { return y / (1.f + __expf(-y)); }

struct EpiArgs { bf16_t* cb; float* cf; int ldc; const float* res0; const float* res1; float* yout; };
template <int EPI>
DEVI void gemm_tile(const bf16_t* __restrict__ A, int lda, const bf16_t* __restrict__ Bt, int ldb, int K, int m0, int n0, const EpiArgs& ea, unsigned char* smem) {
  const int tid = get_tid(), lane = tid & 63, wave = tid >> 6;
  const int wm = wave >> 1, wn = wave & 1, l31 = lane & 31, lh = lane >> 5;
  bf16_t* sA = (bf16_t*)smem;
  bf16_t* sB = sA + 2 * 128 * 72;
  f32x16 acc[2][2];
#pragma unroll
  for (int i = 0; i < 2; ++i)
#pragma unroll
    for (int j = 0; j < 2; ++j)
#pragma unroll
      for (int r = 0; r < 16; ++r) acc[i][j][r] = 0.f;
  const int lr = tid >> 3, lc = (tid & 7) * 8;
  const bf16_t* gA = A + (size_t)(m0 + lr) * lda + lc;
  const bf16_t* gB = Bt + (size_t)(n0 + lr) * ldb + lc;
  u4 ra0[4], rb0[4], ra1[4], rb1[4];
#define G_ISSUE(RA, RB, K0) { _Pragma("unroll") for (int i = 0; i < 4; ++i) { GLOAD16(RA[i], gA + (size_t)i * 32 * lda + (K0)); GLOAD16(RB[i], gB + (size_t)i * 32 * ldb + (K0)); } }
#define G_STASH(RA, RB, BUF) { _Pragma("unroll") for (int i = 0; i < 4; ++i) { *(u4*)(sA + (BUF) * 128 * 72 + (lr + i * 32) * 72 + lc) = RA[i]; *(u4*)(sB + (BUF) * 128 * 72 + (lr + i * 32) * 72 + lc) = RB[i]; } }
#define G_COMPUTE(BUF) { const bf16_t* cA = sA + (BUF) * 128 * 72 + (wm * 64 + l31) * 72 + lh * 8; const bf16_t* cB = sB + (BUF) * 128 * 72 + (wn * 64 + l31) * 72 + lh * 8; \
    _Pragma("unroll") for (int ks = 0; ks < 4; ++ks) { \
      bf16x8 a0 = *(const bf16x8*)(cA + ks * 16), a1 = *(const bf16x8*)(cA + 32 * 72 + ks * 16); \
      bf16x8 b0 = *(const bf16x8*)(cB + ks * 16), b1 = *(const bf16x8*)(cB + 32 * 72 + ks * 16); \
      acc[0][0] = MFMA32(a0, b0, acc[0][0]); acc[0][1] = MFMA32(a0, b1, acc[0][1]); \
      acc[1][0] = MFMA32(a1, b0, acc[1][0]); acc[1][1] = MFMA32(a1, b1, acc[1][1]); } }
  const int nk = K >> 6;
  VMWAIT(0);
  G_ISSUE(ra0, rb0, 0);
  G_ISSUE(ra1, rb1, 64);
  __syncthreads();
  VMWAIT(8);
  G_STASH(ra0, rb0, 0);
  LDS_BARRIER();
  for (int kt = 0; kt < nk; kt += 2) {
    G_ISSUE(ra0, rb0, ((kt + 2 < nk) ? kt + 2 : nk - 1) << 6);
    G_COMPUTE(0);
    VMWAIT(8);
    G_STASH(ra1, rb1, 1);
    LDS_BARRIER();
    G_ISSUE(ra1, rb1, ((kt + 3 < nk) ? kt + 3 : nk - 1) << 6);
    G_COMPUTE(1);
    VMWAIT(8);
    if (kt + 2 < nk) G_STASH(ra0, rb0, 0);
    LDS_BARRIER();
  }
  VMWAIT(0);
#pragma unroll
  for (int i = 0; i < 4; ++i) asm volatile("" :: "v"(ra0[i]), "v"(rb0[i]), "v"(ra1[i]), "v"(rb1[i]));
#undef G_ISSUE
#undef G_STASH
#undef G_COMPUTE
#pragma unroll
  for (int i = 0; i < 2; ++i)
#pragma unroll
    for (int r = 0; r < 16; ++r) {
      const int row = m0 + wm * 64 + i * 32 + (r >> 2) * 8 + lh * 4 + (r & 3);
#pragma unroll
      for (int j = 0; j < 2; ++j) {
        const int col = n0 + wn * 64 + j * 32 + l31;
        const float v = acc[i][j][r];
        if (EPI == 0) ea.cb[(size_t)row * ea.ldc + col] = f2bf(v);
        else if (EPI == 1) {
          const float* rp = ea.res1 ? (row < TP ? ea.res0 + (size_t)row * DM : ea.res1 + (size_t)(row - TP) * DM) : ea.res0 + (size_t)row * DM;
          ea.yout[(size_t)row * DM + col] = rp[col] + v;
        } else if (EPI == 4) { unsafeAtomicAdd(ea.yout + (size_t)row * DM + col, v); }
        else if (EPI == 2) { const float rl = v > 0.f ? v : 0.f; ea.cb[(size_t)row * ea.ldc + col] = f2bf(rl * rl); }
        else ea.cf[(size_t)row * ea.ldc + col] = v;
      }
    }
}
template <int EPI>
DEVI void gemm_phase(const bf16_t* A, int lda, const bf16_t* Bt, int K, int M, int N, const EpiArgs& ea, unsigned char* smem) {
  const int nM = M >> 7, nN = N >> 7, nwg = nM * nN;
  const int q = nwg >> 3, r = nwg & 7;
  for (int L = blockIdx.x; L < nwg; L += gridDim.x) {
    const int xcd = L & 7, off = L >> 3;
    const int wg = (xcd < r ? xcd * (q + 1) : r * (q + 1) + (xcd - r) * q) + off;
    const int nig = 8 * nN, gid = wg / nig, fm = gid * 8, gsz = (nM - fm) < 8 ? (nM - fm) : 8;
    const int pm = fm + ((wg % nig) % gsz), pn = (wg % nig) / gsz;
    gemm_tile<EPI>(A, lda, Bt, K, K, pm << 7, pn << 7, ea, smem);
  }
}

DEVI void gemm_phase_res(const bf16_t* A, int lda, const bf16_t* Bt, int K, const EpiArgs& ea, unsigned char* smem) {
  gemm_phase<1>(A, lda, Bt, K, TP, 1024, ea, smem);
  const int S = (K == 4096) ? 16 : (K >> 7), klen = K / S;
  for (int it = blockIdx.x; it < 32 * S; it += gridDim.x) {
    const int tile = it / S, ks = it % S;
    gemm_tile<4>(A + (size_t)ks * klen, lda, Bt + (size_t)ks * klen, K, klen, TP + ((tile >> 3) << 7), (tile & 7) << 7, ea, smem);
  }
}

DEVI void convert_tile(const float* __restrict__ W, bf16_t* __restrict__ Wt, int K, int N, int k0, int n0, int thr, int shift, unsigned char* smem) {
  float* tile = (float*)smem;
  const int tid = get_tid();
  __syncthreads();
#pragma unroll
  for (int i = 0; i < 4; ++i) {
    const int r = (tid >> 4) + 16 * i, c = (tid & 15) * 4;
    float4 v = make_float4(0.f, 0.f, 0.f, 0.f);
    if (n0 + c < N) v = *(const float4*)(W + (size_t)(k0 + r) * N + n0 + c);
    tile[r * 65 + c] = v.x; tile[r * 65 + c + 1] = v.y; tile[r * 65 + c + 2] = v.z; tile[r * 65 + c + 3] = v.w;
  }
  __syncthreads();
  const int n = tid >> 2, kc = (tid & 3) * 16;
  if (n0 + n < N) {
    const int nn = n0 + n, nd = nn + (nn >= thr ? shift : 0);
    unsigned o[8];
#pragma unroll
    for (int e = 0; e < 8; ++e) o[e] = pk2(tile[(kc + 2 * e) * 65 + n], tile[(kc + 2 * e + 1) * 65 + n]);
    u4* dst = (u4*)(Wt + (size_t)nd * K + k0 + kc);
    dst[0] = mk4(o[0], o[1], o[2], o[3]); dst[1] = mk4(o[4], o[5], o[6], o[7]);
  }
}
DEVI void convert_group(int& base, int bid, int nb, const float* W, bf16_t* Wt, int nl, int K, int N, int NPAD, int thr, int shift, unsigned char* smem) {
  const int tk = K >> 6, tn = (N + 63) >> 6, per = tk * tn, tot = per * nl;
  int first = ((bid - base) % nb + nb) % nb;
  for (int t = first; t < tot; t += nb) {
    const int l = t / per, r = t % per;
    convert_tile(W + (size_t)l * K * N, Wt + (size_t)l * NPAD * K, K, N, (r / tn) << 6, (r % tn) << 6, thr, shift, smem);
  }
  base += tot;
}

DEVI void norm_row(const float* __restrict__ src, const float* __restrict__ gain, bf16_t* __restrict__ dst, int lane) {
  float4 v[4]; float ss = 0.f;
#pragma unroll
  for (int i = 0; i < 4; ++i) { v[i] = *(const float4*)(src + lane * 4 + 256 * i); ss += v[i].x * v[i].x + v[i].y * v[i].y + v[i].z * v[i].z + v[i].w * v[i].w; }
  ss = wave_sum(ss);
  const float sc = rsqrtf(ss * (1.f / 1024.f) + EPS);
#pragma unroll
  for (int i = 0; i < 4; ++i) {
    const float4 g = *(const float4*)(gain + lane * 4 + 256 * i);
    u2 o; o.x = pk2(v[i].x * sc * g.x, v[i].y * sc * g.y); o.y = pk2(v[i].z * sc * g.z, v[i].w * sc * g.w);
    *(u2*)(dst + lane * 4 + 256 * i) = o;
  }
}

DEVI void norm_row2(const float* __restrict__ s0, const float* __restrict__ s1, const float* __restrict__ gain, bf16_t* __restrict__ d0, bf16_t* __restrict__ d1, int lane) {
  float4 v[4], w[4]; float ss = 0.f, tt = 0.f;
#pragma unroll
  for (int i = 0; i < 4; ++i) { v[i] = *(const float4*)(s0 + lane * 4 + 256 * i); w[i] = *(const float4*)(s1 + lane * 4 + 256 * i); }
#pragma unroll
  for (int i = 0; i < 4; ++i) { ss += v[i].x * v[i].x + v[i].y * v[i].y + v[i].z * v[i].z + v[i].w * v[i].w; tt += w[i].x * w[i].x + w[i].y * w[i].y + w[i].z * w[i].z + w[i].w * w[i].w; }
#pragma unroll
  for (int o = 32; o >= 1; o >>= 1) { ss += __shfl_xor(ss, o); tt += __shfl_xor(tt, o); }
  const float sc = rsqrtf(ss * (1.f / 1024.f) + EPS), tc = rsqrtf(tt * (1.f / 1024.f) + EPS);
#pragma unroll
  for (int i = 0; i < 4; ++i) {
    const float4 g = *(const float4*)(gain + lane * 4 + 256 * i);
    u2 o; o.x = pk2(v[i].x * sc * g.x, v[i].y * sc * g.y); o.y = pk2(v[i].z * sc * g.z, v[i].w * sc * g.w);
    *(u2*)(d0 + lane * 4 + 256 * i) = o;
    u2 q; q.x = pk2(w[i].x * tc * g.x, w[i].y * tc * g.y); q.y = pk2(w[i].z * tc * g.z, w[i].w * tc * g.w);
    *(u2*)(d1 + lane * 4 + 256 * i) = q;
  }
}
DEVI void norm_all(const float* __restrict__ Y, const float* __restrict__ gain, bf16_t* __restrict__ XN, int gw, int ngw, int lane) {
  for (int r = gw; r < TA; r += ngw) norm_row(Y + (size_t)r * DM, gain, XN + (size_t)r * DM, lane);
}

struct KVSrc { const void* k; const void* v; int kpitch, vpitch, f32; };
template <int D>
DEVI void attn_load(const KVSrc& s, int r0, u4 (&kr)[D / 32], u4 (&vr)[D / 32]) {
  const int tid = get_tid();
#pragma unroll
  for (int i = 0; i < D / 32; ++i) {
    const int c = tid + 256 * i, key = c / (D / 8), dch = c % (D / 8);
    if (s.f32) {
      const float* kp = (const float*)s.k + (size_t)(r0 + key) * s.kpitch + dch * 8;
      const float* vp = (const float*)s.v + (size_t)(r0 + key) * s.vpitch + dch * 8;
      const float4 a = *(const float4*)kp, b = *(const float4*)(kp + 4), c2 = *(const float4*)vp, d2 = *(const float4*)(vp + 4);
      kr[i] = mk4(pk2(a.x, a.y), pk2(a.z, a.w), pk2(b.x, b.y), pk2(b.z, b.w));
      vr[i] = mk4(pk2(c2.x, c2.y), pk2(c2.z, c2.w), pk2(d2.x, d2.y), pk2(d2.z, d2.w));
    } else {
      kr[i] = *(const u4*)((const bf16_t*)s.k + (size_t)(r0 + key) * s.kpitch + dch * 8);
      vr[i] = *(const u4*)((const bf16_t*)s.v + (size_t)(r0 + key) * s.vpitch + dch * 8);
    }
  }
}
template <int D>
DEVI void attn_store(bf16_t* Ks, bf16_t* Vt, const u4 (&kr)[D / 32], const u4 (&vr)[D / 32]) {
  const int tid = get_tid();
#pragma unroll
  for (int i = 0; i < D / 32; ++i) {
    const int c = tid + 256 * i, key = c / (D / 8), dch = c % (D / 8);
    *(u4*)(Ks + key * (D + 8) + dch * 8) = kr[i];
    const int kx = key ^ ((dch & 15) << 2);
    const unsigned w[4] = {vr[i].x, vr[i].y, vr[i].z, vr[i].w};
#pragma unroll
    for (int e = 0; e < 8; ++e) Vt[(dch * 8 + e) * 72 + kx] = (bf16_t)((w[e >> 1] >> (16 * (e & 1))) & 0xffffu);
  }
}

template <int D, int MODE>
DEVI void attn_item(const bf16_t* __restrict__ qsrc, int qpitch, int nq, const float* __restrict__ qgain, float qscale,
                    const KVSrc& segA, int nA, int qposA0, int maskA, const KVSrc& segB, int nB,
                    bf16_t* __restrict__ out, int opitch, unsigned char* smem) {
  constexpr int KPT = D + 8, NKS = D / 16, NDB = D / 32, NCH = D / 32;
  constexpr int STAGE = 64 * KPT + D * 72;
  const int tid = get_tid(), lane = tid & 63, wave = tid >> 6, l31 = lane & 31, lh = lane >> 5;
  bf16_t* sbase = (bf16_t*)smem;
  const bool active = wave * 32 < nq;
  bf16x8 qf[NKS];
  {
    float qv[NKS][8]; float ss = 0.f;
    const bf16_t* qp = qsrc + (size_t)(wave * 32 + l31) * qpitch + lh * 8;
#pragma unroll
    for (int ks = 0; ks < NKS; ++ks) {
      u4 u = mk4(0, 0, 0, 0);
      if (active) u = *(const u4*)(qp + ks * 16);
      const unsigned w[4] = {u.x, u.y, u.z, u.w};
#pragma unroll
      for (int e = 0; e < 4; ++e) { qv[ks][2 * e] = lo2f(w[e]); qv[ks][2 * e + 1] = hi2f(w[e]); }
#pragma unroll
      for (int e = 0; e < 8; ++e) ss += qv[ks][e] * qv[ks][e];
    }
    ss += __shfl_xor(ss, 32);
    const float sc = rsqrtf(ss * (1.f / D) + EPS) * qscale;
#pragma unroll
    for (int ks = 0; ks < NKS; ++ks) {
      const float4 g0 = *(const float4*)(qgain + ks * 16 + lh * 8), g1 = *(const float4*)(qgain + ks * 16 + lh * 8 + 4);
      u4 u;
      u.x = pk2(qv[ks][0] * sc * g0.x, qv[ks][1] * sc * g0.y); u.y = pk2(qv[ks][2] * sc * g0.z, qv[ks][3] * sc * g0.w);
      u.z = pk2(qv[ks][4] * sc * g1.x, qv[ks][5] * sc * g1.y); u.w = pk2(qv[ks][6] * sc * g1.z, qv[ks][7] * sc * g1.w);
      qf[ks] = as_frag(u);
    }
  }
  f32x16 oacc[NDB];
#pragma unroll
  for (int db = 0; db < NDB; ++db)
#pragma unroll
    for (int r = 0; r < 16; ++r) oacc[db][r] = 0.f;
  float carry = 0.f, mx = -1e30f, lsum = 0.f;
  const int ntot = nA + nB;
  const int qpos = qposA0 + wave * 32 + l31;
  u4 kr[NCH], vr[NCH];
  {
    const bool inA = 0 < nA; const int tix = inA ? nA - 1 : nB - 1;
    attn_load<D>(inA ? segA : segB, tix * 64, kr, vr);
    __syncthreads();
    attn_store<D>(sbase, sbase + 64 * KPT, kr, vr);
    __syncthreads();
  }
  for (int it = 0; it < ntot; ++it) {
    const int cur = it & 1;
    if (it + 1 < ntot) {
      const bool nInA = (it + 1) < nA; const int tix = nInA ? nA - 2 - it : nB - 1 - (it + 1 - nA);
      attn_load<D>(nInA ? segA : segB, tix * 64, kr, vr);
    }
    const bool inA = it < nA;
    const int kbase = inA ? (nA - 1 - it) * 64 : 0;
    const bf16_t* Ks = sbase + cur * STAGE;
    const bf16_t* Vt = Ks + 64 * KPT;
    const bool mneed = inA && maskA && (kbase + 63 >= qposA0 + wave * 32);
    const bool skip = !active || (inA && maskA && (kbase > qposA0 + wave * 32 + 31));
    if (!skip) {
      bf16x8 pf[2][2];
      if (MODE == 0) {
        float after = carry;
#pragma unroll
        for (int rt = 1; rt >= 0; --rt) {
          f32x16 z;
#pragma unroll
          for (int r = 0; r < 16; ++r) z[r] = 0.f;
#pragma unroll
          for (int ks = 0; ks < NKS; ++ks) {
            const bf16x8 a = *(const bf16x8*)(Ks + (rt * 32 + l31) * KPT + ks * 16 + lh * 8);
            z = MFMA32(a, qf[ks], z);
          }
          float m[16];
#pragma unroll
          for (int i = 0; i < 16; ++i) {
            float mm = lg2(1.f + ex2(z[i]));
            if (mneed) { const int key = kbase + rt * 32 + (i >> 2) * 8 + lh * 4 + (i & 3); if (key >= qpos) mm = 0.f; }
            m[i] = mm;
          }
          float a_[16];
#pragma unroll
          for (int g = 3; g >= 0; --g) {
            const float s4 = (m[g * 4] + m[g * 4 + 1]) + (m[g * 4 + 2] + m[g * 4 + 3]);
            const float p4 = __shfl_xor(s4, 32);
            float c = after + (lh == 0 ? p4 : 0.f);
            after += s4 + p4;
#pragma unroll
            for (int e = 3; e >= 0; --e) {
              c += m[g * 4 + e];
              float av = ex2(z[g * 4 + e] - c);
              if (mneed) { const int key = kbase + rt * 32 + g * 8 + lh * 4 + e; if (key >= qpos) av = 0.f; }
              a_[g * 4 + e] = av;
            }
          }
#pragma unroll
          for (int s2 = 0; s2 < 2; ++s2)
            pf[rt][s2] = as_frag(mk4(pk2(a_[8 * s2 + 0], a_[8 * s2 + 1]), pk2(a_[8 * s2 + 2], a_[8 * s2 + 3]), pk2(a_[8 * s2 + 4], a_[8 * s2 + 5]), pk2(a_[8 * s2 + 6], a_[8 * s2 + 7])));
        }
        carry = after;
      } else {
        f32x16 z[2];
#pragma unroll
        for (int rt = 0; rt < 2; ++rt) {
          f32x16 zt;
#pragma unroll
          for (int r = 0; r < 16; ++r) zt[r] = 0.f;
#pragma unroll
          for (int ks = 0; ks < NKS; ++ks) {
            const bf16x8 a = *(const bf16x8*)(Ks + (rt * 32 + l31) * KPT + ks * 16 + lh * 8);
            zt = MFMA32(a, qf[ks], zt);
          }
          z[rt] = zt;
        }
        float tm = z[0][0];
#pragma unroll
        for (int rt = 0; rt < 2; ++rt)
#pragma unroll
          for (int i = 0; i < 16; ++i) tm = fmaxf(tm, z[rt][i]);
        tm = fmaxf(tm, __shfl_xor(tm, 32));
        const float nm = fmaxf(mx, tm);
        const float alpha = ex2(mx - nm);
        mx = nm;
        float ps = 0.f;
        float a_[2][16];
#pragma unroll
        for (int rt = 0; rt < 2; ++rt)
#pragma unroll
          for (int i = 0; i < 16; ++i) { a_[rt][i] = ex2(z[rt][i] - nm); ps += a_[rt][i]; }
        lsum = lsum * alpha + ps;
#pragma unroll
        for (int db = 0; db < NDB; ++db)
#pragma unroll
          for (int r = 0; r < 16; ++r) oacc[db][r] *= alpha;
#pragma unroll
        for (int rt = 0; rt < 2; ++rt)
#pragma unroll
          for (int s2 = 0; s2 < 2; ++s2)
            pf[rt][s2] = as_frag(mk4(pk2(a_[rt][8 * s2 + 0], a_[rt][8 * s2 + 1]), pk2(a_[rt][8 * s2 + 2], a_[rt][8 * s2 + 3]), pk2(a_[rt][8 * s2 + 4], a_[rt][8 * s2 + 5]), pk2(a_[rt][8 * s2 + 6], a_[rt][8 * s2 + 7])));
      }
#pragma unroll
      for (int db = 0; db < NDB; ++db) {
        const int d = db * 32 + l31, sw = ((d >> 3) & 15) << 2;
#pragma unroll
        for (int rt = 0; rt < 2; ++rt)
#pragma unroll
          for (int s = 0; s < 2; ++s) {
            const int kb0 = rt * 32 + 16 * s + 4 * lh;
            const u2 lo = *(const u2*)(Vt + d * 72 + (kb0 ^ sw));
            const u2 hi = *(const u2*)(Vt + d * 72 + ((kb0 + 8) ^ sw));
            oacc[db] = MFMA32(as_frag(mk4(lo.x, lo.y, hi.x, hi.y)), pf[rt][s], oacc[db]);
          }
      }
    }
    if (it + 1 < ntot) { bf16_t* nK = sbase + (cur ^ 1) * STAGE; attn_store<D>(nK, nK + 64 * KPT, kr, vr); }
    LDS_BARRIER();
  }
  if (active) {
    float inv = 1.f;
    if (MODE == 1) { const float l = lsum + __shfl_xor(lsum, 32); inv = 1.f / l; }
    bf16_t* op = out + (size_t)(wave * 32 + l31) * opitch + lh * 4;
#pragma unroll
    for (int db = 0; db < NDB; ++db)
#pragma unroll
      for (int g = 0; g < 4; ++g) {
        u2 o; o.x = pk2(oacc[db][g * 4] * inv, oacc[db][g * 4 + 1] * inv); o.y = pk2(oacc[db][g * 4 + 2] * inv, oacc[db][g * 4 + 3] * inv);
        *(u2*)(op + db * 32 + g * 8) = o;
      }
  }
}

DEVI void mem_attn_item(const KP& p, int layer, int item, const bf16_t* P, int np, int mqoff, bf16_t* mix, int mixp, int mixoff, unsigned char* smem) {
  const int h = item & 3;
  int t0, nq; const float *kk, *vv;
  if (item < 512) { t0 = (item >> 2) * 128; nq = 128; kk = p.out + O_PMK + (size_t)layer * 65536; vv = p.out + O_PMV + (size_t)layer * 65536; }
  else { const int b = (item - 512) >> 2; t0 = TP + b * 64; nq = 64; kk = p.in[6] + ((size_t)layer * 8 + b) * 65536; vv = p.in[7] + ((size_t)layer * 8 + b) * 65536; }
  KVSrc s; s.k = kk + h * 64; s.v = vv + h * 64; s.kpitch = 256; s.vpitch = 256; s.f32 = 1;
  attn_item<64, 1>(P + (size_t)t0 * np + mqoff + h * 64, np, nq, p.in[15] + layer * 64, 0.125f * LOG2E, s, 4, 0, 0, s, 0,
                   mix + (size_t)t0 * mixp + mixoff + h * 64, mixp, smem);
}

DEVI void gdn_prep_item(const KP& p, int j, int ci, int h, const bf16_t* P, unsigned char* smem) {
  constexpr int NP = NP_GDN;
  const int tid = get_tid(), lane = tid & 63, wave = tid >> 6;
  const int item = ci * 6 + h;
  const bool samp = ci >= 256;
  const int b = ci - 256;
  const int t0 = samp ? TP + b * 64 : ci * 64;
  float* stage = (float*)smem;
  float* sL = (float*)smem;
  bf16_t* qn = (bf16_t*)(smem + 33280);
  bf16_t* kn = qn + 64 * 136;
  float* sgc = (float*)(smem + 33280 + 2 * 64 * 136 * 2);
  float* sbeta = sgc + 64;
  float* segc = sbeta + 64;
  unsigned char* gi = p.ws + WS_G + (size_t)item * G_ITEM;
  bf16_t* gU = (bf16_t*)gi; bf16_t* gW = gU + 8192; bf16_t* gQD = gW + 8192; bf16_t* gKDT = gQD + 8192; bf16_t* gAI = gKDT + 8192;
  const float* convw = p.in[17] + (size_t)j * 4 * 2304;
  const float* cstate = p.in[2] + ((size_t)j * 8 + (samp ? b : 0)) * 3 * 2304;
  const bf16_t* Pc = P + (size_t)t0 * NP;
  __syncthreads();
  if (wave == 0) {
    const float braw = bf2f(Pc[(size_t)lane * NP + 3072 + h]), araw = bf2f(Pc[(size_t)lane * NP + 3078 + h]);
    const float beta = 1.f / (1.f + expf(-braw));
    const float xx = araw + p.in[19][j * 6 + h];
    const float sp = xx > 20.f ? xx : log1pf(expf(xx));
    float g = -expf(p.in[18][j * 6 + h]) * sp;
#pragma unroll
    for (int d = 1; d < 64; d <<= 1) { const float v = __shfl_up(g, d); if (lane >= d) g += v; }
    sgc[lane] = g; sbeta[lane] = beta; segc[lane] = expf(g);
    if (lane == 63) ((float*)(p.ws + WS_GL))[item] = expf(g);
  }
  if (samp || ci == 255) {
    float* dst = samp ? p.out + O_SGC + ((size_t)j * 8 + b) * 3 * 2304 : p.out + O_PGC + (size_t)j * 3 * 2304;
    for (int idx = tid; idx < 1152; idx += 256) {
      const int r = idx / 384, cc = idx % 384, ch = (cc >> 7) * 768 + h * 128 + (cc & 127);
      dst[r * 2304 + ch] = bf2f(Pc[(size_t)(61 + r) * NP + ch]);
    }
  }
  const float gcl_dummy = 0.f; (void)gcl_dummy;
#pragma unroll 1
  for (int which = 0; which < 2; ++which) {
    {
      const int c = tid & 127, th = tid >> 7, ch = which * 768 + h * 128 + c;
      const float w0 = convw[ch], w1 = convw[2304 + ch], w2 = convw[2 * 2304 + ch], w3 = convw[3 * 2304 + ch];
      float xm3, xm2, xm1;
      if (th == 1) { xm3 = bf2f(Pc[(size_t)29 * NP + ch]); xm2 = bf2f(Pc[(size_t)30 * NP + ch]); xm1 = bf2f(Pc[(size_t)31 * NP + ch]); }
      else if (samp) { xm3 = cstate[ch]; xm2 = cstate[2304 + ch]; xm1 = cstate[2 * 2304 + ch]; }
      else if (ci == 0) { xm3 = xm2 = xm1 = 0.f; }
      else { xm3 = bf2f(Pc[-(ptrdiff_t)3 * NP + ch]); xm2 = bf2f(Pc[-(ptrdiff_t)2 * NP + ch]); xm1 = bf2f(Pc[-(ptrdiff_t)NP + ch]); }
      const bf16_t* pp = Pc + (size_t)(th * 32) * NP + ch;
#pragma unroll 8
      for (int tt = 0; tt < 32; ++tt) {
        const float x0 = bf2f(pp[(size_t)tt * NP]);
        const float y = w0 * xm3 + w1 * xm2 + w2 * xm1 + w3 * x0;
        stage[(th * 32 + tt) * 129 + c] = silu(y);
        xm3 = xm2; xm2 = xm1; xm1 = x0;
      }
    }
    __syncthreads();
    {
      const int tt = tid >> 2, part = tid & 3;
      float v[32]; float ss = 0.f;
#pragma unroll
      for (int e = 0; e < 32; ++e) { v[e] = stage[tt * 129 + part * 32 + e]; ss += v[e] * v[e]; }
      ss += __shfl_xor(ss, 1); ss += __shfl_xor(ss, 2);
      float rinv = rsqrtf(ss + EPS);
      if (which == 0) rinv *= 0.08838834764831845f;
      bf16_t* dn = (which == 0 ? qn : kn) + tt * 136 + part * 32;
      const float eg = segc[tt];
#pragma unroll
      for (int e = 0; e < 32; e += 8) {
        u4 u; u.x = pk2(v[e] * rinv, v[e + 1] * rinv); u.y = pk2(v[e + 2] * rinv, v[e + 3] * rinv); u.z = pk2(v[e + 4] * rinv, v[e + 5] * rinv); u.w = pk2(v[e + 6] * rinv, v[e + 7] * rinv);
        *(u4*)(dn + e) = u;
        if (which == 0) {
          const float s2 = rinv * eg;
          u4 w; w.x = pk2(v[e] * s2, v[e + 1] * s2); w.y = pk2(v[e + 2] * s2, v[e + 3] * s2); w.z = pk2(v[e + 4] * s2, v[e + 5] * s2); w.w = pk2(v[e + 6] * s2, v[e + 7] * s2);
          *(u4*)(gQD + tt * 128 + part * 32 + e) = w;
        }
      }
    }
    __syncthreads();
  }
  {
    const int d = tid & 127, th = tid >> 7;
    const float gcl = sgc[63];
#pragma unroll
    for (int q8 = 0; q8 < 4; ++q8) {
      float f[8];
#pragma unroll
      for (int e = 0; e < 8; ++e) { const int tt = th * 32 + q8 * 8 + e; f[e] = bf2f(kn[tt * 136 + d]) * expf(gcl - sgc[tt]); }
      *(u4*)(gKDT + d * 64 + th * 32 + q8 * 8) = mk4(pk2(f[0], f[1]), pk2(f[2], f[3]), pk2(f[4], f[5]), pk2(f[6], f[7]));
    }
  }
  {
    const int l31 = lane & 31, lh = lane >> 5, ri = wave >> 1, cj = wave & 1;
    f32x16 kk, qk;
#pragma unroll
    for (int r = 0; r < 16; ++r) { kk[r] = 0.f; qk[r] = 0.f; }
#pragma unroll
    for (int ks = 0; ks < 8; ++ks) {
      const bf16x8 ak = *(const bf16x8*)(kn + (ri * 32 + l31) * 136 + ks * 16 + lh * 8);
      const bf16x8 aq = *(const bf16x8*)(qn + (ri * 32 + l31) * 136 + ks * 16 + lh * 8);
      const bf16x8 bk = *(const bf16x8*)(kn + (cj * 32 + l31) * 136 + ks * 16 + lh * 8);
      kk = MFMA32(ak, bk, kk); qk = MFMA32(aq, bk, qk);
    }
    const int jj = cj * 32 + l31; const float gj = sgc[jj];
#pragma unroll
    for (int r = 0; r < 16; ++r) {
      const int ii = ri * 32 + (r >> 2) * 8 + lh * 4 + (r & 3);
      const float dec = ii >= jj ? expf(sgc[ii] - gj) : 0.f;
      sL[ii * 64 + jj] = ii > jj ? sbeta[ii] * kk[r] * dec : 0.f;
      gAI[ii * 64 + jj] = f2bf(qk[r] * dec);
    }
  }
  __syncthreads();
  {
    float x[64];
    if (tid < 128) {
      const int ch = 1536 + h * 128 + tid;
      const float w0 = convw[ch], w1 = convw[2304 + ch], w2 = convw[2 * 2304 + ch], w3 = convw[3 * 2304 + ch];
      float xm3, xm2, xm1;
      if (samp) { xm3 = cstate[ch]; xm2 = cstate[2304 + ch]; xm1 = cstate[2 * 2304 + ch]; }
      else if (ci == 0) { xm3 = xm2 = xm1 = 0.f; }
      else { xm3 = bf2f(Pc[-(ptrdiff_t)3 * NP + ch]); xm2 = bf2f(Pc[-(ptrdiff_t)2 * NP + ch]); xm1 = bf2f(Pc[-(ptrdiff_t)NP + ch]); }
#pragma unroll
      for (int tt = 0; tt < 64; ++tt) {
        const float x0 = bf2f(Pc[(size_t)tt * NP + ch]);
        const float y = w0 * xm3 + w1 * xm2 + w2 * xm1 + w3 * x0;
        x[tt] = silu(y) * sbeta[tt];
        xm3 = xm2; xm2 = xm1; xm1 = x0;
        if ((tt & 7) == 7) __builtin_amdgcn_sched_barrier(0);
      }
    } else {
#pragma unroll
      for (int tt = 0; tt < 64; ++tt) { x[tt] = bf2f(kn[tt * 136 + tid - 128]) * sbeta[tt] * segc[tt]; if ((tt & 7) == 7) __builtin_amdgcn_sched_barrier(0); }
    }
#pragma unroll
    for (int i = 1; i < 64; ++i) {
      float a = x[i];
#pragma unroll
      for (int jx = 0; jx < i; ++jx) a -= sL[i * 64 + jx] * x[jx];
      x[i] = a;
      __builtin_amdgcn_sched_barrier(0);
    }
    bf16_t* dst = (tid < 128 ? gU : gW) + (tid & 127);
#pragma unroll
    for (int tt = 0; tt < 64; ++tt) { dst[tt * 128] = f2bf(x[tt]); if ((tt & 7) == 7) __builtin_amdgcn_sched_barrier(0); }
  }
}

struct ScanFrags { u4 w[4], qd[4], ai[2], kdt[2][2]; unsigned u[4]; float gl; };
DEVI void scan_load(const KP& p, int item, int wave, int lane, int sl, ScanFrags& f) {
  const int n = lane & 15, g = lane >> 4;
  const unsigned char* gi = p.ws + WS_G + (size_t)item * G_ITEM;
  const bf16_t* gU = (const bf16_t*)gi; const bf16_t* gW = gU + 8192; const bf16_t* gQD = gW + 8192; const bf16_t* gKDT = gQD + 8192; const bf16_t* gAI = gKDT + 8192;
#pragma unroll
  for (int s = 0; s < 4; ++s) { GLOAD16(f.w[s], gW + (16 * wave + n) * 128 + 32 * s + 8 * g); GLOAD16(f.qd[s], gQD + (16 * wave + n) * 128 + 32 * s + 8 * g); }
#pragma unroll
  for (int s = 0; s < 2; ++s) {
    GLOAD16(f.ai[s], gAI + (16 * wave + n) * 64 + 32 * s + 8 * g);
#pragma unroll
    for (int tt = 0; tt < 2; ++tt) GLOAD16(f.kdt[tt][s], gKDT + (32 * wave + 16 * tt + n) * 64 + 32 * s + 8 * g);
  }
  const bf16_t* up = gU + (16 * wave + 4 * g) * 128 + sl * 16 + n;
#pragma unroll
  for (int r = 0; r < 4; ++r) asm volatile("global_load_ushort %0, %1, off" : "=&v"(f.u[r]) : "v"(up + r * 128) : "memory");
  const float* glp = (const float*)(p.ws + WS_GL) + item;
  asm volatile("global_load_dword %0, %1, off" : "=&v"(f.gl) : "v"(glp) : "memory");
}
DEVI void scan_wait19(ScanFrags& f) {
  asm volatile("s_waitcnt vmcnt(19)"
               : "+v"(f.w[0]), "+v"(f.w[1]), "+v"(f.w[2]), "+v"(f.w[3]), "+v"(f.qd[0]), "+v"(f.qd[1]), "+v"(f.qd[2]), "+v"(f.qd[3]),
                 "+v"(f.ai[0]), "+v"(f.ai[1]), "+v"(f.kdt[0][0]), "+v"(f.kdt[0][1]), "+v"(f.kdt[1][0]), "+v"(f.kdt[1][1]),
                 "+v"(f.u[0]), "+v"(f.u[1]), "+v"(f.u[2]), "+v"(f.u[3]), "+v"(f.gl)
               :: "memory");
}
DEVI void scan_keep(const ScanFrags& f) {
#pragma unroll
  for (int s = 0; s < 4; ++s) asm volatile("" :: "v"(f.w[s]), "v"(f.qd[s]));
#pragma unroll
  for (int s = 0; s < 2; ++s) asm volatile("" :: "v"(f.ai[s]), "v"(f.kdt[0][s]), "v"(f.kdt[1][s]));
  asm volatile("" :: "v"(f.u[0]), "v"(f.u[1]), "v"(f.u[2]), "v"(f.u[3]), "v"(f.gl));
}
DEVI void scan_step(const ScanFrags& f, f32x4 (&sacc)[2], bf16_t* St, bf16_t* Vnt, bf16_t* O, int t0, int h, int sl, int wave, int n, int g) {
  bf16x8 sf[4];
#pragma unroll
  for (int s = 0; s < 4; ++s) sf[s] = *(const bf16x8*)(St + n * 136 + 32 * s + 8 * g);
  f32x4 wsa = {0.f, 0.f, 0.f, 0.f}, oa = {0.f, 0.f, 0.f, 0.f};
#pragma unroll
  for (int s = 0; s < 4; ++s) wsa = MFMA16(as_frag(f.w[s]), sf[s], wsa);
  float vn[4];
  vn[0] = lo2f(f.u[0]) - wsa[0]; vn[1] = lo2f(f.u[1]) - wsa[1]; vn[2] = lo2f(f.u[2]) - wsa[2]; vn[3] = lo2f(f.u[3]) - wsa[3];
  { u2 o; o.x = pk2(vn[0], vn[1]); o.y = pk2(vn[2], vn[3]); *(u2*)(Vnt + n * 72 + 16 * wave + 4 * g) = o; }
#pragma unroll
  for (int s = 0; s < 4; ++s) oa = MFMA16(as_frag(f.qd[s]), sf[s], oa);
  LDS_BARRIER();
  bf16x8 vf[2];
#pragma unroll
  for (int s = 0; s < 2; ++s) vf[s] = *(const bf16x8*)(Vnt + n * 72 + 32 * s + 8 * g);
#pragma unroll
  for (int s = 0; s < 2; ++s) oa = MFMA16(as_frag(f.ai[s]), vf[s], oa);
#pragma unroll
  for (int r = 0; r < 4; ++r) O[(size_t)(t0 + 16 * wave + 4 * g + r) * 768 + h * 128 + sl * 16 + n] = f2bf(oa[r]);
#pragma unroll
  for (int tt = 0; tt < 2; ++tt) {
#pragma unroll
    for (int r = 0; r < 4; ++r) sacc[tt][r] *= f.gl;
#pragma unroll
    for (int s = 0; s < 2; ++s) sacc[tt] = MFMA16(as_frag(f.kdt[tt][s]), vf[s], sacc[tt]);
    u2 o; o.x = pk2(sacc[tt][0], sacc[tt][1]); o.y = pk2(sacc[tt][2], sacc[tt][3]);
    *(u2*)(St + n * 136 + 32 * wave + 16 * tt + 4 * g) = o;
  }
  LDS_BARRIER();
}
DEVI void gdn_scan_stream(const KP& p, int j, int ci0, int nch, int h, int sl, const float* s0, float* sout, bf16_t* O, unsigned char* smem) {
  const int tid = get_tid(), lane = tid & 63, wave = tid >> 6, n = lane & 15, g = lane >> 4;
  bf16_t* St = (bf16_t*)smem;
  bf16_t* Vnt = St + 16 * 136;
  f32x4 sacc[2];
#pragma unroll
  for (int tt = 0; tt < 2; ++tt)
#pragma unroll
    for (int r = 0; r < 4; ++r) sacc[tt][r] = s0 ? s0[(size_t)(32 * wave + 16 * tt + 4 * g + r) * 128 + sl * 16 + n] : 0.f;
  __syncthreads();
#pragma unroll
  for (int tt = 0; tt < 2; ++tt) { u2 o; o.x = pk2(sacc[tt][0], sacc[tt][1]); o.y = pk2(sacc[tt][2], sacc[tt][3]); *(u2*)(St + n * 136 + 32 * wave + 16 * tt + 4 * g) = o; }
  ScanFrags f0, f1;
#define CL(c) ((ci0 + (((c) < nch) ? (c) : nch - 1)) * 6 + h)
#define T0(c) (((ci0 + (c)) >= 256) ? TP + (ci0 + (c) - 256) * 64 : (ci0 + (c)) * 64)
  VMWAIT(0);
  scan_load(p, CL(0), wave, lane, sl, f0);
  LDS_BARRIER();
  for (int c = 0; c < nch; c += 2) {
    scan_load(p, CL(c + 1), wave, lane, sl, f1); scan_wait19(f0);
    scan_step(f0, sacc, St, Vnt, O, T0(c), h, sl, wave, n, g);
    if (c + 1 < nch) {
      scan_load(p, CL(c + 2), wave, lane, sl, f0); scan_wait19(f1);
      scan_step(f1, sacc, St, Vnt, O, T0(c + 1), h, sl, wave, n, g);
    }
  }
  VMWAIT(0);
  scan_keep(f0); scan_keep(f1);
#undef CL
#undef T0
#pragma unroll
  for (int tt = 0; tt < 2; ++tt)
#pragma unroll
    for (int r = 0; r < 4; ++r) sout[(size_t)(32 * wave + 16 * tt + 4 * g + r) * 128 + sl * 16 + n] = sacc[tt][r];
}

DEVI int next_item(unsigned* ctr) {
  __shared__ int s_item;
  __syncthreads();
  if (get_tid() == 0) s_item = (int)atomicAdd(ctr, 1u);
  __syncthreads();
  return s_item;
}

DEVI unsigned xcc_id() { return (unsigned)__builtin_amdgcn_s_getreg((3 << 11) | 20) & 0xFu; }
DEVI unsigned ld_relaxed(unsigned* p) { return __hip_atomic_load(p, __ATOMIC_RELAXED, __HIP_MEMORY_SCOPE_AGENT); }
DEVI void gbar_setup(unsigned* ctr, unsigned nb, unsigned* sb) {
  if (get_tid() == 0) {
    const unsigned x = xcc_id();
    __hip_atomic_fetch_add(ctr + 544 + 8 * x, 1u, __ATOMIC_RELAXED, __HIP_MEMORY_SCOPE_AGENT);
    unsigned nx, mine;
    for (;;) {
      unsigned sum = 0; nx = 0; mine = 0;
      for (unsigned j = 0; j < 16; ++j) { const unsigned c = ld_relaxed(ctr + 544 + 8 * j); sum += c; nx += c ? 1u : 0u; mine = (j == x) ? c : mine; }
      if (sum == nb) break;
      __builtin_amdgcn_s_sleep(2);
    }
    sb[0] = x; sb[1] = mine; sb[2] = nx;
  }
  __syncthreads();
}
DEVI void gbar(unsigned* ctr, unsigned* sb, unsigned& gen) {
  asm volatile("s_waitcnt vmcnt(0)" ::: "memory");
  __syncthreads();
  gen++;
  if (get_tid() == 0) {
    const unsigned x = sb[0], nloc = sb[1], nx = sb[2];
    const unsigned old = __hip_atomic_fetch_add(ctr + 704 + 8 * x, 1u, __ATOMIC_RELAXED, __HIP_MEMORY_SCOPE_AGENT);
    if (old + 1u == gen * nloc) {
      __builtin_amdgcn_fence(__ATOMIC_RELEASE, "agent");
      asm volatile("s_waitcnt vmcnt(0)" ::: "memory");
      __hip_atomic_fetch_add(ctr + 528, 1u, __ATOMIC_RELAXED, __HIP_MEMORY_SCOPE_AGENT);
    }
    while (ld_relaxed(ctr + 528) < gen * nx) __builtin_amdgcn_s_sleep(2);
    __builtin_amdgcn_fence(__ATOMIC_ACQUIRE, "agent");
    asm volatile("s_waitcnt vmcnt(0)" ::: "memory");
  }
  __syncthreads();
}
#ifndef ONLY
#define ENAB(k) true
#else
#define ENAB(k) ((ONLY) == (k))
#endif
__global__ void __launch_bounds__(256, 2) mk_fwd(KP p) {
  __shared__ __attribute__((aligned(16))) unsigned char smem[73728];
  cg::grid_group grid = cg::this_grid();
  const int bid = blockIdx.x, nb = gridDim.x;
  const int ngw = nb * 4;
  unsigned char* ws = p.ws;
  unsigned* ctr = (unsigned*)(ws + WS_CTR);
  float* Y = p.out + O_YP;
  bf16_t* XN = (bf16_t*)(ws + WS_XN);
  bf16_t* MIX = (bf16_t*)(ws + WS_MIX);
  bf16_t* Pb = (bf16_t*)(ws + WS_P);
  bf16_t* Hb = (bf16_t*)(ws + WS_H);
  bool did = false;
  unsigned bgen = 0;
  __shared__ unsigned s_bar[4];
  gbar_setup(ctr, nb, s_bar);
  grid.sync();
  for (int ph = p.ph_lo; ph < p.ph_hi; ++ph) {
    const int layer = ph == 0 ? 0 : (ph - 1) / 9, sub = ph == 0 ? -1 : (ph - 1) % 9;
    const int kind = layer & 1, j = layer >> 1;
    if (sub == 3 && kind == 1) continue;
    if (sub == 8 && layer == 3) continue;
    if (did) gbar(ctr, s_bar, bgen);
    did = true;
    const int tid = get_tid(), lane = tid & 63, wave = tid >> 6, gw = bid * 4 + wave;
    (void)tid;
    const int np = kind ? NP_SB : NP_GDN, mqoff = kind ? MQ_SB : MQ_GDN, mixp = kind ? 768 : 1024, mixoff = kind ? 512 : 768;
    if (ph == 0 && ENAB(0)) {
      int base = 0;
      convert_group(base, bid, nb, p.in[12], (bf16_t*)(ws + WS_WIG), 2, 1024, 3340, 3456, 3084, 116, smem);
      convert_group(base, bid, nb, p.in[13], (bf16_t*)(ws + WS_WIS), 2, 1024, 1792, 1792, 1 << 30, 0, smem);
      convert_group(base, bid, nb, p.in[14], (bf16_t*)(ws + WS_WKV), 4, 1024, 512, 512, 1 << 30, 0, smem);
      convert_group(base, bid, nb, p.in[23], (bf16_t*)(ws + WS_WOG), 2, 1024, 1024, 1024, 1 << 30, 0, smem);
      convert_group(base, bid, nb, p.in[24], (bf16_t*)(ws + WS_WOS), 2, 768, 1024, 1024, 1 << 30, 0, smem);
      convert_group(base, bid, nb, p.in[25], (bf16_t*)(ws + WS_WUP), 4, 1024, 4096, 4096, 1 << 30, 0, smem);
      convert_group(base, bid, nb, p.in[26], (bf16_t*)(ws + WS_WDN), 4, 4096, 1024, 1024, 1 << 30, 0, smem);
      for (int r = gw; r < TA; r += ngw) norm_row(r < TP ? p.in[0] + (size_t)r * DM : p.in[1] + (size_t)(r - TP) * DM, p.in[9], XN + (size_t)r * DM, lane);
      for (int i = bid * 256 + tid; i < TS * DM / 4; i += nb * 256) ((float4*)(Y + (size_t)TP * DM))[i] = ((const float4*)p.in[1])[i];
      for (int r = gw; r < 1024; r += ngw) norm_row(p.in[8] + (size_t)(r & 255) * DM, p.in[10] + (r >> 8) * DM, (bf16_t*)(ws + WS_MEMN) + (size_t)r * DM, lane);
    } else if (sub == 0 && ENAB(1)) {
      EpiArgs ea{}; ea.cb = Pb; ea.ldc = np;
      const bf16_t* wt = kind ? (const bf16_t*)(ws + WS_WIS) + (size_t)j * 1792 * 1024 : (const bf16_t*)(ws + WS_WIG) + (size_t)j * 3456 * 1024;
      gemm_phase<0>(XN, DM, wt, 1024, TA, np, ea, smem);
      if (layer == 0) {
        for (int t = bid; t < 32; t += nb) {
          const int l = t >> 3, r = t & 7;
          EpiArgs e2{}; e2.cf = (float*)(ws + WS_MEMKV) + (size_t)l * 256 * 512; e2.ldc = 512;
          gemm_tile<3>((const bf16_t*)(ws + WS_MEMN) + (size_t)l * 256 * DM, DM, (const bf16_t*)(ws + WS_WKV) + (size_t)l * 512 * DM, DM, 1024, (r >> 2) << 7, (r & 3) << 7, e2, smem);
        }
      }
    } else if (sub == 1 && ENAB(2)) {
      if (layer == 0) {
        const float* kv = (const float*)(ws + WS_MEMKV);
        for (int it = gw; it < 4096; it += ngw) {
          const int l = it >> 10, m = (it >> 2) & 255, hh = it & 3;
          const float kx = kv[((size_t)l * 256 + m) * 512 + hh * 64 + lane], vx = kv[((size_t)l * 256 + m) * 512 + 256 + hh * 64 + lane];
          const float ss = wave_sum(kx * kx);
          p.out[O_PMK + ((size_t)l * 256 + m) * 256 + hh * 64 + lane] = kx * rsqrtf(ss * (1.f / 64.f) + EPS) * p.in[16][l * 64 + lane];
          p.out[O_PMV + ((size_t)l * 256 + m) * 256 + hh * 64 + lane] = vx;
        }
      }
      if (kind == 0) {
        for (int it = bid; it < NITEM; it += nb) gdn_prep_item(p, j, it / 6, it % 6, Pb, smem);
      } else {
        bf16_t* Kb = (bf16_t*)(ws + WS_G);
        const float* kg = p.in[22] + j * 128;
        for (int t = gw; t < TA; t += ngw) {
          const bf16_t* pr = Pb + (size_t)t * np;
          const u4 ku = *(const u4*)(pr + 512 + lane * 8), vu = *(const u4*)(pr + 1024 + lane * 8);
          float kf[8] = {lo2f(ku.x), hi2f(ku.x), lo2f(ku.y), hi2f(ku.y), lo2f(ku.z), hi2f(ku.z), lo2f(ku.w), hi2f(ku.w)};
          float ss = 0.f;
#pragma unroll
          for (int e = 0; e < 8; ++e) ss += kf[e] * kf[e];
          ss += __shfl_xor(ss, 1); ss += __shfl_xor(ss, 2); ss += __shfl_xor(ss, 4); ss += __shfl_xor(ss, 8);
          const float sc = rsqrtf(ss * (1.f / 128.f) + EPS);
          const int c0 = (lane & 15) * 8;
#pragma unroll
          for (int e = 0; e < 8; ++e) kf[e] *= sc * kg[c0 + e];
          float* ok = t < TP ? p.out + O_PSK + ((size_t)j * TP + t) * 512 : p.out + O_SSK + ((size_t)j * TS + (t - TP)) * 512;
          float* ov = t < TP ? p.out + O_PSV + ((size_t)j * TP + t) * 512 : p.out + O_SSV + ((size_t)j * TS + (t - TP)) * 512;
          *(float4*)(ok + lane * 8) = make_float4(kf[0], kf[1], kf[2], kf[3]); *(float4*)(ok + lane * 8 + 4) = make_float4(kf[4], kf[5], kf[6], kf[7]);
          *(float4*)(ov + lane * 8) = make_float4(lo2f(vu.x), hi2f(vu.x), lo2f(vu.y), hi2f(vu.y)); *(float4*)(ov + lane * 8 + 4) = make_float4(lo2f(vu.z), hi2f(vu.z), lo2f(vu.w), hi2f(vu.w));
          *(u4*)(Kb + (size_t)t * 512 + lane * 8) = mk4(pk2(kf[0], kf[1]), pk2(kf[2], kf[3]), pk2(kf[4], kf[5]), pk2(kf[6], kf[7]));
        }
      }
    } else if (sub == 2 && ENAB(3)) {
      unsigned* c = ctr + layer * 4;
      if (kind == 0) {
        bf16_t* O = XN;
        if (bid < 64 && (bid & 7) < 6) {
          const int h = bid & 7, sl = bid >> 3;
          gdn_scan_stream(p, j, 0, 256, h, sl, nullptr, p.out + O_PGS + ((size_t)j * 6 + h) * 16384, O, smem);
        }
        for (;;) {
          const int it = next_item(c);
          if (it >= 384 + 544) break;
          if (it < 384) { const int b = it / 48, r = it % 48, h = r >> 3, sl = r & 7;
            gdn_scan_stream(p, j, 256 + b, 1, h, sl, p.in[3] + (((size_t)j * 8 + b) * 6 + h) * 16384, p.out + O_SGS + (((size_t)j * 8 + b) * 6 + h) * 16384, O, smem);
          } else mem_attn_item(p, layer, it - 384, Pb, np, mqoff, MIX, mixp, mixoff, smem);
        }
      } else {
        const bf16_t* Kb = (const bf16_t*)(ws + WS_G);
        const float qs = 0.08838834764831845f * LOG2E;
        for (;;) {
          const int it = next_item(c);
          if (it >= 512 + 32 + 544) break;
          if (it < 512) {
            const int qb = 127 - (it >> 2), h = it & 3;
            KVSrc s; s.k = Kb + h * 128; s.v = Pb + 1024 + h * 128; s.kpitch = 512; s.vpitch = np; s.f32 = 0;
            attn_item<128, 0>(Pb + (size_t)(qb * 128) * np + h * 128, np, 128, p.in[21] + j * 128, qs, s, 2 * qb + 2, qb * 128, 1, s, 0,
                              MIX + (size_t)(qb * 128) * mixp + h * 128, mixp, smem);
          } else if (it < 544) {
            const int b = (it - 512) >> 2, h = it & 3, t0 = TP + b * 64;
            KVSrc sa; sa.k = Kb + (size_t)t0 * 512 + h * 128; sa.v = Pb + (size_t)t0 * np + 1024 + h * 128; sa.kpitch = 512; sa.vpitch = np; sa.f32 = 0;
            KVSrc sb; sb.k = p.in[4] + ((size_t)j * 8 + b) * 2048 * 512 + h * 128; sb.v = p.in[5] + ((size_t)j * 8 + b) * 2048 * 512 + h * 128; sb.kpitch = 512; sb.vpitch = 512; sb.f32 = 1;
            attn_item<128, 0>(Pb + (size_t)t0 * np + h * 128, np, 64, p.in[21] + j * 128, qs, sa, 1, 0, 1, sb, 32,
                              MIX + (size_t)t0 * mixp + h * 128, mixp, smem);
          } else mem_attn_item(p, layer, it - 544, Pb, np, mqoff, MIX, mixp, mixoff, smem);
        }
      }
    } else if (sub == 3 && ENAB(4)) {
      const bf16_t* O = XN;
      const float* og = p.in[20] + j * 128;
      for (int it = gw; it < TA * 6; it += ngw) {
        const int t = it / 6, h = it % 6;
        const unsigned ou = *(const unsigned*)(O + (size_t)t * 768 + h * 128 + lane * 2);
        const unsigned zu = *(const unsigned*)(Pb + (size_t)t * np + 2304 + h * 128 + lane * 2);
        const float o0 = lo2f(ou), o1 = hi2f(ou), z0 = lo2f(zu), z1 = hi2f(zu);
        const float ss = wave_sum(o0 * o0 + o1 * o1);
        const float sc = rsqrtf(ss * (1.f / 128.f) + EPS);
        *(unsigned*)(MIX + (size_t)t * 1024 + h * 128 + lane * 2) = pk2(o0 * sc * og[lane * 2] * silu(z0), o1 * sc * og[lane * 2 + 1] * silu(z1));
      }
    } else if (sub == 4 && ENAB(5)) {
      EpiArgs ea{}; ea.yout = Y;
      if (layer == 0) { ea.res0 = p.in[0]; ea.res1 = p.in[1]; } else { ea.res0 = Y; ea.res1 = nullptr; }
      const bf16_t* wt = kind ? (const bf16_t*)(ws + WS_WOS) + (size_t)j * 1024 * 768 : (const bf16_t*)(ws + WS_WOG) + (size_t)j * 1024 * 1024;
      gemm_phase_res(MIX, mixp, wt, mixp, ea, smem);
    } else if (sub == 5) {
      norm_all(Y, p.in[11] + layer * DM, XN, gw, ngw, lane);
    } else if (sub == 6 && ENAB(6)) {
      EpiArgs ea{}; ea.cb = Hb; ea.ldc = DFF;
      gemm_phase<2>(XN, DM, (const bf16_t*)(ws + WS_WUP) + (size_t)layer * 4096 * 1024, 1024, TA, 4096, ea, smem);
    } else if (sub == 7 && ENAB(7)) {
      EpiArgs ea{}; ea.yout = Y; ea.res0 = Y; ea.res1 = nullptr;
      gemm_phase_res(Hb, DFF, (const bf16_t*)(ws + WS_WDN) + (size_t)layer * 1024 * 4096, 4096, ea, smem);
    } else if (sub == 8) {
      norm_all(Y, p.in[9] + (layer + 1) * DM, XN, gw, ngw, lane);
    }
  }
}

extern "C" void kernel_launch(void* const* d_in, const int* in_sizes, int n_in, void* d_out, int out_size, void* d_ws, size_t ws_size, hipStream_t stream) {
  static int grid_blocks = 0;
  if (!grid_blocks) {
    int dev = 0, cus = 0, per_cu = 0;
    (void)hipGetDevice(&dev);
    (void)hipDeviceGetAttribute(&cus, hipDeviceAttributeMultiprocessorCount, dev);
    (void)hipOccupancyMaxActiveBlocksPerMultiprocessor(&per_cu, mk_fwd, 256, 0);
    if (per_cu > 2) per_cu = 2;
    if (per_cu < 1) per_cu = 1;
    grid_blocks = cus * per_cu;
    if (ws_size < WS_END) fprintf(stderr, "kernel_launch: workspace too small: %zu < %zu\n", ws_size, (size_t)WS_END);
  }
  (void)hipMemsetAsync((char*)d_ws + WS_CTR, 0, 4096, stream);
  KP p{};
  for (int i = 0; i < 27; ++i) p.in[i] = (const float*)d_in[i];
  p.out = (float*)d_out; p.ws = (unsigned char*)d_ws; p.ph_lo = 0; p.ph_hi = 37;
  void* args[] = {&p};
  hipError_t e = hipLaunchCooperativeKernel((void*)mk_fwd, dim3(grid_blocks), dim3(256), args, 0, stream);
  if (e != hipSuccess) fprintf(stderr, "cooperative launch failed: %s (grid %d)\n", hipGetErrorString(e), grid_blocks);
}
```

```cpp
#include <hip/hip_runtime.h>
#include <hip/hip_cooperative_groups.h>
#include <cstdio>
#include <cstdint>
namespace cg = cooperative_groups;

typedef unsigned short bf16_t;
typedef short bf16x8 __attribute__((ext_vector_type(8)));
typedef float f32x16 __attribute__((ext_vector_type(16)));
typedef float f32x4 __attribute__((ext_vector_type(4)));
typedef unsigned u4 __attribute__((ext_vector_type(4)));
typedef unsigned u2 __attribute__((ext_vector_type(2)));
#define DEVI __device__ __forceinline__
__device__ __forceinline__ u4 mk4(unsigned a, unsigned b, unsigned c, unsigned d) { u4 r; r.x = a; r.y = b; r.z = c; r.w = d; return r; }
__device__ __forceinline__ u2 mk2(unsigned a, unsigned b) { u2 r; r.x = a; r.y = b; return r; }
#define MFMA32(a, b, c) __builtin_amdgcn_mfma_f32_32x32x16_bf16((a), (b), (c), 0, 0, 0)
#define LDS_BARRIER() do { asm volatile("s_waitcnt lgkmcnt(0)" ::: "memory"); __builtin_amdgcn_s_barrier(); } while (0)
#define GLOAD16(dst, ptr) asm volatile("global_load_dwordx4 %0, %1, off" : "=&v"(dst) : "v"(ptr) : "memory")
#define VMWAIT(n) asm volatile("s_waitcnt vmcnt(" #n ")" ::: "memory")
#define MFMA16(a, b, c) __builtin_amdgcn_mfma_f32_16x16x32_bf16((a), (b), (c), 0, 0, 0)

constexpr int DM = 1024, TP = 16384, TS = 512, TA = TP + TS, DFF = 4096;
constexpr int NP_GDN = 3456, NP_SB = 1792, MQ_GDN = 3200, MQ_SB = 1536;
constexpr int NCHUNK = 264, NITEM = NCHUNK * 6;
constexpr float EPS = 1e-6f;
constexpr float LOG2E = 1.4426950408889634f;
constexpr size_t O_YP = 0, O_PGC = 17301504, O_PGS = 17315328, O_PSK = 17511936, O_PSV = 34289152, O_PMK = 51066368, O_PMV = 51328512,
                 O_SGC = 51590656, O_SGS = 51701248, O_SSK = 53274112, O_SSV = 53798400;
constexpr size_t WS_CTR = 0;
constexpr size_t WS_WIG = 4096;
constexpr size_t WS_WIS = WS_WIG + 2ull * 3456 * 1024 * 2;
constexpr size_t WS_WKV = WS_WIS + 2ull * 1792 * 1024 * 2;
constexpr size_t WS_WOG = WS_WKV + 4ull * 512 * 1024 * 2;
constexpr size_t WS_WOS = WS_WOG + 2ull * 1024 * 1024 * 2;
constexpr size_t WS_WUP = WS_WOS + 2ull * 1024 * 768 * 2;
constexpr size_t WS_WDN = WS_WUP + 4ull * 4096 * 1024 * 2;
constexpr size_t WS_XN = WS_WDN + 4ull * 4096 * 1024 * 2;
constexpr size_t WS_MIX = WS_XN + (size_t)TA * 1024 * 2;
constexpr size_t WS_MEMN = WS_MIX + (size_t)TA * 1024 * 2;
constexpr size_t WS_MEMKV = WS_MEMN + 4ull * 256 * 1024 * 2;
constexpr size_t WS_BIG = WS_MEMKV + 4ull * 256 * 512 * 4;
constexpr size_t WS_P = WS_BIG;
constexpr size_t WS_G = WS_P + (size_t)TA * 3456 * 2;
constexpr size_t G_ITEM = 73728;
constexpr size_t WS_GL = WS_G + (size_t)NITEM * G_ITEM;
constexpr size_t WS_H = WS_BIG;
constexpr size_t WS_END = WS_GL + 8192;

struct KP { const float* in[27]; float* out; unsigned char* ws; int ph_lo, ph_hi; };

DEVI int get_tid() { int t = __builtin_amdgcn_workitem_id_x(); asm volatile("" : "+v"(t)); return t; }
DEVI float bf2f(bf16_t b) { return __uint_as_float(((unsigned)b) << 16); }
typedef float f32x2_t __attribute__((ext_vector_type(2)));
typedef __bf16 bf16x2_t __attribute__((ext_vector_type(2)));
DEVI unsigned pk2(float lo, float hi) { f32x2_t v = {lo, hi}; return __builtin_bit_cast(unsigned, __builtin_convertvector(v, bf16x2_t)); }
DEVI bf16_t f2bf(float f) { return (bf16_t)(pk2(f, 0.f) & 0xffffu); }
DEVI float lo2f(unsigned u) { return __uint_as_float(u << 16); }
DEVI float hi2f(unsigned u) { return __uint_as_float(u & 0xffff0000u); }
DEVI float ex2(float x) { return __builtin_amdgcn_exp2f(x); }
DEVI float lg2(float x) { return __builtin_amdgcn_logf(x); }
DEVI float wave_sum(float v) {
#pragma unroll
  for (int o = 32; o >= 1; o >>= 1) v += __shfl_xor(v, o);
  return v;
}
DEVI bf16x8 as_frag(u4 u) { return __builtin_bit_cast(bf16x8, u); }
DEVI float silu(float y) { return y / (1.f + __expf(-y)); }

struct EpiArgs { bf16_t* cb; float* cf; int ldc; const float* res0; const float* res1; float* yout; };
template <int EPI>
DEVI void gemm_tile(const bf16_t* __restrict__ A, int lda, const bf16_t* __restrict__ Bt, int ldb, int K, int m0, int n0, const EpiArgs& ea, unsigned char* smem) {
  const int tid = get_tid(), lane = tid & 63, wave = tid >> 6;
  const int wm = wave >> 1, wn = wave & 1, l31 = lane & 31, lh = lane >> 5;
  bf16_t* sA = (bf16_t*)smem;
  bf16_t* sB = sA + 2 * 128 * 72;
  f32x16 acc[2][2];
#pragma unroll
  for (int i = 0; i < 2; ++i)
#pragma unroll
    for (int j = 0; j < 2; ++j)
#pragma unroll
      for (int r = 0; r < 16; ++r) acc[i][j][r] = 0.f;
  const int lr = tid >> 3, lc = (tid & 7) * 8;
  const bf16_t* gA = A + (size_t)(m0 + lr) * lda + lc;
  const bf16_t* gB = Bt + (size_t)(n0 + lr) * ldb + lc;
  u4 ra0[4], rb0[4], ra1[4], rb1[4];
#define G_ISSUE(RA, RB, K0) { _Pragma("unroll") for (int i = 0; i < 4; ++i) { GLOAD16(RA[i], gA + (size_t)i * 32 * lda + (K0)); GLOAD16(RB[i], gB + (size_t)i * 32 * ldb + (K0)); } }
#define G_STASH(RA, RB, BUF) { _Pragma("unroll") for (int i = 0; i < 4; ++i) { *(u4*)(sA + (BUF) * 128 * 72 + (lr + i * 32) * 72 + lc) = RA[i]; *(u4*)(sB + (BUF) * 128 * 72 + (lr + i * 32) * 72 + lc) = RB[i]; } }
#define G_COMPUTE(BUF) { const bf16_t* cA = sA + (BUF) * 128 * 72 + (wm * 64 + l31) * 72 + lh * 8; const bf16_t* cB = sB + (BUF) * 128 * 72 + (wn * 64 + l31) * 72 + lh * 8; \
    _Pragma("unroll") for (int ks = 0; ks < 4; ++ks) { \
      bf16x8 a0 = *(const bf16x8*)(cA + ks * 16), a1 = *(const bf16x8*)(cA + 32 * 72 + ks * 16); \
      bf16x8 b0 = *(const bf16x8*)(cB + ks * 16), b1 = *(const bf16x8*)(cB + 32 * 72 + ks * 16); \
      acc[0][0] = MFMA32(a0, b0, acc[0][0]); acc[0][1] = MFMA32(a0, b1, acc[0][1]); \
      acc[1][0] = MFMA32(a1, b0, acc[1][0]); acc[1][1] = MFMA32(a1, b1, acc[1][1]); } }
  const int nk = K >> 6;
  VMWAIT(0);
  G_ISSUE(ra0, rb0, 0);
  G_ISSUE(ra1, rb1, 64);
  __syncthreads();
  VMWAIT(8);
  G_STASH(ra0, rb0, 0);
  LDS_BARRIER();
  for (int kt = 0; kt < nk; kt += 2) {
    G_ISSUE(ra0, rb0, ((kt + 2 < nk) ? kt + 2 : nk - 1) << 6);
    G_COMPUTE(0);
    VMWAIT(8);
    G_STASH(ra1, rb1, 1);
    LDS_BARRIER();
    G_ISSUE(ra1, rb1, ((kt + 3 < nk) ? kt + 3 : nk - 1) << 6);
    G_COMPUTE(1);
    VMWAIT(8);
    if (kt + 2 < nk) G_STASH(ra0, rb0, 0);
    LDS_BARRIER();
  }
  VMWAIT(0);
#pragma unroll
  for (int i = 0; i < 4; ++i) asm volatile("" :: "v"(ra0[i]), "v"(rb0[i]), "v"(ra1[i]), "v"(rb1[i]));
#undef G_ISSUE
#undef G_STASH
#undef G_COMPUTE
#pragma unroll
  for (int i = 0; i < 2; ++i)
#pragma unroll
    for (int r = 0; r < 16; ++r) {
      const int row = m0 + wm * 64 + i * 32 + (r >> 2) * 8 + lh * 4 + (r & 3);
#pragma unroll
      for (int j = 0; j < 2; ++j) {
        const int col = n0 + wn * 64 + j * 32 + l31;
        const float v = acc[i][j][r];
        if (EPI == 0) ea.cb[(size_t)row * ea.ldc + col] = f2bf(v);
        else if (EPI == 1) {
          const float* rp = ea.res1 ? (row < TP ? ea.res0 + (size_t)row * DM : ea.res1 + (size_t)(row - TP) * DM) : ea.res0 + (size_t)row * DM;
          ea.yout[(size_t)row * DM + col] = rp[col] + v;
        } else if (EPI == 4) { unsafeAtomicAdd(ea.yout + (size_t)row * DM + col, v); }
        else if (EPI == 2) { const float rl = v > 0.f ? v : 0.f; ea.cb[(size_t)row * ea.ldc + col] = f2bf(rl * rl); }
        else ea.cf[(size_t)row * ea.ldc + col] = v;
      }
    }
}
template <int EPI>
DEVI void gemm_phase(const bf16_t* A, int lda, const bf16_t* Bt, int K, int M, int N, const EpiArgs& ea, unsigned char* smem) {
  const int nM = M >> 7, nN = N >> 7, nwg = nM * nN;
  const int q = nwg >> 3, r = nwg & 7;
  for (int L = blockIdx.x; L < nwg; L += gridDim.x) {
    const int xcd = L & 7, off = L >> 3;
    const int wg = (xcd < r ? xcd * (q + 1) : r * (q + 1) + (xcd - r) * q) + off;
    const int nig = 8 * nN, gid = wg / nig, fm = gid * 8, gsz = (nM - fm) < 8 ? (nM - fm) : 8;
    const int pm = fm + ((wg % nig) % gsz), pn = (wg % nig) / gsz;
    gemm_tile<EPI>(A, lda, Bt, K, K, pm << 7, pn << 7, ea, smem);
  }
}

DEVI void gemm_phase_res(const bf16_t* A, int lda, const bf16_t* Bt, int K, const EpiArgs& ea, unsigned char* smem) {
  gemm_phase<1>(A, lda, Bt, K, TP, 1024, ea, smem);
  const int S = (K == 4096) ? 16 : (K >> 7), klen = K / S;
  for (int it = blockIdx.x; it < 32 * S; it += gridDim.x) {
    const int tile = it / S, ks = it % S;
    gemm_tile<4>(A + (size_t)ks * klen, lda, Bt + (size_t)ks * klen, K, klen, TP + ((tile >> 3) << 7), (tile & 7) << 7, ea, smem);
  }
}

DEVI void convert_tile(const float* __restrict__ W, bf16_t* __restrict__ Wt, int K, int N, int k0, int n0, int thr, int shift, unsigned char* smem) {
  float* tile = (float*)smem;
  const int tid = get_tid();
  __syncthreads();
#pragma unroll
  for (int i = 0; i < 4; ++i) {
    const int r = (tid >> 4) + 16 * i, c = (tid & 15) * 4;
    float4 v = make_float4(0.f, 0.f, 0.f, 0.f);
    if (n0 + c < N) v = *(const float4*)(W + (size_t)(k0 + r) * N + n0 + c);
    tile[r * 65 + c] = v.x; tile[r * 65 + c + 1] = v.y; tile[r * 65 + c + 2] = v.z; tile[r * 65 + c + 3] = v.w;
  }
  __syncthreads();
  const int n = tid >> 2, kc = (tid & 3) * 16;
  if (n0 + n < N) {
    const int nn = n0 + n, nd = nn + (nn >= thr ? shift : 0);
    unsigned o[8];
#pragma unroll
    for (int e = 0; e < 8; ++e) o[e] = pk2(tile[(kc + 2 * e) * 65 + n], tile[(kc + 2 * e + 1) * 65 + n]);
    u4* dst = (u4*)(Wt + (size_t)nd * K + k0 + kc);
    dst[0] = mk4(o[0], o[1], o[2], o[3]); dst[1] = mk4(o[4], o[5], o[6], o[7]);
  }
}
DEVI void convert_group(int& base, int bid, int nb, const float* W, bf16_t* Wt, int nl, int K, int N, int NPAD, int thr, int shift, unsigned char* smem) {
  const int tk = K >> 6, tn = (N + 63) >> 6, per = tk * tn, tot = per * nl;
  int first = ((bid - base) % nb + nb) % nb;
  for (int t = first; t < tot; t += nb) {
    const int l = t / per, r = t % per;
    convert_tile(W + (size_t)l * K * N, Wt + (size_t)l * NPAD * K, K, N, (r / tn) << 6, (r % tn) << 6, thr, shift, smem);
  }
  base += tot;
}

DEVI void norm_row(const float* __restrict__ src, const float* __restrict__ gain, bf16_t* __restrict__ dst, int lane) {
  float4 v[4]; float ss = 0.f;
#pragma unroll
  for (int i = 0; i < 4; ++i) { v[i] = *(const float4*)(src + lane * 4 + 256 * i); ss += v[i].x * v[i].x + v[i].y * v[i].y + v[i].z * v[i].z + v[i].w * v[i].w; }
  ss = wave_sum(ss);
  const float sc = rsqrtf(ss * (1.f / 1024.f) + EPS);
#pragma unroll
  for (int i = 0; i < 4; ++i) {
    const float4 g = *(const float4*)(gain + lane * 4 + 256 * i);
    u2 o; o.x = pk2(v[i].x * sc * g.x, v[i].y * sc * g.y); o.y = pk2(v[i].z * sc * g.z, v[i].w * sc * g.w);
    *(u2*)(dst + lane * 4 + 256 * i) = o;
  }
}

DEVI void norm_row2(const float* __restrict__ s0, const float* __restrict__ s1, const float* __restrict__ gain, bf16_t* __restrict__ d0, bf16_t* __restrict__ d1, int lane) {
  float4 v[4], w[4]; float ss = 0.f, tt = 0.f;
#pragma unroll
  for (int i = 0; i < 4; ++i) { v[i] = *(const float4*)(s0 + lane * 4 + 256 * i); w[i] = *(const float4*)(s1 + lane * 4 + 256 * i); }
#pragma unroll
  for (int i = 0; i < 4; ++i) { ss += v[i].x * v[i].x + v[i].y * v[i].y + v[i].z * v[i].z + v[i].w * v[i].w; tt += w[i].x * w[i].x + w[i].y * w[i].y + w[i].z * w[i].z + w[i].w * w[i].w; }
#pragma unroll
  for (int o = 32; o >= 1; o >>= 1) { ss += __shfl_xor(ss, o); tt += __shfl_xor(tt, o); }
  const float sc = rsqrtf(ss * (1.f / 1024.f) + EPS), tc = rsqrtf(tt * (1.f / 1024.f) + EPS);
#pragma unroll
  for (int i = 0; i < 4; ++i) {
    const float4 g = *(const float4*)(gain + lane * 4 + 256 * i);
    u2 o; o.x = pk2(v[i].x * sc * g.x, v[i].y * sc * g.y); o.y = pk2(v[i].z * sc * g.z, v[i].w * sc * g.w);
    *(u2*)(d0 + lane * 4 + 256 * i) = o;
    u2 q; q.x = pk2(w[i].x * tc * g.x, w[i].y * tc * g.y); q.y = pk2(w[i].z * tc * g.z, w[i].w * tc * g.w);
    *(u2*)(d1 + lane * 4 + 256 * i) = q;
  }
}
DEVI void norm_all(const float* __restrict__ Y, const float* __restrict__ gain, bf16_t* __restrict__ XN, int gw, int ngw, int lane) {
  for (int r = gw; r < TA; r += ngw) norm_row(Y + (size_t)r * DM, gain, XN + (size_t)r * DM, lane);
}

struct KVSrc { const void* k; const void* v; int kpitch, vpitch, f32; };
template <int D>
DEVI void attn_load(const KVSrc& s, int r0, u4 (&kr)[D / 32], u4 (&vr)[D / 32]) {
  const int tid = get_tid();
#pragma unroll
  for (int i = 0; i < D / 32; ++i) {
    const int c = tid + 256 * i, key = c / (D / 8), dch = c % (D / 8);
    if (s.f32) {
      const float* kp = (const float*)s.k + (size_t)(r0 + key) * s.kpitch + dch * 8;
      const float* vp = (const float*)s.v + (size_t)(r0 + key) * s.vpitch + dch * 8;
      const float4 a = *(const float4*)kp, b = *(const float4*)(kp + 4), c2 = *(const float4*)vp, d2 = *(const float4*)(vp + 4);
      kr[i] = mk4(pk2(a.x, a.y), pk2(a.z, a.w), pk2(b.x, b.y), pk2(b.z, b.w));
      vr[i] = mk4(pk2(c2.x, c2.y), pk2(c2.z, c2.w), pk2(d2.x, d2.y), pk2(d2.z, d2.w));
      __builtin_amdgcn_sched_barrier(0);
    } else {
      kr[i] = *(const u4*)((const bf16_t*)s.k + (size_t)(r0 + key) * s.kpitch + dch * 8);
      vr[i] = *(const u4*)((const bf16_t*)s.v + (size_t)(r0 + key) * s.vpitch + dch * 8);
    }
  }
}
template <int D>
DEVI void attn_store(bf16_t* Ks, bf16_t* Vt, const u4 (&kr)[D / 32], const u4 (&vr)[D / 32]) {
  const int tid = get_tid();
#pragma unroll
  for (int i = 0; i < D / 32; ++i) {
    const int c = tid + 256 * i, key = c / (D / 8), dch = c % (D / 8);
    *(u4*)(Ks + key * (D + 8) + dch * 8) = kr[i];
    const int kx = key ^ ((dch & 15) << 2);
    const unsigned w[4] = {vr[i].x, vr[i].y, vr[i].z, vr[i].w};
#pragma unroll
    for (int e = 0; e < 8; ++e) Vt[(dch * 8 + e) * 72 + kx] = (bf16_t)((w[e >> 1] >> (16 * (e & 1))) & 0xffffu);
  }
}

template <int D, int MODE>
DEVI void attn_item(const bf16_t* __restrict__ qsrc, int qpitch, int nq, const float* __restrict__ qgain, float qscale,
                    const KVSrc& segA, int nA, int qposA0, int maskA, const KVSrc& segB, int nB,
                    bf16_t* __restrict__ out, int opitch, unsigned char* smem, float* __restrict__ carry_out = nullptr) {
  constexpr int KPT = D + 8, NKS = D / 16, NDB = D / 32, NCH = D / 32;
  constexpr int STAGE = 64 * KPT + D * 72;
  const int tid = get_tid(), lane = tid & 63, wave = tid >> 6, l31 = lane & 31, lh = lane >> 5;
  bf16_t* sbase = (bf16_t*)smem;
  const bool active = wave * 32 < nq;
  bf16x8 qf[NKS];
  {
    float qv[NKS][8]; float ss = 0.f;
    const bf16_t* qp = qsrc + (size_t)(wave * 32 + l31) * qpitch + lh * 8;
#pragma unroll
    for (int ks = 0; ks < NKS; ++ks) {
      u4 u = mk4(0, 0, 0, 0);
      if (active) u = *(const u4*)(qp + ks * 16);
      const unsigned w[4] = {u.x, u.y, u.z, u.w};
#pragma unroll
      for (int e = 0; e < 4; ++e) { qv[ks][2 * e] = lo2f(w[e]); qv[ks][2 * e + 1] = hi2f(w[e]); }
#pragma unroll
      for (int e = 0; e < 8; ++e) ss += qv[ks][e] * qv[ks][e];
    }
    ss += __shfl_xor(ss, 32);
    const float sc = rsqrtf(ss * (1.f / D) + EPS) * qscale;
#pragma unroll
    for (int ks = 0; ks < NKS; ++ks) {
      const float4 g0 = *(const float4*)(qgain + ks * 16 + lh * 8), g1 = *(const float4*)(qgain + ks * 16 + lh * 8 + 4);
      u4 u;
      u.x = pk2(qv[ks][0] * sc * g0.x, qv[ks][1] * sc * g0.y); u.y = pk2(qv[ks][2] * sc * g0.z, qv[ks][3] * sc * g0.w);
      u.z = pk2(qv[ks][4] * sc * g1.x, qv[ks][5] * sc * g1.y); u.w = pk2(qv[ks][6] * sc * g1.z, qv[ks][7] * sc * g1.w);
      qf[ks] = as_frag(u);
    }
  }
  f32x16 oacc[NDB];
#pragma unroll
  for (int db = 0; db < NDB; ++db)
#pragma unroll
    for (int r = 0; r < 16; ++r) oacc[db][r] = 0.f;
  float carry = 0.f, mx = -1e30f, lsum = 0.f;
  const int ntot = nA + nB;
  const int qpos = qposA0 + wave * 32 + l31;
  u4 kr[NCH], vr[NCH];
  {
    const bool inA = 0 < nA; const int tix = inA ? nA - 1 : nB - 1;
    attn_load<D>(inA ? segA : segB, tix * 64, kr, vr);
    __syncthreads();
    attn_store<D>(sbase, sbase + 64 * KPT, kr, vr);
    __syncthreads();
  }
  for (int it = 0; it < ntot; ++it) {
    const int cur = it & 1;
    if (it + 1 < ntot) {
      const bool nInA = (it + 1) < nA; const int tix = nInA ? nA - 2 - it : nB - 1 - (it + 1 - nA);
      attn_load<D>(nInA ? segA : segB, tix * 64, kr, vr);
    }
    const bool inA = it < nA;
    const int kbase = inA ? (nA - 1 - it) * 64 : 0;
    const bf16_t* Ks = sbase + cur * STAGE;
    const bf16_t* Vt = Ks + 64 * KPT;
    const bool mneed = inA && maskA && (kbase + 63 >= qposA0 + wave * 32);
    const bool skip = !active || (inA && maskA && (kbase > qposA0 + wave * 32 + 31));
    if (!skip) {
      bf16x8 pf[2][2];
      if (MODE == 0) {
        float after = carry;
#pragma unroll
        for (int rt = 1; rt >= 0; --rt) {
          f32x16 z;
#pragma unroll
          for (int r = 0; r < 16; ++r) z[r] = 0.f;
#pragma unroll
          for (int ks = 0; ks < NKS; ++ks) {
            const bf16x8 a = *(const bf16x8*)(Ks + (rt * 32 + l31) * KPT + ks * 16 + lh * 8);
            z = MFMA32(a, qf[ks], z);
          }
          float m[16];
#pragma unroll
          for (int i = 0; i < 16; ++i) {
            float mm = lg2(1.f + ex2(z[i]));
            if (mneed) { const int key = kbase + rt * 32 + (i >> 2) * 8 + lh * 4 + (i & 3); if (key >= qpos) mm = 0.f; }
            m[i] = mm;
          }
          float a_[16];
#pragma unroll
          for (int g = 3; g >= 0; --g) {
            const float s4 = (m[g * 4] + m[g * 4 + 1]) + (m[g * 4 + 2] + m[g * 4 + 3]);
            const float p4 = __shfl_xor(s4, 32);
            float c = after + (lh == 0 ? p4 : 0.f);
            after += s4 + p4;
#pragma unroll
            for (int e = 3; e >= 0; --e) {
              c += m[g * 4 + e];
              float av = ex2(z[g * 4 + e] - c);
              if (mneed) { const int key = kbase + rt * 32 + g * 8 + lh * 4 + e; if (key >= qpos) av = 0.f; }
              a_[g * 4 + e] = av;
            }
          }
#pragma unroll
          for (int s2 = 0; s2 < 2; ++s2)
            pf[rt][s2] = as_frag(mk4(pk2(a_[8 * s2 + 0], a_[8 * s2 + 1]), pk2(a_[8 * s2 + 2], a_[8 * s2 + 3]), pk2(a_[8 * s2 + 4], a_[8 * s2 + 5]), pk2(a_[8 * s2 + 6], a_[8 * s2 + 7])));
        }
        carry = after;
      } else {
        f32x16 z[2];
#pragma unroll
        for (int rt = 0; rt < 2; ++rt) {
          f32x16 zt;
#pragma unroll
          for (int r = 0; r < 16; ++r) zt[r] = 0.f;
#pragma unroll
          for (int ks = 0; ks < NKS; ++ks) {
            const bf16x8 a = *(const bf16x8*)(Ks + (rt * 32 + l31) * KPT + ks * 16 + lh * 8);
            zt = MFMA32(a, qf[ks], zt);
          }
          z[rt] = zt;
        }
        float tm = z[0][0];
#pragma unroll
        for (int rt = 0; rt < 2; ++rt)
#pragma unroll
          for (int i = 0; i < 16; ++i) tm = fmaxf(tm, z[rt][i]);
        tm = fmaxf(tm, __shfl_xor(tm, 32));
        const float nm = fmaxf(mx, tm);
        const float alpha = ex2(mx - nm);
        mx = nm;
        float ps = 0.f;
        float a_[2][16];
#pragma unroll
        for (int rt = 0; rt < 2; ++rt)
#pragma unroll
          for (int i = 0; i < 16; ++i) { a_[rt][i] = ex2(z[rt][i] - nm); ps += a_[rt][i]; }
        lsum = lsum * alpha + ps;
#pragma unroll
        for (int db = 0; db < NDB; ++db)
#pragma unroll
          for (int r = 0; r < 16; ++r) oacc[db][r] *= alpha;
#pragma unroll
        for (int rt = 0; rt < 2; ++rt)
#pragma unroll
          for (int s2 = 0; s2 < 2; ++s2)
            pf[rt][s2] = as_frag(mk4(pk2(a_[rt][8 * s2 + 0], a_[rt][8 * s2 + 1]), pk2(a_[rt][8 * s2 + 2], a_[rt][8 * s2 + 3]), pk2(a_[rt][8 * s2 + 4], a_[rt][8 * s2 + 5]), pk2(a_[rt][8 * s2 + 6], a_[rt][8 * s2 + 7])));
      }
#pragma unroll
      for (int db = 0; db < NDB; ++db) {
        const int d = db * 32 + l31, sw = ((d >> 3) & 15) << 2;
#pragma unroll
        for (int rt = 0; rt < 2; ++rt)
#pragma unroll
          for (int s = 0; s < 2; ++s) {
            const int kb0 = rt * 32 + 16 * s + 4 * lh;
            const u2 lo = *(const u2*)(Vt + d * 72 + (kb0 ^ sw));
            const u2 hi = *(const u2*)(Vt + d * 72 + ((kb0 + 8) ^ sw));
            oacc[db] = MFMA32(as_frag(mk4(lo.x, lo.y, hi.x, hi.y)), pf[rt][s], oacc[db]);
          }
      }
    }
    if (it + 1 < ntot) { bf16_t* nK = sbase + (cur ^ 1) * STAGE; attn_store<D>(nK, nK + 64 * KPT, kr, vr); }
    LDS_BARRIER();
  }
  if (active && carry_out && lh == 0) carry_out[(size_t)(wave * 32 + l31) * 4] = carry;
  if (active) {
    float inv = 1.f;
    if (MODE == 1) { const float l = lsum + __shfl_xor(lsum, 32); inv = 1.f / l; }
    bf16_t* op = out + (size_t)(wave * 32 + l31) * opitch + lh * 4;
#pragma unroll
    for (int db = 0; db < NDB; ++db)
#pragma unroll
      for (int g = 0; g < 4; ++g) {
        u2 o; o.x = pk2(oacc[db][g * 4] * inv, oacc[db][g * 4 + 1] * inv); o.y = pk2(oacc[db][g * 4 + 2] * inv, oacc[db][g * 4 + 3] * inv);
        *(u2*)(op + db * 32 + g * 8) = o;
      }
  }
}

DEVI void mem_attn_item(const KP& p, int layer, int item, const bf16_t* P, int np, int mqoff, bf16_t* mix, int mixp, int mixoff, unsigned char* smem) {
  const int h = item & 3;
  int t0, nq; const float *kk, *vv;
  if (item < 512) { t0 = (item >> 2) * 128; nq = 128; kk = p.out + O_PMK + (size_t)layer * 65536; vv = p.out + O_PMV + (size_t)layer * 65536; }
  else { const int b = (item - 512) >> 2; t0 = TP + b * 64; nq = 64; kk = p.in[6] + ((size_t)layer * 8 + b) * 65536; vv = p.in[7] + ((size_t)layer * 8 + b) * 65536; }
  KVSrc s; s.k = kk + h * 64; s.v = vv + h * 64; s.kpitch = 256; s.vpitch = 256; s.f32 = 1;
  attn_item<64, 1>(P + (size_t)t0 * np + mqoff + h * 64, np, nq, p.in[15] + layer * 64, 0.125f * LOG2E, s, 4, 0, 0, s, 0,
                   mix + (size_t)t0 * mixp + mixoff + h * 64, mixp, smem);
}

DEVI void gdn_prep_item(const KP& p, int j, int ci, int h, const bf16_t* P, unsigned char* smem) {
  constexpr int NP = NP_GDN;
  const int tid = get_tid(), lane = tid & 63, wave = tid >> 6;
  const int item = ci * 6 + h;
  const bool samp = ci >= 256;
  const int b = ci - 256;
  const int t0 = samp ? TP + b * 64 : ci * 64;
  float* stage = (float*)smem;
  float* sL = (float*)smem;
  bf16_t* qn = (bf16_t*)(smem + 33280);
  bf16_t* kn = qn + 64 * 136;
  float* sgc = (float*)(smem + 33280 + 2 * 64 * 136 * 2);
  float* sbeta = sgc + 64;
  float* segc = sbeta + 64;
  unsigned char* gi = p.ws + WS_G + (size_t)item * G_ITEM;
  bf16_t* gU = (bf16_t*)gi; bf16_t* gW = gU + 8192; bf16_t* gQD = gW + 8192; bf16_t* gKDT = gQD + 8192; bf16_t* gAI = gKDT + 8192;
  const float* convw = p.in[17] + (size_t)j * 4 * 2304;
  const float* cstate = p.in[2] + ((size_t)j * 8 + (samp ? b : 0)) * 3 * 2304;
  const bf16_t* Pc = P + (size_t)t0 * NP;
  __syncthreads();
  if (wave == 0) {
    const float braw = bf2f(Pc[(size_t)lane * NP + 3072 + h]), araw = bf2f(Pc[(size_t)lane * NP + 3078 + h]);
    const float beta = 1.f / (1.f + __expf(-braw));
    const float xx = araw + p.in[19][j * 6 + h];
    const float sp = xx > 20.f ? xx : __logf(1.f + __expf(xx));
    float g = -__expf(p.in[18][j * 6 + h]) * sp;
#pragma unroll
    for (int d = 1; d < 64; d <<= 1) { const float v = __shfl_up(g, d); if (lane >= d) g += v; }
    sgc[lane] = g; sbeta[lane] = beta; segc[lane] = __expf(g);
    if (lane == 63) ((float*)(p.ws + WS_GL))[item] = __expf(g);
  }
  if (samp || ci == 255) {
    float* dst = samp ? p.out + O_SGC + ((size_t)j * 8 + b) * 3 * 2304 : p.out + O_PGC + (size_t)j * 3 * 2304;
    for (int idx = tid; idx < 1152; idx += 256) {
      const int r = idx / 384, cc = idx % 384, ch = (cc >> 7) * 768 + h * 128 + (cc & 127);
      dst[r * 2304 + ch] = bf2f(Pc[(size_t)(61 + r) * NP + ch]);
    }
  }
  const float gcl_dummy = 0.f; (void)gcl_dummy;
#pragma unroll 1
  for (int which = 0; which < 2; ++which) {
    {
      const int c = tid & 127, th = tid >> 7, ch = which * 768 + h * 128 + c;
      const float w0 = convw[ch], w1 = convw[2304 + ch], w2 = convw[2 * 2304 + ch], w3 = convw[3 * 2304 + ch];
      float xm3, xm2, xm1;
      if (th == 1) { xm3 = bf2f(Pc[(size_t)29 * NP + ch]); xm2 = bf2f(Pc[(size_t)30 * NP + ch]); xm1 = bf2f(Pc[(size_t)31 * NP + ch]); }
      else if (samp) { xm3 = cstate[ch]; xm2 = cstate[2304 + ch]; xm1 = cstate[2 * 2304 + ch]; }
      else if (ci == 0) { xm3 = xm2 = xm1 = 0.f; }
      else { xm3 = bf2f(Pc[-(ptrdiff_t)3 * NP + ch]); xm2 = bf2f(Pc[-(ptrdiff_t)2 * NP + ch]); xm1 = bf2f(Pc[-(ptrdiff_t)NP + ch]); }
      const bf16_t* pp = Pc + (size_t)(th * 32) * NP + ch;
#pragma unroll 8
      for (int tt = 0; tt < 32; ++tt) {
        const float x0 = bf2f(pp[(size_t)tt * NP]);
        const float y = w0 * xm3 + w1 * xm2 + w2 * xm1 + w3 * x0;
        stage[(th * 32 + tt) * 129 + c] = silu(y);
        xm3 = xm2; xm2 = xm1; xm1 = x0;
      }
    }
    __syncthreads();
    {
      const int tt = tid >> 2, part = tid & 3;
      float v[32]; float ss = 0.f;
#pragma unroll
      for (int e = 0; e < 32; ++e) { v[e] = stage[tt * 129 + part * 32 + e]; ss += v[e] * v[e]; }
      ss += __shfl_xor(ss, 1); ss += __shfl_xor(ss, 2);
      float rinv = rsqrtf(ss + EPS);
      if (which == 0) rinv *= 0.08838834764831845f;
      bf16_t* dn = (which == 0 ? qn : kn) + tt * 136 + part * 32;
      const float eg = segc[tt];
#pragma unroll
      for (int e = 0; e < 32; e += 8) {
        u4 u; u.x = pk2(v[e] * rinv, v[e + 1] * rinv); u.y = pk2(v[e + 2] * rinv, v[e + 3] * rinv); u.z = pk2(v[e + 4] * rinv, v[e + 5] * rinv); u.w = pk2(v[e + 6] * rinv, v[e + 7] * rinv);
        *(u4*)(dn + e) = u;
        if (which == 0) {
          const float s2 = rinv * eg;
          u4 w; w.x = pk2(v[e] * s2, v[e + 1] * s2); w.y = pk2(v[e + 2] * s2, v[e + 3] * s2); w.z = pk2(v[e + 4] * s2, v[e + 5] * s2); w.w = pk2(v[e + 6] * s2, v[e + 7] * s2);
          *(u4*)(gQD + tt * 128 + part * 32 + e) = w;
        }
      }
    }
    __syncthreads();
  }
  {
    const int d = tid & 127, th = tid >> 7;
    const float gcl = sgc[63];
#pragma unroll
    for (int q8 = 0; q8 < 4; ++q8) {
      float f[8];
#pragma unroll
      for (int e = 0; e < 8; ++e) { const int tt = th * 32 + q8 * 8 + e; f[e] = bf2f(kn[tt * 136 + d]) * __expf(gcl - sgc[tt]); }
      *(u4*)(gKDT + d * 64 + th * 32 + q8 * 8) = mk4(pk2(f[0], f[1]), pk2(f[2], f[3]), pk2(f[4], f[5]), pk2(f[6], f[7]));
    }
  }
  {
    const int l31 = lane & 31, lh = lane >> 5, ri = wave >> 1, cj = wave & 1;
    f32x16 kk, qk;
#pragma unroll
    for (int r = 0; r < 16; ++r) { kk[r] = 0.f; qk[r] = 0.f; }
#pragma unroll
    for (int ks = 0; ks < 8; ++ks) {
      const bf16x8 ak = *(const bf16x8*)(kn + (ri * 32 + l31) * 136 + ks * 16 + lh * 8);
      const bf16x8 aq = *(const bf16x8*)(qn + (ri * 32 + l31) * 136 + ks * 16 + lh * 8);
      const bf16x8 bk = *(const bf16x8*)(kn + (cj * 32 + l31) * 136 + ks * 16 + lh * 8);
      kk = MFMA32(ak, bk, kk); qk = MFMA32(aq, bk, qk);
    }
    const int jj = cj * 32 + l31; const float gj = sgc[jj];
#pragma unroll
    for (int r = 0; r < 16; ++r) {
      const int ii = ri * 32 + (r >> 2) * 8 + lh * 4 + (r & 3);
      const float dec = ii >= jj ? __expf(sgc[ii] - gj) : 0.f;
      sL[ii * 64 + jj] = ii > jj ? sbeta[ii] * kk[r] * dec : 0.f;
      gAI[ii * 64 + jj] = f2bf(qk[r] * dec);
    }
  }
  __syncthreads();
  {
    float x[64];
    if (tid < 128) {
      const int ch = 1536 + h * 128 + tid;
      const float w0 = convw[ch], w1 = convw[2304 + ch], w2 = convw[2 * 2304 + ch], w3 = convw[3 * 2304 + ch];
      float xm3, xm2, xm1;
      if (samp) { xm3 = cstate[ch]; xm2 = cstate[2304 + ch]; xm1 = cstate[2 * 2304 + ch]; }
      else if (ci == 0) { xm3 = xm2 = xm1 = 0.f; }
      else { xm3 = bf2f(Pc[-(ptrdiff_t)3 * NP + ch]); xm2 = bf2f(Pc[-(ptrdiff_t)2 * NP + ch]); xm1 = bf2f(Pc[-(ptrdiff_t)NP + ch]); }
#pragma unroll
      for (int tt = 0; tt < 64; ++tt) {
        const float x0 = bf2f(Pc[(size_t)tt * NP + ch]);
        const float y = w0 * xm3 + w1 * xm2 + w2 * xm1 + w3 * x0;
        x[tt] = silu(y) * sbeta[tt];
        xm3 = xm2; xm2 = xm1; xm1 = x0;
        if ((tt & 7) == 7) __builtin_amdgcn_sched_barrier(0);
      }
    } else {
#pragma unroll
      for (int tt = 0; tt < 64; ++tt) { x[tt] = bf2f(kn[tt * 136 + tid - 128]) * sbeta[tt] * segc[tt]; if ((tt & 7) == 7) __builtin_amdgcn_sched_barrier(0); }
    }
#pragma unroll
    for (int i = 1; i < 64; ++i) {
      float a = x[i];
#pragma unroll
      for (int jx = 0; jx < i; ++jx) a -= sL[i * 64 + jx] * x[jx];
      x[i] = a;
      __builtin_amdgcn_sched_barrier(0);
    }
    bf16_t* dst = (tid < 128 ? gU : gW) + (tid & 127);
#pragma unroll
    for (int tt = 0; tt < 64; ++tt) { dst[tt * 128] = f2bf(x[tt]); if ((tt & 7) == 7) __builtin_amdgcn_sched_barrier(0); }
  }
}

struct ScanFrags { u4 w[4], qd[4], ai[2], kdt[2][2]; unsigned u[4]; float gl; };
DEVI void scan_load(const KP& p, int item, int wave, int lane, int sl, ScanFrags& f) {
  const int n = lane & 15, g = lane >> 4;
  const unsigned char* gi = p.ws + WS_G + (size_t)item * G_ITEM;
  const bf16_t* gU = (const bf16_t*)gi; const bf16_t* gW = gU + 8192; const bf16_t* gQD = gW + 8192; const bf16_t* gKDT = gQD + 8192; const bf16_t* gAI = gKDT + 8192;
#pragma unroll
  for (int s = 0; s < 4; ++s) { GLOAD16(f.w[s], gW + (16 * wave + n) * 128 + 32 * s + 8 * g); GLOAD16(f.qd[s], gQD + (16 * wave + n) * 128 + 32 * s + 8 * g); }
#pragma unroll
  for (int s = 0; s < 2; ++s) {
    GLOAD16(f.ai[s], gAI + (16 * wave + n) * 64 + 32 * s + 8 * g);
#pragma unroll
    for (int tt = 0; tt < 2; ++tt) GLOAD16(f.kdt[tt][s], gKDT + (32 * wave + 16 * tt + n) * 64 + 32 * s + 8 * g);
  }
  const bf16_t* up = gU + (16 * wave + 4 * g) * 128 + sl * 16 + n;
#pragma unroll
  for (int r = 0; r < 4; ++r) asm volatile("global_load_ushort %0, %1, off" : "=&v"(f.u[r]) : "v"(up + r * 128) : "memory");
  const float* glp = (const float*)(p.ws + WS_GL) + item;
  asm volatile("global_load_dword %0, %1, off" : "=&v"(f.gl) : "v"(glp) : "memory");
}
DEVI void scan_wait19(ScanFrags& f) {
  asm volatile("s_waitcnt vmcnt(19)"
               : "+v"(f.w[0]), "+v"(f.w[1]), "+v"(f.w[2]), "+v"(f.w[3]), "+v"(f.qd[0]), "+v"(f.qd[1]), "+v"(f.qd[2]), "+v"(f.qd[3]),
                 "+v"(f.ai[0]), "+v"(f.ai[1]), "+v"(f.kdt[0][0]), "+v"(f.kdt[0][1]), "+v"(f.kdt[1][0]), "+v"(f.kdt[1][1]),
                 "+v"(f.u[0]), "+v"(f.u[1]), "+v"(f.u[2]), "+v"(f.u[3]), "+v"(f.gl)
               :: "memory");
}
DEVI void scan_keep(const ScanFrags& f) {
#pragma unroll
  for (int s = 0; s < 4; ++s) asm volatile("" :: "v"(f.w[s]), "v"(f.qd[s]));
#pragma unroll
  for (int s = 0; s < 2; ++s) asm volatile("" :: "v"(f.ai[s]), "v"(f.kdt[0][s]), "v"(f.kdt[1][s]));
  asm volatile("" :: "v"(f.u[0]), "v"(f.u[1]), "v"(f.u[2]), "v"(f.u[3]), "v"(f.gl));
}
DEVI void scan_step(const ScanFrags& f, f32x4 (&sacc)[2], bf16_t* St, bf16_t* Vnt, bf16_t* O, int t0, int h, int sl, int wave, int n, int g) {
  bf16x8 sf[4];
#pragma unroll
  for (int s = 0; s < 4; ++s) sf[s] = *(const bf16x8*)(St + n * 136 + 32 * s + 8 * g);
  f32x4 wsa = {0.f, 0.f, 0.f, 0.f}, oa = {0.f, 0.f, 0.f, 0.f};
#pragma unroll
  for (int s = 0; s < 4; ++s) wsa = MFMA16(as_frag(f.w[s]), sf[s], wsa);
  float vn[4];
  vn[0] = lo2f(f.u[0]) - wsa[0]; vn[1] = lo2f(f.u[1]) - wsa[1]; vn[2] = lo2f(f.u[2]) - wsa[2]; vn[3] = lo2f(f.u[3]) - wsa[3];
  { u2 o; o.x = pk2(vn[0], vn[1]); o.y = pk2(vn[2], vn[3]); *(u2*)(Vnt + n * 72 + 16 * wave + 4 * g) = o; }
#pragma unroll
  for (int s = 0; s < 4; ++s) oa = MFMA16(as_frag(f.qd[s]), sf[s], oa);
  LDS_BARRIER();
  bf16x8 vf[2];
#pragma unroll
  for (int s = 0; s < 2; ++s) vf[s] = *(const bf16x8*)(Vnt + n * 72 + 32 * s + 8 * g);
#pragma unroll
  for (int s = 0; s < 2; ++s) oa = MFMA16(as_frag(f.ai[s]), vf[s], oa);
#pragma unroll
  for (int r = 0; r < 4; ++r) O[(size_t)(t0 + 16 * wave + 4 * g + r) * 768 + h * 128 + sl * 16 + n] = f2bf(oa[r]);
#pragma unroll
  for (int tt = 0; tt < 2; ++tt) {
#pragma unroll
    for (int r = 0; r < 4; ++r) sacc[tt][r] *= f.gl;
#pragma unroll
    for (int s = 0; s < 2; ++s) sacc[tt] = MFMA16(as_frag(f.kdt[tt][s]), vf[s], sacc[tt]);
    u2 o; o.x = pk2(sacc[tt][0], sacc[tt][1]); o.y = pk2(sacc[tt][2], sacc[tt][3]);
    *(u2*)(St + n * 136 + 32 * wave + 16 * tt + 4 * g) = o;
  }
  LDS_BARRIER();
}
DEVI void gdn_scan_stream(const KP& p, int j, int ci0, int nch, int h, int sl, const float* s0, float* sout, bf16_t* O, unsigned char* smem) {
  const int tid = get_tid(), lane = tid & 63, wave = tid >> 6, n = lane & 15, g = lane >> 4;
  bf16_t* St = (bf16_t*)smem;
  bf16_t* Vnt = St + 16 * 136;
  f32x4 sacc[2];
#pragma unroll
  for (int tt = 0; tt < 2; ++tt)
#pragma unroll
    for (int r = 0; r < 4; ++r) sacc[tt][r] = s0 ? s0[(size_t)(32 * wave + 16 * tt + 4 * g + r) * 128 + sl * 16 + n] : 0.f;
  __syncthreads();
#pragma unroll
  for (int tt = 0; tt < 2; ++tt) { u2 o; o.x = pk2(sacc[tt][0], sacc[tt][1]); o.y = pk2(sacc[tt][2], sacc[tt][3]); *(u2*)(St + n * 136 + 32 * wave + 16 * tt + 4 * g) = o; }
  ScanFrags f0, f1;
#define CL(c) ((ci0 + (((c) < nch) ? (c) : nch - 1)) * 6 + h)
#define T0(c) (((ci0 + (c)) >= 256) ? TP + (ci0 + (c) - 256) * 64 : (ci0 + (c)) * 64)
  VMWAIT(0);
  scan_load(p, CL(0), wave, lane, sl, f0);
  LDS_BARRIER();
  for (int c = 0; c < nch; c += 2) {
    scan_load(p, CL(c + 1), wave, lane, sl, f1); scan_wait19(f0);
    scan_step(f0, sacc, St, Vnt, O, T0(c), h, sl, wave, n, g);
    if (c + 1 < nch) {
      scan_load(p, CL(c + 2), wave, lane, sl, f0); scan_wait19(f1);
      scan_step(f1, sacc, St, Vnt, O, T0(c + 1), h, sl, wave, n, g);
    }
  }
  VMWAIT(0);
  scan_keep(f0); scan_keep(f1);
#undef CL
#undef T0
#pragma unroll
  for (int tt = 0; tt < 2; ++tt)
#pragma unroll
    for (int r = 0; r < 4; ++r) sout[(size_t)(32 * wave + 16 * tt + 4 * g + r) * 128 + sl * 16 + n] = sacc[tt][r];
}

DEVI int next_item(unsigned* ctr) {
  __shared__ int s_item;
  __syncthreads();
  if (get_tid() == 0) s_item = (int)atomicAdd(ctr, 1u);
  __syncthreads();
  return s_item;
}

DEVI unsigned xcc_id() { return (unsigned)__builtin_amdgcn_s_getreg((3 << 11) | 20) & 0xFu; }
DEVI unsigned ld_relaxed(unsigned* p) { return __hip_atomic_load(p, __ATOMIC_RELAXED, __HIP_MEMORY_SCOPE_AGENT); }
DEVI void gbar_setup(unsigned* ctr, unsigned nb, unsigned* sb) {
  if (get_tid() == 0) {
    const unsigned x = xcc_id();
    __hip_atomic_fetch_add(ctr + 544 + 8 * x, 1u, __ATOMIC_RELAXED, __HIP_MEMORY_SCOPE_AGENT);
    unsigned nx, mine;
    for (;;) {
      unsigned sum = 0; nx = 0; mine = 0;
      for (unsigned j = 0; j < 16; ++j) { const unsigned c = ld_relaxed(ctr + 544 + 8 * j); sum += c; nx += c ? 1u : 0u; mine = (j == x) ? c : mine; }
      if (sum == nb) break;
      __builtin_amdgcn_s_sleep(2);
    }
    sb[0] = x; sb[1] = mine; sb[2] = nx;
  }
  __syncthreads();
}
DEVI void gbar(unsigned* ctr, unsigned* sb, unsigned& gen) {
  asm volatile("s_waitcnt vmcnt(0)" ::: "memory");
  __syncthreads();
  gen++;
  if (get_tid() == 0) {
    const unsigned x = sb[0], nloc = sb[1], nx = sb[2];
    const unsigned old = __hip_atomic_fetch_add(ctr + 704 + 8 * x, 1u, __ATOMIC_RELAXED, __HIP_MEMORY_SCOPE_AGENT);
    if (old + 1u == gen * nloc) {
      __builtin_amdgcn_fence(__ATOMIC_RELEASE, "agent");
      asm volatile("s_waitcnt vmcnt(0)" ::: "memory");
      __hip_atomic_fetch_add(ctr + 528, 1u, __ATOMIC_RELAXED, __HIP_MEMORY_SCOPE_AGENT);
    }
    while (ld_relaxed(ctr + 528) < gen * nx) __builtin_amdgcn_s_sleep(2);
    __builtin_amdgcn_fence(__ATOMIC_ACQUIRE, "agent");
    asm volatile("s_waitcnt vmcnt(0)" ::: "memory");
  }
  __syncthreads();
}
#ifndef ONLY
#define ENAB(k) true
#else
#define ENAB(k) ((ONLY) == (k))
#endif
__global__ void __launch_bounds__(256, 2) mk_fwd(KP p) {
  __shared__ __attribute__((aligned(16))) unsigned char smem[73728];
  cg::grid_group grid = cg::this_grid();
  const int bid = blockIdx.x, nb = gridDim.x;
  const int ngw = nb * 4;
  unsigned char* ws = p.ws;
  unsigned* ctr = (unsigned*)(ws + WS_CTR);
  float* Y = p.out + O_YP;
  bf16_t* XN = (bf16_t*)(ws + WS_XN);
  bf16_t* MIX = (bf16_t*)(ws + WS_MIX);
  bf16_t* Pb = (bf16_t*)(ws + WS_P);
  bf16_t* Hb = (bf16_t*)(ws + WS_H);
  bool did = false;
  unsigned bgen = 0;
  __shared__ unsigned s_bar[4];
  gbar_setup(ctr, nb, s_bar);
  grid.sync();
  for (int ph = p.ph_lo; ph < p.ph_hi; ++ph) {
    const int layer = ph == 0 ? 0 : (ph - 1) / 9, sub = ph == 0 ? -1 : (ph - 1) % 9;
    const int kind = layer & 1, j = layer >> 1;
    if (sub == 8 && layer == 3) continue;
    if (did) gbar(ctr, s_bar, bgen);
    did = true;
    const int tid = get_tid(), lane = tid & 63, wave = tid >> 6, gw = bid * 4 + wave;
    (void)tid;
    const int np = kind ? NP_SB : NP_GDN, mqoff = kind ? MQ_SB : MQ_GDN, mixp = kind ? 768 : 1024, mixoff = kind ? 512 : 768;
    if (ph == 0 && ENAB(0)) {
      int base = 0;
      convert_group(base, bid, nb, p.in[12], (bf16_t*)(ws + WS_WIG), 2, 1024, 3340, 3456, 3084, 116, smem);
      convert_group(base, bid, nb, p.in[13], (bf16_t*)(ws + WS_WIS), 2, 1024, 1792, 1792, 1 << 30, 0, smem);
      convert_group(base, bid, nb, p.in[14], (bf16_t*)(ws + WS_WKV), 4, 1024, 512, 512, 1 << 30, 0, smem);
      convert_group(base, bid, nb, p.in[23], (bf16_t*)(ws + WS_WOG), 2, 1024, 1024, 1024, 1 << 30, 0, smem);
      convert_group(base, bid, nb, p.in[24], (bf16_t*)(ws + WS_WOS), 2, 768, 1024, 1024, 1 << 30, 0, smem);
      convert_group(base, bid, nb, p.in[25], (bf16_t*)(ws + WS_WUP), 4, 1024, 4096, 4096, 1 << 30, 0, smem);
      convert_group(base, bid, nb, p.in[26], (bf16_t*)(ws + WS_WDN), 4, 4096, 1024, 1024, 1 << 30, 0, smem);
      for (int r = gw; r < TA; r += ngw) norm_row(r < TP ? p.in[0] + (size_t)r * DM : p.in[1] + (size_t)(r - TP) * DM, p.in[9], XN + (size_t)r * DM, lane);
      for (int i = bid * 256 + tid; i < TS * DM / 4; i += nb * 256) ((float4*)(Y + (size_t)TP * DM))[i] = ((const float4*)p.in[1])[i];
      for (int r = gw; r < 1024; r += ngw) norm_row(p.in[8] + (size_t)(r & 255) * DM, p.in[10] + (r >> 8) * DM, (bf16_t*)(ws + WS_MEMN) + (size_t)r * DM, lane);
    } else if (sub == 0 && ENAB(1)) {
      EpiArgs ea{}; ea.cb = Pb; ea.ldc = np;
      const bf16_t* wt = kind ? (const bf16_t*)(ws + WS_WIS) + (size_t)j * 1792 * 1024 : (const bf16_t*)(ws + WS_WIG) + (size_t)j * 3456 * 1024;
      gemm_phase<0>(XN, DM, wt, 1024, TA, np, ea, smem);
      if (layer == 0) {
        for (int t = bid; t < 32; t += nb) {
          const int l = t >> 3, r = t & 7;
          EpiArgs e2{}; e2.cf = (float*)(ws + WS_MEMKV) + (size_t)l * 256 * 512; e2.ldc = 512;
          gemm_tile<3>((const bf16_t*)(ws + WS_MEMN) + (size_t)l * 256 * DM, DM, (const bf16_t*)(ws + WS_WKV) + (size_t)l * 512 * DM, DM, 1024, (r >> 2) << 7, (r & 3) << 7, e2, smem);
        }
      }
    } else if (sub == 1 && ENAB(2)) {
      if (layer == 0) {
        const float* kv = (const float*)(ws + WS_MEMKV);
        for (int it = gw; it < 4096; it += ngw) {
          const int l = it >> 10, m = (it >> 2) & 255, hh = it & 3;
          const float kx = kv[((size_t)l * 256 + m) * 512 + hh * 64 + lane], vx = kv[((size_t)l * 256 + m) * 512 + 256 + hh * 64 + lane];
          const float ss = wave_sum(kx * kx);
          p.out[O_PMK + ((size_t)l * 256 + m) * 256 + hh * 64 + lane] = kx * rsqrtf(ss * (1.f / 64.f) + EPS) * p.in[16][l * 64 + lane];
          p.out[O_PMV + ((size_t)l * 256 + m) * 256 + hh * 64 + lane] = vx;
        }
      }
      if (kind == 0) {
        for (int it = bid; it < NITEM; it += nb) gdn_prep_item(p, j, it / 6, it % 6, Pb, smem);
      } else {
        bf16_t* Kb = (bf16_t*)(ws + WS_G);
        const float* kg = p.in[22] + j * 128;
        for (int t = gw; t < TA; t += ngw) {
          const bf16_t* pr = Pb + (size_t)t * np;
          const u4 ku = *(const u4*)(pr + 512 + lane * 8), vu = *(const u4*)(pr + 1024 + lane * 8);
          float kf[8] = {lo2f(ku.x), hi2f(ku.x), lo2f(ku.y), hi2f(ku.y), lo2f(ku.z), hi2f(ku.z), lo2f(ku.w), hi2f(ku.w)};
          float ss = 0.f;
#pragma unroll
          for (int e = 0; e < 8; ++e) ss += kf[e] * kf[e];
          ss += __shfl_xor(ss, 1); ss += __shfl_xor(ss, 2); ss += __shfl_xor(ss, 4); ss += __shfl_xor(ss, 8);
          const float sc = rsqrtf(ss * (1.f / 128.f) + EPS);
          const int c0 = (lane & 15) * 8;
#pragma unroll
          for (int e = 0; e < 8; ++e) kf[e] *= sc * kg[c0 + e];
          float* ok = t < TP ? p.out + O_PSK + ((size_t)j * TP + t) * 512 : p.out + O_SSK + ((size_t)j * TS + (t - TP)) * 512;
          float* ov = t < TP ? p.out + O_PSV + ((size_t)j * TP + t) * 512 : p.out + O_SSV + ((size_t)j * TS + (t - TP)) * 512;
          *(float4*)(ok + lane * 8) = make_float4(kf[0], kf[1], kf[2], kf[3]); *(float4*)(ok + lane * 8 + 4) = make_float4(kf[4], kf[5], kf[6], kf[7]);
          *(float4*)(ov + lane * 8) = make_float4(lo2f(vu.x), hi2f(vu.x), lo2f(vu.y), hi2f(vu.y)); *(float4*)(ov + lane * 8 + 4) = make_float4(lo2f(vu.z), hi2f(vu.z), lo2f(vu.w), hi2f(vu.w));
          *(u4*)(Kb + (size_t)t * 512 + lane * 8) = mk4(pk2(kf[0], kf[1]), pk2(kf[2], kf[3]), pk2(kf[4], kf[5]), pk2(kf[6], kf[7]));
        }
      }
    } else if (sub == 2 && ENAB(3)) {
      unsigned* c = ctr + layer * 4;
      if (kind == 0) {
        bf16_t* O = XN;
        if (bid < 64 && (bid & 7) < 6) {
          const int h = bid & 7, sl = bid >> 3;
          gdn_scan_stream(p, j, 0, 256, h, sl, nullptr, p.out + O_PGS + ((size_t)j * 6 + h) * 16384, O, smem);
        }
        for (;;) {
          const int it = next_item(c);
          if (it >= 384 + 544) break;
          if (it < 384) { const int b = it / 48, r = it % 48, h = r >> 3, sl = r & 7;
            gdn_scan_stream(p, j, 256 + b, 1, h, sl, p.in[3] + (((size_t)j * 8 + b) * 6 + h) * 16384, p.out + O_SGS + (((size_t)j * 8 + b) * 6 + h) * 16384, O, smem);
          } else mem_attn_item(p, layer, it - 384, Pb, np, mqoff, MIX, mixp, mixoff, smem);
        }
      } else {
        const bf16_t* Kb = (const bf16_t*)(ws + WS_G);
        bf16_t* OFAR = (bf16_t*)(ws + WS_G + (32ull << 20));
        float* CARRY = (float*)(ws + WS_G + (64ull << 20));
        const float qs = 0.08838834764831845f * LOG2E;
        for (;;) {
          const int it = next_item(c);
          if (it >= 768 + 32 + 544) break;
          if (it < 768) {
            int qb, idx, whole;
            if (it < 640) { const int pr = it / 20, r = it % 20; if (r < 8) { qb = 127 - 2 * pr; idx = r; whole = 0; } else if (r < 12) { qb = 63 - pr; idx = r - 8; whole = 1; } else { qb = 126 - 2 * pr; idx = r - 12; whole = 0; } }
            else { qb = 31 - ((it - 640) >> 2); idx = (it - 640) & 3; whole = 1; }
            const int h = whole ? idx : (idx >> 1), far = whole ? 0 : (idx & 1), near_ = (!whole && !far);
            const int nAi = whole ? 2 * qb + 2 : qb + 1, koff = near_ ? (qb + 1) * 64 : 0;
            KVSrc s; s.k = Kb + (size_t)koff * 512 + h * 128; s.v = Pb + (size_t)koff * np + 1024 + h * 128; s.kpitch = 512; s.vpitch = np; s.f32 = 0;
            bf16_t* op = far ? OFAR + (size_t)(qb * 128) * 512 + h * 128 : MIX + (size_t)(qb * 128) * mixp + h * 128;
            float* co = near_ ? CARRY + (size_t)(qb * 128) * 4 + h : nullptr;
            attn_item<128, 0>(Pb + (size_t)(qb * 128) * np + h * 128, np, 128, p.in[21] + j * 128, qs, s, nAi, qb * 128 - koff, far ? 0 : 1, s, 0, op, far ? 512 : mixp, smem, co);
          } else if (it < 800) {
            const int b = (it - 768) >> 2, h = it & 3, t0 = TP + b * 64;
            KVSrc sa; sa.k = Kb + (size_t)t0 * 512 + h * 128; sa.v = Pb + (size_t)t0 * np + 1024 + h * 128; sa.kpitch = 512; sa.vpitch = np; sa.f32 = 0;
            KVSrc sb; sb.k = p.in[4] + ((size_t)j * 8 + b) * 2048 * 512 + h * 128; sb.v = p.in[5] + ((size_t)j * 8 + b) * 2048 * 512 + h * 128; sb.kpitch = 512; sb.vpitch = 512; sb.f32 = 1;
            attn_item<128, 0>(Pb + (size_t)t0 * np + h * 128, np, 64, p.in[21] + j * 128, qs, sa, 1, 0, 1, sb, 32,
                              MIX + (size_t)t0 * mixp + h * 128, mixp, smem);
          } else mem_attn_item(p, layer, it - 800, Pb, np, mqoff, MIX, mixp, mixoff, smem);
        }
      }
    } else if (sub == 3 && kind == 1) {
      const bf16_t* OFAR = (const bf16_t*)(ws + WS_G + (32ull << 20));
      const float* CARRY = (const float*)(ws + WS_G + (64ull << 20));
      for (int t = TP / 2 + gw; t < TP; t += ngw) {
        const u4 a = *(const u4*)(MIX + (size_t)t * mixp + lane * 8), b = *(const u4*)(OFAR + (size_t)t * 512 + lane * 8);
        const float sc = ex2(-CARRY[(size_t)t * 4 + (lane >> 4)]);
        u4 o;
        o.x = pk2(lo2f(a.x) + sc * lo2f(b.x), hi2f(a.x) + sc * hi2f(b.x)); o.y = pk2(lo2f(a.y) + sc * lo2f(b.y), hi2f(a.y) + sc * hi2f(b.y));
        o.z = pk2(lo2f(a.z) + sc * lo2f(b.z), hi2f(a.z) + sc * hi2f(b.z)); o.w = pk2(lo2f(a.w) + sc * lo2f(b.w), hi2f(a.w) + sc * hi2f(b.w));
        *(u4*)(MIX + (size_t)t * mixp + lane * 8) = o;
      }
    } else if (sub == 3 && ENAB(4)) {
      const bf16_t* O = XN;
      const float* og = p.in[20] + j * 128;
      for (int it = gw; it < TA * 6; it += ngw) {
        const int t = it / 6, h = it % 6;
        const unsigned ou = *(const unsigned*)(O + (size_t)t * 768 + h * 128 + lane * 2);
        const unsigned zu = *(const unsigned*)(Pb + (size_t)t * np + 2304 + h * 128 + lane * 2);
        const float o0 = lo2f(ou), o1 = hi2f(ou), z0 = lo2f(zu), z1 = hi2f(zu);
        const float ss = wave_sum(o0 * o0 + o1 * o1);
        const float sc = rsqrtf(ss * (1.f / 128.f) + EPS);
        *(unsigned*)(MIX + (size_t)t * 1024 + h * 128 + lane * 2) = pk2(o0 * sc * og[lane * 2] * silu(z0), o1 * sc * og[lane * 2 + 1] * silu(z1));
      }
    } else if (sub == 4 && ENAB(5)) {
      EpiArgs ea{}; ea.yout = Y;
      if (layer == 0) { ea.res0 = p.in[0]; ea.res1 = p.in[1]; } else { ea.res0 = Y; ea.res1 = nullptr; }
      const bf16_t* wt = kind ? (const bf16_t*)(ws + WS_WOS) + (size_t)j * 1024 * 768 : (const bf16_t*)(ws + WS_WOG) + (size_t)j * 1024 * 1024;
      gemm_phase_res(MIX, mixp, wt, mixp, ea, smem);
    } else if (sub == 5) {
      norm_all(Y, p.in[11] + layer * DM, XN, gw, ngw, lane);
    } else if (sub == 6 && ENAB(6)) {
      EpiArgs ea{}; ea.cb = Hb; ea.ldc = DFF;
      gemm_phase<2>(XN, DM, (const bf16_t*)(ws + WS_WUP) + (size_t)layer * 4096 * 1024, 1024, TA, 4096, ea, smem);
    } else if (sub == 7 && ENAB(7)) {
      EpiArgs ea{}; ea.yout = Y; ea.res0 = Y; ea.res1 = nullptr;
      gemm_phase_res(Hb, DFF, (const bf16_t*)(ws + WS_WDN) + (size_t)layer * 1024 * 4096, 4096, ea, smem);
    } else if (sub == 8) {
      norm_all(Y, p.in[9] + (layer + 1) * DM, XN, gw, ngw, lane);
    }
  }
}

extern "C" void kernel_launch(void* const* d_in, const int* in_sizes, int n_in, void* d_out, int out_size, void* d_ws, size_t ws_size, hipStream_t stream) {
  static int grid_blocks = 0;
  if (!grid_blocks) {
    int dev = 0, cus = 0, per_cu = 0;
    (void)hipGetDevice(&dev);
    (void)hipDeviceGetAttribute(&cus, hipDeviceAttributeMultiprocessorCount, dev);
    (void)hipOccupancyMaxActiveBlocksPerMultiprocessor(&per_cu, mk_fwd, 256, 0);
    if (per_cu > 2) per_cu = 2;
    if (per_cu < 1) per_cu = 1;
    grid_blocks = cus * per_cu;
    if (ws_size < WS_END) fprintf(stderr, "kernel_launch: workspace too small: %zu < %zu\n", ws_size, (size_t)WS_END);
  }
  (void)hipMemsetAsync((char*)d_ws + WS_CTR, 0, 4096, stream);
  KP p{};
  for (int i = 0; i < 27; ++i) p.in[i] = (const float*)d_in[i];
  p.out = (float*)d_out; p.ws = (unsigned char*)d_ws; p.ph_lo = 0; p.ph_hi = 37;
  void* args[] = {&p};
  hipError_t e = hipLaunchCooperativeKernel((void*)mk_fwd, dim3(grid_blocks), dim3(256), args, 0, stream);
  if (e != hipSuccess) fprintf(stderr, "cooperative launch failed: %s (grid %d)\n", hipGetErrorString(e), grid_blocks);
}
```

```cpp
#include <hip/hip_runtime.h>
#include <hip/hip_cooperative_groups.h>
#include <cstdio>
#include <cstdint>
namespace cg = cooperative_groups;

typedef unsigned short bf16_t;
typedef short bf16x8 __attribute__((ext_vector_type(8)));
typedef float f32x16 __attribute__((ext_vector_type(16)));
typedef float f32x4 __attribute__((ext_vector_type(4)));
typedef unsigned u4 __attribute__((ext_vector_type(4)));
typedef unsigned u2 __attribute__((ext_vector_type(2)));
#define DEVI __device__ __forceinline__
__device__ __forceinline__ u4 mk4(unsigned a, unsigned b, unsigned c, unsigned d) { u4 r; r.x = a; r.y = b; r.z = c; r.w = d; return r; }
__device__ __forceinline__ u2 mk2(unsigned a, unsigned b) { u2 r; r.x = a; r.y = b; return r; }
#define MFMA32(a, b, c) __builtin_amdgcn_mfma_f32_32x32x16_bf16((a), (b), (c), 0, 0, 0)
#define LDS_BARRIER() do { asm volatile("s_waitcnt lgkmcnt(0)" ::: "memory"); __builtin_amdgcn_s_barrier(); } while (0)
#define GLOAD16(dst, ptr) asm volatile("global_load_dwordx4 %0, %1, off" : "=&v"(dst) : "v"(ptr) : "memory")
#define VMWAIT(n) asm volatile("s_waitcnt vmcnt(" #n ")" ::: "memory")
#define MFMA16(a, b, c) __builtin_amdgcn_mfma_f32_16x16x32_bf16((a), (b), (c), 0, 0, 0)

constexpr int DM = 1024, TP = 16384, TS = 512, TA = TP + TS, DFF = 4096;
constexpr int NP_GDN = 3456, NP_SB = 1792, MQ_GDN = 3200, MQ_SB = 1536;
constexpr int NCHUNK = 264, NITEM = NCHUNK * 6;
constexpr float EPS = 1e-6f;
constexpr float LOG2E = 1.4426950408889634f;
constexpr size_t O_YP = 0, O_PGC = 17301504, O_PGS = 17315328, O_PSK = 17511936, O_PSV = 34289152, O_PMK = 51066368, O_PMV = 51328512,
                 O_SGC = 51590656, O_SGS = 51701248, O_SSK = 53274112, O_SSV = 53798400;
constexpr size_t WS_CTR = 0;
constexpr size_t WS_WIG = 4096;
constexpr size_t WS_WIS = WS_WIG + 2ull * 3456 * 1024 * 2;
constexpr size_t WS_WKV = WS_WIS + 2ull * 1792 * 1024 * 2;
constexpr size_t WS_WOG = WS_WKV + 4ull * 512 * 1024 * 2;
constexpr size_t WS_WOS = WS_WOG + 2ull * 1024 * 1024 * 2;
constexpr size_t WS_WUP = WS_WOS + 2ull * 1024 * 768 * 2;
constexpr size_t WS_WDN = WS_WUP + 4ull * 4096 * 1024 * 2;
constexpr size_t WS_XN = WS_WDN + 4ull * 4096 * 1024 * 2;
constexpr size_t WS_MIX = WS_XN + (size_t)TA * 1024 * 2;
constexpr size_t WS_MEMN = WS_MIX + (size_t)TA * 1024 * 2;
constexpr size_t WS_MEMKV = WS_MEMN + 4ull * 256 * 1024 * 2;
constexpr size_t WS_BIG = WS_MEMKV + 4ull * 256 * 512 * 4;
constexpr size_t WS_P = WS_BIG;
constexpr size_t WS_G = WS_P + (size_t)TA * 3456 * 2;
constexpr size_t G_ITEM = 73728;
constexpr size_t WS_GL = WS_G + (size_t)NITEM * G_ITEM;
constexpr size_t WS_H = WS_BIG;
constexpr size_t WS_END = WS_GL + 8192;

struct KP { const float* in[27]; float* out; unsigned char* ws; int ph_lo, ph_hi; };

DEVI int get_tid() { int t = __builtin_amdgcn_workitem_id_x(); asm volatile("" : "+v"(t)); return t; }
DEVI float bf2f(bf16_t b) { return __uint_as_float(((unsigned)b) << 16); }
typedef float f32x2_t __attribute__((ext_vector_type(2)));
typedef __bf16 bf16x2_t __attribute__((ext_vector_type(2)));
DEVI unsigned pk2(float lo, float hi) { f32x2_t v = {lo, hi}; return __builtin_bit_cast(unsigned, __builtin_convertvector(v, bf16x2_t)); }
DEVI bf16_t f2bf(float f) { return (bf16_t)(pk2(f, 0.f) & 0xffffu); }
DEVI float lo2f(unsigned u) { return __uint_as_float(u << 16); }
DEVI float hi2f(unsigned u) { return __uint_as_float(u & 0xffff0000u); }
DEVI float ex2(float x) { return __builtin_amdgcn_exp2f(x); }
DEVI float lg2(float x) { return __builtin_amdgcn_logf(x); }
DEVI float wave_sum(float v) {
#pragma unroll
  for (int o = 32; o >= 1; o >>= 1) v += __shfl_xor(v, o);
  return v;
}
DEVI bf16x8 as_frag(u4 u) { return __builtin_bit_cast(bf16x8, u); }
DEVI float silu(float y) { return y / (1.f + __expf(-y)); }

struct EpiArgs { bf16_t* cb; float* cf; int ldc; const float* res0; const float* res1; float* yout; };
template <int EPI>
DEVI void gemm_tile(const bf16_t* __restrict__ A, int lda, const bf16_t* __restrict__ Bt, int ldb, int K, int m0, int n0, const EpiArgs& ea, unsigned char* smem) {
  const int tid = get_tid(), lane = tid & 63, wave = tid >> 6;
  const int wm = wave >> 1, wn = wave & 1, l31 = lane & 31, lh = lane >> 5;
  bf16_t* sA = (bf16_t*)smem;
  bf16_t* sB = sA + 2 * 128 * 72;
  f32x16 acc[2][2];
#pragma unroll
  for (int i = 0; i < 2; ++i)
#pragma unroll
    for (int j = 0; j < 2; ++j)
#pragma unroll
      for (int r = 0; r < 16; ++r) acc[i][j][r] = 0.f;
  const int lr = tid >> 3, lc = (tid & 7) * 8;
  const bf16_t* gA = A + (size_t)(m0 + lr) * lda + lc;
  const bf16_t* gB = Bt + (size_t)(n0 + lr) * ldb + lc;
  u4 ra0[4], rb0[4], ra1[4], rb1[4];
#define G_ISSUE(RA, RB, K0) { _Pragma("unroll") for (int i = 0; i < 4; ++i) { GLOAD16(RA[i], gA + (size_t)i * 32 * lda + (K0)); GLOAD16(RB[i], gB + (size_t)i * 32 * ldb + (K0)); } }
#define G_STASH(RA, RB, BUF) { _Pragma("unroll") for (int i = 0; i < 4; ++i) { *(u4*)(sA + (BUF) * 128 * 72 + (lr + i * 32) * 72 + lc) = RA[i]; *(u4*)(sB + (BUF) * 128 * 72 + (lr + i * 32) * 72 + lc) = RB[i]; } }
#define G_COMPUTE(BUF) { __builtin_amdgcn_s_setprio(1); const bf16_t* cA = sA + (BUF) * 128 * 72 + (wm * 64 + l31) * 72 + lh * 8; const bf16_t* cB = sB + (BUF) * 128 * 72 + (wn * 64 + l31) * 72 + lh * 8; \
    _Pragma("unroll") for (int ks = 0; ks < 4; ++ks) { \
      bf16x8 a0 = *(const bf16x8*)(cA + ks * 16), a1 = *(const bf16x8*)(cA + 32 * 72 + ks * 16); \
      bf16x8 b0 = *(const bf16x8*)(cB + ks * 16), b1 = *(const bf16x8*)(cB + 32 * 72 + ks * 16); \
      acc[0][0] = MFMA32(a0, b0, acc[0][0]); acc[0][1] = MFMA32(a0, b1, acc[0][1]); \
      acc[1][0] = MFMA32(a1, b0, acc[1][0]); acc[1][1] = MFMA32(a1, b1, acc[1][1]); } __builtin_amdgcn_s_setprio(0); }
  const int nk = K >> 6;
  VMWAIT(0);
  G_ISSUE(ra0, rb0, 0);
  G_ISSUE(ra1, rb1, 64);
  __syncthreads();
  VMWAIT(8);
  G_STASH(ra0, rb0, 0);
  LDS_BARRIER();
  for (int kt = 0; kt < nk; kt += 2) {
    G_ISSUE(ra0, rb0, ((kt + 2 < nk) ? kt + 2 : nk - 1) << 6);
    G_COMPUTE(0);
    VMWAIT(8);
    G_STASH(ra1, rb1, 1);
    LDS_BARRIER();
    G_ISSUE(ra1, rb1, ((kt + 3 < nk) ? kt + 3 : nk - 1) << 6);
    G_COMPUTE(1);
    VMWAIT(8);
    if (kt + 2 < nk) G_STASH(ra0, rb0, 0);
    LDS_BARRIER();
  }
  VMWAIT(0);
#pragma unroll
  for (int i = 0; i < 4; ++i) asm volatile("" :: "v"(ra0[i]), "v"(rb0[i]), "v"(ra1[i]), "v"(rb1[i]));
#undef G_ISSUE
#undef G_STASH
#undef G_COMPUTE
#pragma unroll
  for (int i = 0; i < 2; ++i)
#pragma unroll
    for (int r = 0; r < 16; ++r) {
      const int row = m0 + wm * 64 + i * 32 + (r >> 2) * 8 + lh * 4 + (r & 3);
#pragma unroll
      for (int j = 0; j < 2; ++j) {
        const int col = n0 + wn * 64 + j * 32 + l31;
        const float v = acc[i][j][r];
        if (EPI == 0) ea.cb[(size_t)row * ea.ldc + col] = f2bf(v);
        else if (EPI == 1) {
          const float* rp = ea.res1 ? (row < TP ? ea.res0 + (size_t)row * DM : ea.res1 + (size_t)(row - TP) * DM) : ea.res0 + (size_t)row * DM;
          ea.yout[(size_t)row * DM + col] = rp[col] + v;
        } else if (EPI == 4) { unsafeAtomicAdd(ea.yout + (size_t)row * DM + col, v); }
        else if (EPI == 2) { const float rl = v > 0.f ? v : 0.f; ea.cb[(size_t)row * ea.ldc + col] = f2bf(rl * rl); }
        else ea.cf[(size_t)row * ea.ldc + col] = v;
      }
    }
}
template <int EPI>
DEVI void gemm_phase(const bf16_t* A, int lda, const bf16_t* Bt, int K, int M, int N, const EpiArgs& ea, unsigned char* smem) {
  const int nM = M >> 7, nN = N >> 7, nwg = nM * nN;
  const int q = nwg >> 3, r = nwg & 7;
  for (int L = blockIdx.x; L < nwg; L += gridDim.x) {
    const int xcd = L & 7, off = L >> 3;
    const int wg = (xcd < r ? xcd * (q + 1) : r * (q + 1) + (xcd - r) * q) + off;
    const int nig = 8 * nN, gid = wg / nig, fm = gid * 8, gsz = (nM - fm) < 8 ? (nM - fm) : 8;
    const int pm = fm + ((wg % nig) % gsz), pn = (wg % nig) / gsz;
    gemm_tile<EPI>(A, lda, Bt, K, K, pm << 7, pn << 7, ea, smem);
  }
}

DEVI void gemm_phase_res(const bf16_t* A, int lda, const bf16_t* Bt, int K, const EpiArgs& ea, unsigned char* smem) {
  gemm_phase<1>(A, lda, Bt, K, TP, 1024, ea, smem);
  const int S = (K == 4096) ? 16 : (K >> 7), klen = K / S;
  for (int it = blockIdx.x; it < 32 * S; it += gridDim.x) {
    const int tile = it / S, ks = it % S;
    gemm_tile<4>(A + (size_t)ks * klen, lda, Bt + (size_t)ks * klen, K, klen, TP + ((tile >> 3) << 7), (tile & 7) << 7, ea, smem);
  }
}

DEVI void convert_tile(const float* __restrict__ W, bf16_t* __restrict__ Wt, int K, int N, int k0, int n0, int thr, int shift, unsigned char* smem) {
  float* tile = (float*)smem;
  const int tid = get_tid();
  __syncthreads();
#pragma unroll
  for (int i = 0; i < 4; ++i) {
    const int r = (tid >> 4) + 16 * i, c = (tid & 15) * 4;
    float4 v = make_float4(0.f, 0.f, 0.f, 0.f);
    if (n0 + c < N) v = *(const float4*)(W + (size_t)(k0 + r) * N + n0 + c);
    tile[r * 65 + c] = v.x; tile[r * 65 + c + 1] = v.y; tile[r * 65 + c + 2] = v.z; tile[r * 65 + c + 3] = v.w;
  }
  __syncthreads();
  const int n = tid >> 2, kc = (tid & 3) * 16;
  if (n0 + n < N) {
    const int nn = n0 + n, nd = nn + (nn >= thr ? shift : 0);
    unsigned o[8];
#pragma unroll
    for (int e = 0; e < 8; ++e) o[e] = pk2(tile[(kc + 2 * e) * 65 + n], tile[(kc + 2 * e + 1) * 65 + n]);
    u4* dst = (u4*)(Wt + (size_t)nd * K + k0 + kc);
    dst[0] = mk4(o[0], o[1], o[2], o[3]); dst[1] = mk4(o[4], o[5], o[6], o[7]);
  }
}
DEVI void convert_group(int& base, int bid, int nb, const float* W, bf16_t* Wt, int nl, int K, int N, int NPAD, int thr, int shift, unsigned char* smem) {
  const int tk = K >> 6, tn = (N + 63) >> 6, per = tk * tn, tot = per * nl;
  int first = ((bid - base) % nb + nb) % nb;
  for (int t = first; t < tot; t += nb) {
    const int l = t / per, r = t % per;
    convert_tile(W + (size_t)l * K * N, Wt + (size_t)l * NPAD * K, K, N, (r / tn) << 6, (r % tn) << 6, thr, shift, smem);
  }
  base += tot;
}

DEVI void norm_row(const float* __restrict__ src, const float* __restrict__ gain, bf16_t* __restrict__ dst, int lane) {
  float4 v[4]; float ss = 0.f;
#pragma unroll
  for (int i = 0; i < 4; ++i) { v[i] = *(const float4*)(src + lane * 4 + 256 * i); ss += v[i].x * v[i].x + v[i].y * v[i].y + v[i].z * v[i].z + v[i].w * v[i].w; }
  ss = wave_sum(ss);
  const float sc = rsqrtf(ss * (1.f / 1024.f) + EPS);
#pragma unroll
  for (int i = 0; i < 4; ++i) {
    const float4 g = *(const float4*)(gain + lane * 4 + 256 * i);
    u2 o; o.x = pk2(v[i].x * sc * g.x, v[i].y * sc * g.y); o.y = pk2(v[i].z * sc * g.z, v[i].w * sc * g.w);
    *(u2*)(dst + lane * 4 + 256 * i) = o;
  }
}

DEVI void norm_row2(const float* __restrict__ s0, const float* __restrict__ s1, const float* __restrict__ gain, bf16_t* __restrict__ d0, bf16_t* __restrict__ d1, int lane) {
  float4 v[4], w[4]; float ss = 0.f, tt = 0.f;
#pragma unroll
  for (int i = 0; i < 4; ++i) { v[i] = *(const float4*)(s0 + lane * 4 + 256 * i); w[i] = *(const float4*)(s1 + lane * 4 + 256 * i); }
#pragma unroll
  for (int i = 0; i < 4; ++i) { ss += v[i].x * v[i].x + v[i].y * v[i].y + v[i].z * v[i].z + v[i].w * v[i].w; tt += w[i].x * w[i].x + w[i].y * w[i].y + w[i].z * w[i].z + w[i].w * w[i].w; }
#pragma unroll
  for (int o = 32; o >= 1; o >>= 1) { ss += __shfl_xor(ss, o); tt += __shfl_xor(tt, o); }
  const float sc = rsqrtf(ss * (1.f / 1024.f) + EPS), tc = rsqrtf(tt * (1.f / 1024.f) + EPS);
#pragma unroll
  for (int i = 0; i < 4; ++i) {
    const float4 g = *(const float4*)(gain + lane * 4 + 256 * i);
    u2 o; o.x = pk2(v[i].x * sc * g.x, v[i].y * sc * g.y); o.y = pk2(v[i].z * sc * g.z, v[i].w * sc * g.w);
    *(u2*)(d0 + lane * 4 + 256 * i) = o;
    u2 q; q.x = pk2(w[i].x * tc * g.x, w[i].y * tc * g.y); q.y = pk2(w[i].z * tc * g.z, w[i].w * tc * g.w);
    *(u2*)(d1 + lane * 4 + 256 * i) = q;
  }
}
DEVI void norm_all(const float* __restrict__ Y, const float* __restrict__ gain, bf16_t* __restrict__ XN, int gw, int ngw, int lane) {
  for (int r = gw; r < TA; r += ngw) norm_row(Y + (size_t)r * DM, gain, XN + (size_t)r * DM, lane);
}

struct KVSrc { const void* k; const void* v; int kpitch, vpitch, f32; };
template <int D>
DEVI void attn_load(const KVSrc& s, int r0, u4 (&kr)[D / 32], u4 (&vr)[D / 32]) {
  const int tid = get_tid();
#pragma unroll
  for (int i = 0; i < D / 32; ++i) {
    const int c = tid + 256 * i, key = c / (D / 8), dch = c % (D / 8);
    if (s.f32) {
      const float* kp = (const float*)s.k + (size_t)(r0 + key) * s.kpitch + dch * 8;
      const float* vp = (const float*)s.v + (size_t)(r0 + key) * s.vpitch + dch * 8;
      const float4 a = *(const float4*)kp, b = *(const float4*)(kp + 4), c2 = *(const float4*)vp, d2 = *(const float4*)(vp + 4);
      kr[i] = mk4(pk2(a.x, a.y), pk2(a.z, a.w), pk2(b.x, b.y), pk2(b.z, b.w));
      vr[i] = mk4(pk2(c2.x, c2.y), pk2(c2.z, c2.w), pk2(d2.x, d2.y), pk2(d2.z, d2.w));
      __builtin_amdgcn_sched_barrier(0);
    } else {
      kr[i] = *(const u4*)((const bf16_t*)s.k + (size_t)(r0 + key) * s.kpitch + dch * 8);
      vr[i] = *(const u4*)((const bf16_t*)s.v + (size_t)(r0 + key) * s.vpitch + dch * 8);
    }
  }
}
template <int D>
DEVI void attn_store(bf16_t* Ks, bf16_t* Vt, const u4 (&kr)[D / 32], const u4 (&vr)[D / 32]) {
  const int tid = get_tid();
#pragma unroll
  for (int i = 0; i < D / 32; ++i) {
    const int c = tid + 256 * i, key = c / (D / 8), dch = c % (D / 8);
    *(u4*)(Ks + key * (D + 8) + dch * 8) = kr[i];
    const int kx = key ^ ((dch & 15) << 2);
    const unsigned w[4] = {vr[i].x, vr[i].y, vr[i].z, vr[i].w};
#pragma unroll
    for (int e = 0; e < 8; ++e) Vt[(dch * 8 + e) * 72 + kx] = (bf16_t)((w[e >> 1] >> (16 * (e & 1))) & 0xffffu);
  }
}

template <int D, int MODE>
DEVI void attn_item(const bf16_t* __restrict__ qsrc, int qpitch, int nq, const float* __restrict__ qgain, float qscale,
                    const KVSrc& segA, int nA, int qposA0, int maskA, const KVSrc& segB, int nB,
                    bf16_t* __restrict__ out, int opitch, unsigned char* smem, float* __restrict__ carry_out = nullptr) {
  constexpr int KPT = D + 8, NKS = D / 16, NDB = D / 32, NCH = D / 32;
  constexpr int STAGE = 64 * KPT + D * 72;
  const int tid = get_tid(), lane = tid & 63, wave = tid >> 6, l31 = lane & 31, lh = lane >> 5;
  bf16_t* sbase = (bf16_t*)smem;
  const bool active = wave * 32 < nq;
  bf16x8 qf[NKS];
  {
    float qv[NKS][8]; float ss = 0.f;
    const bf16_t* qp = qsrc + (size_t)(wave * 32 + l31) * qpitch + lh * 8;
#pragma unroll
    for (int ks = 0; ks < NKS; ++ks) {
      u4 u = mk4(0, 0, 0, 0);
      if (active) u = *(const u4*)(qp + ks * 16);
      const unsigned w[4] = {u.x, u.y, u.z, u.w};
#pragma unroll
      for (int e = 0; e < 4; ++e) { qv[ks][2 * e] = lo2f(w[e]); qv[ks][2 * e + 1] = hi2f(w[e]); }
#pragma unroll
      for (int e = 0; e < 8; ++e) ss += qv[ks][e] * qv[ks][e];
    }
    ss += __shfl_xor(ss, 32);
    const float sc = rsqrtf(ss * (1.f / D) + EPS) * qscale;
#pragma unroll
    for (int ks = 0; ks < NKS; ++ks) {
      const float4 g0 = *(const float4*)(qgain + ks * 16 + lh * 8), g1 = *(const float4*)(qgain + ks * 16 + lh * 8 + 4);
      u4 u;
      u.x = pk2(qv[ks][0] * sc * g0.x, qv[ks][1] * sc * g0.y); u.y = pk2(qv[ks][2] * sc * g0.z, qv[ks][3] * sc * g0.w);
      u.z = pk2(qv[ks][4] * sc * g1.x, qv[ks][5] * sc * g1.y); u.w = pk2(qv[ks][6] * sc * g1.z, qv[ks][7] * sc * g1.w);
      qf[ks] = as_frag(u);
    }
  }
  f32x16 oacc[NDB];
#pragma unroll
  for (int db = 0; db < NDB; ++db)
#pragma unroll
    for (int r = 0; r < 16; ++r) oacc[db][r] = 0.f;
  float carry = 0.f, mx = -1e30f, lsum = 0.f;
  const int ntot = nA + nB;
  const int qpos = qposA0 + wave * 32 + l31;
  u4 kr[NCH], vr[NCH];
  {
    const bool inA = 0 < nA; const int tix = inA ? nA - 1 : nB - 1;
    attn_load<D>(inA ? segA : segB, tix * 64, kr, vr);
    __syncthreads();
    attn_store<D>(sbase, sbase + 64 * KPT, kr, vr);
    __syncthreads();
  }
  for (int it = 0; it < ntot; ++it) {
    const int cur = it & 1;
    if (it + 1 < ntot) {
      const bool nInA = (it + 1) < nA; const int tix = nInA ? nA - 2 - it : nB - 1 - (it + 1 - nA);
      attn_load<D>(nInA ? segA : segB, tix * 64, kr, vr);
    }
    const bool inA = it < nA;
    const int kbase = inA ? (nA - 1 - it) * 64 : 0;
    const bf16_t* Ks = sbase + cur * STAGE;
    const bf16_t* Vt = Ks + 64 * KPT;
    const bool mneed = inA && maskA && (kbase + 63 >= qposA0 + wave * 32);
    const bool skip = !active || (inA && maskA && (kbase > qposA0 + wave * 32 + 31));
    if (!skip) {
      bf16x8 pf[2][2];
      if (MODE == 0) {
        float after = carry;
#pragma unroll
        for (int rt = 1; rt >= 0; --rt) {
          f32x16 z;
#pragma unroll
          for (int r = 0; r < 16; ++r) z[r] = 0.f;
#pragma unroll
          for (int ks = 0; ks < NKS; ++ks) {
            const bf16x8 a = *(const bf16x8*)(Ks + (rt * 32 + l31) * KPT + ks * 16 + lh * 8);
            z = MFMA32(a, qf[ks], z);
          }
          float m[16];
#pragma unroll
          for (int i = 0; i < 16; ++i) {
            float mm = lg2(1.f + ex2(z[i]));
            if (mneed) { const int key = kbase + rt * 32 + (i >> 2) * 8 + lh * 4 + (i & 3); if (key >= qpos) mm = 0.f; }
            m[i] = mm;
          }
          float a_[16];
#pragma unroll
          for (int g = 3; g >= 0; --g) {
            const float s4 = (m[g * 4] + m[g * 4 + 1]) + (m[g * 4 + 2] + m[g * 4 + 3]);
            const float p4 = __shfl_xor(s4, 32);
            float c = after + (lh == 0 ? p4 : 0.f);
            after += s4 + p4;
#pragma unroll
            for (int e = 3; e >= 0; --e) {
              c += m[g * 4 + e];
              float av = ex2(z[g * 4 + e] - c);
              if (mneed) { const int key = kbase + rt * 32 + g * 8 + lh * 4 + e; if (key >= qpos) av = 0.f; }
              a_[g * 4 + e] = av;
            }
          }
#pragma unroll
          for (int s2 = 0; s2 < 2; ++s2)
            pf[rt][s2] = as_frag(mk4(pk2(a_[8 * s2 + 0], a_[8 * s2 + 1]), pk2(a_[8 * s2 + 2], a_[8 * s2 + 3]), pk2(a_[8 * s2 + 4], a_[8 * s2 + 5]), pk2(a_[8 * s2 + 6], a_[8 * s2 + 7])));
        }
        carry = after;
      } else {
        f32x16 z[2];
#pragma unroll
        for (int rt = 0; rt < 2; ++rt) {
          f32x16 zt;
#pragma unroll
          for (int r = 0; r < 16; ++r) zt[r] = 0.f;
#pragma unroll
          for (int ks = 0; ks < NKS; ++ks) {
            const bf16x8 a = *(const bf16x8*)(Ks + (rt * 32 + l31) * KPT + ks * 16 + lh * 8);
            zt = MFMA32(a, qf[ks], zt);
          }
          z[rt] = zt;
        }
        float tm = z[0][0];
#pragma unroll
        for (int rt = 0; rt < 2; ++rt)
#pragma unroll
          for (int i = 0; i < 16; ++i) tm = fmaxf(tm, z[rt][i]);
        tm = fmaxf(tm, __shfl_xor(tm, 32));
        const float nm = fmaxf(mx, tm);
        const float alpha = ex2(mx - nm);
        mx = nm;
        float ps = 0.f;
        float a_[2][16];
#pragma unroll
        for (int rt = 0; rt < 2; ++rt)
#pragma unroll
          for (int i = 0; i < 16; ++i) { a_[rt][i] = ex2(z[rt][i] - nm); ps += a_[rt][i]; }
        lsum = lsum * alpha + ps;
#pragma unroll
        for (int db = 0; db < NDB; ++db)
#pragma unroll
          for (int r = 0; r < 16; ++r) oacc[db][r] *= alpha;
#pragma unroll
        for (int rt = 0; rt < 2; ++rt)
#pragma unroll
          for (int s2 = 0; s2 < 2; ++s2)
            pf[rt][s2] = as_frag(mk4(pk2(a_[rt][8 * s2 + 0], a_[rt][8 * s2 + 1]), pk2(a_[rt][8 * s2 + 2], a_[rt][8 * s2 + 3]), pk2(a_[rt][8 * s2 + 4], a_[rt][8 * s2 + 5]), pk2(a_[rt][8 * s2 + 6], a_[rt][8 * s2 + 7])));
      }
#pragma unroll
      for (int db = 0; db < NDB; ++db) {
        const int d = db * 32 + l31, sw = ((d >> 3) & 15) << 2;
#pragma unroll
        for (int rt = 0; rt < 2; ++rt)
#pragma unroll
          for (int s = 0; s < 2; ++s) {
            const int kb0 = rt * 32 + 16 * s + 4 * lh;
            const u2 lo = *(const u2*)(Vt + d * 72 + (kb0 ^ sw));
            const u2 hi = *(const u2*)(Vt + d * 72 + ((kb0 + 8) ^ sw));
            oacc[db] = MFMA32(as_frag(mk4(lo.x, lo.y, hi.x, hi.y)), pf[rt][s], oacc[db]);
          }
      }
    }
    if (it + 1 < ntot) { bf16_t* nK = sbase + (cur ^ 1) * STAGE; attn_store<D>(nK, nK + 64 * KPT, kr, vr); }
    LDS_BARRIER();
  }
  if (active && carry_out && lh == 0) carry_out[(size_t)(wave * 32 + l31) * 4] = carry;
  if (active) {
    float inv = 1.f;
    if (MODE == 1) { const float l = lsum + __shfl_xor(lsum, 32); inv = 1.f / l; }
    bf16_t* op = out + (size_t)(wave * 32 + l31) * opitch + lh * 4;
#pragma unroll
    for (int db = 0; db < NDB; ++db)
#pragma unroll
      for (int g = 0; g < 4; ++g) {
        u2 o; o.x = pk2(oacc[db][g * 4] * inv, oacc[db][g * 4 + 1] * inv); o.y = pk2(oacc[db][g * 4 + 2] * inv, oacc[db][g * 4 + 3] * inv);
        *(u2*)(op + db * 32 + g * 8) = o;
      }
  }
}

DEVI void mem_attn_item(const KP& p, int layer, int item, const bf16_t* P, int np, int mqoff, bf16_t* mix, int mixp, int mixoff, unsigned char* smem) {
  const int h = item & 3;
  int t0, nq; const float *kk, *vv;
  if (item < 512) { t0 = (item >> 2) * 128; nq = 128; kk = p.out + O_PMK + (size_t)layer * 65536; vv = p.out + O_PMV + (size_t)layer * 65536; }
  else { const int b = (item - 512) >> 2; t0 = TP + b * 64; nq = 64; kk = p.in[6] + ((size_t)layer * 8 + b) * 65536; vv = p.in[7] + ((size_t)layer * 8 + b) * 65536; }
  KVSrc s; s.k = kk + h * 64; s.v = vv + h * 64; s.kpitch = 256; s.vpitch = 256; s.f32 = 1;
  attn_item<64, 1>(P + (size_t)t0 * np + mqoff + h * 64, np, nq, p.in[15] + layer * 64, 0.125f * LOG2E, s, 4, 0, 0, s, 0,
                   mix + (size_t)t0 * mixp + mixoff + h * 64, mixp, smem);
}

DEVI void gdn_prep_item(const KP& p, int j, int ci, int h, const bf16_t* P, unsigned char* smem) {
  constexpr int NP = NP_GDN;
  const int tid = get_tid(), lane = tid & 63, wave = tid >> 6;
  const int item = ci * 6 + h;
  const bool samp = ci >= 256;
  const int b = ci - 256;
  const int t0 = samp ? TP + b * 64 : ci * 64;
  float* stage = (float*)smem;
  float* sL = (float*)smem;
  bf16_t* qn = (bf16_t*)(smem + 33280);
  bf16_t* kn = qn + 64 * 136;
  float* sgc = (float*)(smem + 33280 + 2 * 64 * 136 * 2);
  float* sbeta = sgc + 64;
  float* segc = sbeta + 64;
  unsigned char* gi = p.ws + WS_G + (size_t)item * G_ITEM;
  bf16_t* gU = (bf16_t*)gi; bf16_t* gW = gU + 8192; bf16_t* gQD = gW + 8192; bf16_t* gKDT = gQD + 8192; bf16_t* gAI = gKDT + 8192;
  const float* convw = p.in[17] + (size_t)j * 4 * 2304;
  const float* cstate = p.in[2] + ((size_t)j * 8 + (samp ? b : 0)) * 3 * 2304;
  const bf16_t* Pc = P + (size_t)t0 * NP;
  __syncthreads();
  if (wave == 0) {
    const float braw = bf2f(Pc[(size_t)lane * NP + 3072 + h]), araw = bf2f(Pc[(size_t)lane * NP + 3078 + h]);
    const float beta = 1.f / (1.f + __expf(-braw));
    const float xx = araw + p.in[19][j * 6 + h];
    const float sp = xx > 20.f ? xx : __logf(1.f + __expf(xx));
    float g = -__expf(p.in[18][j * 6 + h]) * sp;
#pragma unroll
    for (int d = 1; d < 64; d <<= 1) { const float v = __shfl_up(g, d); if (lane >= d) g += v; }
    sgc[lane] = g; sbeta[lane] = beta; segc[lane] = __expf(g);
    if (lane == 63) ((float*)(p.ws + WS_GL))[item] = __expf(g);
  }
  if (samp || ci == 255) {
    float* dst = samp ? p.out + O_SGC + ((size_t)j * 8 + b) * 3 * 2304 : p.out + O_PGC + (size_t)j * 3 * 2304;
    for (int idx = tid; idx < 1152; idx += 256) {
      const int r = idx / 384, cc = idx % 384, ch = (cc >> 7) * 768 + h * 128 + (cc & 127);
      dst[r * 2304 + ch] = bf2f(Pc[(size_t)(61 + r) * NP + ch]);
    }
  }
  const float gcl_dummy = 0.f; (void)gcl_dummy;
#pragma unroll 1
  for (int which = 0; which < 2; ++which) {
    {
      const int c = tid & 127, th = tid >> 7, ch = which * 768 + h * 128 + c;
      const float w0 = convw[ch], w1 = convw[2304 + ch], w2 = convw[2 * 2304 + ch], w3 = convw[3 * 2304 + ch];
      float xm3, xm2, xm1;
      if (th == 1) { xm3 = bf2f(Pc[(size_t)29 * NP + ch]); xm2 = bf2f(Pc[(size_t)30 * NP + ch]); xm1 = bf2f(Pc[(size_t)31 * NP + ch]); }
      else if (samp) { xm3 = cstate[ch]; xm2 = cstate[2304 + ch]; xm1 = cstate[2 * 2304 + ch]; }
      else if (ci == 0) { xm3 = xm2 = xm1 = 0.f; }
      else { xm3 = bf2f(Pc[-(ptrdiff_t)3 * NP + ch]); xm2 = bf2f(Pc[-(ptrdiff_t)2 * NP + ch]); xm1 = bf2f(Pc[-(ptrdiff_t)NP + ch]); }
      const bf16_t* pp = Pc + (size_t)(th * 32) * NP + ch;
#pragma unroll 8
      for (int tt = 0; tt < 32; ++tt) {
        const float x0 = bf2f(pp[(size_t)tt * NP]);
        const float y = w0 * xm3 + w1 * xm2 + w2 * xm1 + w3 * x0;
        stage[(th * 32 + tt) * 129 + c] = silu(y);
        xm3 = xm2; xm2 = xm1; xm1 = x0;
      }
    }
    __syncthreads();
    {
      const int tt = tid >> 2, part = tid & 3;
      float v[32]; float ss = 0.f;
#pragma unroll
      for (int e = 0; e < 32; ++e) { v[e] = stage[tt * 129 + part * 32 + e]; ss += v[e] * v[e]; }
      ss += __shfl_xor(ss, 1); ss += __shfl_xor(ss, 2);
      float rinv = rsqrtf(ss + EPS);
      if (which == 0) rinv *= 0.08838834764831845f;
      bf16_t* dn = (which == 0 ? qn : kn) + tt * 136 + part * 32;
      const float eg = segc[tt];
#pragma unroll
      for (int e = 0; e < 32; e += 8) {
        u4 u; u.x = pk2(v[e] * rinv, v[e + 1] * rinv); u.y = pk2(v[e + 2] * rinv, v[e + 3] * rinv); u.z = pk2(v[e + 4] * rinv, v[e + 5] * rinv); u.w = pk2(v[e + 6] * rinv, v[e + 7] * rinv);
        *(u4*)(dn + e) = u;
        if (which == 0) {
          const float s2 = rinv * eg;
          u4 w; w.x = pk2(v[e] * s2, v[e + 1] * s2); w.y = pk2(v[e + 2] * s2, v[e + 3] * s2); w.z = pk2(v[e + 4] * s2, v[e + 5] * s2); w.w = pk2(v[e + 6] * s2, v[e + 7] * s2);
          *(u4*)(gQD + tt * 128 + part * 32 + e) = w;
        }
      }
    }
    __syncthreads();
  }
  {
    const int d = tid & 127, th = tid >> 7;
    const float gcl = sgc[63];
#pragma unroll
    for (int q8 = 0; q8 < 4; ++q8) {
      float f[8];
#pragma unroll
      for (int e = 0; e < 8; ++e) { const int tt = th * 32 + q8 * 8 + e; f[e] = bf2f(kn[tt * 136 + d]) * __expf(gcl - sgc[tt]); }
      *(u4*)(gKDT + d * 64 + th * 32 + q8 * 8) = mk4(pk2(f[0], f[1]), pk2(f[2], f[3]), pk2(f[4], f[5]), pk2(f[6], f[7]));
    }
  }
  {
    const int l31 = lane & 31, lh = lane >> 5, ri = wave >> 1, cj = wave & 1;
    f32x16 kk, qk;
#pragma unroll
    for (int r = 0; r < 16; ++r) { kk[r] = 0.f; qk[r] = 0.f; }
#pragma unroll
    for (int ks = 0; ks < 8; ++ks) {
      const bf16x8 ak = *(const bf16x8*)(kn + (ri * 32 + l31) * 136 + ks * 16 + lh * 8);
      const bf16x8 aq = *(const bf16x8*)(qn + (ri * 32 + l31) * 136 + ks * 16 + lh * 8);
      const bf16x8 bk = *(const bf16x8*)(kn + (cj * 32 + l31) * 136 + ks * 16 + lh * 8);
      kk = MFMA32(ak, bk, kk); qk = MFMA32(aq, bk, qk);
    }
    const int jj = cj * 32 + l31; const float gj = sgc[jj];
#pragma unroll
    for (int r = 0; r < 16; ++r) {
      const int ii = ri * 32 + (r >> 2) * 8 + lh * 4 + (r & 3);
      const float dec = ii >= jj ? __expf(sgc[ii] - gj) : 0.f;
      sL[ii * 64 + jj] = ii > jj ? sbeta[ii] * kk[r] * dec : 0.f;
      gAI[ii * 64 + jj] = f2bf(qk[r] * dec);
    }
  }
  __syncthreads();
  {
    float x[64];
    if (tid < 128) {
      const int ch = 1536 + h * 128 + tid;
      const float w0 = convw[ch], w1 = convw[2304 + ch], w2 = convw[2 * 2304 + ch], w3 = convw[3 * 2304 + ch];
      float xm3, xm2, xm1;
      if (samp) { xm3 = cstate[ch]; xm2 = cstate[2304 + ch]; xm1 = cstate[2 * 2304 + ch]; }
      else if (ci == 0) { xm3 = xm2 = xm1 = 0.f; }
      else { xm3 = bf2f(Pc[-(ptrdiff_t)3 * NP + ch]); xm2 = bf2f(Pc[-(ptrdiff_t)2 * NP + ch]); xm1 = bf2f(Pc[-(ptrdiff_t)NP + ch]); }
#pragma unroll
      for (int tt = 0; tt < 64; ++tt) {
        const float x0 = bf2f(Pc[(size_t)tt * NP + ch]);
        const float y = w0 * xm3 + w1 * xm2 + w2 * xm1 + w3 * x0;
        x[tt] = silu(y) * sbeta[tt];
        xm3 = xm2; xm2 = xm1; xm1 = x0;
        if ((tt & 7) == 7) __builtin_amdgcn_sched_barrier(0);
      }
    } else {
#pragma unroll
      for (int tt = 0; tt < 64; ++tt) { x[tt] = bf2f(kn[tt * 136 + tid - 128]) * sbeta[tt] * segc[tt]; if ((tt & 7) == 7) __builtin_amdgcn_sched_barrier(0); }
    }
#pragma unroll
    for (int i = 1; i < 64; ++i) {
      float a = x[i];
#pragma unroll
      for (int jx = 0; jx < i; ++jx) a -= sL[i * 64 + jx] * x[jx];
      x[i] = a;
      __builtin_amdgcn_sched_barrier(0);
    }
    bf16_t* dst = (tid < 128 ? gU : gW) + (tid & 127);
#pragma unroll
    for (int tt = 0; tt < 64; ++tt) { dst[tt * 128] = f2bf(x[tt]); if ((tt & 7) == 7) __builtin_amdgcn_sched_barrier(0); }
  }
}

struct ScanFrags { u4 w[4], qd[4], ai[2], kdt[2][2]; unsigned u[4]; float gl; };
DEVI void scan_load(const KP& p, int item, int wave, int lane, int sl, ScanFrags& f) {
  const int n = lane & 15, g = lane >> 4;
  const unsigned char* gi = p.ws + WS_G + (size_t)item * G_ITEM;
  const bf16_t* gU = (const bf16_t*)gi; const bf16_t* gW = gU + 8192; const bf16_t* gQD = gW + 8192; const bf16_t* gKDT = gQD + 8192; const bf16_t* gAI = gKDT + 8192;
#pragma unroll
  for (int s = 0; s < 4; ++s) { GLOAD16(f.w[s], gW + (16 * wave + n) * 128 + 32 * s + 8 * g); GLOAD16(f.qd[s], gQD + (16 * wave + n) * 128 + 32 * s + 8 * g); }
#pragma unroll
  for (int s = 0; s < 2; ++s) {
    GLOAD16(f.ai[s], gAI + (16 * wave + n) * 64 + 32 * s + 8 * g);
#pragma unroll
    for (int tt = 0; tt < 2; ++tt) GLOAD16(f.kdt[tt][s], gKDT + (32 * wave + 16 * tt + n) * 64 + 32 * s + 8 * g);
  }
  const bf16_t* up = gU + (16 * wave + 4 * g) * 128 + sl * 16 + n;
#pragma unroll
  for (int r = 0; r < 4; ++r) asm volatile("global_load_ushort %0, %1, off" : "=&v"(f.u[r]) : "v"(up + r * 128) : "memory");
  const float* glp = (const float*)(p.ws + WS_GL) + item;
  asm volatile("global_load_dword %0, %1, off" : "=&v"(f.gl) : "v"(glp) : "memory");
}
DEVI void scan_wait19(ScanFrags& f) {
  asm volatile("s_waitcnt vmcnt(19)"
               : "+v"(f.w[0]), "+v"(f.w[1]), "+v"(f.w[2]), "+v"(f.w[3]), "+v"(f.qd[0]), "+v"(f.qd[1]), "+v"(f.qd[2]), "+v"(f.qd[3]),
                 "+v"(f.ai[0]), "+v"(f.ai[1]), "+v"(f.kdt[0][0]), "+v"(f.kdt[0][1]), "+v"(f.kdt[1][0]), "+v"(f.kdt[1][1]),
                 "+v"(f.u[0]), "+v"(f.u[1]), "+v"(f.u[2]), "+v"(f.u[3]), "+v"(f.gl)
               :: "memory");
}
DEVI void scan_keep(const ScanFrags& f) {
#pragma unroll
  for (int s = 0; s < 4; ++s) asm volatile("" :: "v"(f.w[s]), "v"(f.qd[s]));
#pragma unroll
  for (int s = 0; s < 2; ++s) asm volatile("" :: "v"(f.ai[s]), "v"(f.kdt[0][s]), "v"(f.kdt[1][s]));
  asm volatile("" :: "v"(f.u[0]), "v"(f.u[1]), "v"(f.u[2]), "v"(f.u[3]), "v"(f.gl));
}
DEVI void scan_step(const ScanFrags& f, f32x4 (&sacc)[2], bf16_t* St, bf16_t* Vnt, bf16_t* O, int t0, int h, int sl, int wave, int n, int g) {
  bf16x8 sf[4];
#pragma unroll
  for (int s = 0; s < 4; ++s) sf[s] = *(const bf16x8*)(St + n * 136 + 32 * s + 8 * g);
  f32x4 wsa = {0.f, 0.f, 0.f, 0.f}, oa = {0.f, 0.f, 0.f, 0.f};
#pragma unroll
  for (int s = 0; s < 4; ++s) wsa = MFMA16(as_frag(f.w[s]), sf[s], wsa);
  float vn[4];
  vn[0] = lo2f(f.u[0]) - wsa[0]; vn[1] = lo2f(f.u[1]) - wsa[1]; vn[2] = lo2f(f.u[2]) - wsa[2]; vn[3] = lo2f(f.u[3]) - wsa[3];
  { u2 o; o.x = pk2(vn[0], vn[1]); o.y = pk2(vn[2], vn[3]); *(u2*)(Vnt + n * 72 + 16 * wave + 4 * g) = o; }
#pragma unroll
  for (int s = 0; s < 4; ++s) oa = MFMA16(as_frag(f.qd[s]), sf[s], oa);
  LDS_BARRIER();
  bf16x8 vf[2];
#pragma unroll
  for (int s = 0; s < 2; ++s) vf[s] = *(const bf16x8*)(Vnt + n * 72 + 32 * s + 8 * g);
#pragma unroll
  for (int s = 0; s < 2; ++s) oa = MFMA16(as_frag(f.ai[s]), vf[s], oa);
#pragma unroll
  for (int r = 0; r < 4; ++r) O[(size_t)(t0 + 16 * wave + 4 * g + r) * 768 + h * 128 + sl * 16 + n] = f2bf(oa[r]);
#pragma unroll
  for (int tt = 0; tt < 2; ++tt) {
#pragma unroll
    for (int r = 0; r < 4; ++r) sacc[tt][r] *= f.gl;
#pragma unroll
    for (int s = 0; s < 2; ++s) sacc[tt] = MFMA16(as_frag(f.kdt[tt][s]), vf[s], sacc[tt]);
    u2 o; o.x = pk2(sacc[tt][0], sacc[tt][1]); o.y = pk2(sacc[tt][2], sacc[tt][3]);
    *(u2*)(St + n * 136 + 32 * wave + 16 * tt + 4 * g) = o;
  }
  LDS_BARRIER();
}
DEVI void gdn_scan_stream(const KP& p, int j, int ci0, int nch, int h, int sl, const float* s0, float* sout, bf16_t* O, unsigned char* smem) {
  const int tid = get_tid(), lane = tid & 63, wave = tid >> 6, n = lane & 15, g = lane >> 4;
  bf16_t* St = (bf16_t*)smem;
  bf16_t* Vnt = St + 16 * 136;
  f32x4 sacc[2];
#pragma unroll
  for (int tt = 0; tt < 2; ++tt)
#pragma unroll
    for (int r = 0; r < 4; ++r) sacc[tt][r] = s0 ? s0[(size_t)(32 * wave + 16 * tt + 4 * g + r) * 128 + sl * 16 + n] : 0.f;
  __syncthreads();
#pragma unroll
  for (int tt = 0; tt < 2; ++tt) { u2 o; o.x = pk2(sacc[tt][0], sacc[tt][1]); o.y = pk2(sacc[tt][2], sacc[tt][3]); *(u2*)(St + n * 136 + 32 * wave + 16 * tt + 4 * g) = o; }
  ScanFrags f0, f1;
#define CL(c) ((ci0 + (((c) < nch) ? (c) : nch - 1)) * 6 + h)
#define T0(c) (((ci0 + (c)) >= 256) ? TP + (ci0 + (c) - 256) * 64 : (ci0 + (c)) * 64)
  VMWAIT(0);
  scan_load(p, CL(0), wave, lane, sl, f0);
  LDS_BARRIER();
  for (int c = 0; c < nch; c += 2) {
    scan_load(p, CL(c + 1), wave, lane, sl, f1); scan_wait19(f0);
    scan_step(f0, sacc, St, Vnt, O, T0(c), h, sl, wave, n, g);
    if (c + 1 < nch) {
      scan_load(p, CL(c + 2), wave, lane, sl, f0); scan_wait19(f1);
      scan_step(f1, sacc, St, Vnt, O, T0(c + 1), h, sl, wave, n, g);
    }
  }
  VMWAIT(0);
  scan_keep(f0); scan_keep(f1);
#undef CL
#undef T0
#pragma unroll
  for (int tt = 0; tt < 2; ++tt)
#pragma unroll
    for (int r = 0; r < 4; ++r) sout[(size_t)(32 * wave + 16 * tt + 4 * g + r) * 128 + sl * 16 + n] = sacc[tt][r];
}

DEVI int next_item(unsigned* ctr) {
  __shared__ int s_item;
  __syncthreads();
  if (get_tid() == 0) s_item = (int)atomicAdd(ctr, 1u);
  __syncthreads();
  return s_item;
}

DEVI unsigned xcc_id() { return (unsigned)__builtin_amdgcn_s_getreg((3 << 11) | 20) & 0xFu; }
DEVI unsigned ld_relaxed(unsigned* p) { return __hip_atomic_load(p, __ATOMIC_RELAXED, __HIP_MEMORY_SCOPE_AGENT); }
DEVI void gbar_setup(unsigned* ctr, unsigned nb, unsigned* sb) {
  if (get_tid() == 0) {
    const unsigned x = xcc_id();
    __hip_atomic_fetch_add(ctr + 544 + 8 * x, 1u, __ATOMIC_RELAXED, __HIP_MEMORY_SCOPE_AGENT);
    unsigned nx, mine;
    for (;;) {
      unsigned sum = 0; nx = 0; mine = 0;
      for (unsigned j = 0; j < 16; ++j) { const unsigned c = ld_relaxed(ctr + 544 + 8 * j); sum += c; nx += c ? 1u : 0u; mine = (j == x) ? c : mine; }
      if (sum == nb) break;
      __builtin_amdgcn_s_sleep(2);
    }
    sb[0] = x; sb[1] = mine; sb[2] = nx;
  }
  __syncthreads();
}
DEVI void gbar(unsigned* ctr, unsigned* sb, unsigned& gen) {
  asm volatile("s_waitcnt vmcnt(0)" ::: "memory");
  __syncthreads();
  gen++;
  if (get_tid() == 0) {
    const unsigned x = sb[0], nloc = sb[1], nx = sb[2];
    const unsigned old = __hip_atomic_fetch_add(ctr + 704 + 8 * x, 1u, __ATOMIC_RELAXED, __HIP_MEMORY_SCOPE_AGENT);
    if (old + 1u == gen * nloc) {
      __builtin_amdgcn_fence(__ATOMIC_RELEASE, "agent");
      asm volatile("s_waitcnt vmcnt(0)" ::: "memory");
      __hip_atomic_fetch_add(ctr + 528, 1u, __ATOMIC_RELAXED, __HIP_MEMORY_SCOPE_AGENT);
    }
    while (ld_relaxed(ctr + 528) < gen * nx) __builtin_amdgcn_s_sleep(2);
    __builtin_amdgcn_fence(__ATOMIC_ACQUIRE, "agent");
    asm volatile("s_waitcnt vmcnt(0)" ::: "memory");
  }
  __syncthreads();
}
#ifndef ONLY
#define ENAB(k) true
#else
#define ENAB(k) ((ONLY) == (k))
#endif
__global__ void __launch_bounds__(256, 2) mk_fwd(KP p) {
  __shared__ __attribute__((aligned(16))) unsigned char smem[73728];
  cg::grid_group grid = cg::this_grid();
  const int bid = blockIdx.x, nb = gridDim.x;
  const int ngw = nb * 4;
  unsigned char* ws = p.ws;
  unsigned* ctr = (unsigned*)(ws + WS_CTR);
  float* Y = p.out + O_YP;
  bf16_t* XN = (bf16_t*)(ws + WS_XN);
  bf16_t* MIX = (bf16_t*)(ws + WS_MIX);
  bf16_t* Pb = (bf16_t*)(ws + WS_P);
  bf16_t* Hb = (bf16_t*)(ws + WS_H);
  bool did = false;
  unsigned bgen = 0;
  __shared__ unsigned s_bar[4];
  gbar_setup(ctr, nb, s_bar);
  grid.sync();
  for (int ph = p.ph_lo; ph < p.ph_hi; ++ph) {
    const int layer = ph == 0 ? 0 : (ph - 1) / 9, sub = ph == 0 ? -1 : (ph - 1) % 9;
    const int kind = layer & 1, j = layer >> 1;
    if (sub == 8 && layer == 3) continue;
    if (did) gbar(ctr, s_bar, bgen);
    did = true;
    const int tid = get_tid(), lane = tid & 63, wave = tid >> 6, gw = bid * 4 + wave;
    (void)tid;
    const int np = kind ? NP_SB : NP_GDN, mqoff = kind ? MQ_SB : MQ_GDN, mixp = kind ? 768 : 1024, mixoff = kind ? 512 : 768;
    if (ph == 0 && ENAB(0)) {
      int base = 0;
      convert_group(base, bid, nb, p.in[12], (bf16_t*)(ws + WS_WIG), 2, 1024, 3340, 3456, 3084, 116, smem);
      convert_group(base, bid, nb, p.in[13], (bf16_t*)(ws + WS_WIS), 2, 1024, 1792, 1792, 1 << 30, 0, smem);
      convert_group(base, bid, nb, p.in[14], (bf16_t*)(ws + WS_WKV), 4, 1024, 512, 512, 1 << 30, 0, smem);
      convert_group(base, bid, nb, p.in[23], (bf16_t*)(ws + WS_WOG), 2, 1024, 1024, 1024, 1 << 30, 0, smem);
      convert_group(base, bid, nb, p.in[24], (bf16_t*)(ws + WS_WOS), 2, 768, 1024, 1024, 1 << 30, 0, smem);
      convert_group(base, bid, nb, p.in[25], (bf16_t*)(ws + WS_WUP), 4, 1024, 4096, 4096, 1 << 30, 0, smem);
      convert_group(base, bid, nb, p.in[26], (bf16_t*)(ws + WS_WDN), 4, 4096, 1024, 1024, 1 << 30, 0, smem);
      for (int r = gw; r < TA; r += ngw) norm_row(r < TP ? p.in[0] + (size_t)r * DM : p.in[1] + (size_t)(r - TP) * DM, p.in[9], XN + (size_t)r * DM, lane);
      for (int i = bid * 256 + tid; i < TS * DM / 4; i += nb * 256) ((float4*)(Y + (size_t)TP * DM))[i] = ((const float4*)p.in[1])[i];
      for (int r = gw; r < 1024; r += ngw) norm_row(p.in[8] + (size_t)(r & 255) * DM, p.in[10] + (r >> 8) * DM, (bf16_t*)(ws + WS_MEMN) + (size_t)r * DM, lane);
    } else if (sub == 0 && ENAB(1)) {
      EpiArgs ea{}; ea.cb = Pb; ea.ldc = np;
      const bf16_t* wt = kind ? (const bf16_t*)(ws + WS_WIS) + (size_t)j * 1792 * 1024 : (const bf16_t*)(ws + WS_WIG) + (size_t)j * 3456 * 1024;
      gemm_phase<0>(XN, DM, wt, 1024, TA, np, ea, smem);
      if (layer == 0) {
        for (int t = bid; t < 32; t += nb) {
          const int l = t >> 3, r = t & 7;
          EpiArgs e2{}; e2.cf = (float*)(ws + WS_MEMKV) + (size_t)l * 256 * 512; e2.ldc = 512;
          gemm_tile<3>((const bf16_t*)(ws + WS_MEMN) + (size_t)l * 256 * DM, DM, (const bf16_t*)(ws + WS_WKV) + (size_t)l * 512 * DM, DM, 1024, (r >> 2) << 7, (r & 3) << 7, e2, smem);
        }
      }
    } else if (sub == 1 && ENAB(2)) {
      if (layer == 0) {
        const float* kv = (const float*)(ws + WS_MEMKV);
        for (int it = gw; it < 4096; it += ngw) {
          const int l = it >> 10, m = (it >> 2) & 255, hh = it & 3;
          const float kx = kv[((size_t)l * 256 + m) * 512 + hh * 64 + lane], vx = kv[((size_t)l * 256 + m) * 512 + 256 + hh * 64 + lane];
          const float ss = wave_sum(kx * kx);
          p.out[O_PMK + ((size_t)l * 256 + m) * 256 + hh * 64 + lane] = kx * rsqrtf(ss * (1.f / 64.f) + EPS) * p.in[16][l * 64 + lane];
          p.out[O_PMV + ((size_t)l * 256 + m) * 256 + hh * 64 + lane] = vx;
        }
      }
      if (kind == 0) {
        for (int it = bid; it < NITEM; it += nb) gdn_prep_item(p, j, it / 6, it % 6, Pb, smem);
      } else {
        bf16_t* Kb = (bf16_t*)(ws + WS_G);
        const float* kg = p.in[22] + j * 128;
        for (int t = gw; t < TA; t += ngw) {
          const bf16_t* pr = Pb + (size_t)t * np;
          const u4 ku = *(const u4*)(pr + 512 + lane * 8), vu = *(const u4*)(pr + 1024 + lane * 8);
          float kf[8] = {lo2f(ku.x), hi2f(ku.x), lo2f(ku.y), hi2f(ku.y), lo2f(ku.z), hi2f(ku.z), lo2f(ku.w), hi2f(ku.w)};
          float ss = 0.f;
#pragma unroll
          for (int e = 0; e < 8; ++e) ss += kf[e] * kf[e];
          ss += __shfl_xor(ss, 1); ss += __shfl_xor(ss, 2); ss += __shfl_xor(ss, 4); ss += __shfl_xor(ss, 8);
          const float sc = rsqrtf(ss * (1.f / 128.f) + EPS);
          const int c0 = (lane & 15) * 8;
#pragma unroll
          for (int e = 0; e < 8; ++e) kf[e] *= sc * kg[c0 + e];
          float* ok = t < TP ? p.out + O_PSK + ((size_t)j * TP + t) * 512 : p.out + O_SSK + ((size_t)j * TS + (t - TP)) * 512;
          float* ov = t < TP ? p.out + O_PSV + ((size_t)j * TP + t) * 512 : p.out + O_SSV + ((size_t)j * TS + (t - TP)) * 512;
          *(float4*)(ok + lane * 8) = make_float4(kf[0], kf[1], kf[2], kf[3]); *(float4*)(ok + lane * 8 + 4) = make_float4(kf[4], kf[5], kf[6], kf[7]);
          *(float4*)(ov + lane * 8) = make_float4(lo2f(vu.x), hi2f(vu.x), lo2f(vu.y), hi2f(vu.y)); *(float4*)(ov + lane * 8 + 4) = make_float4(lo2f(vu.z), hi2f(vu.z), lo2f(vu.w), hi2f(vu.w));
          *(u4*)(Kb + (size_t)t * 512 + lane * 8) = mk4(pk2(kf[0], kf[1]), pk2(kf[2], kf[3]), pk2(kf[4], kf[5]), pk2(kf[6], kf[7]));
        }
      }
    } else if (sub == 2 && ENAB(3)) {
      unsigned* c = ctr + layer * 4;
      if (kind == 0) {
        bf16_t* O = XN;
        if (bid < 64 && (bid & 7) < 6) {
          const int h = bid & 7, sl = bid >> 3;
          gdn_scan_stream(p, j, 0, 256, h, sl, nullptr, p.out + O_PGS + ((size_t)j * 6 + h) * 16384, O, smem);
        }
        for (;;) {
          const int it = next_item(c);
          if (it >= 384 + 544) break;
          if (it < 384) { const int b = it / 48, r = it % 48, h = r >> 3, sl = r & 7;
            gdn_scan_stream(p, j, 256 + b, 1, h, sl, p.in[3] + (((size_t)j * 8 + b) * 6 + h) * 16384, p.out + O_SGS + (((size_t)j * 8 + b) * 6 + h) * 16384, O, smem);
          } else mem_attn_item(p, layer, it - 384, Pb, np, mqoff, MIX, mixp, mixoff, smem);
        }
      } else {
        const bf16_t* Kb = (const bf16_t*)(ws + WS_G);
        bf16_t* OFAR = (bf16_t*)(ws + WS_G + (32ull << 20));
        float* CARRY = (float*)(ws + WS_G + (64ull << 20));
        const float qs = 0.08838834764831845f * LOG2E;
        for (;;) {
          const int it = next_item(c);
          if (it >= 768 + 32 + 544) break;
          if (it < 768) {
            int qb, idx, whole;
            if (it < 640) { const int pr = it / 20, r = it % 20; if (r < 8) { qb = 127 - 2 * pr; idx = r; whole = 0; } else if (r < 12) { qb = 63 - pr; idx = r - 8; whole = 1; } else { qb = 126 - 2 * pr; idx = r - 12; whole = 0; } }
            else { qb = 31 - ((it - 640) >> 2); idx = (it - 640) & 3; whole = 1; }
            const int h = whole ? idx : (idx >> 1), far = whole ? 0 : (idx & 1), near_ = (!whole && !far);
            const int nAi = whole ? 2 * qb + 2 : qb + 1, koff = near_ ? (qb + 1) * 64 : 0;
            KVSrc s; s.k = Kb + (size_t)koff * 512 + h * 128; s.v = Pb + (size_t)koff * np + 1024 + h * 128; s.kpitch = 512; s.vpitch = np; s.f32 = 0;
            bf16_t* op = far ? OFAR + (size_t)(qb * 128) * 512 + h * 128 : MIX + (size_t)(qb * 128) * mixp + h * 128;
            float* co = near_ ? CARRY + (size_t)(qb * 128) * 4 + h : nullptr;
            attn_item<128, 0>(Pb + (size_t)(qb * 128) * np + h * 128, np, 128, p.in[21] + j * 128, qs, s, nAi, qb * 128 - koff, far ? 0 : 1, s, 0, op, far ? 512 : mixp, smem, co);
          } else if (it < 800) {
            const int b = (it - 768) >> 2, h = it & 3, t0 = TP + b * 64;
            KVSrc sa; sa.k = Kb + (size_t)t0 * 512 + h * 128; sa.v = Pb + (size_t)t0 * np + 1024 + h * 128; sa.kpitch = 512; sa.vpitch = np; sa.f32 = 0;
            KVSrc sb; sb.k = p.in[4] + ((size_t)j * 8 + b) * 2048 * 512 + h * 128; sb.v = p.in[5] + ((size_t)j * 8 + b) * 2048 * 512 + h * 128; sb.kpitch = 512; sb.vpitch = 512; sb.f32 = 1;
            attn_item<128, 0>(Pb + (size_t)t0 * np + h * 128, np, 64, p.in[21] + j * 128, qs, sa, 1, 0, 1, sb, 32,
                              MIX + (size_t)t0 * mixp + h * 128, mixp, smem);
          } else mem_attn_item(p, layer, it - 800, Pb, np, mqoff, MIX, mixp, mixoff, smem);
        }
      }
    } else if (sub == 3 && kind == 1) {
      const bf16_t* OFAR = (const bf16_t*)(ws + WS_G + (32ull << 20));
      const float* CARRY = (const float*)(ws + WS_G + (64ull << 20));
      for (int t = TP / 2 + gw; t < TP; t += ngw) {
        const u4 a = *(const u4*)(MIX + (size_t)t * mixp + lane * 8), b = *(const u4*)(OFAR + (size_t)t * 512 + lane * 8);
        const float sc = ex2(-CARRY[(size_t)t * 4 + (lane >> 4)]);
        u4 o;
        o.x = pk2(lo2f(a.x) + sc * lo2f(b.x), hi2f(a.x) + sc * hi2f(b.x)); o.y = pk2(lo2f(a.y) + sc * lo2f(b.y), hi2f(a.y) + sc * hi2f(b.y));
        o.z = pk2(lo2f(a.z) + sc * lo2f(b.z), hi2f(a.z) + sc * hi2f(b.z)); o.w = pk2(lo2f(a.w) + sc * lo2f(b.w), hi2f(a.w) + sc * hi2f(b.w));
        *(u4*)(MIX + (size_t)t * mixp + lane * 8) = o;
      }
    } else if (sub == 3 && ENAB(4)) {
      const bf16_t* O = XN;
      const float* og = p.in[20] + j * 128;
      for (int it = gw; it < TA * 6; it += ngw) {
        const int t = it / 6, h = it % 6;
        const unsigned ou = *(const unsigned*)(O + (size_t)t * 768 + h * 128 + lane * 2);
        const unsigned zu = *(const unsigned*)(Pb + (size_t)t * np + 2304 + h * 128 + lane * 2);
        const float o0 = lo2f(ou), o1 = hi2f(ou), z0 = lo2f(zu), z1 = hi2f(zu);
        const float ss = wave_sum(o0 * o0 + o1 * o1);
        const float sc = rsqrtf(ss * (1.f / 128.f) + EPS);
        *(unsigned*)(MIX + (size_t)t * 1024 + h * 128 + lane * 2) = pk2(o0 * sc * og[lane * 2] * silu(z0), o1 * sc * og[lane * 2 + 1] * silu(z1));
      }
    } else if (sub == 4 && ENAB(5)) {
      EpiArgs ea{}; ea.yout = Y;
      if (layer == 0) { ea.res0 = p.in[0]; ea.res1 = p.in[1]; } else { ea.res0 = Y; ea.res1 = nullptr; }
      const bf16_t* wt = kind ? (const bf16_t*)(ws + WS_WOS) + (size_t)j * 1024 * 768 : (const bf16_t*)(ws + WS_WOG) + (size_t)j * 1024 * 1024;
      gemm_phase_res(MIX, mixp, wt, mixp, ea, smem);
    } else if (sub == 5) {
      norm_all(Y, p.in[11] + layer * DM, XN, gw, ngw, lane);
    } else if (sub == 6 && ENAB(6)) {
      EpiArgs ea{}; ea.cb = Hb; ea.ldc = DFF;
      gemm_phase<2>(XN, DM, (const bf16_t*)(ws + WS_WUP) + (size_t)layer * 4096 * 1024, 1024, TA, 4096, ea, smem);
    } else if (sub == 7 && ENAB(7)) {
      EpiArgs ea{}; ea.yout = Y; ea.res0 = Y; ea.res1 = nullptr;
      gemm_phase_res(Hb, DFF, (const bf16_t*)(ws + WS_WDN) + (size_t)layer * 1024 * 4096, 4096, ea, smem);
    } else if (sub == 8) {
      norm_all(Y, p.in[9] + (layer + 1) * DM, XN, gw, ngw, lane);
    }
  }
}

extern "C" void kernel_launch(void* const* d_in, const int* in_sizes, int n_in, void* d_out, int out_size, void* d_ws, size_t ws_size, hipStream_t stream) {
  static int grid_blocks = 0;
  if (!grid_blocks) {
    int dev = 0, cus = 0, per_cu = 0;
    (void)hipGetDevice(&dev);
    (void)hipDeviceGetAttribute(&cus, hipDeviceAttributeMultiprocessorCount, dev);
    (void)hipOccupancyMaxActiveBlocksPerMultiprocessor(&per_cu, mk_fwd, 256, 0);
    if (per_cu > 2) per_cu = 2;
    if (per_cu < 1) per_cu = 1;
    grid_blocks = cus * per_cu;
    if (ws_size < WS_END) fprintf(stderr, "kernel_launch: workspace too small: %zu < %zu\n", ws_size, (size_t)WS_END);
  }
  (void)hipMemsetAsync((char*)d_ws + WS_CTR, 0, 4096, stream);
  KP p{};
  for (int i = 0; i < 27; ++i) p.in[i] = (const float*)d_in[i];
  p.out = (float*)d_out; p.ws = (unsigned char*)d_ws; p.ph_lo = 0; p.ph_hi = 37;
  void* args[] = {&p};
  hipError_t e = hipLaunchCooperativeKernel((void*)mk_fwd, dim3(grid_blocks), dim3(256), args, 0, stream);
  if (e != hipSuccess) fprintf(stderr, "cooperative launch failed: %s (grid %d)\n", hipGetErrorString(e), grid_blocks);
}
```

```cpp
#include <hip/hip_runtime.h>
#include <hip/hip_cooperative_groups.h>
#include <cstdio>
#include <cstdint>
namespace cg = cooperative_groups;

typedef unsigned short bf16_t;
typedef short bf16x8 __attribute__((ext_vector_type(8)));
typedef float f32x16 __attribute__((ext_vector_type(16)));
typedef float f32x4 __attribute__((ext_vector_type(4)));
typedef unsigned u4 __attribute__((ext_vector_type(4)));
typedef unsigned u2 __attribute__((ext_vector_type(2)));
#define DEVI __device__ __forceinline__
__device__ __forceinline__ u4 mk4(unsigned a, unsigned b, unsigned c, unsigned d) { u4 r; r.x = a; r.y = b; r.z = c; r.w = d; return r; }
__device__ __forceinline__ u2 mk2(unsigned a, unsigned b) { u2 r; r.x = a; r.y = b; return r; }
#define MFMA32(a, b, c) __builtin_amdgcn_mfma_f32_32x32x16_bf16((a), (b), (c), 0, 0, 0)
#define LDS_BARRIER() do { asm volatile("s_waitcnt lgkmcnt(0)" ::: "memory"); __builtin_amdgcn_s_barrier(); } while (0)
#define GLOAD16(dst, ptr) asm volatile("global_load_dwordx4 %0, %1, off" : "=&v"(dst) : "v"(ptr) : "memory")
#define VMWAIT(n) asm volatile("s_waitcnt vmcnt(" #n ")" ::: "memory")
#define MFMA16(a, b, c) __builtin_amdgcn_mfma_f32_16x16x32_bf16((a), (b), (c), 0, 0, 0)

constexpr int DM = 1024, TP = 16384, TS = 512, TA = TP + TS, DFF = 4096;
constexpr int NP_GDN = 3456, NP_SB = 1792, MQ_GDN = 3200, MQ_SB = 1536;
constexpr int NCHUNK = 264, NITEM = NCHUNK * 6;
constexpr float EPS = 1e-6f;
constexpr float LOG2E = 1.4426950408889634f;
constexpr size_t O_YP = 0, O_PGC = 17301504, O_PGS = 17315328, O_PSK = 17511936, O_PSV = 34289152, O_PMK = 51066368, O_PMV = 51328512,
                 O_SGC = 51590656, O_SGS = 51701248, O_SSK = 53274112, O_SSV = 53798400;
constexpr size_t WS_CTR = 0;
constexpr size_t WS_WIG = 4096;
constexpr size_t WS_WIS = WS_WIG + 2ull * 3456 * 1024 * 2;
constexpr size_t WS_WKV = WS_WIS + 2ull * 1792 * 1024 * 2;
constexpr size_t WS_WOG = WS_WKV + 4ull * 512 * 1024 * 2;
constexpr size_t WS_WOS = WS_WOG + 2ull * 1024 * 1024 * 2;
constexpr size_t WS_WUP = WS_WOS + 2ull * 1024 * 768 * 2;
constexpr size_t WS_WDN = WS_WUP + 4ull * 4096 * 1024 * 2;
constexpr size_t WS_XN = WS_WDN + 4ull * 4096 * 1024 * 2;
constexpr size_t WS_MIX = WS_XN + (size_t)TA * 1024 * 2;
constexpr size_t WS_MEMN = WS_MIX + (size_t)TA * 1024 * 2;
constexpr size_t WS_MEMKV = WS_MEMN + 4ull * 256 * 1024 * 2;
constexpr size_t WS_BIG = WS_MEMKV + 4ull * 256 * 512 * 4;
constexpr size_t WS_P = WS_BIG;
constexpr size_t WS_G = WS_P + (size_t)TA * 3456 * 2;
constexpr size_t G_ITEM = 73728;
constexpr size_t WS_GL = WS_G + (size_t)NITEM * G_ITEM;
constexpr size_t WS_H = WS_BIG;
constexpr size_t WS_END = WS_GL + 8192;

struct KP { const float* in[27]; float* out; unsigned char* ws; int ph_lo, ph_hi; };

DEVI int get_tid() { int t = __builtin_amdgcn_workitem_id_x(); asm volatile("" : "+v"(t)); return t; }
DEVI float bf2f(bf16_t b) { return __uint_as_float(((unsigned)b) << 16); }
typedef float f32x2_t __attribute__((ext_vector_type(2)));
typedef __bf16 bf16x2_t __attribute__((ext_vector_type(2)));
DEVI unsigned pk2(float lo, float hi) { f32x2_t v = {lo, hi}; return __builtin_bit_cast(unsigned, __builtin_convertvector(v, bf16x2_t)); }
DEVI bf16_t f2bf(float f) { return (bf16_t)(pk2(f, 0.f) & 0xffffu); }
DEVI float lo2f(unsigned u) { return __uint_as_float(u << 16); }
DEVI float hi2f(unsigned u) { return __uint_as_float(u & 0xffff0000u); }
DEVI float ex2(float x) { return __builtin_amdgcn_exp2f(x); }
DEVI float lg2(float x) { return __builtin_amdgcn_logf(x); }
DEVI float wave_sum(float v) {
#pragma unroll
  for (int o = 32; o >= 1; o >>= 1) v += __shfl_xor(v, o);
  return v;
}
DEVI bf16x8 as_frag(u4 u) { return __builtin_bit_cast(bf16x8, u); }
DEVI float silu(float y) { return y / (1.f + __expf(-y)); }

struct EpiArgs { bf16_t* cb; float* cf; int ldc; const float* res0; const float* res1; float* yout; };
template <int EPI>
DEVI void gemm_tile(const bf16_t* __restrict__ A, int lda, const bf16_t* __restrict__ Bt, int ldb, int K, int m0, int n0, const EpiArgs& ea, unsigned char* smem) {
  const int tid = get_tid(), lane = tid & 63, wave = tid >> 6;
  const int wm = wave >> 1, wn = wave & 1, l31 = lane & 31, lh = lane >> 5;
  bf16_t* sA = (bf16_t*)smem;
  bf16_t* sB = sA + 2 * 128 * 72;
  f32x16 acc[2][2];
#pragma unroll
  for (int i = 0; i < 2; ++i)
#pragma unroll
    for (int j = 0; j < 2; ++j)
#pragma unroll
      for (int r = 0; r < 16; ++r) acc[i][j][r] = 0.f;
  const int lr = tid >> 3, lc = (tid & 7) * 8;
  const bf16_t* gA = A + (size_t)(m0 + lr) * lda + lc;
  const bf16_t* gB = Bt + (size_t)(n0 + lr) * ldb + lc;
  u4 ra0[4], rb0[4], ra1[4], rb1[4];
#define G_ISSUE(RA, RB, K0) { _Pragma("unroll") for (int i = 0; i < 4; ++i) { GLOAD16(RA[i], gA + (size_t)i * 32 * lda + (K0)); GLOAD16(RB[i], gB + (size_t)i * 32 * ldb + (K0)); } }
#define G_STASH(RA, RB, BUF) { _Pragma("unroll") for (int i = 0; i < 4; ++i) { *(u4*)(sA + (BUF) * 128 * 72 + (lr + i * 32) * 72 + lc) = RA[i]; *(u4*)(sB + (BUF) * 128 * 72 + (lr + i * 32) * 72 + lc) = RB[i]; } }
#define G_COMPUTE(BUF) { __builtin_amdgcn_s_setprio(1); const bf16_t* cA = sA + (BUF) * 128 * 72 + (wm * 64 + l31) * 72 + lh * 8; const bf16_t* cB = sB + (BUF) * 128 * 72 + (wn * 64 + l31) * 72 + lh * 8; \
    _Pragma("unroll") for (int ks = 0; ks < 4; ++ks) { \
      bf16x8 a0 = *(const bf16x8*)(cA + ks * 16), a1 = *(const bf16x8*)(cA + 32 * 72 + ks * 16); \
      bf16x8 b0 = *(const bf16x8*)(cB + ks * 16), b1 = *(const bf16x8*)(cB + 32 * 72 + ks * 16); \
      acc[0][0] = MFMA32(a0, b0, acc[0][0]); acc[0][1] = MFMA32(a0, b1, acc[0][1]); \
      acc[1][0] = MFMA32(a1, b0, acc[1][0]); acc[1][1] = MFMA32(a1, b1, acc[1][1]); } __builtin_amdgcn_s_setprio(0); }
  const int nk = K >> 6;
  VMWAIT(0);
  G_ISSUE(ra0, rb0, 0);
  G_ISSUE(ra1, rb1, 64);
  __syncthreads();
  VMWAIT(8);
  G_STASH(ra0, rb0, 0);
  LDS_BARRIER();
  for (int kt = 0; kt < nk; kt += 2) {
    G_ISSUE(ra0, rb0, ((kt + 2 < nk) ? kt + 2 : nk - 1) << 6);
    G_COMPUTE(0);
    VMWAIT(8);
    G_STASH(ra1, rb1, 1);
    LDS_BARRIER();
    G_ISSUE(ra1, rb1, ((kt + 3 < nk) ? kt + 3 : nk - 1) << 6);
    G_COMPUTE(1);
    VMWAIT(8);
    if (kt + 2 < nk) G_STASH(ra0, rb0, 0);
    LDS_BARRIER();
  }
  VMWAIT(0);
#pragma unroll
  for (int i = 0; i < 4; ++i) asm volatile("" :: "v"(ra0[i]), "v"(rb0[i]), "v"(ra1[i]), "v"(rb1[i]));
#undef G_ISSUE
#undef G_STASH
#undef G_COMPUTE
#pragma unroll
  for (int i = 0; i < 2; ++i)
#pragma unroll
    for (int r = 0; r < 16; ++r) {
      const int row = m0 + wm * 64 + i * 32 + (r >> 2) * 8 + lh * 4 + (r & 3);
#pragma unroll
      for (int j = 0; j < 2; ++j) {
        const int col = n0 + wn * 64 + j * 32 + l31;
        const float v = acc[i][j][r];
        if (EPI == 0) ea.cb[(size_t)row * ea.ldc + col] = f2bf(v);
        else if (EPI == 1) {
          const float* rp = ea.res1 ? (row < TP ? ea.res0 + (size_t)row * DM : ea.res1 + (size_t)(row - TP) * DM) : ea.res0 + (size_t)row * DM;
          ea.yout[(size_t)row * DM + col] = rp[col] + v;
        } else if (EPI == 4) { unsafeAtomicAdd(ea.yout + (size_t)row * DM + col, v); }
        else if (EPI == 2) { const float rl = v > 0.f ? v : 0.f; ea.cb[(size_t)row * ea.ldc + col] = f2bf(rl * rl); }
        else ea.cf[(size_t)row * ea.ldc + col] = v;
      }
    }
}
template <int EPI>
DEVI void gemm_phase(const bf16_t* A, int lda, const bf16_t* Bt, int K, int M, int N, const EpiArgs& ea, unsigned char* smem) {
  const int nM = M >> 7, nN = N >> 7, nwg = nM * nN;
  const int q = nwg >> 3, r = nwg & 7;
  for (int L = blockIdx.x; L < nwg; L += gridDim.x) {
    const int xcd = L & 7, off = L >> 3;
    const int wg = (xcd < r ? xcd * (q + 1) : r * (q + 1) + (xcd - r) * q) + off;
    const int nig = 8 * nN, gid = wg / nig, fm = gid * 8, gsz = (nM - fm) < 8 ? (nM - fm) : 8;
    const int pm = fm + ((wg % nig) % gsz), pn = (wg % nig) / gsz;
    gemm_tile<EPI>(A, lda, Bt, K, K, pm << 7, pn << 7, ea, smem);
  }
}

DEVI void gemm_phase_res(const bf16_t* A, int lda, const bf16_t* Bt, int K, const EpiArgs& ea, unsigned char* smem) {
  gemm_phase<1>(A, lda, Bt, K, TP, 1024, ea, smem);
  const int S = (K == 4096) ? 16 : (K >> 7), klen = K / S;
  for (int it = blockIdx.x; it < 32 * S; it += gridDim.x) {
    const int tile = it / S, ks = it % S;
    gemm_tile<4>(A + (size_t)ks * klen, lda, Bt + (size_t)ks * klen, K, klen, TP + ((tile >> 3) << 7), (tile & 7) << 7, ea, smem);
  }
}

DEVI void convert_tile(const float* __restrict__ W, bf16_t* __restrict__ Wt, int K, int N, int k0, int n0, int thr, int shift, unsigned char* smem) {
  float* tile = (float*)smem;
  const int tid = get_tid();
  __syncthreads();
#pragma unroll
  for (int i = 0; i < 4; ++i) {
    const int r = (tid >> 4) + 16 * i, c = (tid & 15) * 4;
    float4 v = make_float4(0.f, 0.f, 0.f, 0.f);
    if (n0 + c < N) v = *(const float4*)(W + (size_t)(k0 + r) * N + n0 + c);
    tile[r * 65 + c] = v.x; tile[r * 65 + c + 1] = v.y; tile[r * 65 + c + 2] = v.z; tile[r * 65 + c + 3] = v.w;
  }
  __syncthreads();
  const int n = tid >> 2, kc = (tid & 3) * 16;
  if (n0 + n < N) {
    const int nn = n0 + n, nd = nn + (nn >= thr ? shift : 0);
    unsigned o[8];
#pragma unroll
    for (int e = 0; e < 8; ++e) o[e] = pk2(tile[(kc + 2 * e) * 65 + n], tile[(kc + 2 * e + 1) * 65 + n]);
    u4* dst = (u4*)(Wt + (size_t)nd * K + k0 + kc);
    dst[0] = mk4(o[0], o[1], o[2], o[3]); dst[1] = mk4(o[4], o[5], o[6], o[7]);
  }
}
DEVI void convert_group(int& base, int bid, int nb, const float* W, bf16_t* Wt, int nl, int K, int N, int NPAD, int thr, int shift, unsigned char* smem) {
  const int tk = K >> 6, tn = (N + 63) >> 6, per = tk * tn, tot = per * nl;
  int first = ((bid - base) % nb + nb) % nb;
  for (int t = first; t < tot; t += nb) {
    const int l = t / per, r = t % per;
    convert_tile(W + (size_t)l * K * N, Wt + (size_t)l * NPAD * K, K, N, (r / tn) << 6, (r % tn) << 6, thr, shift, smem);
  }
  base += tot;
}

DEVI void norm_row(const float* __restrict__ src, const float* __restrict__ gain, bf16_t* __restrict__ dst, int lane) {
  float4 v[4]; float ss = 0.f;
#pragma unroll
  for (int i = 0; i < 4; ++i) { v[i] = *(const float4*)(src + lane * 4 + 256 * i); ss += v[i].x * v[i].x + v[i].y * v[i].y + v[i].z * v[i].z + v[i].w * v[i].w; }
  ss = wave_sum(ss);
  const float sc = rsqrtf(ss * (1.f / 1024.f) + EPS);
#pragma unroll
  for (int i = 0; i < 4; ++i) {
    const float4 g = *(const float4*)(gain + lane * 4 + 256 * i);
    u2 o; o.x = pk2(v[i].x * sc * g.x, v[i].y * sc * g.y); o.y = pk2(v[i].z * sc * g.z, v[i].w * sc * g.w);
    *(u2*)(dst + lane * 4 + 256 * i) = o;
  }
}

DEVI void norm_row2(const float* __restrict__ s0, const float* __restrict__ s1, const float* __restrict__ gain, bf16_t* __restrict__ d0, bf16_t* __restrict__ d1, int lane) {
  float4 v[4], w[4]; float ss = 0.f, tt = 0.f;
#pragma unroll
  for (int i = 0; i < 4; ++i) { v[i] = *(const float4*)(s0 + lane * 4 + 256 * i); w[i] = *(const float4*)(s1 + lane * 4 + 256 * i); }
#pragma unroll
  for (int i = 0; i < 4; ++i) { ss += v[i].x * v[i].x + v[i].y * v[i].y + v[i].z * v[i].z + v[i].w * v[i].w; tt += w[i].x * w[i].x + w[i].y * w[i].y + w[i].z * w[i].z + w[i].w * w[i].w; }
#pragma unroll
  for (int o = 32; o >= 1; o >>= 1) { ss += __shfl_xor(ss, o); tt += __shfl_xor(tt, o); }
  const float sc = rsqrtf(ss * (1.f / 1024.f) + EPS), tc = rsqrtf(tt * (1.f / 1024.f) + EPS);
#pragma unroll
  for (int i = 0; i < 4; ++i) {
    const float4 g = *(const float4*)(gain + lane * 4 + 256 * i);
    u2 o; o.x = pk2(v[i].x * sc * g.x, v[i].y * sc * g.y); o.y = pk2(v[i].z * sc * g.z, v[i].w * sc * g.w);
    *(u2*)(d0 + lane * 4 + 256 * i) = o;
    u2 q; q.x = pk2(w[i].x * tc * g.x, w[i].y * tc * g.y); q.y = pk2(w[i].z * tc * g.z, w[i].w * tc * g.w);
    *(u2*)(d1 + lane * 4 + 256 * i) = q;
  }
}
DEVI void norm_all(const float* __restrict__ Y, const float* __restrict__ gain, bf16_t* __restrict__ XN, int gw, int ngw, int lane) {
  for (int r = gw; r < TA; r += ngw) norm_row(Y + (size_t)r * DM, gain, XN + (size_t)r * DM, lane);
}

struct KVSrc { const void* k; const void* v; int kpitch, vpitch, f32; };
template <int D>
DEVI void attn_load(const KVSrc& s, int r0, u4 (&kr)[D / 32], u4 (&vr)[D / 32]) {
  const int tid = get_tid();
#pragma unroll
  for (int i = 0; i < D / 32; ++i) {
    const int c = tid + 256 * i, key = c / (D / 8), dch = c % (D / 8);
    if (s.f32) {
      const float* kp = (const float*)s.k + (size_t)(r0 + key) * s.kpitch + dch * 8;
      const float* vp = (const float*)s.v + (size_t)(r0 + key) * s.vpitch + dch * 8;
      const float4 a = *(const float4*)kp, b = *(const float4*)(kp + 4), c2 = *(const float4*)vp, d2 = *(const float4*)(vp + 4);
      kr[i] = mk4(pk2(a.x, a.y), pk2(a.z, a.w), pk2(b.x, b.y), pk2(b.z, b.w));
      vr[i] = mk4(pk2(c2.x, c2.y), pk2(c2.z, c2.w), pk2(d2.x, d2.y), pk2(d2.z, d2.w));
      __builtin_amdgcn_sched_barrier(0);
    } else {
      kr[i] = *(const u4*)((const bf16_t*)s.k + (size_t)(r0 + key) * s.kpitch + dch * 8);
      vr[i] = *(const u4*)((const bf16_t*)s.v + (size_t)(r0 + key) * s.vpitch + dch * 8);
    }
  }
}
template <int D>
DEVI void attn_store(bf16_t* Ks, bf16_t* Vt, const u4 (&kr)[D / 32], const u4 (&vr)[D / 32]) {
  const int tid = get_tid();
#pragma unroll
  for (int i = 0; i < D / 32; ++i) {
    const int c = tid + 256 * i, key = c / (D / 8), dch = c % (D / 8);
    *(u4*)(Ks + key * (D + 8) + dch * 8) = kr[i];
    const int kx = key ^ ((dch & 15) << 2);
    const unsigned w[4] = {vr[i].x, vr[i].y, vr[i].z, vr[i].w};
#pragma unroll
    for (int e = 0; e < 8; ++e) Vt[(dch * 8 + e) * 72 + kx] = (bf16_t)((w[e >> 1] >> (16 * (e & 1))) & 0xffffu);
  }
}

template <int D, int MODE>
DEVI void attn_item(const bf16_t* __restrict__ qsrc, int qpitch, int nq, const float* __restrict__ qgain, float qscale,
                    const KVSrc& segA, int nA, int qposA0, int maskA, const KVSrc& segB, int nB,
                    bf16_t* __restrict__ out, int opitch, unsigned char* smem, float* __restrict__ carry_out = nullptr) {
  constexpr int KPT = D + 8, NKS = D / 16, NDB = D / 32, NCH = D / 32;
  constexpr int STAGE = 64 * KPT + D * 72;
  const int tid = get_tid(), lane = tid & 63, wave = tid >> 6, l31 = lane & 31, lh = lane >> 5;
  bf16_t* sbase = (bf16_t*)smem;
  const bool active = wave * 32 < nq;
  bf16x8 qf[NKS];
  {
    float qv[NKS][8]; float ss = 0.f;
    const bf16_t* qp = qsrc + (size_t)(wave * 32 + l31) * qpitch + lh * 8;
#pragma unroll
    for (int ks = 0; ks < NKS; ++ks) {
      u4 u = mk4(0, 0, 0, 0);
      if (active) u = *(const u4*)(qp + ks * 16);
      const unsigned w[4] = {u.x, u.y, u.z, u.w};
#pragma unroll
      for (int e = 0; e < 4; ++e) { qv[ks][2 * e] = lo2f(w[e]); qv[ks][2 * e + 1] = hi2f(w[e]); }
#pragma unroll
      for (int e = 0; e < 8; ++e) ss += qv[ks][e] * qv[ks][e];
    }
    ss += __shfl_xor(ss, 32);
    const float sc = rsqrtf(ss * (1.f / D) + EPS) * qscale;
#pragma unroll
    for (int ks = 0; ks < NKS; ++ks) {
      const float4 g0 = *(const float4*)(qgain + ks * 16 + lh * 8), g1 = *(const float4*)(qgain + ks * 16 + lh * 8 + 4);
      u4 u;
      u.x = pk2(qv[ks][0] * sc * g0.x, qv[ks][1] * sc * g0.y); u.y = pk2(qv[ks][2] * sc * g0.z, qv[ks][3] * sc * g0.w);
      u.z = pk2(qv[ks][4] * sc * g1.x, qv[ks][5] * sc * g1.y); u.w = pk2(qv[ks][6] * sc * g1.z, qv[ks][7] * sc * g1.w);
      qf[ks] = as_frag(u);
    }
  }
  f32x16 oacc[NDB];
#pragma unroll
  for (int db = 0; db < NDB; ++db)
#pragma unroll
    for (int r = 0; r < 16; ++r) oacc[db][r] = 0.f;
  float carry = 1.f, mx = -1e30f, lsum = 0.f;
  const int ntot = nA + nB;
  const int qpos = qposA0 + wave * 32 + l31;
  u4 kr[NCH], vr[NCH];
  {
    const bool inA = 0 < nA; const int tix = inA ? nA - 1 : nB - 1;
    attn_load<D>(inA ? segA : segB, tix * 64, kr, vr);
    __syncthreads();
    attn_store<D>(sbase, sbase + 64 * KPT, kr, vr);
    __syncthreads();
  }
  for (int it = 0; it < ntot; ++it) {
    const int cur = it & 1;
    if (it + 1 < ntot) {
      const bool nInA = (it + 1) < nA; const int tix = nInA ? nA - 2 - it : nB - 1 - (it + 1 - nA);
      attn_load<D>(nInA ? segA : segB, tix * 64, kr, vr);
    }
    const bool inA = it < nA;
    const int kbase = inA ? (nA - 1 - it) * 64 : 0;
    const bf16_t* Ks = sbase + cur * STAGE;
    const bf16_t* Vt = Ks + 64 * KPT;
    const bool mneed = inA && maskA && (kbase + 63 >= qposA0 + wave * 32);
    const bool skip = !active || (inA && maskA && (kbase > qposA0 + wave * 32 + 31));
    if (!skip) {
      bf16x8 pf[2][2];
      if (MODE == 0) {
        float after = carry;
#pragma unroll
        for (int rt = 1; rt >= 0; --rt) {
          f32x16 z;
#pragma unroll
          for (int r = 0; r < 16; ++r) z[r] = 0.f;
#pragma unroll
          for (int ks = 0; ks < NKS; ++ks) {
            const bf16x8 a = *(const bf16x8*)(Ks + (rt * 32 + l31) * KPT + ks * 16 + lh * 8);
            z = MFMA32(a, qf[ks], z);
          }
          float ee[16], rr[16];
#pragma unroll
          for (int i = 0; i < 16; ++i) {
            float e = ex2(z[i]);
            if (mneed) { const int key = kbase + rt * 32 + (i >> 2) * 8 + lh * 4 + (i & 3); if (key >= qpos) e = 0.f; }
            ee[i] = e; rr[i] = __builtin_amdgcn_rcpf(1.f + e);
          }
          float a_[16];
#pragma unroll
          for (int g = 3; g >= 0; --g) {
            const float s4 = (rr[g * 4] * rr[g * 4 + 1]) * (rr[g * 4 + 2] * rr[g * 4 + 3]);
            const float p4 = __shfl_xor(s4, 32);
            float c = lh == 0 ? after * p4 : after;
            after *= s4 * p4;
#pragma unroll
            for (int e = 3; e >= 0; --e) { c *= rr[g * 4 + e]; a_[g * 4 + e] = ee[g * 4 + e] * c; }
          }
#pragma unroll
          for (int s2 = 0; s2 < 2; ++s2)
            pf[rt][s2] = as_frag(mk4(pk2(a_[8 * s2 + 0], a_[8 * s2 + 1]), pk2(a_[8 * s2 + 2], a_[8 * s2 + 3]), pk2(a_[8 * s2 + 4], a_[8 * s2 + 5]), pk2(a_[8 * s2 + 6], a_[8 * s2 + 7])));
        }
        carry = after;
      } else {
        f32x16 z[2];
#pragma unroll
        for (int rt = 0; rt < 2; ++rt) {
          f32x16 zt;
#pragma unroll
          for (int r = 0; r < 16; ++r) zt[r] = 0.f;
#pragma unroll
          for (int ks = 0; ks < NKS; ++ks) {
            const bf16x8 a = *(const bf16x8*)(Ks + (rt * 32 + l31) * KPT + ks * 16 + lh * 8);
            zt = MFMA32(a, qf[ks], zt);
          }
          z[rt] = zt;
        }
        float tm = z[0][0];
#pragma unroll
        for (int rt = 0; rt < 2; ++rt)
#pragma unroll
          for (int i = 0; i < 16; ++i) tm = fmaxf(tm, z[rt][i]);
        tm = fmaxf(tm, __shfl_xor(tm, 32));
        const float nm = fmaxf(mx, tm);
        const float alpha = ex2(mx - nm);
        mx = nm;
        float ps = 0.f;
        float a_[2][16];
#pragma unroll
        for (int rt = 0; rt < 2; ++rt)
#pragma unroll
          for (int i = 0; i < 16; ++i) { a_[rt][i] = ex2(z[rt][i] - nm); ps += a_[rt][i]; }
        lsum = lsum * alpha + ps;
#pragma unroll
        for (int db = 0; db < NDB; ++db)
#pragma unroll
          for (int r = 0; r < 16; ++r) oacc[db][r] *= alpha;
#pragma unroll
        for (int rt = 0; rt < 2; ++rt)
#pragma unroll
          for (int s2 = 0; s2 < 2; ++s2)
            pf[rt][s2] = as_frag(mk4(pk2(a_[rt][8 * s2 + 0], a_[rt][8 * s2 + 1]), pk2(a_[rt][8 * s2 + 2], a_[rt][8 * s2 + 3]), pk2(a_[rt][8 * s2 + 4], a_[rt][8 * s2 + 5]), pk2(a_[rt][8 * s2 + 6], a_[rt][8 * s2 + 7])));
      }
#pragma unroll
      for (int db = 0; db < NDB; ++db) {
        const int d = db * 32 + l31, sw = ((d >> 3) & 15) << 2;
#pragma unroll
        for (int rt = 0; rt < 2; ++rt)
#pragma unroll
          for (int s = 0; s < 2; ++s) {
            const int kb0 = rt * 32 + 16 * s + 4 * lh;
            const u2 lo = *(const u2*)(Vt + d * 72 + (kb0 ^ sw));
            const u2 hi = *(const u2*)(Vt + d * 72 + ((kb0 + 8) ^ sw));
            oacc[db] = MFMA32(as_frag(mk4(lo.x, lo.y, hi.x, hi.y)), pf[rt][s], oacc[db]);
          }
      }
    }
    if (it + 1 < ntot) { bf16_t* nK = sbase + (cur ^ 1) * STAGE; attn_store<D>(nK, nK + 64 * KPT, kr, vr); }
    LDS_BARRIER();
  }
  if (active && carry_out && lh == 0) carry_out[(size_t)(wave * 32 + l31) * 4] = carry;
  if (active) {
    float inv = 1.f;
    if (MODE == 1) { const float l = lsum + __shfl_xor(lsum, 32); inv = 1.f / l; }
    bf16_t* op = out + (size_t)(wave * 32 + l31) * opitch + lh * 4;
#pragma unroll
    for (int db = 0; db < NDB; ++db)
#pragma unroll
      for (int g = 0; g < 4; ++g) {
        u2 o; o.x = pk2(oacc[db][g * 4] * inv, oacc[db][g * 4 + 1] * inv); o.y = pk2(oacc[db][g * 4 + 2] * inv, oacc[db][g * 4 + 3] * inv);
        *(u2*)(op + db * 32 + g * 8) = o;
      }
  }
}

DEVI void mem_attn_item(const KP& p, int layer, int item, const bf16_t* P, int np, int mqoff, bf16_t* mix, int mixp, int mixoff, unsigned char* smem) {
  const int h = item & 3;
  int t0, nq; const float *kk, *vv;
  if (item < 512) { t0 = (item >> 2) * 128; nq = 128; kk = p.out + O_PMK + (size_t)layer * 65536; vv = p.out + O_PMV + (size_t)layer * 65536; }
  else { const int b = (item - 512) >> 2; t0 = TP + b * 64; nq = 64; kk = p.in[6] + ((size_t)layer * 8 + b) * 65536; vv = p.in[7] + ((size_t)layer * 8 + b) * 65536; }
  KVSrc s; s.k = kk + h * 64; s.v = vv + h * 64; s.kpitch = 256; s.vpitch = 256; s.f32 = 1;
  attn_item<64, 1>(P + (size_t)t0 * np + mqoff + h * 64, np, nq, p.in[15] + layer * 64, 0.125f * LOG2E, s, 4, 0, 0, s, 0,
                   mix + (size_t)t0 * mixp + mixoff + h * 64, mixp, smem);
}

DEVI void gdn_prep_item(const KP& p, int j, int ci, int h, const bf16_t* P, unsigned char* smem) {
  constexpr int NP = NP_GDN;
  const int tid = get_tid(), lane = tid & 63, wave = tid >> 6;
  const int item = ci * 6 + h;
  const bool samp = ci >= 256;
  const int b = ci - 256;
  const int t0 = samp ? TP + b * 64 : ci * 64;
  float* stage = (float*)smem;
  float* sL = (float*)smem;
  bf16_t* qn = (bf16_t*)(smem + 33280);
  bf16_t* kn = qn + 64 * 136;
  float* sgc = (float*)(smem + 33280 + 2 * 64 * 136 * 2);
  float* sbeta = sgc + 64;
  float* segc = sbeta + 64;
  unsigned char* gi = p.ws + WS_G + (size_t)item * G_ITEM;
  bf16_t* gU = (bf16_t*)gi; bf16_t* gW = gU + 8192; bf16_t* gQD = gW + 8192; bf16_t* gKDT = gQD + 8192; bf16_t* gAI = gKDT + 8192;
  const float* convw = p.in[17] + (size_t)j * 4 * 2304;
  const float* cstate = p.in[2] + ((size_t)j * 8 + (samp ? b : 0)) * 3 * 2304;
  const bf16_t* Pc = P + (size_t)t0 * NP;
  __syncthreads();
  if (wave == 0) {
    const float braw = bf2f(Pc[(size_t)lane * NP + 3072 + h]), araw = bf2f(Pc[(size_t)lane * NP + 3078 + h]);
    const float beta = 1.f / (1.f + __expf(-braw));
    const float xx = araw + p.in[19][j * 6 + h];
    const float sp = xx > 20.f ? xx : __logf(1.f + __expf(xx));
    float g = -__expf(p.in[18][j * 6 + h]) * sp;
#pragma unroll
    for (int d = 1; d < 64; d <<= 1) { const float v = __shfl_up(g, d); if (lane >= d) g += v; }
    sgc[lane] = g; sbeta[lane] = beta; segc[lane] = __expf(g);
    if (lane == 63) ((float*)(p.ws + WS_GL))[item] = __expf(g);
  }
  if (samp || ci == 255) {
    float* dst = samp ? p.out + O_SGC + ((size_t)j * 8 + b) * 3 * 2304 : p.out + O_PGC + (size_t)j * 3 * 2304;
    for (int idx = tid; idx < 1152; idx += 256) {
      const int r = idx / 384, cc = idx % 384, ch = (cc >> 7) * 768 + h * 128 + (cc & 127);
      dst[r * 2304 + ch] = bf2f(Pc[(size_t)(61 + r) * NP + ch]);
    }
  }
  const float gcl_dummy = 0.f; (void)gcl_dummy;
#pragma unroll 1
  for (int which = 0; which < 2; ++which) {
    {
      const int c = tid & 127, th = tid >> 7, ch = which * 768 + h * 128 + c;
      const float w0 = convw[ch], w1 = convw[2304 + ch], w2 = convw[2 * 2304 + ch], w3 = convw[3 * 2304 + ch];
      float xm3, xm2, xm1;
      if (th == 1) { xm3 = bf2f(Pc[(size_t)29 * NP + ch]); xm2 = bf2f(Pc[(size_t)30 * NP + ch]); xm1 = bf2f(Pc[(size_t)31 * NP + ch]); }
      else if (samp) { xm3 = cstate[ch]; xm2 = cstate[2304 + ch]; xm1 = cstate[2 * 2304 + ch]; }
      else if (ci == 0) { xm3 = xm2 = xm1 = 0.f; }
      else { xm3 = bf2f(Pc[-(ptrdiff_t)3 * NP + ch]); xm2 = bf2f(Pc[-(ptrdiff_t)2 * NP + ch]); xm1 = bf2f(Pc[-(ptrdiff_t)NP + ch]); }
      const bf16_t* pp = Pc + (size_t)(th * 32) * NP + ch;
#pragma unroll 8
      for (int tt = 0; tt < 32; ++tt) {
        const float x0 = bf2f(pp[(size_t)tt * NP]);
        const float y = w0 * xm3 + w1 * xm2 + w2 * xm1 + w3 * x0;
        stage[(th * 32 + tt) * 129 + c] = silu(y);
        xm3 = xm2; xm2 = xm1; xm1 = x0;
      }
    }
    __syncthreads();
    {
      const int tt = tid >> 2, part = tid & 3;
      float v[32]; float ss = 0.f;
#pragma unroll
      for (int e = 0; e < 32; ++e) { v[e] = stage[tt * 129 + part * 32 + e]; ss += v[e] * v[e]; }
      ss += __shfl_xor(ss, 1); ss += __shfl_xor(ss, 2);
      float rinv = rsqrtf(ss + EPS);
      if (which == 0) rinv *= 0.08838834764831845f;
      bf16_t* dn = (which == 0 ? qn : kn) + tt * 136 + part * 32;
      const float eg = segc[tt];
#pragma unroll
      for (int e = 0; e < 32; e += 8) {
        u4 u; u.x = pk2(v[e] * rinv, v[e + 1] * rinv); u.y = pk2(v[e + 2] * rinv, v[e + 3] * rinv); u.z = pk2(v[e + 4] * rinv, v[e + 5] * rinv); u.w = pk2(v[e + 6] * rinv, v[e + 7] * rinv);
        *(u4*)(dn + e) = u;
        if (which == 0) {
          const float s2 = rinv * eg;
          u4 w; w.x = pk2(v[e] * s2, v[e + 1] * s2); w.y = pk2(v[e + 2] * s2, v[e + 3] * s2); w.z = pk2(v[e + 4] * s2, v[e + 5] * s2); w.w = pk2(v[e + 6] * s2, v[e + 7] * s2);
          *(u4*)(gQD + tt * 128 + part * 32 + e) = w;
        }
      }
    }
    __syncthreads();
  }
  {
    const int d = tid & 127, th = tid >> 7;
    const float gcl = sgc[63];
#pragma unroll
    for (int q8 = 0; q8 < 4; ++q8) {
      float f[8];
#pragma unroll
      for (int e = 0; e < 8; ++e) { const int tt = th * 32 + q8 * 8 + e; f[e] = bf2f(kn[tt * 136 + d]) * __expf(gcl - sgc[tt]); }
      *(u4*)(gKDT + d * 64 + th * 32 + q8 * 8) = mk4(pk2(f[0], f[1]), pk2(f[2], f[3]), pk2(f[4], f[5]), pk2(f[6], f[7]));
    }
  }
  {
    const int l31 = lane & 31, lh = lane >> 5, ri = wave >> 1, cj = wave & 1;
    f32x16 kk, qk;
#pragma unroll
    for (int r = 0; r < 16; ++r) { kk[r] = 0.f; qk[r] = 0.f; }
#pragma unroll
    for (int ks = 0; ks < 8; ++ks) {
      const bf16x8 ak = *(const bf16x8*)(kn + (ri * 32 + l31) * 136 + ks * 16 + lh * 8);
      const bf16x8 aq = *(const bf16x8*)(qn + (ri * 32 + l31) * 136 + ks * 16 + lh * 8);
      const bf16x8 bk = *(const bf16x8*)(kn + (cj * 32 + l31) * 136 + ks * 16 + lh * 8);
      kk = MFMA32(ak, bk, kk); qk = MFMA32(aq, bk, qk);
    }
    const int jj = cj * 32 + l31; const float gj = sgc[jj];
#pragma unroll
    for (int r = 0; r < 16; ++r) {
      const int ii = ri * 32 + (r >> 2) * 8 + lh * 4 + (r & 3);
      const float dec = ii >= jj ? __expf(sgc[ii] - gj) : 0.f;
      sL[ii * 64 + jj] = ii > jj ? sbeta[ii] * kk[r] * dec : 0.f;
      gAI[ii * 64 + jj] = f2bf(qk[r] * dec);
    }
  }
  __syncthreads();
  {
    float x[64];
    if (tid < 128) {
      const int ch = 1536 + h * 128 + tid;
      const float w0 = convw[ch], w1 = convw[2304 + ch], w2 = convw[2 * 2304 + ch], w3 = convw[3 * 2304 + ch];
      float xm3, xm2, xm1;
      if (samp) { xm3 = cstate[ch]; xm2 = cstate[2304 + ch]; xm1 = cstate[2 * 2304 + ch]; }
      else if (ci == 0) { xm3 = xm2 = xm1 = 0.f; }
      else { xm3 = bf2f(Pc[-(ptrdiff_t)3 * NP + ch]); xm2 = bf2f(Pc[-(ptrdiff_t)2 * NP + ch]); xm1 = bf2f(Pc[-(ptrdiff_t)NP + ch]); }
#pragma unroll
      for (int tt = 0; tt < 64; ++tt) {
        const float x0 = bf2f(Pc[(size_t)tt * NP + ch]);
        const float y = w0 * xm3 + w1 * xm2 + w2 * xm1 + w3 * x0;
        x[tt] = silu(y) * sbeta[tt];
        xm3 = xm2; xm2 = xm1; xm1 = x0;
        if ((tt & 7) == 7) __builtin_amdgcn_sched_barrier(0);
      }
    } else {
#pragma unroll
      for (int tt = 0; tt < 64; ++tt) { x[tt] = bf2f(kn[tt * 136 + tid - 128]) * sbeta[tt] * segc[tt]; if ((tt & 7) == 7) __builtin_amdgcn_sched_barrier(0); }
    }
#pragma unroll
    for (int i = 1; i < 64; ++i) {
      float a = x[i];
#pragma unroll
      for (int jx = 0; jx < i; ++jx) a -= sL[i * 64 + jx] * x[jx];
      x[i] = a;
      __builtin_amdgcn_sched_barrier(0);
    }
    if (tid < 128) {
#pragma unroll
      for (int t8 = 0; t8 < 8; ++t8) {
        *(u4*)(gU + tid * 64 + t8 * 8) = mk4(pk2(x[t8 * 8], x[t8 * 8 + 1]), pk2(x[t8 * 8 + 2], x[t8 * 8 + 3]), pk2(x[t8 * 8 + 4], x[t8 * 8 + 5]), pk2(x[t8 * 8 + 6], x[t8 * 8 + 7]));
        __builtin_amdgcn_sched_barrier(0);
      }
    } else {
      bf16_t* dst = gW + (tid & 127);
#pragma unroll
      for (int tt = 0; tt < 64; ++tt) { dst[tt * 128] = f2bf(x[tt]); if ((tt & 7) == 7) __builtin_amdgcn_sched_barrier(0); }
    }
  }
}

struct ScanFrags { u4 w[4], qd[4], ai[2], kdt[2][2]; u2 u; float gl; };
DEVI void scan_load(const KP& p, int item, int wave, int lane, int sl, ScanFrags& f) {
  const int n = lane & 15, g = lane >> 4;
  const unsigned char* gi = p.ws + WS_G + (size_t)item * G_ITEM;
  const bf16_t* gU = (const bf16_t*)gi; const bf16_t* gW = gU + 8192; const bf16_t* gQD = gW + 8192; const bf16_t* gKDT = gQD + 8192; const bf16_t* gAI = gKDT + 8192;
#pragma unroll
  for (int s = 0; s < 4; ++s) { GLOAD16(f.w[s], gW + (16 * wave + n) * 128 + 32 * s + 8 * g); GLOAD16(f.qd[s], gQD + (16 * wave + n) * 128 + 32 * s + 8 * g); }
#pragma unroll
  for (int s = 0; s < 2; ++s) {
    GLOAD16(f.ai[s], gAI + (16 * wave + n) * 64 + 32 * s + 8 * g);
#pragma unroll
    for (int tt = 0; tt < 2; ++tt) GLOAD16(f.kdt[tt][s], gKDT + (32 * wave + 16 * tt + n) * 64 + 32 * s + 8 * g);
  }
  const bf16_t* up = gU + (sl * 16 + n) * 64 + 16 * wave + 4 * g;
  asm volatile("global_load_dwordx2 %0, %1, off" : "=&v"(f.u) : "v"(up) : "memory");
  const float* glp = (const float*)(p.ws + WS_GL) + item;
  asm volatile("global_load_dword %0, %1, off" : "=&v"(f.gl) : "v"(glp) : "memory");
}
DEVI void scan_wait32(ScanFrags& f) {
  asm volatile("s_waitcnt vmcnt(32)"
               : "+v"(f.w[0]), "+v"(f.w[1]), "+v"(f.w[2]), "+v"(f.w[3]), "+v"(f.qd[0]), "+v"(f.qd[1]), "+v"(f.qd[2]), "+v"(f.qd[3]),
                 "+v"(f.ai[0]), "+v"(f.ai[1]), "+v"(f.kdt[0][0]), "+v"(f.kdt[0][1]), "+v"(f.kdt[1][0]), "+v"(f.kdt[1][1]),
                 "+v"(f.u), "+v"(f.gl)
               :: "memory");
}
DEVI void scan_keep(const ScanFrags& f) {
#pragma unroll
  for (int s = 0; s < 4; ++s) asm volatile("" :: "v"(f.w[s]), "v"(f.qd[s]));
#pragma unroll
  for (int s = 0; s < 2; ++s) asm volatile("" :: "v"(f.ai[s]), "v"(f.kdt[0][s]), "v"(f.kdt[1][s]));
  asm volatile("" :: "v"(f.u), "v"(f.gl));
}
DEVI void scan_step(const ScanFrags& f, f32x4 (&sacc)[2], bf16_t* St, bf16_t* Vnt, bf16_t* O, int t0, int h, int sl, int wave, int n, int g) {
  bf16x8 sf[4];
#pragma unroll
  for (int s = 0; s < 4; ++s) sf[s] = *(const bf16x8*)(St + n * 136 + 32 * s + 8 * g);
  f32x4 wsa = {0.f, 0.f, 0.f, 0.f}, oa = {0.f, 0.f, 0.f, 0.f};
#pragma unroll
  for (int s = 0; s < 4; ++s) wsa = MFMA16(as_frag(f.w[s]), sf[s], wsa);
  float vn[4];
  vn[0] = lo2f(f.u.x) - wsa[0]; vn[1] = hi2f(f.u.x) - wsa[1]; vn[2] = lo2f(f.u.y) - wsa[2]; vn[3] = hi2f(f.u.y) - wsa[3];
  { u2 o; o.x = pk2(vn[0], vn[1]); o.y = pk2(vn[2], vn[3]); *(u2*)(Vnt + n * 72 + 16 * wave + 4 * g) = o; }
#pragma unroll
  for (int s = 0; s < 4; ++s) oa = MFMA16(as_frag(f.qd[s]), sf[s], oa);
  LDS_BARRIER();
  bf16x8 vf[2];
#pragma unroll
  for (int s = 0; s < 2; ++s) vf[s] = *(const bf16x8*)(Vnt + n * 72 + 32 * s + 8 * g);
#pragma unroll
  for (int s = 0; s < 2; ++s) oa = MFMA16(as_frag(f.ai[s]), vf[s], oa);
#pragma unroll
  for (int r = 0; r < 4; ++r) O[(size_t)(t0 + 16 * wave + 4 * g + r) * 768 + h * 128 + sl * 16 + n] = f2bf(oa[r]);
#pragma unroll
  for (int tt = 0; tt < 2; ++tt) {
#pragma unroll
    for (int r = 0; r < 4; ++r) sacc[tt][r] *= f.gl;
#pragma unroll
    for (int s = 0; s < 2; ++s) sacc[tt] = MFMA16(as_frag(f.kdt[tt][s]), vf[s], sacc[tt]);
    u2 o; o.x = pk2(sacc[tt][0], sacc[tt][1]); o.y = pk2(sacc[tt][2], sacc[tt][3]);
    *(u2*)(St + n * 136 + 32 * wave + 16 * tt + 4 * g) = o;
  }
  LDS_BARRIER();
}
DEVI void gdn_scan_stream(const KP& p, int j, int ci0, int nch, int h, int sl, const float* s0, float* sout, bf16_t* O, unsigned char* smem) {
  const int tid = get_tid(), lane = tid & 63, wave = tid >> 6, n = lane & 15, g = lane >> 4;
  bf16_t* St = (bf16_t*)smem;
  bf16_t* Vnt = St + 16 * 136;
  f32x4 sacc[2];
#pragma unroll
  for (int tt = 0; tt < 2; ++tt)
#pragma unroll
    for (int r = 0; r < 4; ++r) sacc[tt][r] = s0 ? s0[(size_t)(32 * wave + 16 * tt + 4 * g + r) * 128 + sl * 16 + n] : 0.f;
  __syncthreads();
#pragma unroll
  for (int tt = 0; tt < 2; ++tt) { u2 o; o.x = pk2(sacc[tt][0], sacc[tt][1]); o.y = pk2(sacc[tt][2], sacc[tt][3]); *(u2*)(St + n * 136 + 32 * wave + 16 * tt + 4 * g) = o; }
  ScanFrags f0, f1, f2;
#define CL(c) ((ci0 + (((c) < nch) ? (c) : nch - 1)) * 6 + h)
#define T0(c) (((ci0 + (c)) >= 256) ? TP + (ci0 + (c) - 256) * 64 : (ci0 + (c)) * 64)
  VMWAIT(0);
  scan_load(p, CL(0), wave, lane, sl, f0);
  scan_load(p, CL(1), wave, lane, sl, f1);
  LDS_BARRIER();
  for (int c = 0; c < nch; c += 3) {
    scan_load(p, CL(c + 2), wave, lane, sl, f2); scan_wait32(f0);
    scan_step(f0, sacc, St, Vnt, O, T0(c), h, sl, wave, n, g);
    if (c + 1 < nch) {
      scan_load(p, CL(c + 3), wave, lane, sl, f0); scan_wait32(f1);
      scan_step(f1, sacc, St, Vnt, O, T0(c + 1), h, sl, wave, n, g);
    }
    if (c + 2 < nch) {
      scan_load(p, CL(c + 4), wave, lane, sl, f1); scan_wait32(f2);
      scan_step(f2, sacc, St, Vnt, O, T0(c + 2), h, sl, wave, n, g);
    }
  }
  VMWAIT(0);
  scan_keep(f0); scan_keep(f1); scan_keep(f2);
#undef CL
#undef T0
#pragma unroll
  for (int tt = 0; tt < 2; ++tt)
#pragma unroll
    for (int r = 0; r < 4; ++r) sout[(size_t)(32 * wave + 16 * tt + 4 * g + r) * 128 + sl * 16 + n] = sacc[tt][r];
}

DEVI int next_item(unsigned* ctr) {
  __shared__ int s_item;
  __syncthreads();
  if (get_tid() == 0) s_item = (int)atomicAdd(ctr, 1u);
  __syncthreads();
  return s_item;
}

DEVI unsigned xcc_id() { return (unsigned)__builtin_amdgcn_s_getreg((3 << 11) | 20) & 0xFu; }
DEVI unsigned ld_relaxed(unsigned* p) { return __hip_atomic_load(p, __ATOMIC_RELAXED, __HIP_MEMORY_SCOPE_AGENT); }
DEVI void gbar_setup(unsigned* ctr, unsigned nb, unsigned* sb) {
  if (get_tid() == 0) {
    const unsigned x = xcc_id();
    __hip_atomic_fetch_add(ctr + 544 + 8 * x, 1u, __ATOMIC_RELAXED, __HIP_MEMORY_SCOPE_AGENT);
    unsigned nx, mine;
    for (;;) {
      unsigned sum = 0; nx = 0; mine = 0;
      for (unsigned j = 0; j < 16; ++j) { const unsigned c = ld_relaxed(ctr + 544 + 8 * j); sum += c; nx += c ? 1u : 0u; mine = (j == x) ? c : mine; }
      if (sum == nb) break;
      __builtin_amdgcn_s_sleep(2);
    }
    sb[0] = x; sb[1] = mine; sb[2] = nx;
  }
  __syncthreads();
}
DEVI void gbar(unsigned* ctr, unsigned* sb, unsigned& gen) {
  asm volatile("s_waitcnt vmcnt(0)" ::: "memory");
  __syncthreads();
  gen++;
  if (get_tid() == 0) {
    const unsigned x = sb[0], nloc = sb[1], nx = sb[2];
    const unsigned old = __hip_atomic_fetch_add(ctr + 704 + 8 * x, 1u, __ATOMIC_RELAXED, __HIP_MEMORY_SCOPE_AGENT);
    if (old + 1u == gen * nloc) {
      __builtin_amdgcn_fence(__ATOMIC_RELEASE, "agent");
      asm volatile("s_waitcnt vmcnt(0)" ::: "memory");
      __hip_atomic_fetch_add(ctr + 528, 1u, __ATOMIC_RELAXED, __HIP_MEMORY_SCOPE_AGENT);
    }
    for (unsigned it = 0; ld_relaxed(ctr + 528) < gen * nx; ++it) {
      if (it < 8) __builtin_amdgcn_s_sleep(4); else if (it < 24) __builtin_amdgcn_s_sleep(32); else __builtin_amdgcn_s_sleep(127);
    }
    __builtin_amdgcn_fence(__ATOMIC_ACQUIRE, "agent");
    asm volatile("s_waitcnt vmcnt(0)" ::: "memory");
  }
  __syncthreads();
}
#ifndef ONLY
#define ENAB(k) true
#else
#define ENAB(k) ((ONLY) == (k))
#endif
__global__ void __launch_bounds__(256, 2) mk_fwd(KP p) {
  __shared__ __attribute__((aligned(16))) unsigned char smem[73728];
  cg::grid_group grid = cg::this_grid();
  const int bid = blockIdx.x, nb = gridDim.x;
  const int ngw = nb * 4;
  unsigned char* ws = p.ws;
  unsigned* ctr = (unsigned*)(ws + WS_CTR);
  float* Y = p.out + O_YP;
  bf16_t* XN = (bf16_t*)(ws + WS_XN);
  bf16_t* MIX = (bf16_t*)(ws + WS_MIX);
  bf16_t* Pb = (bf16_t*)(ws + WS_P);
  bf16_t* Hb = (bf16_t*)(ws + WS_H);
  bool did = false;
  unsigned bgen = 0;
  __shared__ unsigned s_bar[4];
  gbar_setup(ctr, nb, s_bar);
  grid.sync();
  for (int ph = p.ph_lo; ph < p.ph_hi; ++ph) {
    const int layer = ph == 0 ? 0 : (ph - 1) / 9, sub = ph == 0 ? -1 : (ph - 1) % 9;
    const int kind = layer & 1, j = layer >> 1;
    if (sub == 8 && layer == 3) continue;
    if (did) gbar(ctr, s_bar, bgen);
    did = true;
    const int np = kind ? NP_SB : NP_GDN, mqoff = kind ? MQ_SB : MQ_GDN, mixp = kind ? 768 : 1024, mixoff = kind ? 512 : 768;
    if (ph == 0 && ENAB(0)) {
      const int tid = get_tid(), lane = tid & 63, gw = bid * 4 + (tid >> 6); (void)tid; (void)lane; (void)gw;
      int base = 0;
      convert_group(base, bid, nb, p.in[12], (bf16_t*)(ws + WS_WIG), 2, 1024, 3340, 3456, 3084, 116, smem);
      convert_group(base, bid, nb, p.in[13], (bf16_t*)(ws + WS_WIS), 2, 1024, 1792, 1792, 1 << 30, 0, smem);
      convert_group(base, bid, nb, p.in[14], (bf16_t*)(ws + WS_WKV), 4, 1024, 512, 512, 1 << 30, 0, smem);
      convert_group(base, bid, nb, p.in[23], (bf16_t*)(ws + WS_WOG), 2, 1024, 1024, 1024, 1 << 30, 0, smem);
      convert_group(base, bid, nb, p.in[24], (bf16_t*)(ws + WS_WOS), 2, 768, 1024, 1024, 1 << 30, 0, smem);
      convert_group(base, bid, nb, p.in[25], (bf16_t*)(ws + WS_WUP), 4, 1024, 4096, 4096, 1 << 30, 0, smem);
      convert_group(base, bid, nb, p.in[26], (bf16_t*)(ws + WS_WDN), 4, 4096, 1024, 1024, 1 << 30, 0, smem);
      for (int r = gw; r < TA; r += ngw) norm_row(r < TP ? p.in[0] + (size_t)r * DM : p.in[1] + (size_t)(r - TP) * DM, p.in[9], XN + (size_t)r * DM, lane);
      for (int i = bid * 256 + tid; i < TS * DM / 4; i += nb * 256) ((float4*)(Y + (size_t)TP * DM))[i] = ((const float4*)p.in[1])[i];
      for (int r = gw; r < 1024; r += ngw) norm_row(p.in[8] + (size_t)(r & 255) * DM, p.in[10] + (r >> 8) * DM, (bf16_t*)(ws + WS_MEMN) + (size_t)r * DM, lane);
    } else if (sub == 0 && ENAB(1)) {
      EpiArgs ea{}; ea.cb = Pb; ea.ldc = np;
      const bf16_t* wt = kind ? (const bf16_t*)(ws + WS_WIS) + (size_t)j * 1792 * 1024 : (const bf16_t*)(ws + WS_WIG) + (size_t)j * 3456 * 1024;
      gemm_phase<0>(XN, DM, wt, 1024, TA, np, ea, smem);
      if (layer == 0) {
        for (int t = bid; t < 32; t += nb) {
          const int l = t >> 3, r = t & 7;
          EpiArgs e2{}; e2.cf = (float*)(ws + WS_MEMKV) + (size_t)l * 256 * 512; e2.ldc = 512;
          gemm_tile<3>((const bf16_t*)(ws + WS_MEMN) + (size_t)l * 256 * DM, DM, (const bf16_t*)(ws + WS_WKV) + (size_t)l * 512 * DM, DM, 1024, (r >> 2) << 7, (r & 3) << 7, e2, smem);
        }
      }
    } else if (sub == 1 && ENAB(2)) {
      const int tid = get_tid(), lane = tid & 63, gw = bid * 4 + (tid >> 6); (void)tid; (void)lane; (void)gw;
      if (layer == 0) {
        const float* kv = (const float*)(ws + WS_MEMKV);
        for (int it = gw; it < 4096; it += ngw) {
          const int l = it >> 10, m = (it >> 2) & 255, hh = it & 3;
          const float kx = kv[((size_t)l * 256 + m) * 512 + hh * 64 + lane], vx = kv[((size_t)l * 256 + m) * 512 + 256 + hh * 64 + lane];
          const float ss = wave_sum(kx * kx);
          p.out[O_PMK + ((size_t)l * 256 + m) * 256 + hh * 64 + lane] = kx * rsqrtf(ss * (1.f / 64.f) + EPS) * p.in[16][l * 64 + lane];
          p.out[O_PMV + ((size_t)l * 256 + m) * 256 + hh * 64 + lane] = vx;
        }
      }
      if (kind == 0) {
        for (int it = bid; it < NITEM; it += nb) gdn_prep_item(p, j, it / 6, it % 6, Pb, smem);
      } else {
        bf16_t* Kb = (bf16_t*)(ws + WS_G);
        const float* kg = p.in[22] + j * 128;
        for (int t = gw; t < TA; t += ngw) {
          const bf16_t* pr = Pb + (size_t)t * np;
          const u4 ku = *(const u4*)(pr + 512 + lane * 8), vu = *(const u4*)(pr + 1024 + lane * 8);
          float kf[8] = {lo2f(ku.x), hi2f(ku.x), lo2f(ku.y), hi2f(ku.y), lo2f(ku.z), hi2f(ku.z), lo2f(ku.w), hi2f(ku.w)};
          float ss = 0.f;
#pragma unroll
          for (int e = 0; e < 8; ++e) ss += kf[e] * kf[e];
          ss += __shfl_xor(ss, 1); ss += __shfl_xor(ss, 2); ss += __shfl_xor(ss, 4); ss += __shfl_xor(ss, 8);
          const float sc = rsqrtf(ss * (1.f / 128.f) + EPS);
          const int c0 = (lane & 15) * 8;
#pragma unroll
          for (int e = 0; e < 8; ++e) kf[e] *= sc * kg[c0 + e];
          float* ok = t < TP ? p.out + O_PSK + ((size_t)j * TP + t) * 512 : p.out + O_SSK + ((size_t)j * TS + (t - TP)) * 512;
          float* ov = t < TP ? p.out + O_PSV + ((size_t)j * TP + t) * 512 : p.out + O_SSV + ((size_t)j * TS + (t - TP)) * 512;
          *(float4*)(ok + lane * 8) = make_float4(kf[0], kf[1], kf[2], kf[3]); *(float4*)(ok + lane * 8 + 4) = make_float4(kf[4], kf[5], kf[6], kf[7]);
          *(float4*)(ov + lane * 8) = make_float4(lo2f(vu.x), hi2f(vu.x), lo2f(vu.y), hi2f(vu.y)); *(float4*)(ov + lane * 8 + 4) = make_float4(lo2f(vu.z), hi2f(vu.z), lo2f(vu.w), hi2f(vu.w));
          *(u4*)(Kb + (size_t)t * 512 + lane * 8) = mk4(pk2(kf[0], kf[1]), pk2(kf[2], kf[3]), pk2(kf[4], kf[5]), pk2(kf[6], kf[7]));
        }
      }
    } else if (sub == 2 && ENAB(3)) {
      unsigned* c = ctr + layer * 4;
      if (kind == 0) {
        bf16_t* O = XN;
        if (bid < 64 && (bid & 7) < 6) {
          const int h = bid & 7, sl = bid >> 3;
          gdn_scan_stream(p, j, 0, 256, h, sl, nullptr, p.out + O_PGS + ((size_t)j * 6 + h) * 16384, O, smem);
        }
        for (;;) {
          const int it = next_item(c);
          if (it >= 384 + 544) break;
          if (it < 384) { const int b = it / 48, r = it % 48, h = r >> 3, sl = r & 7;
            gdn_scan_stream(p, j, 256 + b, 1, h, sl, p.in[3] + (((size_t)j * 8 + b) * 6 + h) * 16384, p.out + O_SGS + (((size_t)j * 8 + b) * 6 + h) * 16384, O, smem);
          } else mem_attn_item(p, layer, it - 384, Pb, np, mqoff, MIX, mixp, mixoff, smem);
        }
      } else {
        const bf16_t* Kb = (const bf16_t*)(ws + WS_G);
        bf16_t* OFAR = (bf16_t*)(ws + WS_G + (32ull << 20));
        float* CARRY = (float*)(ws + WS_G + (64ull << 20));
        const float qs = 0.08838834764831845f * LOG2E;
        for (;;) {
          const int it = next_item(c);
          if (it >= 768 + 32 + 544) break;
          if (it < 768) {
            int qb, idx, whole;
            if (it < 640) { const int pr = it / 20, r = it % 20; if (r < 8) { qb = 127 - 2 * pr; idx = r; whole = 0; } else if (r < 12) { qb = 63 - pr; idx = r - 8; whole = 1; } else { qb = 126 - 2 * pr; idx = r - 12; whole = 0; } }
            else { qb = 31 - ((it - 640) >> 2); idx = (it - 640) & 3; whole = 1; }
            const int h = whole ? idx : (idx >> 1), far = whole ? 0 : (idx & 1), near_ = (!whole && !far);
            const int nAi = whole ? 2 * qb + 2 : qb + 1, koff = near_ ? (qb + 1) * 64 : 0;
            KVSrc s; s.k = Kb + (size_t)koff * 512 + h * 128; s.v = Pb + (size_t)koff * np + 1024 + h * 128; s.kpitch = 512; s.vpitch = np; s.f32 = 0;
            bf16_t* op = far ? OFAR + (size_t)(qb * 128) * 512 + h * 128 : MIX + (size_t)(qb * 128) * mixp + h * 128;
            float* co = near_ ? CARRY + (size_t)(qb * 128) * 4 + h : nullptr;
            attn_item<128, 0>(Pb + (size_t)(qb * 128) * np + h * 128, np, 128, p.in[21] + j * 128, qs, s, nAi, qb * 128 - koff, far ? 0 : 1, s, 0, op, far ? 512 : mixp, smem, co);
          } else if (it < 800) {
            const int b = (it - 768) >> 2, h = it & 3, t0 = TP + b * 64;
            KVSrc sa; sa.k = Kb + (size_t)t0 * 512 + h * 128; sa.v = Pb + (size_t)t0 * np + 1024 + h * 128; sa.kpitch = 512; sa.vpitch = np; sa.f32 = 0;
            KVSrc sb; sb.k = p.in[4] + ((size_t)j * 8 + b) * 2048 * 512 + h * 128; sb.v = p.in[5] + ((size_t)j * 8 + b) * 2048 * 512 + h * 128; sb.kpitch = 512; sb.vpitch = 512; sb.f32 = 1;
            attn_item<128, 0>(Pb + (size_t)t0 * np + h * 128, np, 64, p.in[21] + j * 128, qs, sa, 1, 0, 1, sb, 32,
                              MIX + (size_t)t0 * mixp + h * 128, mixp, smem);
          } else mem_attn_item(p, layer, it - 800, Pb, np, mqoff, MIX, mixp, mixoff, smem);
        }
      }
    } else if (sub == 3 && kind == 1) {
      const int tid = get_tid(), lane = tid & 63, gw = bid * 4 + (tid >> 6); (void)tid; (void)lane; (void)gw;
      const bf16_t* OFAR = (const bf16_t*)(ws + WS_G + (32ull << 20));
      const float* CARRY = (const float*)(ws + WS_G + (64ull << 20));
      for (int t = TP / 2 + gw; t < TP; t += ngw) {
        const u4 a = *(const u4*)(MIX + (size_t)t * mixp + lane * 8), b = *(const u4*)(OFAR + (size_t)t * 512 + lane * 8);
        const float sc = CARRY[(size_t)t * 4 + (lane >> 4)];
        u4 o;
        o.x = pk2(lo2f(a.x) + sc * lo2f(b.x), hi2f(a.x) + sc * hi2f(b.x)); o.y = pk2(lo2f(a.y) + sc * lo2f(b.y), hi2f(a.y) + sc * hi2f(b.y));
        o.z = pk2(lo2f(a.z) + sc * lo2f(b.z), hi2f(a.z) + sc * hi2f(b.z)); o.w = pk2(lo2f(a.w) + sc * lo2f(b.w), hi2f(a.w) + sc * hi2f(b.w));
        *(u4*)(MIX + (size_t)t * mixp + lane * 8) = o;
      }
    } else if (sub == 3 && ENAB(4)) {
      const int tid = get_tid(), lane = tid & 63, gw = bid * 4 + (tid >> 6); (void)tid; (void)lane; (void)gw;
      const bf16_t* O = XN;
      const float* og = p.in[20] + j * 128;
      for (int it = gw; it < TA * 6; it += ngw) {
        const int t = it / 6, h = it % 6;
        const unsigned ou = *(const unsigned*)(O + (size_t)t * 768 + h * 128 + lane * 2);
        const unsigned zu = *(const unsigned*)(Pb + (size_t)t * np + 2304 + h * 128 + lane * 2);
        const float o0 = lo2f(ou), o1 = hi2f(ou), z0 = lo2f(zu), z1 = hi2f(zu);
        const float ss = wave_sum(o0 * o0 + o1 * o1);
        const float sc = rsqrtf(ss * (1.f / 128.f) + EPS);
        *(unsigned*)(MIX + (size_t)t * 1024 + h * 128 + lane * 2) = pk2(o0 * sc * og[lane * 2] * silu(z0), o1 * sc * og[lane * 2 + 1] * silu(z1));
      }
    } else if (sub == 4 && ENAB(5)) {
      EpiArgs ea{}; ea.yout = Y;
      if (layer == 0) { ea.res0 = p.in[0]; ea.res1 = p.in[1]; } else { ea.res0 = Y; ea.res1 = nullptr; }
      const bf16_t* wt = kind ? (const bf16_t*)(ws + WS_WOS) + (size_t)j * 1024 * 768 : (const bf16_t*)(ws + WS_WOG) + (size_t)j * 1024 * 1024;
      gemm_phase_res(MIX, mixp, wt, mixp, ea, smem);
    } else if (sub == 5) {
      const int tid = get_tid(), lane = tid & 63, gw = bid * 4 + (tid >> 6); (void)tid; (void)lane; (void)gw;
      norm_all(Y, p.in[11] + layer * DM, XN, gw, ngw, lane);
    } else if (sub == 6 && ENAB(6)) {
      EpiArgs ea{}; ea.cb = Hb; ea.ldc = DFF;
      gemm_phase<2>(XN, DM, (const bf16_t*)(ws + WS_WUP) + (size_t)layer * 4096 * 1024, 1024, TA, 4096, ea, smem);
    } else if (sub == 7 && ENAB(7)) {
      EpiArgs ea{}; ea.yout = Y; ea.res0 = Y; ea.res1 = nullptr;
      gemm_phase_res(Hb, DFF, (const bf16_t*)(ws + WS_WDN) + (size_t)layer * 1024 * 4096, 4096, ea, smem);
    } else if (sub == 8) {
      const int tid = get_tid(), lane = tid & 63, gw = bid * 4 + (tid >> 6); (void)tid; (void)lane; (void)gw;
      norm_all(Y, p.in[9] + (layer + 1) * DM, XN, gw, ngw, lane);
    }
  }
}

extern "C" void kernel_launch(void* const* d_in, const int* in_sizes, int n_in, void* d_out, int out_size, void* d_ws, size_t ws_size, hipStream_t stream) {
  static int grid_blocks = 0;
  if (!grid_blocks) {
    int dev = 0, cus = 0, per_cu = 0;
    (void)hipGetDevice(&dev);
    (void)hipDeviceGetAttribute(&cus, hipDeviceAttributeMultiprocessorCount, dev);
    (void)hipOccupancyMaxActiveBlocksPerMultiprocessor(&per_cu, mk_fwd, 256, 0);
    if (per_cu > 2) per_cu = 2;
    if (per_cu < 1) per_cu = 1;
    grid_blocks = cus * per_cu;
    if (ws_size < WS_END) fprintf(stderr, "kernel_launch: workspace too small: %zu < %zu\n", ws_size, (size_t)WS_END);
  }
  (void)hipMemsetAsync((char*)d_ws + WS_CTR, 0, 4096, stream);
  KP p{};
  for (int i = 0; i < 27; ++i) p.in[i] = (const float*)d_in[i];
  p.out = (float*)d_out; p.ws = (unsigned char*)d_ws; p.ph_lo = 0; p.ph_hi = 37;
  void* args[] = {&p};
  hipError_t e = hipLaunchCooperativeKernel((void*)mk_fwd, dim3(grid_blocks), dim3(256), args, 0, stream);
  if (e != hipSuccess) fprintf(stderr, "cooperative launch failed: %s (grid %d)\n", hipGetErrorString(e), grid_blocks);
}
```

```cpp
#include <hip/hip_runtime.h>
#include <hip/hip_cooperative_groups.h>
#include <cstdio>
#include <cstdint>
namespace cg = cooperative_groups;

typedef unsigned short bf16_t;
typedef short bf16x8 __attribute__((ext_vector_type(8)));
typedef float f32x16 __attribute__((ext_vector_type(16)));
typedef float f32x4 __attribute__((ext_vector_type(4)));
typedef unsigned u4 __attribute__((ext_vector_type(4)));
typedef unsigned u2 __attribute__((ext_vector_type(2)));
#define DEVI __device__ __forceinline__
__device__ __forceinline__ u4 mk4(unsigned a, unsigned b, unsigned c, unsigned d) { u4 r; r.x = a; r.y = b; r.z = c; r.w = d; return r; }
__device__ __forceinline__ u2 mk2(unsigned a, unsigned b) { u2 r; r.x = a; r.y = b; return r; }
#define MFMA32(a, b, c) __builtin_amdgcn_mfma_f32_32x32x16_bf16((a), (b), (c), 0, 0, 0)
#define LDS_BARRIER() do { asm volatile("s_waitcnt lgkmcnt(0)" ::: "memory"); __builtin_amdgcn_s_barrier(); } while (0)
#define GLOAD16(dst, ptr) asm volatile("global_load_dwordx4 %0, %1, off" : "=&v"(dst) : "v"(ptr) : "memory")
#define VMWAIT(n) asm volatile("s_waitcnt vmcnt(" #n ")" ::: "memory")
#define MFMA16(a, b, c) __builtin_amdgcn_mfma_f32_16x16x32_bf16((a), (b), (c), 0, 0, 0)

constexpr int DM = 1024, TP = 16384, TS = 512, TA = TP + TS, DFF = 4096;
constexpr int NP_GDN = 3456, NP_SB = 1792, MQ_GDN = 3200, MQ_SB = 1536;
constexpr int NCHUNK = 264, NITEM = NCHUNK * 6;
constexpr float EPS = 1e-6f;
constexpr float LOG2E = 1.4426950408889634f;
constexpr size_t O_YP = 0, O_PGC = 17301504, O_PGS = 17315328, O_PSK = 17511936, O_PSV = 34289152, O_PMK = 51066368, O_PMV = 51328512,
                 O_SGC = 51590656, O_SGS = 51701248, O_SSK = 53274112, O_SSV = 53798400;
constexpr size_t WS_CTR = 0;
constexpr size_t WS_WIG = 4096;
constexpr size_t WS_WIS = WS_WIG + 2ull * 3456 * 1024 * 2;
constexpr size_t WS_WKV = WS_WIS + 2ull * 1792 * 1024 * 2;
constexpr size_t WS_WOG = WS_WKV + 4ull * 512 * 1024 * 2;
constexpr size_t WS_WOS = WS_WOG + 2ull * 1024 * 1024 * 2;
constexpr size_t WS_WUP = WS_WOS + 2ull * 1024 * 768 * 2;
constexpr size_t WS_WDN = WS_WUP + 4ull * 4096 * 1024 * 2;
constexpr size_t WS_XN = WS_WDN + 4ull * 4096 * 1024 * 2;
constexpr size_t WS_MIX = WS_XN + (size_t)TA * 1024 * 2;
constexpr size_t WS_MEMN = WS_MIX + (size_t)TA * 1024 * 2;
constexpr size_t WS_MEMKV = WS_MEMN + 4ull * 256 * 1024 * 2;
constexpr size_t WS_BIG = WS_MEMKV + 4ull * 256 * 512 * 4;
constexpr size_t WS_P = WS_BIG;
constexpr size_t WS_G = WS_P + (size_t)TA * 3456 * 2;
constexpr size_t G_ITEM = 73728;
constexpr size_t WS_GL = WS_G + (size_t)NITEM * G_ITEM;
constexpr size_t WS_H = WS_BIG;
constexpr size_t WS_END = WS_GL + 8192;

struct KP { const float* in[27]; float* out; unsigned char* ws; int ph_lo, ph_hi; };

DEVI int get_tid() { int t = __builtin_amdgcn_workitem_id_x(); asm volatile("" : "+v"(t)); return t; }
DEVI float bf2f(bf16_t b) { return __uint_as_float(((unsigned)b) << 16); }
typedef float f32x2_t __attribute__((ext_vector_type(2)));
typedef __bf16 bf16x2_t __attribute__((ext_vector_type(2)));
DEVI unsigned pk2(float lo, float hi) { f32x2_t v = {lo, hi}; return __builtin_bit_cast(unsigned, __builtin_convertvector(v, bf16x2_t)); }
DEVI bf16_t f2bf(float f) { return (bf16_t)(pk2(f, 0.f) & 0xffffu); }
DEVI float lo2f(unsigned u) { return __uint_as_float(u << 16); }
DEVI float hi2f(unsigned u) { return __uint_as_float(u & 0xffff0000u); }
DEVI float ex2(float x) { return __builtin_amdgcn_exp2f(x); }
DEVI float lg2(float x) { return __builtin_amdgcn_logf(x); }
DEVI float wave_sum(float v) {
#pragma unroll
  for (int o = 32; o >= 1; o >>= 1) v += __shfl_xor(v, o);
  return v;
}
DEVI bf16x8 as_frag(u4 u) { return __builtin_bit_cast(bf16x8, u); }
DEVI float silu(float y) { return y / (1.f + __expf(-y)); }

struct EpiArgs { bf16_t* cb; float* cf; int ldc; const float* res0; const float* res1; float* yout; };
template <int EPI>
DEVI void gemm_tile(const bf16_t* __restrict__ A, int lda, const bf16_t* __restrict__ Bt, int ldb, int K, int m0, int n0, const EpiArgs& ea, unsigned char* smem) {
  const int tid = get_tid(), lane = tid & 63, wave = tid >> 6;
  const int wm = wave >> 1, wn = wave & 1, l31 = lane & 31, lh = lane >> 5;
  bf16_t* sA = (bf16_t*)smem;
  bf16_t* sB = sA + 2 * 128 * 72;
  f32x16 acc[2][2];
#pragma unroll
  for (int i = 0; i < 2; ++i)
#pragma unroll
    for (int j = 0; j < 2; ++j)
#pragma unroll
      for (int r = 0; r < 16; ++r) acc[i][j][r] = 0.f;
  const int lr = tid >> 3, lc = (tid & 7) * 8;
  const bf16_t* gA = A + (size_t)(m0 + lr) * lda + lc;
  const bf16_t* gB = Bt + (size_t)(n0 + lr) * ldb + lc;
  u4 ra0[4], rb0[4], ra1[4], rb1[4];
#define G_ISSUE(RA, RB, K0) { _Pragma("unroll") for (int i = 0; i < 4; ++i) { GLOAD16(RA[i], gA + (size_t)i * 32 * lda + (K0)); GLOAD16(RB[i], gB + (size_t)i * 32 * ldb + (K0)); } }
#define G_STASH(RA, RB, BUF) { _Pragma("unroll") for (int i = 0; i < 4; ++i) { *(u4*)(sA + (BUF) * 128 * 72 + (lr + i * 32) * 72 + lc) = RA[i]; *(u4*)(sB + (BUF) * 128 * 72 + (lr + i * 32) * 72 + lc) = RB[i]; } }
#define G_COMPUTE(BUF) { __builtin_amdgcn_s_setprio(1); const bf16_t* cA = sA + (BUF) * 128 * 72 + (wm * 64 + l31) * 72 + lh * 8; const bf16_t* cB = sB + (BUF) * 128 * 72 + (wn * 64 + l31) * 72 + lh * 8; \
    _Pragma("unroll") for (int ks = 0; ks < 4; ++ks) { \
      bf16x8 a0 = *(const bf16x8*)(cA + ks * 16), a1 = *(const bf16x8*)(cA + 32 * 72 + ks * 16); \
      bf16x8 b0 = *(const bf16x8*)(cB + ks * 16), b1 = *(const bf16x8*)(cB + 32 * 72 + ks * 16); \
      acc[0][0] = MFMA32(a0, b0, acc[0][0]); acc[0][1] = MFMA32(a0, b1, acc[0][1]); \
      acc[1][0] = MFMA32(a1, b0, acc[1][0]); acc[1][1] = MFMA32(a1, b1, acc[1][1]); } __builtin_amdgcn_s_setprio(0); }
  const int nk = K >> 6;
  VMWAIT(0);
  G_ISSUE(ra0, rb0, 0);
  G_ISSUE(ra1, rb1, 64);
  __syncthreads();
  VMWAIT(8);
  G_STASH(ra0, rb0, 0);
  LDS_BARRIER();
  for (int kt = 0; kt < nk; kt += 2) {
    G_ISSUE(ra0, rb0, ((kt + 2 < nk) ? kt + 2 : nk - 1) << 6);
    G_COMPUTE(0);
    VMWAIT(8);
    G_STASH(ra1, rb1, 1);
    LDS_BARRIER();
    G_ISSUE(ra1, rb1, ((kt + 3 < nk) ? kt + 3 : nk - 1) << 6);
    G_COMPUTE(1);
    VMWAIT(8);
    if (kt + 2 < nk) G_STASH(ra0, rb0, 0);
    LDS_BARRIER();
  }
  VMWAIT(0);
#pragma unroll
  for (int i = 0; i < 4; ++i) asm volatile("" :: "v"(ra0[i]), "v"(rb0[i]), "v"(ra1[i]), "v"(rb1[i]));
#undef G_ISSUE
#undef G_STASH
#undef G_COMPUTE
#pragma unroll
  for (int i = 0; i < 2; ++i)
#pragma unroll
    for (int r = 0; r < 16; ++r) {
      const int row = m0 + wm * 64 + i * 32 + (r >> 2) * 8 + lh * 4 + (r & 3);
#pragma unroll
      for (int j = 0; j < 2; ++j) {
        const int col = n0 + wn * 64 + j * 32 + l31;
        const float v = acc[i][j][r];
        if (EPI == 0) ea.cb[(size_t)row * ea.ldc + col] = f2bf(v);
        else if (EPI == 1) {
          const float* rp = ea.res1 ? (row < TP ? ea.res0 + (size_t)row * DM : ea.res1 + (size_t)(row - TP) * DM) : ea.res0 + (size_t)row * DM;
          ea.yout[(size_t)row * DM + col] = rp[col] + v;
        } else if (EPI == 4) { unsafeAtomicAdd(ea.yout + (size_t)row * DM + col, v); }
        else if (EPI == 2) { const float rl = v > 0.f ? v : 0.f; ea.cb[(size_t)row * ea.ldc + col] = f2bf(rl * rl); }
        else ea.cf[(size_t)row * ea.ldc + col] = v;
      }
    }
}
template <int EPI>
DEVI void gemm_phase(const bf16_t* A, int lda, const bf16_t* Bt, int K, int M, int N, const EpiArgs& ea, unsigned char* smem) {
  const int nM = M >> 7, nN = N >> 7, nwg = nM * nN;
  const int q = nwg >> 3, r = nwg & 7;
  for (int L = blockIdx.x; L < nwg; L += gridDim.x) {
    const int xcd = L & 7, off = L >> 3;
    const int wg = (xcd < r ? xcd * (q + 1) : r * (q + 1) + (xcd - r) * q) + off;
    const int nig = 8 * nN, gid = wg / nig, fm = gid * 8, gsz = (nM - fm) < 8 ? (nM - fm) : 8;
    const int pm = fm + ((wg % nig) % gsz), pn = (wg % nig) / gsz;
    gemm_tile<EPI>(A, lda, Bt, K, K, pm << 7, pn << 7, ea, smem);
  }
}


template <int EPI>
DEVI void gemm_tile_big(const bf16_t* __restrict__ A, int lda, const bf16_t* __restrict__ Bt, int ldb, int K, int m0, int n0, const EpiArgs& ea, unsigned char* smem) {
  const int tid = get_tid(), lane = tid & 63, wave = tid >> 6;
  const int wm = wave >> 1, wn = wave & 1, l31 = lane & 31, lh = lane >> 5;
  bf16_t* sA = (bf16_t*)smem;
  bf16_t* sB = sA + 256 * 72;
  f32x16 acc[4][2];
#pragma unroll
  for (int i = 0; i < 4; ++i)
#pragma unroll
    for (int j = 0; j < 2; ++j)
#pragma unroll
      for (int r = 0; r < 16; ++r) acc[i][j][r] = 0.f;
  const int lr = tid >> 3, lc = (tid & 7) * 8;
  const bf16_t* gA = A + (size_t)(m0 + lr) * lda + lc;
  const bf16_t* gB = Bt + (size_t)(n0 + lr) * ldb + lc;
  u4 ra[8], rb[4];
#define B_ISSUE(K0) { _Pragma("unroll") for (int i = 0; i < 8; ++i) GLOAD16(ra[i], gA + (size_t)i * 32 * lda + (K0)); _Pragma("unroll") for (int i = 0; i < 4; ++i) GLOAD16(rb[i], gB + (size_t)i * 32 * ldb + (K0)); }
#define B_STASH() { _Pragma("unroll") for (int i = 0; i < 8; ++i) *(u4*)(sA + (lr + i * 32) * 72 + lc) = ra[i]; _Pragma("unroll") for (int i = 0; i < 4; ++i) *(u4*)(sB + (lr + i * 32) * 72 + lc) = rb[i]; }
  const int nk = K >> 6;
  VMWAIT(0);
  B_ISSUE(0);
  __syncthreads();
  VMWAIT(0);
  B_STASH();
  LDS_BARRIER();
  for (int kt = 0; kt < nk; ++kt) {
    B_ISSUE(((kt + 1 < nk) ? kt + 1 : kt) << 6);
    {
      __builtin_amdgcn_s_setprio(1);
      const bf16_t* cA = sA + (wm * 128 + l31) * 72 + lh * 8;
      const bf16_t* cB = sB + (wn * 64 + l31) * 72 + lh * 8;
#pragma unroll
      for (int ks = 0; ks < 4; ++ks) {
        const bf16x8 b0 = *(const bf16x8*)(cB + ks * 16), b1 = *(const bf16x8*)(cB + 32 * 72 + ks * 16);
#pragma unroll
        for (int i = 0; i < 4; ++i) {
          const bf16x8 a = *(const bf16x8*)(cA + i * 32 * 72 + ks * 16);
          acc[i][0] = MFMA32(a, b0, acc[i][0]); acc[i][1] = MFMA32(a, b1, acc[i][1]);
        }
      }
      __builtin_amdgcn_s_setprio(0);
    }
    LDS_BARRIER();
    VMWAIT(0);
    if (kt + 1 < nk) B_STASH();
    LDS_BARRIER();
  }
#pragma unroll
  for (int i = 0; i < 8; ++i) asm volatile("" :: "v"(ra[i]));
#pragma unroll
  for (int i = 0; i < 4; ++i) asm volatile("" :: "v"(rb[i]));
#undef B_ISSUE
#undef B_STASH
#pragma unroll
  for (int i = 0; i < 4; ++i)
#pragma unroll
    for (int r = 0; r < 16; ++r) {
      const int row = m0 + wm * 128 + i * 32 + (r >> 2) * 8 + lh * 4 + (r & 3);
#pragma unroll
      for (int j = 0; j < 2; ++j) {
        const int col = n0 + wn * 64 + j * 32 + l31;
        const float v = acc[i][j][r];
        if (EPI == 0) ea.cb[(size_t)row * ea.ldc + col] = f2bf(v);
        else if (EPI == 1) { const float* rp = ea.res0 + (size_t)row * DM; ea.yout[(size_t)row * DM + col] = rp[col] + v; }
        else if (EPI == 2) { const float rl = v > 0.f ? v : 0.f; ea.cb[(size_t)row * ea.ldc + col] = f2bf(rl * rl); }
      }
      if ((r & 3) == 3) __builtin_amdgcn_sched_barrier(0);
    }
}
template <int EPI>
DEVI void gemm_phase_big(const bf16_t* A, int lda, const bf16_t* Bt, int K, int N, const EpiArgs& ea, unsigned char* smem) {
  const int nM = TP >> 8, nN = N >> 7, nwg = nM * nN;
  const int q = nwg >> 3, r = nwg & 7;
  for (int L = blockIdx.x; L < nwg; L += gridDim.x) {
    const int xcd = L & 7, off = L >> 3;
    const int wg = (xcd < r ? xcd * (q + 1) : r * (q + 1) + (xcd - r) * q) + off;
    const int nig = 8 * nN, gid = wg / nig, fm = gid * 8, gsz = (nM - fm) < 8 ? (nM - fm) : 8;
    const int pm = fm + ((wg % nig) % gsz), pn = (wg % nig) / gsz;
    gemm_tile_big<EPI>(A, lda, Bt, K, K, pm << 8, pn << 7, ea, smem);
  }
}
template <int EPI>
DEVI void gemm_phase_sample(const bf16_t* A, int lda, const bf16_t* Bt, int K, int N, const EpiArgs& ea, unsigned char* smem) {
  const int nN = N >> 7;
  for (int t = blockIdx.x; t < 4 * nN; t += gridDim.x) gemm_tile<EPI>(A, lda, Bt, K, K, TP + ((t / nN) << 7), (t % nN) << 7, ea, smem);
}

DEVI void gemm_phase_res(const bf16_t* A, int lda, const bf16_t* Bt, int K, const EpiArgs& ea, unsigned char* smem) {
  gemm_phase_big<1>(A, lda, Bt, K, 1024, ea, smem);
  const int S = (K == 4096) ? 16 : (K >> 7), klen = K / S;
  for (int it = blockIdx.x; it < 32 * S; it += gridDim.x) {
    const int tile = it / S, ks = it % S;
    gemm_tile<4>(A + (size_t)ks * klen, lda, Bt + (size_t)ks * klen, K, klen, TP + ((tile >> 3) << 7), (tile & 7) << 7, ea, smem);
  }
}

DEVI void convert_tile(const float* __restrict__ W, bf16_t* __restrict__ Wt, int K, int N, int k0, int n0, int thr, int shift, unsigned char* smem) {
  float* tile = (float*)smem;
  const int tid = get_tid();
  __syncthreads();
#pragma unroll
  for (int i = 0; i < 4; ++i) {
    const int r = (tid >> 4) + 16 * i, c = (tid & 15) * 4;
    float4 v = make_float4(0.f, 0.f, 0.f, 0.f);
    if (n0 + c < N) v = *(const float4*)(W + (size_t)(k0 + r) * N + n0 + c);
    tile[r * 65 + c] = v.x; tile[r * 65 + c + 1] = v.y; tile[r * 65 + c + 2] = v.z; tile[r * 65 + c + 3] = v.w;
  }
  __syncthreads();
  const int n = tid >> 2, kc = (tid & 3) * 16;
  if (n0 + n < N) {
    const int nn = n0 + n, nd = nn + (nn >= thr ? shift : 0);
    unsigned o[8];
#pragma unroll
    for (int e = 0; e < 8; ++e) o[e] = pk2(tile[(kc + 2 * e) * 65 + n], tile[(kc + 2 * e + 1) * 65 + n]);
    u4* dst = (u4*)(Wt + (size_t)nd * K + k0 + kc);
    dst[0] = mk4(o[0], o[1], o[2], o[3]); dst[1] = mk4(o[4], o[5], o[6], o[7]);
  }
}
DEVI void convert_group(int& base, int bid, int nb, const float* W, bf16_t* Wt, int nl, int K, int N, int NPAD, int thr, int shift, unsigned char* smem) {
  const int tk = K >> 6, tn = (N + 63) >> 6, per = tk * tn, tot = per * nl;
  int first = ((bid - base) % nb + nb) % nb;
  for (int t = first; t < tot; t += nb) {
    const int l = t / per, r = t % per;
    convert_tile(W + (size_t)l * K * N, Wt + (size_t)l * NPAD * K, K, N, (r / tn) << 6, (r % tn) << 6, thr, shift, smem);
  }
  base += tot;
}

DEVI void norm_row(const float* __restrict__ src, const float* __restrict__ gain, bf16_t* __restrict__ dst, int lane) {
  float4 v[4]; float ss = 0.f;
#pragma unroll
  for (int i = 0; i < 4; ++i) { v[i] = *(const float4*)(src + lane * 4 + 256 * i); ss += v[i].x * v[i].x + v[i].y * v[i].y + v[i].z * v[i].z + v[i].w * v[i].w; }
  ss = wave_sum(ss);
  const float sc = rsqrtf(ss * (1.f / 1024.f) + EPS);
#pragma unroll
  for (int i = 0; i < 4; ++i) {
    const float4 g = *(const float4*)(gain + lane * 4 + 256 * i);
    u2 o; o.x = pk2(v[i].x * sc * g.x, v[i].y * sc * g.y); o.y = pk2(v[i].z * sc * g.z, v[i].w * sc * g.w);
    *(u2*)(dst + lane * 4 + 256 * i) = o;
  }
}

DEVI void norm_row2(const float* __restrict__ s0, const float* __restrict__ s1, const float* __restrict__ gain, bf16_t* __restrict__ d0, bf16_t* __restrict__ d1, int lane) {
  float4 v[4], w[4]; float ss = 0.f, tt = 0.f;
#pragma unroll
  for (int i = 0; i < 4; ++i) { v[i] = *(const float4*)(s0 + lane * 4 + 256 * i); w[i] = *(const float4*)(s1 + lane * 4 + 256 * i); }
#pragma unroll
  for (int i = 0; i < 4; ++i) { ss += v[i].x * v[i].x + v[i].y * v[i].y + v[i].z * v[i].z + v[i].w * v[i].w; tt += w[i].x * w[i].x + w[i].y * w[i].y + w[i].z * w[i].z + w[i].w * w[i].w; }
#pragma unroll
  for (int o = 32; o >= 1; o >>= 1) { ss += __shfl_xor(ss, o); tt += __shfl_xor(tt, o); }
  const float sc = rsqrtf(ss * (1.f / 1024.f) + EPS), tc = rsqrtf(tt * (1.f / 1024.f) + EPS);
#pragma unroll
  for (int i = 0; i < 4; ++i) {
    const float4 g = *(const float4*)(gain + lane * 4 + 256 * i);
    u2 o; o.x = pk2(v[i].x * sc * g.x, v[i].y * sc * g.y); o.y = pk2(v[i].z * sc * g.z, v[i].w * sc * g.w);
    *(u2*)(d0 + lane * 4 + 256 * i) = o;
    u2 q; q.x = pk2(w[i].x * tc * g.x, w[i].y * tc * g.y); q.y = pk2(w[i].z * tc * g.z, w[i].w * tc * g.w);
    *(u2*)(d1 + lane * 4 + 256 * i) = q;
  }
}
DEVI void norm_all(const float* __restrict__ Y, const float* __restrict__ gain, bf16_t* __restrict__ XN, int gw, int ngw, int lane) {
  for (int r = gw; r < TA; r += ngw) norm_row(Y + (size_t)r * DM, gain, XN + (size_t)r * DM, lane);
}

struct KVSrc { const void* k; const void* v; int kpitch, vpitch, f32; };
template <int D>
DEVI void attn_load(const KVSrc& s, int r0, u4 (&kr)[D / 32], u4 (&vr)[D / 32]) {
  const int tid = get_tid();
#pragma unroll
  for (int i = 0; i < D / 32; ++i) {
    const int c = tid + 256 * i, key = c / (D / 8), dch = c % (D / 8);
    if (s.f32) {
      const float* kp = (const float*)s.k + (size_t)(r0 + key) * s.kpitch + dch * 8;
      const float* vp = (const float*)s.v + (size_t)(r0 + key) * s.vpitch + dch * 8;
      const float4 a = *(const float4*)kp, b = *(const float4*)(kp + 4), c2 = *(const float4*)vp, d2 = *(const float4*)(vp + 4);
      kr[i] = mk4(pk2(a.x, a.y), pk2(a.z, a.w), pk2(b.x, b.y), pk2(b.z, b.w));
      vr[i] = mk4(pk2(c2.x, c2.y), pk2(c2.z, c2.w), pk2(d2.x, d2.y), pk2(d2.z, d2.w));
      __builtin_amdgcn_sched_barrier(0);
    } else {
      kr[i] = *(const u4*)((const bf16_t*)s.k + (size_t)(r0 + key) * s.kpitch + dch * 8);
      vr[i] = *(const u4*)((const bf16_t*)s.v + (size_t)(r0 + key) * s.vpitch + dch * 8);
    }
  }
}
template <int D>
DEVI void attn_store(bf16_t* Ks, bf16_t* Vt, const u4 (&kr)[D / 32], const u4 (&vr)[D / 32]) {
  const int tid = get_tid();
#pragma unroll
  for (int i = 0; i < D / 32; ++i) {
    const int c = tid + 256 * i, key = c / (D / 8), dch = c % (D / 8);
    *(u4*)(Ks + key * (D + 8) + dch * 8) = kr[i];
    const int kx = key ^ ((dch & 15) << 2);
    const unsigned w[4] = {vr[i].x, vr[i].y, vr[i].z, vr[i].w};
#pragma unroll
    for (int e = 0; e < 8; ++e) Vt[(dch * 8 + e) * 72 + kx] = (bf16_t)((w[e >> 1] >> (16 * (e & 1))) & 0xffffu);
  }
}

template <int D, int MODE>
DEVI void attn_item(const bf16_t* __restrict__ qsrc, int qpitch, int nq, const float* __restrict__ qgain, float qscale,
                    const KVSrc& segA, int nA, int qposA0, int maskA, const KVSrc& segB, int nB,
                    bf16_t* __restrict__ out, int opitch, unsigned char* smem, float* __restrict__ carry_out = nullptr) {
  constexpr int KPT = D + 8, NKS = D / 16, NDB = D / 32, NCH = D / 32;
  constexpr int STAGE = 64 * KPT + D * 72;
  const int tid = get_tid(), lane = tid & 63, wave = tid >> 6, l31 = lane & 31, lh = lane >> 5;
  bf16_t* sbase = (bf16_t*)smem;
  const bool active = wave * 32 < nq;
  bf16x8 qf[NKS];
  {
    float qv[NKS][8]; float ss = 0.f;
    const bf16_t* qp = qsrc + (size_t)(wave * 32 + l31) * qpitch + lh * 8;
#pragma unroll
    for (int ks = 0; ks < NKS; ++ks) {
      u4 u = mk4(0, 0, 0, 0);
      if (active) u = *(const u4*)(qp + ks * 16);
      const unsigned w[4] = {u.x, u.y, u.z, u.w};
#pragma unroll
      for (int e = 0; e < 4; ++e) { qv[ks][2 * e] = lo2f(w[e]); qv[ks][2 * e + 1] = hi2f(w[e]); }
#pragma unroll
      for (int e = 0; e < 8; ++e) ss += qv[ks][e] * qv[ks][e];
    }
    ss += __shfl_xor(ss, 32);
    const float sc = rsqrtf(ss * (1.f / D) + EPS) * qscale;
#pragma unroll
    for (int ks = 0; ks < NKS; ++ks) {
      const float4 g0 = *(const float4*)(qgain + ks * 16 + lh * 8), g1 = *(const float4*)(qgain + ks * 16 + lh * 8 + 4);
      u4 u;
      u.x = pk2(qv[ks][0] * sc * g0.x, qv[ks][1] * sc * g0.y); u.y = pk2(qv[ks][2] * sc * g0.z, qv[ks][3] * sc * g0.w);
      u.z = pk2(qv[ks][4] * sc * g1.x, qv[ks][5] * sc * g1.y); u.w = pk2(qv[ks][6] * sc * g1.z, qv[ks][7] * sc * g1.w);
      qf[ks] = as_frag(u);
    }
  }
  f32x16 oacc[NDB];
#pragma unroll
  for (int db = 0; db < NDB; ++db)
#pragma unroll
    for (int r = 0; r < 16; ++r) oacc[db][r] = 0.f;
  float carry = 1.f, mx = -1e30f, lsum = 0.f;
  const int ntot = nA + nB;
  const int qpos = qposA0 + wave * 32 + l31;
  u4 kr[NCH], vr[NCH];
  {
    const bool inA = 0 < nA; const int tix = inA ? nA - 1 : nB - 1;
    attn_load<D>(inA ? segA : segB, tix * 64, kr, vr);
    __syncthreads();
    attn_store<D>(sbase, sbase + 64 * KPT, kr, vr);
    __syncthreads();
  }
  for (int it = 0; it < ntot; ++it) {
    const int cur = it & 1;
    if (it + 1 < ntot) {
      const bool nInA = (it + 1) < nA; const int tix = nInA ? nA - 2 - it : nB - 1 - (it + 1 - nA);
      attn_load<D>(nInA ? segA : segB, tix * 64, kr, vr);
    }
    const bool inA = it < nA;
    const int kbase = inA ? (nA - 1 - it) * 64 : 0;
    const bf16_t* Ks = sbase + cur * STAGE;
    const bf16_t* Vt = Ks + 64 * KPT;
    const bool mneed = inA && maskA && (kbase + 63 >= qposA0 + wave * 32);
    const bool skip = !active || (inA && maskA && (kbase > qposA0 + wave * 32 + 31));
    if (!skip) {
      bf16x8 pf[2][2];
      if (MODE == 0) {
        float after = carry;
#pragma unroll
        for (int rt = 1; rt >= 0; --rt) {
          f32x16 z;
#pragma unroll
          for (int r = 0; r < 16; ++r) z[r] = 0.f;
#pragma unroll
          for (int ks = 0; ks < NKS; ++ks) {
            const bf16x8 a = *(const bf16x8*)(Ks + (rt * 32 + l31) * KPT + ks * 16 + lh * 8);
            z = MFMA32(a, qf[ks], z);
          }
          float ee[16], rr[16];
#pragma unroll
          for (int i = 0; i < 16; ++i) {
            float e = ex2(z[i]);
            if (mneed) { const int key = kbase + rt * 32 + (i >> 2) * 8 + lh * 4 + (i & 3); if (key >= qpos) e = 0.f; }
            ee[i] = e; rr[i] = __builtin_amdgcn_rcpf(1.f + e);
          }
          float a_[16];
#pragma unroll
          for (int g = 3; g >= 0; --g) {
            const float s4 = (rr[g * 4] * rr[g * 4 + 1]) * (rr[g * 4 + 2] * rr[g * 4 + 3]);
            const float p4 = __shfl_xor(s4, 32);
            float c = lh == 0 ? after * p4 : after;
            after *= s4 * p4;
#pragma unroll
            for (int e = 3; e >= 0; --e) { c *= rr[g * 4 + e]; a_[g * 4 + e] = ee[g * 4 + e] * c; }
          }
#pragma unroll
          for (int s2 = 0; s2 < 2; ++s2)
            pf[rt][s2] = as_frag(mk4(pk2(a_[8 * s2 + 0], a_[8 * s2 + 1]), pk2(a_[8 * s2 + 2], a_[8 * s2 + 3]), pk2(a_[8 * s2 + 4], a_[8 * s2 + 5]), pk2(a_[8 * s2 + 6], a_[8 * s2 + 7])));
        }
        carry = after;
      } else {
        f32x16 z[2];
#pragma unroll
        for (int rt = 0; rt < 2; ++rt) {
          f32x16 zt;
#pragma unroll
          for (int r = 0; r < 16; ++r) zt[r] = 0.f;
#pragma unroll
          for (int ks = 0; ks < NKS; ++ks) {
            const bf16x8 a = *(const bf16x8*)(Ks + (rt * 32 + l31) * KPT + ks * 16 + lh * 8);
            zt = MFMA32(a, qf[ks], zt);
          }
          z[rt] = zt;
        }
        float tm = z[0][0];
#pragma unroll
        for (int rt = 0; rt < 2; ++rt)
#pragma unroll
          for (int i = 0; i < 16; ++i) tm = fmaxf(tm, z[rt][i]);
        tm = fmaxf(tm, __shfl_xor(tm, 32));
        const float nm = fmaxf(mx, tm);
        const float alpha = ex2(mx - nm);
        mx = nm;
        float ps = 0.f;
        float a_[2][16];
#pragma unroll
        for (int rt = 0; rt < 2; ++rt)
#pragma unroll
          for (int i = 0; i < 16; ++i) { a_[rt][i] = ex2(z[rt][i] - nm); ps += a_[rt][i]; }
        lsum = lsum * alpha + ps;
#pragma unroll
        for (int db = 0; db < NDB; ++db)
#pragma unroll
          for (int r = 0; r < 16; ++r) oacc[db][r] *= alpha;
#pragma unroll
        for (int rt = 0; rt < 2; ++rt)
#pragma unroll
          for (int s2 = 0; s2 < 2; ++s2)
            pf[rt][s2] = as_frag(mk4(pk2(a_[rt][8 * s2 + 0], a_[rt][8 * s2 + 1]), pk2(a_[rt][8 * s2 + 2], a_[rt][8 * s2 + 3]), pk2(a_[rt][8 * s2 + 4], a_[rt][8 * s2 + 5]), pk2(a_[rt][8 * s2 + 6], a_[rt][8 * s2 + 7])));
      }
#pragma unroll
      for (int db = 0; db < NDB; ++db) {
        const int d = db * 32 + l31, sw = ((d >> 3) & 15) << 2;
#pragma unroll
        for (int rt = 0; rt < 2; ++rt)
#pragma unroll
          for (int s = 0; s < 2; ++s) {
            const int kb0 = rt * 32 + 16 * s + 4 * lh;
            const u2 lo = *(const u2*)(Vt + d * 72 + (kb0 ^ sw));
            const u2 hi = *(const u2*)(Vt + d * 72 + ((kb0 + 8) ^ sw));
            oacc[db] = MFMA32(as_frag(mk4(lo.x, lo.y, hi.x, hi.y)), pf[rt][s], oacc[db]);
          }
      }
    }
    if (it + 1 < ntot) { bf16_t* nK = sbase + (cur ^ 1) * STAGE; attn_store<D>(nK, nK + 64 * KPT, kr, vr); }
    LDS_BARRIER();
  }
  if (active && carry_out && lh == 0) carry_out[(size_t)(wave * 32 + l31) * 4] = carry;
  if (active) {
    float inv = 1.f;
    if (MODE == 1) { const float l = lsum + __shfl_xor(lsum, 32); inv = 1.f / l; }
    bf16_t* op = out + (size_t)(wave * 32 + l31) * opitch + lh * 4;
#pragma unroll
    for (int db = 0; db < NDB; ++db)
#pragma unroll
      for (int g = 0; g < 4; ++g) {
        u2 o; o.x = pk2(oacc[db][g * 4] * inv, oacc[db][g * 4 + 1] * inv); o.y = pk2(oacc[db][g * 4 + 2] * inv, oacc[db][g * 4 + 3] * inv);
        *(u2*)(op + db * 32 + g * 8) = o;
      }
  }
}

DEVI void mem_attn_item(const KP& p, int layer, int item, const bf16_t* P, int np, int mqoff, bf16_t* mix, int mixp, int mixoff, unsigned char* smem) {
  const int h = item & 3;
  int t0, nq; const float *kk, *vv;
  if (item < 512) { t0 = (item >> 2) * 128; nq = 128; kk = p.out + O_PMK + (size_t)layer * 65536; vv = p.out + O_PMV + (size_t)layer * 65536; }
  else { const int b = (item - 512) >> 2; t0 = TP + b * 64; nq = 64; kk = p.in[6] + ((size_t)layer * 8 + b) * 65536; vv = p.in[7] + ((size_t)layer * 8 + b) * 65536; }
  KVSrc s; s.k = kk + h * 64; s.v = vv + h * 64; s.kpitch = 256; s.vpitch = 256; s.f32 = 1;
  attn_item<64, 1>(P + (size_t)t0 * np + mqoff + h * 64, np, nq, p.in[15] + layer * 64, 0.125f * LOG2E, s, 4, 0, 0, s, 0,
                   mix + (size_t)t0 * mixp + mixoff + h * 64, mixp, smem);
}

DEVI void gdn_prep_item(const KP& p, int j, int ci, int h, const bf16_t* P, unsigned char* smem) {
  constexpr int NP = NP_GDN;
  const int tid = get_tid(), lane = tid & 63, wave = tid >> 6;
  const int item = ci * 6 + h;
  const bool samp = ci >= 256;
  const int b = ci - 256;
  const int t0 = samp ? TP + b * 64 : ci * 64;
  float* stage = (float*)smem;
  float* sL = (float*)smem;
  bf16_t* qn = (bf16_t*)(smem + 33280);
  bf16_t* kn = qn + 64 * 136;
  float* sgc = (float*)(smem + 33280 + 2 * 64 * 136 * 2);
  float* sbeta = sgc + 64;
  float* segc = sbeta + 64;
  unsigned char* gi = p.ws + WS_G + (size_t)item * G_ITEM;
  bf16_t* gU = (bf16_t*)gi; bf16_t* gW = gU + 8192; bf16_t* gQD = gW + 8192; bf16_t* gKDT = gQD + 8192; bf16_t* gAI = gKDT + 8192;
  const float* convw = p.in[17] + (size_t)j * 4 * 2304;
  const float* cstate = p.in[2] + ((size_t)j * 8 + (samp ? b : 0)) * 3 * 2304;
  const bf16_t* Pc = P + (size_t)t0 * NP;
  __syncthreads();
  if (wave == 0) {
    const float braw = bf2f(Pc[(size_t)lane * NP + 3072 + h]), araw = bf2f(Pc[(size_t)lane * NP + 3078 + h]);
    const float beta = 1.f / (1.f + __expf(-braw));
    const float xx = araw + p.in[19][j * 6 + h];
    const float sp = xx > 20.f ? xx : __logf(1.f + __expf(xx));
    float g = -__expf(p.in[18][j * 6 + h]) * sp;
#pragma unroll
    for (int d = 1; d < 64; d <<= 1) { const float v = __shfl_up(g, d); if (lane >= d) g += v; }
    sgc[lane] = g; sbeta[lane] = beta; segc[lane] = __expf(g);
    if (lane == 63) ((float*)(p.ws + WS_GL))[item] = __expf(g);
  }
  if (samp || ci == 255) {
    float* dst = samp ? p.out + O_SGC + ((size_t)j * 8 + b) * 3 * 2304 : p.out + O_PGC + (size_t)j * 3 * 2304;
    for (int idx = tid; idx < 1152; idx += 256) {
      const int r = idx / 384, cc = idx % 384, ch = (cc >> 7) * 768 + h * 128 + (cc & 127);
      dst[r * 2304 + ch] = bf2f(Pc[(size_t)(61 + r) * NP + ch]);
    }
  }
  const float gcl_dummy = 0.f; (void)gcl_dummy;
#pragma unroll 1
  for (int which = 0; which < 2; ++which) {
    {
      const int c = tid & 127, th = tid >> 7, ch = which * 768 + h * 128 + c;
      const float w0 = convw[ch], w1 = convw[2304 + ch], w2 = convw[2 * 2304 + ch], w3 = convw[3 * 2304 + ch];
      float xm3, xm2, xm1;
      if (th == 1) { xm3 = bf2f(Pc[(size_t)29 * NP + ch]); xm2 = bf2f(Pc[(size_t)30 * NP + ch]); xm1 = bf2f(Pc[(size_t)31 * NP + ch]); }
      else if (samp) { xm3 = cstate[ch]; xm2 = cstate[2304 + ch]; xm1 = cstate[2 * 2304 + ch]; }
      else if (ci == 0) { xm3 = xm2 = xm1 = 0.f; }
      else { xm3 = bf2f(Pc[-(ptrdiff_t)3 * NP + ch]); xm2 = bf2f(Pc[-(ptrdiff_t)2 * NP + ch]); xm1 = bf2f(Pc[-(ptrdiff_t)NP + ch]); }
      const bf16_t* pp = Pc + (size_t)(th * 32) * NP + ch;
#pragma unroll 8
      for (int tt = 0; tt < 32; ++tt) {
        const float x0 = bf2f(pp[(size_t)tt * NP]);
        const float y = w0 * xm3 + w1 * xm2 + w2 * xm1 + w3 * x0;
        stage[(th * 32 + tt) * 129 + c] = silu(y);
        xm3 = xm2; xm2 = xm1; xm1 = x0;
      }
    }
    __syncthreads();
    {
      const int tt = tid >> 2, part = tid & 3;
      float v[32]; float ss = 0.f;
#pragma unroll
      for (int e = 0; e < 32; ++e) { v[e] = stage[tt * 129 + part * 32 + e]; ss += v[e] * v[e]; }
      ss += __shfl_xor(ss, 1); ss += __shfl_xor(ss, 2);
      float rinv = rsqrtf(ss + EPS);
      if (which == 0) rinv *= 0.08838834764831845f;
      bf16_t* dn = (which == 0 ? qn : kn) + tt * 136 + part * 32;
      const float eg = segc[tt];
#pragma unroll
      for (int e = 0; e < 32; e += 8) {
        u4 u; u.x = pk2(v[e] * rinv, v[e + 1] * rinv); u.y = pk2(v[e + 2] * rinv, v[e + 3] * rinv); u.z = pk2(v[e + 4] * rinv, v[e + 5] * rinv); u.w = pk2(v[e + 6] * rinv, v[e + 7] * rinv);
        *(u4*)(dn + e) = u;
        if (which == 0) {
          const float s2 = rinv * eg;
          u4 w; w.x = pk2(v[e] * s2, v[e + 1] * s2); w.y = pk2(v[e + 2] * s2, v[e + 3] * s2); w.z = pk2(v[e + 4] * s2, v[e + 5] * s2); w.w = pk2(v[e + 6] * s2, v[e + 7] * s2);
          *(u4*)(gQD + tt * 128 + part * 32 + e) = w;
        }
      }
    }
    __syncthreads();
  }
  {
    const int d = tid & 127, th = tid >> 7;
    const float gcl = sgc[63];
#pragma unroll
    for (int q8 = 0; q8 < 4; ++q8) {
      float f[8];
#pragma unroll
      for (int e = 0; e < 8; ++e) { const int tt = th * 32 + q8 * 8 + e; f[e] = bf2f(kn[tt * 136 + d]) * __expf(gcl - sgc[tt]); }
      *(u4*)(gKDT + d * 64 + th * 32 + q8 * 8) = mk4(pk2(f[0], f[1]), pk2(f[2], f[3]), pk2(f[4], f[5]), pk2(f[6], f[7]));
    }
  }
  {
    const int l31 = lane & 31, lh = lane >> 5, ri = wave >> 1, cj = wave & 1;
    f32x16 kk, qk;
#pragma unroll
    for (int r = 0; r < 16; ++r) { kk[r] = 0.f; qk[r] = 0.f; }
#pragma unroll
    for (int ks = 0; ks < 8; ++ks) {
      const bf16x8 ak = *(const bf16x8*)(kn + (ri * 32 + l31) * 136 + ks * 16 + lh * 8);
      const bf16x8 aq = *(const bf16x8*)(qn + (ri * 32 + l31) * 136 + ks * 16 + lh * 8);
      const bf16x8 bk = *(const bf16x8*)(kn + (cj * 32 + l31) * 136 + ks * 16 + lh * 8);
      kk = MFMA32(ak, bk, kk); qk = MFMA32(aq, bk, qk);
    }
    const int jj = cj * 32 + l31; const float gj = sgc[jj];
#pragma unroll
    for (int r = 0; r < 16; ++r) {
      const int ii = ri * 32 + (r >> 2) * 8 + lh * 4 + (r & 3);
      const float dec = ii >= jj ? __expf(sgc[ii] - gj) : 0.f;
      sL[ii * 64 + jj] = ii > jj ? sbeta[ii] * kk[r] * dec : 0.f;
      gAI[ii * 64 + jj] = f2bf(qk[r] * dec);
    }
  }
  __syncthreads();
  {
    float x[64];
    if (tid < 128) {
      const int ch = 1536 + h * 128 + tid;
      const float w0 = convw[ch], w1 = convw[2304 + ch], w2 = convw[2 * 2304 + ch], w3 = convw[3 * 2304 + ch];
      float xm3, xm2, xm1;
      if (samp) { xm3 = cstate[ch]; xm2 = cstate[2304 + ch]; xm1 = cstate[2 * 2304 + ch]; }
      else if (ci == 0) { xm3 = xm2 = xm1 = 0.f; }
      else { xm3 = bf2f(Pc[-(ptrdiff_t)3 * NP + ch]); xm2 = bf2f(Pc[-(ptrdiff_t)2 * NP + ch]); xm1 = bf2f(Pc[-(ptrdiff_t)NP + ch]); }
#pragma unroll
      for (int tt = 0; tt < 64; ++tt) {
        const float x0 = bf2f(Pc[(size_t)tt * NP + ch]);
        const float y = w0 * xm3 + w1 * xm2 + w2 * xm1 + w3 * x0;
        x[tt] = silu(y) * sbeta[tt];
        xm3 = xm2; xm2 = xm1; xm1 = x0;
        if ((tt & 7) == 7) __builtin_amdgcn_sched_barrier(0);
      }
    } else {
#pragma unroll
      for (int tt = 0; tt < 64; ++tt) { x[tt] = bf2f(kn[tt * 136 + tid - 128]) * sbeta[tt] * segc[tt]; if ((tt & 7) == 7) __builtin_amdgcn_sched_barrier(0); }
    }
#pragma unroll
    for (int i = 1; i < 64; ++i) {
      float a = x[i];
#pragma unroll
      for (int jx = 0; jx < i; ++jx) a -= sL[i * 64 + jx] * x[jx];
      x[i] = a;
      __builtin_amdgcn_sched_barrier(0);
    }
    if (tid < 128) {
#pragma unroll
      for (int t8 = 0; t8 < 8; ++t8) {
        *(u4*)(gU + tid * 64 + t8 * 8) = mk4(pk2(x[t8 * 8], x[t8 * 8 + 1]), pk2(x[t8 * 8 + 2], x[t8 * 8 + 3]), pk2(x[t8 * 8 + 4], x[t8 * 8 + 5]), pk2(x[t8 * 8 + 6], x[t8 * 8 + 7]));
        __builtin_amdgcn_sched_barrier(0);
      }
    } else {
      bf16_t* dst = gW + (tid & 127);
#pragma unroll
      for (int tt = 0; tt < 64; ++tt) { dst[tt * 128] = f2bf(x[tt]); if ((tt & 7) == 7) __builtin_amdgcn_sched_barrier(0); }
    }
  }
}

struct ScanFrags { u4 w[4], qd[4], ai[2], kdt[2][2]; u2 u; float gl; };
DEVI void scan_load(const KP& p, int item, int wave, int lane, int sl, ScanFrags& f) {
  const int n = lane & 15, g = lane >> 4;
  const unsigned char* gi = p.ws + WS_G + (size_t)item * G_ITEM;
  const bf16_t* gU = (const bf16_t*)gi; const bf16_t* gW = gU + 8192; const bf16_t* gQD = gW + 8192; const bf16_t* gKDT = gQD + 8192; const bf16_t* gAI = gKDT + 8192;
#pragma unroll
  for (int s = 0; s < 4; ++s) { GLOAD16(f.w[s], gW + (16 * wave + n) * 128 + 32 * s + 8 * g); GLOAD16(f.qd[s], gQD + (16 * wave + n) * 128 + 32 * s + 8 * g); }
#pragma unroll
  for (int s = 0; s < 2; ++s) {
    GLOAD16(f.ai[s], gAI + (16 * wave + n) * 64 + 32 * s + 8 * g);
#pragma unroll
    for (int tt = 0; tt < 2; ++tt) GLOAD16(f.kdt[tt][s], gKDT + (32 * wave + 16 * tt + n) * 64 + 32 * s + 8 * g);
  }
  const bf16_t* up = gU + (sl * 16 + n) * 64 + 16 * wave + 4 * g;
  asm volatile("global_load_dwordx2 %0, %1, off" : "=&v"(f.u) : "v"(up) : "memory");
  const float* glp = (const float*)(p.ws + WS_GL) + item;
  asm volatile("global_load_dword %0, %1, off" : "=&v"(f.gl) : "v"(glp) : "memory");
}
DEVI void scan_wait32(ScanFrags& f) {
  asm volatile("s_waitcnt vmcnt(32)"
               : "+v"(f.w[0]), "+v"(f.w[1]), "+v"(f.w[2]), "+v"(f.w[3]), "+v"(f.qd[0]), "+v"(f.qd[1]), "+v"(f.qd[2]), "+v"(f.qd[3]),
                 "+v"(f.ai[0]), "+v"(f.ai[1]), "+v"(f.kdt[0][0]), "+v"(f.kdt[0][1]), "+v"(f.kdt[1][0]), "+v"(f.kdt[1][1]),
                 "+v"(f.u), "+v"(f.gl)
               :: "memory");
}
DEVI void scan_keep(const ScanFrags& f) {
#pragma unroll
  for (int s = 0; s < 4; ++s) asm volatile("" :: "v"(f.w[s]), "v"(f.qd[s]));
#pragma unroll
  for (int s = 0; s < 2; ++s) asm volatile("" :: "v"(f.ai[s]), "v"(f.kdt[0][s]), "v"(f.kdt[1][s]));
  asm volatile("" :: "v"(f.u), "v"(f.gl));
}
DEVI void scan_step(const ScanFrags& f, f32x4 (&sacc)[2], bf16_t* St, bf16_t* Vnt, bf16_t* O, int t0, int h, int sl, int wave, int n, int g) {
  bf16x8 sf[4];
#pragma unroll
  for (int s = 0; s < 4; ++s) sf[s] = *(const bf16x8*)(St + n * 136 + 32 * s + 8 * g);
  f32x4 wsa = {0.f, 0.f, 0.f, 0.f}, oa = {0.f, 0.f, 0.f, 0.f};
#pragma unroll
  for (int s = 0; s < 4; ++s) wsa = MFMA16(as_frag(f.w[s]), sf[s], wsa);
  float vn[4];
  vn[0] = lo2f(f.u.x) - wsa[0]; vn[1] = hi2f(f.u.x) - wsa[1]; vn[2] = lo2f(f.u.y) - wsa[2]; vn[3] = hi2f(f.u.y) - wsa[3];
  { u2 o; o.x = pk2(vn[0], vn[1]); o.y = pk2(vn[2], vn[3]); *(u2*)(Vnt + n * 72 + 16 * wave + 4 * g) = o; }
#pragma unroll
  for (int s = 0; s < 4; ++s) oa = MFMA16(as_frag(f.qd[s]), sf[s], oa);
  LDS_BARRIER();
  bf16x8 vf[2];
#pragma unroll
  for (int s = 0; s < 2; ++s) vf[s] = *(const bf16x8*)(Vnt + n * 72 + 32 * s + 8 * g);
#pragma unroll
  for (int s = 0; s < 2; ++s) oa = MFMA16(as_frag(f.ai[s]), vf[s], oa);
#pragma unroll
  for (int r = 0; r < 4; ++r) O[(size_t)(t0 + 16 * wave + 4 * g + r) * 768 + h * 128 + sl * 16 + n] = f2bf(oa[r]);
#pragma unroll
  for (int tt = 0; tt < 2; ++tt) {
#pragma unroll
    for (int r = 0; r < 4; ++r) sacc[tt][r] *= f.gl;
#pragma unroll
    for (int s = 0; s < 2; ++s) sacc[tt] = MFMA16(as_frag(f.kdt[tt][s]), vf[s], sacc[tt]);
    u2 o; o.x = pk2(sacc[tt][0], sacc[tt][1]); o.y = pk2(sacc[tt][2], sacc[tt][3]);
    *(u2*)(St + n * 136 + 32 * wave + 16 * tt + 4 * g) = o;
  }
  LDS_BARRIER();
}
DEVI void gdn_scan_stream(const KP& p, int j, int ci0, int nch, int h, int sl, const float* s0, float* sout, bf16_t* O, unsigned char* smem) {
  const int tid = get_tid(), lane = tid & 63, wave = tid >> 6, n = lane & 15, g = lane >> 4;
  bf16_t* St = (bf16_t*)smem;
  bf16_t* Vnt = St + 16 * 136;
  f32x4 sacc[2];
#pragma unroll
  for (int tt = 0; tt < 2; ++tt)
#pragma unroll
    for (int r = 0; r < 4; ++r) sacc[tt][r] = s0 ? s0[(size_t)(32 * wave + 16 * tt + 4 * g + r) * 128 + sl * 16 + n] : 0.f;
  __syncthreads();
#pragma unroll
  for (int tt = 0; tt < 2; ++tt) { u2 o; o.x = pk2(sacc[tt][0], sacc[tt][1]); o.y = pk2(sacc[tt][2], sacc[tt][3]); *(u2*)(St + n * 136 + 32 * wave + 16 * tt + 4 * g) = o; }
  ScanFrags f0, f1, f2;
#define CL(c) ((ci0 + (((c) < nch) ? (c) : nch - 1)) * 6 + h)
#define T0(c) (((ci0 + (c)) >= 256) ? TP + (ci0 + (c) - 256) * 64 : (ci0 + (c)) * 64)
  VMWAIT(0);
  scan_load(p, CL(0), wave, lane, sl, f0);
  scan_load(p, CL(1), wave, lane, sl, f1);
  LDS_BARRIER();
  for (int c = 0; c < nch; c += 3) {
    scan_load(p, CL(c + 2), wave, lane, sl, f2); scan_wait32(f0);
    scan_step(f0, sacc, St, Vnt, O, T0(c), h, sl, wave, n, g);
    if (c + 1 < nch) {
      scan_load(p, CL(c + 3), wave, lane, sl, f0); scan_wait32(f1);
      scan_step(f1, sacc, St, Vnt, O, T0(c + 1), h, sl, wave, n, g);
    }
    if (c + 2 < nch) {
      scan_load(p, CL(c + 4), wave, lane, sl, f1); scan_wait32(f2);
      scan_step(f2, sacc, St, Vnt, O, T0(c + 2), h, sl, wave, n, g);
    }
  }
  VMWAIT(0);
  scan_keep(f0); scan_keep(f1); scan_keep(f2);
#undef CL
#undef T0
#pragma unroll
  for (int tt = 0; tt < 2; ++tt)
#pragma unroll
    for (int r = 0; r < 4; ++r) sout[(size_t)(32 * wave + 16 * tt + 4 * g + r) * 128 + sl * 16 + n] = sacc[tt][r];
}

DEVI int next_item(unsigned* ctr) {
  __shared__ int s_item;
  __syncthreads();
  if (get_tid() == 0) s_item = (int)atomicAdd(ctr, 1u);
  __syncthreads();
  return s_item;
}

DEVI unsigned xcc_id() { return (unsigned)__builtin_amdgcn_s_getreg((3 << 11) | 20) & 0xFu; }
DEVI unsigned ld_relaxed(unsigned* p) { return __hip_atomic_load(p, __ATOMIC_RELAXED, __HIP_MEMORY_SCOPE_AGENT); }
DEVI void gbar_setup(unsigned* ctr, unsigned nb, unsigned* sb) {
  if (get_tid() == 0) {
    const unsigned x = xcc_id();
    __hip_atomic_fetch_add(ctr + 544 + 8 * x, 1u, __ATOMIC_RELAXED, __HIP_MEMORY_SCOPE_AGENT);
    unsigned nx, mine;
    for (;;) {
      unsigned sum = 0; nx = 0; mine = 0;
      for (unsigned j = 0; j < 16; ++j) { const unsigned c = ld_relaxed(ctr + 544 + 8 * j); sum += c; nx += c ? 1u : 0u; mine = (j == x) ? c : mine; }
      if (sum == nb) break;
      __builtin_amdgcn_s_sleep(2);
    }
    sb[0] = x; sb[1] = mine; sb[2] = nx;
  }
  __syncthreads();
}
DEVI void gbar(unsigned* ctr, unsigned* sb, unsigned& gen) {
  asm volatile("s_waitcnt vmcnt(0)" ::: "memory");
  __syncthreads();
  gen++;
  if (get_tid() == 0) {
    const unsigned x = sb[0], nloc = sb[1], nx = sb[2];
    const unsigned old = __hip_atomic_fetch_add(ctr + 704 + 8 * x, 1u, __ATOMIC_RELAXED, __HIP_MEMORY_SCOPE_AGENT);
    if (old + 1u == gen * nloc) {
      __builtin_amdgcn_fence(__ATOMIC_RELEASE, "agent");
      asm volatile("s_waitcnt vmcnt(0)" ::: "memory");
      __hip_atomic_fetch_add(ctr + 528, 1u, __ATOMIC_RELAXED, __HIP_MEMORY_SCOPE_AGENT);
    }
    for (unsigned it = 0; ld_relaxed(ctr + 528) < gen * nx; ++it) {
      if (it < 8) __builtin_amdgcn_s_sleep(4); else if (it < 24) __builtin_amdgcn_s_sleep(32); else __builtin_amdgcn_s_sleep(127);
    }
    __builtin_amdgcn_fence(__ATOMIC_ACQUIRE, "agent");
    asm volatile("s_waitcnt vmcnt(0)" ::: "memory");
  }
  __syncthreads();
}
#ifndef ONLY
#define ENAB(k) true
#else
#define ENAB(k) ((ONLY) == (k))
#endif
__global__ void __launch_bounds__(256, 2) mk_fwd(KP p) {
  __shared__ __attribute__((aligned(16))) unsigned char smem[73728];
  cg::grid_group grid = cg::this_grid();
  const int bid = blockIdx.x, nb = gridDim.x;
  const int ngw = nb * 4;
  unsigned char* ws = p.ws;
  unsigned* ctr = (unsigned*)(ws + WS_CTR);
  float* Y = p.out + O_YP;
  bf16_t* XN = (bf16_t*)(ws + WS_XN);
  bf16_t* MIX = (bf16_t*)(ws + WS_MIX);
  bf16_t* Pb = (bf16_t*)(ws + WS_P);
  bf16_t* Hb = (bf16_t*)(ws + WS_H);
  bool did = false;
  unsigned bgen = 0;
  __shared__ unsigned s_bar[4];
  gbar_setup(ctr, nb, s_bar);
  grid.sync();
  for (int ph = p.ph_lo; ph < p.ph_hi; ++ph) {
    const int layer = ph == 0 ? 0 : (ph - 1) / 9, sub = ph == 0 ? -1 : (ph - 1) % 9;
    const int kind = layer & 1, j = layer >> 1;
    if (sub == 8 && layer == 3) continue;
    if (did) gbar(ctr, s_bar, bgen);
    did = true;
    const int np = kind ? NP_SB : NP_GDN, mqoff = kind ? MQ_SB : MQ_GDN, mixp = kind ? 768 : 1024, mixoff = kind ? 512 : 768;
    if (ph == 0 && ENAB(0)) {
      const int tid = get_tid(), lane = tid & 63, gw = bid * 4 + (tid >> 6); (void)tid; (void)lane; (void)gw;
      int base = 0;
      convert_group(base, bid, nb, p.in[12], (bf16_t*)(ws + WS_WIG), 2, 1024, 3340, 3456, 3084, 116, smem);
      convert_group(base, bid, nb, p.in[13], (bf16_t*)(ws + WS_WIS), 2, 1024, 1792, 1792, 1 << 30, 0, smem);
      convert_group(base, bid, nb, p.in[14], (bf16_t*)(ws + WS_WKV), 4, 1024, 512, 512, 1 << 30, 0, smem);
      convert_group(base, bid, nb, p.in[23], (bf16_t*)(ws + WS_WOG), 2, 1024, 1024, 1024, 1 << 30, 0, smem);
      convert_group(base, bid, nb, p.in[24], (bf16_t*)(ws + WS_WOS), 2, 768, 1024, 1024, 1 << 30, 0, smem);
      convert_group(base, bid, nb, p.in[25], (bf16_t*)(ws + WS_WUP), 4, 1024, 4096, 4096, 1 << 30, 0, smem);
      convert_group(base, bid, nb, p.in[26], (bf16_t*)(ws + WS_WDN), 4, 4096, 1024, 1024, 1 << 30, 0, smem);
      for (int r = gw; r < TA; r += ngw) norm_row(r < TP ? p.in[0] + (size_t)r * DM : p.in[1] + (size_t)(r - TP) * DM, p.in[9], XN + (size_t)r * DM, lane);
      for (int i = bid * 256 + tid; i < TS * DM / 4; i += nb * 256) ((float4*)(Y + (size_t)TP * DM))[i] = ((const float4*)p.in[1])[i];
      for (int r = gw; r < 1024; r += ngw) norm_row(p.in[8] + (size_t)(r & 255) * DM, p.in[10] + (r >> 8) * DM, (bf16_t*)(ws + WS_MEMN) + (size_t)r * DM, lane);
    } else if (sub == 0 && ENAB(1)) {
      EpiArgs ea{}; ea.cb = Pb; ea.ldc = np;
      const bf16_t* wt = kind ? (const bf16_t*)(ws + WS_WIS) + (size_t)j * 1792 * 1024 : (const bf16_t*)(ws + WS_WIG) + (size_t)j * 3456 * 1024;
      gemm_phase<0>(XN, DM, wt, 1024, TA, np, ea, smem);
      if (layer == 0) {
        for (int t = bid; t < 32; t += nb) {
          const int l = t >> 3, r = t & 7;
          EpiArgs e2{}; e2.cf = (float*)(ws + WS_MEMKV) + (size_t)l * 256 * 512; e2.ldc = 512;
          gemm_tile<3>((const bf16_t*)(ws + WS_MEMN) + (size_t)l * 256 * DM, DM, (const bf16_t*)(ws + WS_WKV) + (size_t)l * 512 * DM, DM, 1024, (r >> 2) << 7, (r & 3) << 7, e2, smem);
        }
      }
    } else if (sub == 1 && ENAB(2)) {
      const int tid = get_tid(), lane = tid & 63, gw = bid * 4 + (tid >> 6); (void)tid; (void)lane; (void)gw;
      if (layer == 0) {
        const float* kv = (const float*)(ws + WS_MEMKV);
        for (int it = gw; it < 4096; it += ngw) {
          const int l = it >> 10, m = (it >> 2) & 255, hh = it & 3;
          const float kx = kv[((size_t)l * 256 + m) * 512 + hh * 64 + lane], vx = kv[((size_t)l * 256 + m) * 512 + 256 + hh * 64 + lane];
          const float ss = wave_sum(kx * kx);
          p.out[O_PMK + ((size_t)l * 256 + m) * 256 + hh * 64 + lane] = kx * rsqrtf(ss * (1.f / 64.f) + EPS) * p.in[16][l * 64 + lane];
          p.out[O_PMV + ((size_t)l * 256 + m) * 256 + hh * 64 + lane] = vx;
        }
      }
      if (kind == 0) {
        for (int it = bid; it < NITEM; it += nb) gdn_prep_item(p, j, it / 6, it % 6, Pb, smem);
      } else {
        bf16_t* Kb = (bf16_t*)(ws + WS_G);
        const float* kg = p.in[22] + j * 128;
        for (int t = gw; t < TA; t += ngw) {
          const bf16_t* pr = Pb + (size_t)t * np;
          const u4 ku = *(const u4*)(pr + 512 + lane * 8), vu = *(const u4*)(pr + 1024 + lane * 8);
          float kf[8] = {lo2f(ku.x), hi2f(ku.x), lo2f(ku.y), hi2f(ku.y), lo2f(ku.z), hi2f(ku.z), lo2f(ku.w), hi2f(ku.w)};
          float ss = 0.f;
#pragma unroll
          for (int e = 0; e < 8; ++e) ss += kf[e] * kf[e];
          ss += __shfl_xor(ss, 1); ss += __shfl_xor(ss, 2); ss += __shfl_xor(ss, 4); ss += __shfl_xor(ss, 8);
          const float sc = rsqrtf(ss * (1.f / 128.f) + EPS);
          const int c0 = (lane & 15) * 8;
#pragma unroll
          for (int e = 0; e < 8; ++e) kf[e] *= sc * kg[c0 + e];
          float* ok = t < TP ? p.out + O_PSK + ((size_t)j * TP + t) * 512 : p.out + O_SSK + ((size_t)j * TS + (t - TP)) * 512;
          float* ov = t < TP ? p.out + O_PSV + ((size_t)j * TP + t) * 512 : p.out + O_SSV + ((size_t)j * TS + (t - TP)) * 512;
          *(float4*)(ok + lane * 8) = make_float4(kf[0], kf[1], kf[2], kf[3]); *(float4*)(ok + lane * 8 + 4) = make_float4(kf[4], kf[5], kf[6], kf[7]);
          *(float4*)(ov + lane * 8) = make_float4(lo2f(vu.x), hi2f(vu.x), lo2f(vu.y), hi2f(vu.y)); *(float4*)(ov + lane * 8 + 4) = make_float4(lo2f(vu.z), hi2f(vu.z), lo2f(vu.w), hi2f(vu.w));
          *(u4*)(Kb + (size_t)t * 512 + lane * 8) = mk4(pk2(kf[0], kf[1]), pk2(kf[2], kf[3]), pk2(kf[4], kf[5]), pk2(kf[6], kf[7]));
        }
      }
    } else if (sub == 2 && ENAB(3)) {
      unsigned* c = ctr + layer * 4;
      if (kind == 0) {
        bf16_t* O = XN;
        if (bid < 64 && (bid & 7) < 6) {
          const int h = bid & 7, sl = bid >> 3;
          gdn_scan_stream(p, j, 0, 256, h, sl, nullptr, p.out + O_PGS + ((size_t)j * 6 + h) * 16384, O, smem);
        }
        for (;;) {
          const int it = next_item(c);
          if (it >= 384 + 544) break;
          if (it < 384) { const int b = it / 48, r = it % 48, h = r >> 3, sl = r & 7;
            gdn_scan_stream(p, j, 256 + b, 1, h, sl, p.in[3] + (((size_t)j * 8 + b) * 6 + h) * 16384, p.out + O_SGS + (((size_t)j * 8 + b) * 6 + h) * 16384, O, smem);
          } else mem_attn_item(p, layer, it - 384, Pb, np, mqoff, MIX, mixp, mixoff, smem);
        }
      } else {
        const bf16_t* Kb = (const bf16_t*)(ws + WS_G);
        bf16_t* OFAR = (bf16_t*)(ws + WS_G + (32ull << 20));
        float* CARRY = (float*)(ws + WS_G + (64ull << 20));
        const float qs = 0.08838834764831845f * LOG2E;
        for (;;) {
          const int it = next_item(c);
          if (it >= 768 + 32 + 544) break;
          if (it < 768) {
            int qb, idx, whole;
            if (it < 640) { const int pr = it / 20, r = it % 20; if (r < 8) { qb = 127 - 2 * pr; idx = r; whole = 0; } else if (r < 12) { qb = 63 - pr; idx = r - 8; whole = 1; } else { qb = 126 - 2 * pr; idx = r - 12; whole = 0; } }
            else { qb = 31 - ((it - 640) >> 2); idx = (it - 640) & 3; whole = 1; }
            const int h = whole ? idx : (idx >> 1), far = whole ? 0 : (idx & 1), near_ = (!whole && !far);
            const int nAi = whole ? 2 * qb + 2 : qb + 1, koff = near_ ? (qb + 1) * 64 : 0;
            KVSrc s; s.k = Kb + (size_t)koff * 512 + h * 128; s.v = Pb + (size_t)koff * np + 1024 + h * 128; s.kpitch = 512; s.vpitch = np; s.f32 = 0;
            bf16_t* op = far ? OFAR + (size_t)(qb * 128) * 512 + h * 128 : MIX + (size_t)(qb * 128) * mixp + h * 128;
            float* co = near_ ? CARRY + (size_t)(qb * 128) * 4 + h : nullptr;
            attn_item<128, 0>(Pb + (size_t)(qb * 128) * np + h * 128, np, 128, p.in[21] + j * 128, qs, s, nAi, qb * 128 - koff, far ? 0 : 1, s, 0, op, far ? 512 : mixp, smem, co);
          } else if (it < 800) {
            const int b = (it - 768) >> 2, h = it & 3, t0 = TP + b * 64;
            KVSrc sa; sa.k = Kb + (size_t)t0 * 512 + h * 128; sa.v = Pb + (size_t)t0 * np + 1024 + h * 128; sa.kpitch = 512; sa.vpitch = np; sa.f32 = 0;
            KVSrc sb; sb.k = p.in[4] + ((size_t)j * 8 + b) * 2048 * 512 + h * 128; sb.v = p.in[5] + ((size_t)j * 8 + b) * 2048 * 512 + h * 128; sb.kpitch = 512; sb.vpitch = 512; sb.f32 = 1;
            attn_item<128, 0>(Pb + (size_t)t0 * np + h * 128, np, 64, p.in[21] + j * 128, qs, sa, 1, 0, 1, sb, 32,
                              MIX + (size_t)t0 * mixp + h * 128, mixp, smem);
          } else mem_attn_item(p, layer, it - 800, Pb, np, mqoff, MIX, mixp, mixoff, smem);
        }
      }
    } else if (sub == 3 && kind == 1) {
      const int tid = get_tid(), lane = tid & 63, gw = bid * 4 + (tid >> 6); (void)tid; (void)lane; (void)gw;
      const bf16_t* OFAR = (const bf16_t*)(ws + WS_G + (32ull << 20));
      const float* CARRY = (const float*)(ws + WS_G + (64ull << 20));
      for (int t = TP / 2 + gw; t < TP; t += ngw) {
        const u4 a = *(const u4*)(MIX + (size_t)t * mixp + lane * 8), b = *(const u4*)(OFAR + (size_t)t * 512 + lane * 8);
        const float sc = CARRY[(size_t)t * 4 + (lane >> 4)];
        u4 o;
        o.x = pk2(lo2f(a.x) + sc * lo2f(b.x), hi2f(a.x) + sc * hi2f(b.x)); o.y = pk2(lo2f(a.y) + sc * lo2f(b.y), hi2f(a.y) + sc * hi2f(b.y));
        o.z = pk2(lo2f(a.z) + sc * lo2f(b.z), hi2f(a.z) + sc * hi2f(b.z)); o.w = pk2(lo2f(a.w) + sc * lo2f(b.w), hi2f(a.w) + sc * hi2f(b.w));
        *(u4*)(MIX + (size_t)t * mixp + lane * 8) = o;
      }
    } else if (sub == 3 && ENAB(4)) {
      const int tid = get_tid(), lane = tid & 63, gw = bid * 4 + (tid >> 6); (void)tid; (void)lane; (void)gw;
      const bf16_t* O = XN;
      const float* og = p.in[20] + j * 128;
      for (int it = gw; it < TA * 6; it += ngw) {
        const int t = it / 6, h = it % 6;
        const unsigned ou = *(const unsigned*)(O + (size_t)t * 768 + h * 128 + lane * 2);
        const unsigned zu = *(const unsigned*)(Pb + (size_t)t * np + 2304 + h * 128 + lane * 2);
        const float o0 = lo2f(ou), o1 = hi2f(ou), z0 = lo2f(zu), z1 = hi2f(zu);
        const float ss = wave_sum(o0 * o0 + o1 * o1);
        const float sc = rsqrtf(ss * (1.f / 128.f) + EPS);
        *(unsigned*)(MIX + (size_t)t * 1024 + h * 128 + lane * 2) = pk2(o0 * sc * og[lane * 2] * silu(z0), o1 * sc * og[lane * 2 + 1] * silu(z1));
      }
    } else if (sub == 4 && ENAB(5)) {
      EpiArgs ea{}; ea.yout = Y;
      if (layer == 0) { ea.res0 = p.in[0]; ea.res1 = p.in[1]; } else { ea.res0 = Y; ea.res1 = nullptr; }
      const bf16_t* wt = kind ? (const bf16_t*)(ws + WS_WOS) + (size_t)j * 1024 * 768 : (const bf16_t*)(ws + WS_WOG) + (size_t)j * 1024 * 1024;
      gemm_phase_res(MIX, mixp, wt, mixp, ea, smem);
    } else if (sub == 5) {
      const int tid = get_tid(), lane = tid & 63, gw = bid * 4 + (tid >> 6); (void)tid; (void)lane; (void)gw;
      norm_all(Y, p.in[11] + layer * DM, XN, gw, ngw, lane);
    } else if (sub == 6 && ENAB(6)) {
      EpiArgs ea{}; ea.cb = Hb; ea.ldc = DFF;
      gemm_phase_big<2>(XN, DM, (const bf16_t*)(ws + WS_WUP) + (size_t)layer * 4096 * 1024, 1024, 4096, ea, smem);
      gemm_phase_sample<2>(XN, DM, (const bf16_t*)(ws + WS_WUP) + (size_t)layer * 4096 * 1024, 1024, 4096, ea, smem);
    } else if (sub == 7 && ENAB(7)) {
      EpiArgs ea{}; ea.yout = Y; ea.res0 = Y; ea.res1 = nullptr;
      gemm_phase_res(Hb, DFF, (const bf16_t*)(ws + WS_WDN) + (size_t)layer * 1024 * 4096, 4096, ea, smem);
    } else if (sub == 8) {
      const int tid = get_tid(), lane = tid & 63, gw = bid * 4 + (tid >> 6); (void)tid; (void)lane; (void)gw;
      norm_all(Y, p.in[9] + (layer + 1) * DM, XN, gw, ngw, lane);
    }
  }
}

extern "C" void kernel_launch(void* const* d_in, const int* in_sizes, int n_in, void* d_out, int out_size, void* d_ws, size_t ws_size, hipStream_t stream) {
  static int grid_blocks = 0;
  if (!grid_blocks) {
    int dev = 0, cus = 0, per_cu = 0;
    (void)hipGetDevice(&dev);
    (void)hipDeviceGetAttribute(&cus, hipDeviceAttributeMultiprocessorCount, dev);
    (void)hipOccupancyMaxActiveBlocksPerMultiprocessor(&per_cu, mk_fwd, 256, 0);
    if (per_cu > 2) per_cu = 2;
    if (per_cu < 1) per_cu = 1;
    grid_blocks = cus * per_cu;
    if (ws_size < WS_END) fprintf(stderr, "kernel_launch: workspace too small: %zu < %zu\n", ws_size, (size_t)WS_END);
  }
  (void)hipMemsetAsync((char*)d_ws + WS_CTR, 0, 4096, stream);
  KP p{};
  for (int i = 0; i < 27; ++i) p.in[i] = (const float*)d_in[i];
  p.out = (float*)d_out; p.ws = (unsigned char*)d_ws; p.ph_lo = 0; p.ph_hi = 37;
  void* args[] = {&p};
  hipError_t e = hipLaunchCooperativeKernel((void*)mk_fwd, dim3(grid_blocks), dim3(256), args, 0, stream);
  if (e != hipSuccess) fprintf(stderr, "cooperative launch failed: %s (grid %d)\n", hipGetErrorString(e), grid_blocks);
}
```

```cpp
#include <hip/hip_runtime.h>
#include <hip/hip_cooperative_groups.h>
#include <cstdio>
#include <cstdint>
namespace cg = cooperative_groups;

typedef unsigned short bf16_t;
typedef short bf16x8 __attribute__((ext_vector_type(8)));
typedef float f32x16 __attribute__((ext_vector_type(16)));
typedef float f32x4 __attribute__((ext_vector_type(4)));
typedef unsigned u4 __attribute__((ext_vector_type(4)));
typedef unsigned u2 __attribute__((ext_vector_type(2)));
#define DEVI __device__ __forceinline__
__device__ __forceinline__ u4 mk4(unsigned a, unsigned b, unsigned c, unsigned d) { u4 r; r.x = a; r.y = b; r.z = c; r.w = d; return r; }
__device__ __forceinline__ u2 mk2(unsigned a, unsigned b) { u2 r; r.x = a; r.y = b; return r; }
#define MFMA32(a, b, c) __builtin_amdgcn_mfma_f32_32x32x16_bf16((a), (b), (c), 0, 0, 0)
#define LDS_BARRIER() do { asm volatile("s_waitcnt lgkmcnt(0)" ::: "memory"); __builtin_amdgcn_s_barrier(); } while (0)
#define GLOAD16(dst, ptr) asm volatile("global_load_dwordx4 %0, %1, off" : "=&v"(dst) : "v"(ptr) : "memory")
#define VMWAIT(n) asm volatile("s_waitcnt vmcnt(" #n ")" ::: "memory")
#define MFMA16(a, b, c) __builtin_amdgcn_mfma_f32_16x16x32_bf16((a), (b), (c), 0, 0, 0)

constexpr int DM = 1024, TP = 16384, TS = 512, TA = TP + TS, DFF = 4096;
constexpr int NP_GDN = 3456, NP_SB = 1792, MQ_GDN = 3200, MQ_SB = 1536;
constexpr int NCHUNK = 264, NITEM = NCHUNK * 6;
constexpr float EPS = 1e-6f;
constexpr float LOG2E = 1.4426950408889634f;
constexpr size_t O_YP = 0, O_PGC = 17301504, O_PGS = 17315328, O_PSK = 17511936, O_PSV = 34289152, O_PMK = 51066368, O_PMV = 51328512,
                 O_SGC = 51590656, O_SGS = 51701248, O_SSK = 53274112, O_SSV = 53798400;
constexpr size_t WS_CTR = 0;
constexpr size_t WS_WIG = 4096;
constexpr size_t WS_WIS = WS_WIG + 2ull * 3456 * 1024 * 2;
constexpr size_t WS_WKV = WS_WIS + 2ull * 1792 * 1024 * 2;
constexpr size_t WS_WOG = WS_WKV + 4ull * 512 * 1024 * 2;
constexpr size_t WS_WOS = WS_WOG + 2ull * 1024 * 1024 * 2;
constexpr size_t WS_WUP = WS_WOS + 2ull * 1024 * 768 * 2;
constexpr size_t WS_WDN = WS_WUP + 4ull * 4096 * 1024 * 2;
constexpr size_t WS_XN = WS_WDN + 4ull * 4096 * 1024 * 2;
constexpr size_t WS_MIX = WS_XN + (size_t)TA * 1024 * 2;
constexpr size_t WS_MEMN = WS_MIX + (size_t)TA * 1024 * 2;
constexpr size_t WS_MEMKV = WS_MEMN + 4ull * 256 * 1024 * 2;
constexpr size_t WS_BIG = WS_MEMKV + 4ull * 256 * 512 * 4;
constexpr size_t WS_P = WS_BIG;
constexpr size_t WS_G = WS_P + (size_t)TA * 3456 * 2;
constexpr size_t G_ITEM = 73728;
constexpr size_t WS_GL = WS_G + (size_t)NITEM * G_ITEM;
constexpr size_t WS_H = WS_BIG;
constexpr size_t WS_END = WS_GL + 8192;

struct KP { const float* in[27]; float* out; unsigned char* ws; int ph_lo, ph_hi; };

DEVI int get_tid() { int t = __builtin_amdgcn_workitem_id_x(); asm volatile("" : "+v"(t)); return t; }
DEVI float bf2f(bf16_t b) { return __uint_as_float(((unsigned)b) << 16); }
typedef float f32x2_t __attribute__((ext_vector_type(2)));
typedef __bf16 bf16x2_t __attribute__((ext_vector_type(2)));
DEVI unsigned pk2(float lo, float hi) { f32x2_t v = {lo, hi}; return __builtin_bit_cast(unsigned, __builtin_convertvector(v, bf16x2_t)); }
DEVI bf16_t f2bf(float f) { return (bf16_t)(pk2(f, 0.f) & 0xffffu); }
DEVI float lo2f(unsigned u) { return __uint_as_float(u << 16); }
DEVI float hi2f(unsigned u) { return __uint_as_float(u & 0xffff0000u); }
DEVI float ex2(float x) { return __builtin_amdgcn_exp2f(x); }
DEVI float lg2(float x) { return __builtin_amdgcn_logf(x); }
DEVI float wave_sum(float v) {
#pragma unroll
  for (int o = 32; o >= 1; o >>= 1) v += __shfl_xor(v, o);
  return v;
}
DEVI bf16x8 as_frag(u4 u) { return __builtin_bit_cast(bf16x8, u); }
DEVI float silu(float y) { return y / (1.f + __expf(-y)); }

struct EpiArgs { bf16_t* cb; float* cf; int ldc; const float* res0; const float* res1; float* yout; };
template <int EPI>
DEVI void gemm_tile(const bf16_t* __restrict__ A, int lda, const bf16_t* __restrict__ Bt, int ldb, int K, int m0, int n0, const EpiArgs& ea, unsigned char* smem) {
  const int tid = get_tid(), lane = tid & 63, wave = tid >> 6;
  const int wm = wave >> 1, wn = wave & 1, l31 = lane & 31, lh = lane >> 5;
  bf16_t* sA = (bf16_t*)smem;
  bf16_t* sB = sA + 2 * 128 * 72;
  f32x16 acc[2][2];
#pragma unroll
  for (int i = 0; i < 2; ++i)
#pragma unroll
    for (int j = 0; j < 2; ++j)
#pragma unroll
      for (int r = 0; r < 16; ++r) acc[i][j][r] = 0.f;
  const int lr = tid >> 3, lc = (tid & 7) * 8;
  const bf16_t* gA = A + (size_t)(m0 + lr) * lda + lc;
  const bf16_t* gB = Bt + (size_t)(n0 + lr) * ldb + lc;
  u4 ra0[4], rb0[4], ra1[4], rb1[4];
#define G_ISSUE(RA, RB, K0) { _Pragma("unroll") for (int i = 0; i < 4; ++i) { GLOAD16(RA[i], gA + (size_t)i * 32 * lda + (K0)); GLOAD16(RB[i], gB + (size_t)i * 32 * ldb + (K0)); } }
#define G_STASH(RA, RB, BUF) { _Pragma("unroll") for (int i = 0; i < 4; ++i) { *(u4*)(sA + (BUF) * 128 * 72 + (lr + i * 32) * 72 + lc) = RA[i]; *(u4*)(sB + (BUF) * 128 * 72 + (lr + i * 32) * 72 + lc) = RB[i]; } }
#define G_COMPUTE(BUF) { __builtin_amdgcn_s_setprio(1); const bf16_t* cA = sA + (BUF) * 128 * 72 + (wm * 64 + l31) * 72 + lh * 8; const bf16_t* cB = sB + (BUF) * 128 * 72 + (wn * 64 + l31) * 72 + lh * 8; \
    _Pragma("unroll") for (int ks = 0; ks < 4; ++ks) { \
      bf16x8 a0 = *(const bf16x8*)(cA + ks * 16), a1 = *(const bf16x8*)(cA + 32 * 72 + ks * 16); \
      bf16x8 b0 = *(const bf16x8*)(cB + ks * 16), b1 = *(const bf16x8*)(cB + 32 * 72 + ks * 16); \
      acc[0][0] = MFMA32(a0, b0, acc[0][0]); acc[0][1] = MFMA32(a0, b1, acc[0][1]); \
      acc[1][0] = MFMA32(a1, b0, acc[1][0]); acc[1][1] = MFMA32(a1, b1, acc[1][1]); } __builtin_amdgcn_s_setprio(0); }
  const int nk = K >> 6;
  VMWAIT(0);
  G_ISSUE(ra0, rb0, 0);
  G_ISSUE(ra1, rb1, 64);
  __syncthreads();
  VMWAIT(8);
  G_STASH(ra0, rb0, 0);
  LDS_BARRIER();
  for (int kt = 0; kt < nk; kt += 2) {
    G_ISSUE(ra0, rb0, ((kt + 2 < nk) ? kt + 2 : nk - 1) << 6);
    G_COMPUTE(0);
    VMWAIT(8);
    G_STASH(ra1, rb1, 1);
    LDS_BARRIER();
    G_ISSUE(ra1, rb1, ((kt + 3 < nk) ? kt + 3 : nk - 1) << 6);
    G_COMPUTE(1);
    VMWAIT(8);
    if (kt + 2 < nk) G_STASH(ra0, rb0, 0);
    LDS_BARRIER();
  }
  VMWAIT(0);
#pragma unroll
  for (int i = 0; i < 4; ++i) asm volatile("" :: "v"(ra0[i]), "v"(rb0[i]), "v"(ra1[i]), "v"(rb1[i]));
#undef G_ISSUE
#undef G_STASH
#undef G_COMPUTE
#pragma unroll
  for (int i = 0; i < 2; ++i)
#pragma unroll
    for (int r = 0; r < 16; ++r) {
      const int row = m0 + wm * 64 + i * 32 + (r >> 2) * 8 + lh * 4 + (r & 3);
#pragma unroll
      for (int j = 0; j < 2; ++j) {
        const int col = n0 + wn * 64 + j * 32 + l31;
        const float v = acc[i][j][r];
        if (EPI == 0) ea.cb[(size_t)row * ea.ldc + col] = f2bf(v);
        else if (EPI == 1) {
          const float* rp = ea.res1 ? (row < TP ? ea.res0 + (size_t)row * DM : ea.res1 + (size_t)(row - TP) * DM) : ea.res0 + (size_t)row * DM;
          ea.yout[(size_t)row * DM + col] = rp[col] + v;
        } else if (EPI == 4) { unsafeAtomicAdd(ea.yout + (size_t)row * DM + col, v); }
        else if (EPI == 2) { const float rl = v > 0.f ? v : 0.f; ea.cb[(size_t)row * ea.ldc + col] = f2bf(rl * rl); }
        else ea.cf[(size_t)row * ea.ldc + col] = v;
      }
    }
}
template <int EPI>
DEVI void gemm_phase(const bf16_t* A, int lda, const bf16_t* Bt, int K, int M, int N, const EpiArgs& ea, unsigned char* smem) {
  const int nM = M >> 7, nN = N >> 7, nwg = nM * nN;
  const int q = nwg >> 3, r = nwg & 7;
  for (int L = blockIdx.x; L < nwg; L += gridDim.x) {
    const int xcd = L & 7, off = L >> 3;
    const int wg = (xcd < r ? xcd * (q + 1) : r * (q + 1) + (xcd - r) * q) + off;
    const int nig = 8 * nN, gid = wg / nig, fm = gid * 8, gsz = (nM - fm) < 8 ? (nM - fm) : 8;
    const int pm = fm + ((wg % nig) % gsz), pn = (wg % nig) / gsz;
    gemm_tile<EPI>(A, lda, Bt, K, K, pm << 7, pn << 7, ea, smem);
  }
}


template <int EPI>
DEVI void gemm_tile_big(const bf16_t* __restrict__ A, int lda, const bf16_t* __restrict__ Bt, int ldb, int K, int m0, int n0, const EpiArgs& ea, unsigned char* smem) {
  const int tid = get_tid(), lane = tid & 63, wave = tid >> 6;
  const int wm = wave >> 1, wn = wave & 1, l31 = lane & 31, lh = lane >> 5;
  bf16_t* sA = (bf16_t*)smem;
  bf16_t* sB = sA + 256 * 72;
  f32x16 acc[4][2];
#pragma unroll
  for (int i = 0; i < 4; ++i)
#pragma unroll
    for (int j = 0; j < 2; ++j)
#pragma unroll
      for (int r = 0; r < 16; ++r) acc[i][j][r] = 0.f;
  const int lr = tid >> 3, lc = (tid & 7) * 8;
  const bf16_t* gA = A + (size_t)(m0 + lr) * lda + lc;
  const bf16_t* gB = Bt + (size_t)(n0 + lr) * ldb + lc;
  u4 ra[8], rb[4];
#define B_ISSUE(K0) { _Pragma("unroll") for (int i = 0; i < 8; ++i) GLOAD16(ra[i], gA + (size_t)i * 32 * lda + (K0)); _Pragma("unroll") for (int i = 0; i < 4; ++i) GLOAD16(rb[i], gB + (size_t)i * 32 * ldb + (K0)); }
#define B_STASH() { _Pragma("unroll") for (int i = 0; i < 8; ++i) *(u4*)(sA + (lr + i * 32) * 72 + lc) = ra[i]; _Pragma("unroll") for (int i = 0; i < 4; ++i) *(u4*)(sB + (lr + i * 32) * 72 + lc) = rb[i]; }
  const int nk = K >> 6;
  VMWAIT(0);
  B_ISSUE(0);
  __syncthreads();
  VMWAIT(0);
  B_STASH();
  LDS_BARRIER();
  for (int kt = 0; kt < nk; ++kt) {
    B_ISSUE(((kt + 1 < nk) ? kt + 1 : kt) << 6);
    {
      __builtin_amdgcn_s_setprio(1);
      const bf16_t* cA = sA + (wm * 128 + l31) * 72 + lh * 8;
      const bf16_t* cB = sB + (wn * 64 + l31) * 72 + lh * 8;
#pragma unroll
      for (int ks = 0; ks < 4; ++ks) {
        const bf16x8 b0 = *(const bf16x8*)(cB + ks * 16), b1 = *(const bf16x8*)(cB + 32 * 72 + ks * 16);
#pragma unroll
        for (int i = 0; i < 4; ++i) {
          const bf16x8 a = *(const bf16x8*)(cA + i * 32 * 72 + ks * 16);
          acc[i][0] = MFMA32(a, b0, acc[i][0]); acc[i][1] = MFMA32(a, b1, acc[i][1]);
        }
      }
      __builtin_amdgcn_s_setprio(0);
    }
    LDS_BARRIER();
    VMWAIT(0);
    if (kt + 1 < nk) B_STASH();
    LDS_BARRIER();
  }
#pragma unroll
  for (int i = 0; i < 8; ++i) asm volatile("" :: "v"(ra[i]));
#pragma unroll
  for (int i = 0; i < 4; ++i) asm volatile("" :: "v"(rb[i]));
#undef B_ISSUE
#undef B_STASH
#pragma unroll
  for (int i = 0; i < 4; ++i)
#pragma unroll
    for (int r = 0; r < 16; ++r) {
      const int row = m0 + wm * 128 + i * 32 + (r >> 2) * 8 + lh * 4 + (r & 3);
#pragma unroll
      for (int j = 0; j < 2; ++j) {
        const int col = n0 + wn * 64 + j * 32 + l31;
        const float v = acc[i][j][r];
        if (EPI == 0) ea.cb[(size_t)row * ea.ldc + col] = f2bf(v);
        else if (EPI == 1) { const float* rp = ea.res0 + (size_t)row * DM; ea.yout[(size_t)row * DM + col] = rp[col] + v; }
        else if (EPI == 2) { const float rl = v > 0.f ? v : 0.f; ea.cb[(size_t)row * ea.ldc + col] = f2bf(rl * rl); }
      }
      if ((r & 3) == 3) __builtin_amdgcn_sched_barrier(0);
    }
}
template <int EPI>
DEVI void gemm_phase_big(const bf16_t* A, int lda, const bf16_t* Bt, int K, int N, const EpiArgs& ea, unsigned char* smem) {
  const int nM = TP >> 8, nN = N >> 7, nwg = nM * nN;
  const int q = nwg >> 3, r = nwg & 7;
  for (int L = blockIdx.x; L < nwg; L += gridDim.x) {
    const int xcd = L & 7, off = L >> 3;
    const int wg = (xcd < r ? xcd * (q + 1) : r * (q + 1) + (xcd - r) * q) + off;
    const int nig = 8 * nN, gid = wg / nig, fm = gid * 8, gsz = (nM - fm) < 8 ? (nM - fm) : 8;
    const int pm = fm + ((wg % nig) % gsz), pn = (wg % nig) / gsz;
    gemm_tile_big<EPI>(A, lda, Bt, K, K, pm << 8, pn << 7, ea, smem);
  }
}
template <int EPI>
DEVI void gemm_phase_sample(const bf16_t* A, int lda, const bf16_t* Bt, int K, int N, const EpiArgs& ea, unsigned char* smem) {
  const int nN = N >> 7;
  for (int t = blockIdx.x; t < 4 * nN; t += gridDim.x) gemm_tile<EPI>(A, lda, Bt, K, K, TP + ((t / nN) << 7), (t % nN) << 7, ea, smem);
}

DEVI void gemm_phase_res(const bf16_t* A, int lda, const bf16_t* Bt, int K, const EpiArgs& ea, unsigned char* smem) {
  gemm_phase_big<1>(A, lda, Bt, K, 1024, ea, smem);
  const int S = (K == 4096) ? 16 : (K >> 7), klen = K / S;
  for (int it = blockIdx.x; it < 32 * S; it += gridDim.x) {
    const int tile = it / S, ks = it % S;
    gemm_tile<4>(A + (size_t)ks * klen, lda, Bt + (size_t)ks * klen, K, klen, TP + ((tile >> 3) << 7), (tile & 7) << 7, ea, smem);
  }
}

DEVI void convert_tile(const float* __restrict__ W, bf16_t* __restrict__ Wt, int K, int N, int k0, int n0, int thr, int shift, unsigned char* smem) {
  float* tile = (float*)smem;
  const int tid = get_tid();
  __syncthreads();
#pragma unroll
  for (int i = 0; i < 4; ++i) {
    const int r = (tid >> 4) + 16 * i, c = (tid & 15) * 4;
    float4 v = make_float4(0.f, 0.f, 0.f, 0.f);
    if (n0 + c < N) v = *(const float4*)(W + (size_t)(k0 + r) * N + n0 + c);
    tile[r * 65 + c] = v.x; tile[r * 65 + c + 1] = v.y; tile[r * 65 + c + 2] = v.z; tile[r * 65 + c + 3] = v.w;
  }
  __syncthreads();
  const int n = tid >> 2, kc = (tid & 3) * 16;
  if (n0 + n < N) {
    const int nn = n0 + n, nd = nn + (nn >= thr ? shift : 0);
    unsigned o[8];
#pragma unroll
    for (int e = 0; e < 8; ++e) o[e] = pk2(tile[(kc + 2 * e) * 65 + n], tile[(kc + 2 * e + 1) * 65 + n]);
    u4* dst = (u4*)(Wt + (size_t)nd * K + k0 + kc);
    dst[0] = mk4(o[0], o[1], o[2], o[3]); dst[1] = mk4(o[4], o[5], o[6], o[7]);
  }
}
DEVI void convert_group(int& base, int bid, int nb, const float* W, bf16_t* Wt, int nl, int K, int N, int NPAD, int thr, int shift, unsigned char* smem) {
  const int tk = K >> 6, tn = (N + 63) >> 6, per = tk * tn, tot = per * nl;
  int first = ((bid - base) % nb + nb) % nb;
  for (int t = first; t < tot; t += nb) {
    const int l = t / per, r = t % per;
    convert_tile(W + (size_t)l * K * N, Wt + (size_t)l * NPAD * K, K, N, (r / tn) << 6, (r % tn) << 6, thr, shift, smem);
  }
  base += tot;
}

DEVI void norm_row(const float* __restrict__ src, const float* __restrict__ gain, bf16_t* __restrict__ dst, int lane) {
  float4 v[4]; float ss = 0.f;
#pragma unroll
  for (int i = 0; i < 4; ++i) { v[i] = *(const float4*)(src + lane * 4 + 256 * i); ss += v[i].x * v[i].x + v[i].y * v[i].y + v[i].z * v[i].z + v[i].w * v[i].w; }
  ss = wave_sum(ss);
  const float sc = rsqrtf(ss * (1.f / 1024.f) + EPS);
#pragma unroll
  for (int i = 0; i < 4; ++i) {
    const float4 g = *(const float4*)(gain + lane * 4 + 256 * i);
    u2 o; o.x = pk2(v[i].x * sc * g.x, v[i].y * sc * g.y); o.y = pk2(v[i].z * sc * g.z, v[i].w * sc * g.w);
    *(u2*)(dst + lane * 4 + 256 * i) = o;
  }
}

DEVI void norm_row2(const float* __restrict__ s0, const float* __restrict__ s1, const float* __restrict__ gain, bf16_t* __restrict__ d0, bf16_t* __restrict__ d1, int lane) {
  float4 v[4], w[4]; float ss = 0.f, tt = 0.f;
#pragma unroll
  for (int i = 0; i < 4; ++i) { v[i] = *(const float4*)(s0 + lane * 4 + 256 * i); w[i] = *(const float4*)(s1 + lane * 4 + 256 * i); }
#pragma unroll
  for (int i = 0; i < 4; ++i) { ss += v[i].x * v[i].x + v[i].y * v[i].y + v[i].z * v[i].z + v[i].w * v[i].w; tt += w[i].x * w[i].x + w[i].y * w[i].y + w[i].z * w[i].z + w[i].w * w[i].w; }
#pragma unroll
  for (int o = 32; o >= 1; o >>= 1) { ss += __shfl_xor(ss, o); tt += __shfl_xor(tt, o); }
  const float sc = rsqrtf(ss * (1.f / 1024.f) + EPS), tc = rsqrtf(tt * (1.f / 1024.f) + EPS);
#pragma unroll
  for (int i = 0; i < 4; ++i) {
    const float4 g = *(const float4*)(gain + lane * 4 + 256 * i);
    u2 o; o.x = pk2(v[i].x * sc * g.x, v[i].y * sc * g.y); o.y = pk2(v[i].z * sc * g.z, v[i].w * sc * g.w);
    *(u2*)(d0 + lane * 4 + 256 * i) = o;
    u2 q; q.x = pk2(w[i].x * tc * g.x, w[i].y * tc * g.y); q.y = pk2(w[i].z * tc * g.z, w[i].w * tc * g.w);
    *(u2*)(d1 + lane * 4 + 256 * i) = q;
  }
}
DEVI void norm_all(const float* __restrict__ Y, const float* __restrict__ gain, bf16_t* __restrict__ XN, int gw, int ngw, int lane) {
  for (int r = gw; r < TA; r += ngw) norm_row(Y + (size_t)r * DM, gain, XN + (size_t)r * DM, lane);
}

struct KVSrc { const void* k; const void* v; int kpitch, vpitch, f32; };
template <int D>
DEVI void attn_load(const KVSrc& s, int r0, u4 (&kr)[D / 32], u4 (&vr)[D / 32]) {
  const int tid = get_tid();
#pragma unroll
  for (int i = 0; i < D / 32; ++i) {
    const int c = tid + 256 * i, key = c / (D / 8), dch = c % (D / 8);
    if (s.f32) {
      const float* kp = (const float*)s.k + (size_t)(r0 + key) * s.kpitch + dch * 8;
      const float* vp = (const float*)s.v + (size_t)(r0 + key) * s.vpitch + dch * 8;
      const float4 a = *(const float4*)kp, b = *(const float4*)(kp + 4), c2 = *(const float4*)vp, d2 = *(const float4*)(vp + 4);
      kr[i] = mk4(pk2(a.x, a.y), pk2(a.z, a.w), pk2(b.x, b.y), pk2(b.z, b.w));
      vr[i] = mk4(pk2(c2.x, c2.y), pk2(c2.z, c2.w), pk2(d2.x, d2.y), pk2(d2.z, d2.w));
      __builtin_amdgcn_sched_barrier(0);
    } else {
      kr[i] = *(const u4*)((const bf16_t*)s.k + (size_t)(r0 + key) * s.kpitch + dch * 8);
      vr[i] = *(const u4*)((const bf16_t*)s.v + (size_t)(r0 + key) * s.vpitch + dch * 8);
    }
  }
}
template <int D>
DEVI void attn_store(bf16_t* Ks, bf16_t* Vt, const u4 (&kr)[D / 32], const u4 (&vr)[D / 32]) {
  const int tid = get_tid();
#pragma unroll
  for (int i = 0; i < D / 32; ++i) {
    const int c = tid + 256 * i, key = c / (D / 8), dch = c % (D / 8);
    *(u4*)(Ks + key * (D + 8) + dch * 8) = kr[i];
    const int kx = key ^ ((dch & 15) << 2);
    const unsigned w[4] = {vr[i].x, vr[i].y, vr[i].z, vr[i].w};
#pragma unroll
    for (int e = 0; e < 8; ++e) Vt[(dch * 8 + e) * 72 + kx] = (bf16_t)((w[e >> 1] >> (16 * (e & 1))) & 0xffffu);
  }
}

template <int D, int MODE>
DEVI void attn_item(const bf16_t* __restrict__ qsrc, int qpitch, int nq, const float* __restrict__ qgain, float qscale,
                    const KVSrc& segA, int nA, int qposA0, int maskA, const KVSrc& segB, int nB,
                    bf16_t* __restrict__ out, int opitch, unsigned char* smem, float* __restrict__ carry_out = nullptr) {
  constexpr int KPT = D + 8, NKS = D / 16, NDB = D / 32, NCH = D / 32;
  constexpr int STAGE = 64 * KPT + D * 72;
  const int tid = get_tid(), lane = tid & 63, wave = tid >> 6, l31 = lane & 31, lh = lane >> 5;
  bf16_t* sbase = (bf16_t*)smem;
  const bool active = wave * 32 < nq;
  bf16x8 qf[NKS];
  {
    float qv[NKS][8]; float ss = 0.f;
    const bf16_t* qp = qsrc + (size_t)(wave * 32 + l31) * qpitch + lh * 8;
#pragma unroll
    for (int ks = 0; ks < NKS; ++ks) {
      u4 u = mk4(0, 0, 0, 0);
      if (active) u = *(const u4*)(qp + ks * 16);
      const unsigned w[4] = {u.x, u.y, u.z, u.w};
#pragma unroll
      for (int e = 0; e < 4; ++e) { qv[ks][2 * e] = lo2f(w[e]); qv[ks][2 * e + 1] = hi2f(w[e]); }
#pragma unroll
      for (int e = 0; e < 8; ++e) ss += qv[ks][e] * qv[ks][e];
    }
    ss += __shfl_xor(ss, 32);
    const float sc = rsqrtf(ss * (1.f / D) + EPS) * qscale;
#pragma unroll
    for (int ks = 0; ks < NKS; ++ks) {
      const float4 g0 = *(const float4*)(qgain + ks * 16 + lh * 8), g1 = *(const float4*)(qgain + ks * 16 + lh * 8 + 4);
      u4 u;
      u.x = pk2(qv[ks][0] * sc * g0.x, qv[ks][1] * sc * g0.y); u.y = pk2(qv[ks][2] * sc * g0.z, qv[ks][3] * sc * g0.w);
      u.z = pk2(qv[ks][4] * sc * g1.x, qv[ks][5] * sc * g1.y); u.w = pk2(qv[ks][6] * sc * g1.z, qv[ks][7] * sc * g1.w);
      qf[ks] = as_frag(u);
    }
  }
  f32x16 oacc[NDB];
#pragma unroll
  for (int db = 0; db < NDB; ++db)
#pragma unroll
    for (int r = 0; r < 16; ++r) oacc[db][r] = 0.f;
  float carry = 1.f, mx = -1e30f, lsum = 0.f;
  const int ntot = nA + nB;
  const int qpos = qposA0 + wave * 32 + l31;
  u4 kr[NCH], vr[NCH];
  {
    const bool inA = 0 < nA; const int tix = inA ? nA - 1 : nB - 1;
    attn_load<D>(inA ? segA : segB, tix * 64, kr, vr);
    __syncthreads();
    attn_store<D>(sbase, sbase + 64 * KPT, kr, vr);
    __syncthreads();
  }
  for (int it = 0; it < ntot; ++it) {
    const int cur = it & 1;
    if (it + 1 < ntot) {
      const bool nInA = (it + 1) < nA; const int tix = nInA ? nA - 2 - it : nB - 1 - (it + 1 - nA);
      attn_load<D>(nInA ? segA : segB, tix * 64, kr, vr);
    }
    const bool inA = it < nA;
    const int kbase = inA ? (nA - 1 - it) * 64 : 0;
    const bf16_t* Ks = sbase + cur * STAGE;
    const bf16_t* Vt = Ks + 64 * KPT;
    const bool mneed = inA && maskA && (kbase + 63 >= qposA0 + wave * 32);
    const bool skip = !active || (inA && maskA && (kbase > qposA0 + wave * 32 + 31));
    if (!skip) {
      bf16x8 pf[2][2];
      if (MODE == 0) {
        float after = carry;
#pragma unroll
        for (int rt = 1; rt >= 0; --rt) {
          f32x16 z;
#pragma unroll
          for (int r = 0; r < 16; ++r) z[r] = 0.f;
#pragma unroll
          for (int ks = 0; ks < NKS; ++ks) {
            const bf16x8 a = *(const bf16x8*)(Ks + (rt * 32 + l31) * KPT + ks * 16 + lh * 8);
            z = MFMA32(a, qf[ks], z);
          }
          float ee[16], rr[16];
#pragma unroll
          for (int i = 0; i < 16; ++i) {
            float e = ex2(z[i]);
            if (mneed) { const int key = kbase + rt * 32 + (i >> 2) * 8 + lh * 4 + (i & 3); if (key >= qpos) e = 0.f; }
            ee[i] = e; rr[i] = __builtin_amdgcn_rcpf(1.f + e);
          }
          float a_[16];
#pragma unroll
          for (int g = 3; g >= 0; --g) {
            const float s4 = (rr[g * 4] * rr[g * 4 + 1]) * (rr[g * 4 + 2] * rr[g * 4 + 3]);
            const float p4 = __shfl_xor(s4, 32);
            float c = lh == 0 ? after * p4 : after;
            after *= s4 * p4;
#pragma unroll
            for (int e = 3; e >= 0; --e) { c *= rr[g * 4 + e]; a_[g * 4 + e] = ee[g * 4 + e] * c; }
          }
#pragma unroll
          for (int s2 = 0; s2 < 2; ++s2)
            pf[rt][s2] = as_frag(mk4(pk2(a_[8 * s2 + 0], a_[8 * s2 + 1]), pk2(a_[8 * s2 + 2], a_[8 * s2 + 3]), pk2(a_[8 * s2 + 4], a_[8 * s2 + 5]), pk2(a_[8 * s2 + 6], a_[8 * s2 + 7])));
        }
        carry = after;
      } else {
        f32x16 z[2];
#pragma unroll
        for (int rt = 0; rt < 2; ++rt) {
          f32x16 zt;
#pragma unroll
          for (int r = 0; r < 16; ++r) zt[r] = 0.f;
#pragma unroll
          for (int ks = 0; ks < NKS; ++ks) {
            const bf16x8 a = *(const bf16x8*)(Ks + (rt * 32 + l31) * KPT + ks * 16 + lh * 8);
            zt = MFMA32(a, qf[ks], zt);
          }
          z[rt] = zt;
        }
        float tm = z[0][0];
#pragma unroll
        for (int rt = 0; rt < 2; ++rt)
#pragma unroll
          for (int i = 0; i < 16; ++i) tm = fmaxf(tm, z[rt][i]);
        tm = fmaxf(tm, __shfl_xor(tm, 32));
        const float nm = fmaxf(mx, tm);
        const float alpha = ex2(mx - nm);
        mx = nm;
        float ps = 0.f;
        float a_[2][16];
#pragma unroll
        for (int rt = 0; rt < 2; ++rt)
#pragma unroll
          for (int i = 0; i < 16; ++i) { a_[rt][i] = ex2(z[rt][i] - nm); ps += a_[rt][i]; }
        lsum = lsum * alpha + ps;
#pragma unroll
        for (int db = 0; db < NDB; ++db)
#pragma unroll
          for (int r = 0; r < 16; ++r) oacc[db][r] *= alpha;
#pragma unroll
        for (int rt = 0; rt < 2; ++rt)
#pragma unroll
          for (int s2 = 0; s2 < 2; ++s2)
            pf[rt][s2] = as_frag(mk4(pk2(a_[rt][8 * s2 + 0], a_[rt][8 * s2 + 1]), pk2(a_[rt][8 * s2 + 2], a_[rt][8 * s2 + 3]), pk2(a_[rt][8 * s2 + 4], a_[rt][8 * s2 + 5]), pk2(a_[rt][8 * s2 + 6], a_[rt][8 * s2 + 7])));
      }
#pragma unroll
      for (int db = 0; db < NDB; ++db) {
        const int d = db * 32 + l31, sw = ((d >> 3) & 15) << 2;
#pragma unroll
        for (int rt = 0; rt < 2; ++rt)
#pragma unroll
          for (int s = 0; s < 2; ++s) {
            const int kb0 = rt * 32 + 16 * s + 4 * lh;
            const u2 lo = *(const u2*)(Vt + d * 72 + (kb0 ^ sw));
            const u2 hi = *(const u2*)(Vt + d * 72 + ((kb0 + 8) ^ sw));
            oacc[db] = MFMA32(as_frag(mk4(lo.x, lo.y, hi.x, hi.y)), pf[rt][s], oacc[db]);
          }
      }
    }
    if (it + 1 < ntot) { bf16_t* nK = sbase + (cur ^ 1) * STAGE; attn_store<D>(nK, nK + 64 * KPT, kr, vr); }
    LDS_BARRIER();
  }
  if (active && carry_out && lh == 0) carry_out[(size_t)(wave * 32 + l31) * 4] = carry;
  if (active) {
    float inv = 1.f;
    if (MODE == 1) { const float l = lsum + __shfl_xor(lsum, 32); inv = 1.f / l; }
    bf16_t* op = out + (size_t)(wave * 32 + l31) * opitch + lh * 4;
#pragma unroll
    for (int db = 0; db < NDB; ++db)
#pragma unroll
      for (int g = 0; g < 4; ++g) {
        u2 o; o.x = pk2(oacc[db][g * 4] * inv, oacc[db][g * 4 + 1] * inv); o.y = pk2(oacc[db][g * 4 + 2] * inv, oacc[db][g * 4 + 3] * inv);
        *(u2*)(op + db * 32 + g * 8) = o;
      }
  }
}

DEVI void mem_attn_item(const KP& p, int layer, int item, const bf16_t* P, int np, int mqoff, bf16_t* mix, int mixp, int mixoff, unsigned char* smem) {
  const int h = item & 3;
  int t0, nq; const float *kk, *vv;
  if (item < 512) { t0 = (item >> 2) * 128; nq = 128; kk = p.out + O_PMK + (size_t)layer * 65536; vv = p.out + O_PMV + (size_t)layer * 65536; }
  else { const int b = (item - 512) >> 2; t0 = TP + b * 64; nq = 64; kk = p.in[6] + ((size_t)layer * 8 + b) * 65536; vv = p.in[7] + ((size_t)layer * 8 + b) * 65536; }
  KVSrc s; s.k = kk + h * 64; s.v = vv + h * 64; s.kpitch = 256; s.vpitch = 256; s.f32 = 1;
  attn_item<64, 1>(P + (size_t)t0 * np + mqoff + h * 64, np, nq, p.in[15] + layer * 64, 0.125f * LOG2E, s, 4, 0, 0, s, 0,
                   mix + (size_t)t0 * mixp + mixoff + h * 64, mixp, smem);
}

DEVI void gdn_prep_item(const KP& p, int j, int ci, int h, const bf16_t* P, unsigned char* smem) {
  constexpr int NP = NP_GDN;
  const int tid = get_tid(), lane = tid & 63, wave = tid >> 6;
  const int item = ci * 6 + h;
  const bool samp = ci >= 256;
  const int b = ci - 256;
  const int t0 = samp ? TP + b * 64 : ci * 64;
  float* stage = (float*)smem;
  float* sL = (float*)smem;
  bf16_t* qn = (bf16_t*)(smem + 33280);
  bf16_t* kn = qn + 64 * 136;
  float* sgc = (float*)(smem + 33280 + 2 * 64 * 136 * 2);
  float* sbeta = sgc + 64;
  float* segc = sbeta + 64;
  unsigned char* gi = p.ws + WS_G + (size_t)item * G_ITEM;
  bf16_t* gU = (bf16_t*)gi; bf16_t* gW = gU + 8192; bf16_t* gQD = gW + 8192; bf16_t* gKDT = gQD + 8192; bf16_t* gAI = gKDT + 8192;
  const float* convw = p.in[17] + (size_t)j * 4 * 2304;
  const float* cstate = p.in[2] + ((size_t)j * 8 + (samp ? b : 0)) * 3 * 2304;
  const bf16_t* Pc = P + (size_t)t0 * NP;
  __syncthreads();
  if (wave == 0) {
    const float braw = bf2f(Pc[(size_t)lane * NP + 3072 + h]), araw = bf2f(Pc[(size_t)lane * NP + 3078 + h]);
    const float beta = 1.f / (1.f + __expf(-braw));
    const float xx = araw + p.in[19][j * 6 + h];
    const float sp = xx > 20.f ? xx : __logf(1.f + __expf(xx));
    float g = -__expf(p.in[18][j * 6 + h]) * sp;
#pragma unroll
    for (int d = 1; d < 64; d <<= 1) { const float v = __shfl_up(g, d); if (lane >= d) g += v; }
    sgc[lane] = g; sbeta[lane] = beta; segc[lane] = __expf(g);
    if (lane == 63) ((float*)(p.ws + WS_GL))[item] = __expf(g);
  }
  if (samp || ci == 255) {
    float* dst = samp ? p.out + O_SGC + ((size_t)j * 8 + b) * 3 * 2304 : p.out + O_PGC + (size_t)j * 3 * 2304;
    for (int idx = tid; idx < 1152; idx += 256) {
      const int r = idx / 384, cc = idx % 384, ch = (cc >> 7) * 768 + h * 128 + (cc & 127);
      dst[r * 2304 + ch] = bf2f(Pc[(size_t)(61 + r) * NP + ch]);
    }
  }
  const float gcl_dummy = 0.f; (void)gcl_dummy;
#pragma unroll 1
  for (int which = 0; which < 2; ++which) {
    {
      const int c = tid & 127, th = tid >> 7, ch = which * 768 + h * 128 + c;
      const float w0 = convw[ch], w1 = convw[2304 + ch], w2 = convw[2 * 2304 + ch], w3 = convw[3 * 2304 + ch];
      float xm3, xm2, xm1;
      if (th == 1) { xm3 = bf2f(Pc[(size_t)29 * NP + ch]); xm2 = bf2f(Pc[(size_t)30 * NP + ch]); xm1 = bf2f(Pc[(size_t)31 * NP + ch]); }
      else if (samp) { xm3 = cstate[ch]; xm2 = cstate[2304 + ch]; xm1 = cstate[2 * 2304 + ch]; }
      else if (ci == 0) { xm3 = xm2 = xm1 = 0.f; }
      else { xm3 = bf2f(Pc[-(ptrdiff_t)3 * NP + ch]); xm2 = bf2f(Pc[-(ptrdiff_t)2 * NP + ch]); xm1 = bf2f(Pc[-(ptrdiff_t)NP + ch]); }
      const bf16_t* pp = Pc + (size_t)(th * 32) * NP + ch;
#pragma unroll 8
      for (int tt = 0; tt < 32; ++tt) {
        const float x0 = bf2f(pp[(size_t)tt * NP]);
        const float y = w0 * xm3 + w1 * xm2 + w2 * xm1 + w3 * x0;
        stage[(th * 32 + tt) * 129 + c] = silu(y);
        xm3 = xm2; xm2 = xm1; xm1 = x0;
      }
    }
    __syncthreads();
    {
      const int tt = tid >> 2, part = tid & 3;
      float v[32]; float ss = 0.f;
#pragma unroll
      for (int e = 0; e < 32; ++e) { v[e] = stage[tt * 129 + part * 32 + e]; ss += v[e] * v[e]; }
      ss += __shfl_xor(ss, 1); ss += __shfl_xor(ss, 2);
      float rinv = rsqrtf(ss + EPS);
      if (which == 0) rinv *= 0.08838834764831845f;
      bf16_t* dn = (which == 0 ? qn : kn) + tt * 136 + part * 32;
      const float eg = segc[tt];
#pragma unroll
      for (int e = 0; e < 32; e += 8) {
        u4 u; u.x = pk2(v[e] * rinv, v[e + 1] * rinv); u.y = pk2(v[e + 2] * rinv, v[e + 3] * rinv); u.z = pk2(v[e + 4] * rinv, v[e + 5] * rinv); u.w = pk2(v[e + 6] * rinv, v[e + 7] * rinv);
        *(u4*)(dn + e) = u;
        if (which == 0) {
          const float s2 = rinv * eg;
          u4 w; w.x = pk2(v[e] * s2, v[e + 1] * s2); w.y = pk2(v[e + 2] * s2, v[e + 3] * s2); w.z = pk2(v[e + 4] * s2, v[e + 5] * s2); w.w = pk2(v[e + 6] * s2, v[e + 7] * s2);
          *(u4*)(gQD + tt * 128 + part * 32 + e) = w;
        }
      }
    }
    __syncthreads();
  }
  {
    const int d = tid & 127, th = tid >> 7;
    const float gcl = sgc[63];
#pragma unroll
    for (int q8 = 0; q8 < 4; ++q8) {
      float f[8];
#pragma unroll
      for (int e = 0; e < 8; ++e) { const int tt = th * 32 + q8 * 8 + e; f[e] = bf2f(kn[tt * 136 + d]) * __expf(gcl - sgc[tt]); }
      *(u4*)(gKDT + d * 64 + th * 32 + q8 * 8) = mk4(pk2(f[0], f[1]), pk2(f[2], f[3]), pk2(f[4], f[5]), pk2(f[6], f[7]));
    }
  }
  {
    const int l31 = lane & 31, lh = lane >> 5, ri = wave >> 1, cj = wave & 1;
    f32x16 kk, qk;
#pragma unroll
    for (int r = 0; r < 16; ++r) { kk[r] = 0.f; qk[r] = 0.f; }
#pragma unroll
    for (int ks = 0; ks < 8; ++ks) {
      const bf16x8 ak = *(const bf16x8*)(kn + (ri * 32 + l31) * 136 + ks * 16 + lh * 8);
      const bf16x8 aq = *(const bf16x8*)(qn + (ri * 32 + l31) * 136 + ks * 16 + lh * 8);
      const bf16x8 bk = *(const bf16x8*)(kn + (cj * 32 + l31) * 136 + ks * 16 + lh * 8);
      kk = MFMA32(ak, bk, kk); qk = MFMA32(aq, bk, qk);
    }
    const int jj = cj * 32 + l31; const float gj = sgc[jj];
#pragma unroll
    for (int r = 0; r < 16; ++r) {
      const int ii = ri * 32 + (r >> 2) * 8 + lh * 4 + (r & 3);
      const float dec = ii >= jj ? __expf(sgc[ii] - gj) : 0.f;
      sL[ii * 64 + jj] = ii > jj ? sbeta[ii] * kk[r] * dec : 0.f;
      gAI[ii * 64 + jj] = f2bf(qk[r] * dec);
    }
  }
  __syncthreads();
  {
    float x[64];
    if (tid < 128) {
      const int ch = 1536 + h * 128 + tid;
      const float w0 = convw[ch], w1 = convw[2304 + ch], w2 = convw[2 * 2304 + ch], w3 = convw[3 * 2304 + ch];
      float xm3, xm2, xm1;
      if (samp) { xm3 = cstate[ch]; xm2 = cstate[2304 + ch]; xm1 = cstate[2 * 2304 + ch]; }
      else if (ci == 0) { xm3 = xm2 = xm1 = 0.f; }
      else { xm3 = bf2f(Pc[-(ptrdiff_t)3 * NP + ch]); xm2 = bf2f(Pc[-(ptrdiff_t)2 * NP + ch]); xm1 = bf2f(Pc[-(ptrdiff_t)NP + ch]); }
#pragma unroll
      for (int tt = 0; tt < 64; ++tt) {
        const float x0 = bf2f(Pc[(size_t)tt * NP + ch]);
        const float y = w0 * xm3 + w1 * xm2 + w2 * xm1 + w3 * x0;
        x[tt] = silu(y) * sbeta[tt];
        xm3 = xm2; xm2 = xm1; xm1 = x0;
        if ((tt & 7) == 7) __builtin_amdgcn_sched_barrier(0);
      }
    } else {
#pragma unroll
      for (int tt = 0; tt < 64; ++tt) { x[tt] = bf2f(kn[tt * 136 + tid - 128]) * sbeta[tt] * segc[tt]; if ((tt & 7) == 7) __builtin_amdgcn_sched_barrier(0); }
    }
#pragma unroll
    for (int i = 1; i < 64; ++i) {
      float a = x[i];
#pragma unroll
      for (int jx = 0; jx < i; ++jx) a -= sL[i * 64 + jx] * x[jx];
      x[i] = a;
      __builtin_amdgcn_sched_barrier(0);
    }
    if (tid < 128) {
#pragma unroll
      for (int t8 = 0; t8 < 8; ++t8) {
        *(u4*)(gU + tid * 64 + t8 * 8) = mk4(pk2(x[t8 * 8], x[t8 * 8 + 1]), pk2(x[t8 * 8 + 2], x[t8 * 8 + 3]), pk2(x[t8 * 8 + 4], x[t8 * 8 + 5]), pk2(x[t8 * 8 + 6], x[t8 * 8 + 7]));
        __builtin_amdgcn_sched_barrier(0);
      }
    } else {
      bf16_t* dst = gW + (tid & 127);
#pragma unroll
      for (int tt = 0; tt < 64; ++tt) { dst[tt * 128] = f2bf(x[tt]); if ((tt & 7) == 7) __builtin_amdgcn_sched_barrier(0); }
    }
  }
}

struct ScanFrags { u4 w[4], qd[4], ai[2], kdt[2][2]; u2 u; float gl; };
DEVI void scan_load(const KP& p, int item, int wave, int lane, int sl, ScanFrags& f) {
  const int n = lane & 15, g = lane >> 4;
  const unsigned char* gi = p.ws + WS_G + (size_t)item * G_ITEM;
  const bf16_t* gU = (const bf16_t*)gi; const bf16_t* gW = gU + 8192; const bf16_t* gQD = gW + 8192; const bf16_t* gKDT = gQD + 8192; const bf16_t* gAI = gKDT + 8192;
#pragma unroll
  for (int s = 0; s < 4; ++s) { GLOAD16(f.w[s], gW + (16 * wave + n) * 128 + 32 * s + 8 * g); GLOAD16(f.qd[s], gQD + (16 * wave + n) * 128 + 32 * s + 8 * g); }
#pragma unroll
  for (int s = 0; s < 2; ++s) {
    GLOAD16(f.ai[s], gAI + (16 * wave + n) * 64 + 32 * s + 8 * g);
#pragma unroll
    for (int tt = 0; tt < 2; ++tt) GLOAD16(f.kdt[tt][s], gKDT + (32 * wave + 16 * tt + n) * 64 + 32 * s + 8 * g);
  }
  const bf16_t* up = gU + (sl * 16 + n) * 64 + 16 * wave + 4 * g;
  asm volatile("global_load_dwordx2 %0, %1, off" : "=&v"(f.u) : "v"(up) : "memory");
  const float* glp = (const float*)(p.ws + WS_GL) + item;
  asm volatile("global_load_dword %0, %1, off" : "=&v"(f.gl) : "v"(glp) : "memory");
}
DEVI void scan_wait32(ScanFrags& f) {
  asm volatile("s_waitcnt vmcnt(32)"
               : "+v"(f.w[0]), "+v"(f.w[1]), "+v"(f.w[2]), "+v"(f.w[3]), "+v"(f.qd[0]), "+v"(f.qd[1]), "+v"(f.qd[2]), "+v"(f.qd[3]),
                 "+v"(f.ai[0]), "+v"(f.ai[1]), "+v"(f.kdt[0][0]), "+v"(f.kdt[0][1]), "+v"(f.kdt[1][0]), "+v"(f.kdt[1][1]),
                 "+v"(f.u), "+v"(f.gl)
               :: "memory");
}
DEVI void scan_keep(const ScanFrags& f) {
#pragma unroll
  for (int s = 0; s < 4; ++s) asm volatile("" :: "v"(f.w[s]), "v"(f.qd[s]));
#pragma unroll
  for (int s = 0; s < 2; ++s) asm volatile("" :: "v"(f.ai[s]), "v"(f.kdt[0][s]), "v"(f.kdt[1][s]));
  asm volatile("" :: "v"(f.u), "v"(f.gl));
}
DEVI void scan_step(const ScanFrags& f, f32x4 (&sacc)[2], bf16_t* St, bf16_t* Vnt, bf16_t* O, int t0, int h, int sl, int wave, int n, int g) {
  bf16x8 sf[4];
#pragma unroll
  for (int s = 0; s < 4; ++s) sf[s] = *(const bf16x8*)(St + n * 136 + 32 * s + 8 * g);
  f32x4 wsa = {0.f, 0.f, 0.f, 0.f}, oa = {0.f, 0.f, 0.f, 0.f};
#pragma unroll
  for (int s = 0; s < 4; ++s) wsa = MFMA16(as_frag(f.w[s]), sf[s], wsa);
  float vn[4];
  vn[0] = lo2f(f.u.x) - wsa[0]; vn[1] = hi2f(f.u.x) - wsa[1]; vn[2] = lo2f(f.u.y) - wsa[2]; vn[3] = hi2f(f.u.y) - wsa[3];
  { u2 o; o.x = pk2(vn[0], vn[1]); o.y = pk2(vn[2], vn[3]); *(u2*)(Vnt + n * 72 + 16 * wave + 4 * g) = o; }
#pragma unroll
  for (int s = 0; s < 4; ++s) oa = MFMA16(as_frag(f.qd[s]), sf[s], oa);
  LDS_BARRIER();
  bf16x8 vf[2];
#pragma unroll
  for (int s = 0; s < 2; ++s) vf[s] = *(const bf16x8*)(Vnt + n * 72 + 32 * s + 8 * g);
#pragma unroll
  for (int s = 0; s < 2; ++s) oa = MFMA16(as_frag(f.ai[s]), vf[s], oa);
#pragma unroll
  for (int r = 0; r < 4; ++r) O[(size_t)(t0 + 16 * wave + 4 * g + r) * 768 + h * 128 + sl * 16 + n] = f2bf(oa[r]);
#pragma unroll
  for (int tt = 0; tt < 2; ++tt) {
#pragma unroll
    for (int r = 0; r < 4; ++r) sacc[tt][r] *= f.gl;
#pragma unroll
    for (int s = 0; s < 2; ++s) sacc[tt] = MFMA16(as_frag(f.kdt[tt][s]), vf[s], sacc[tt]);
    u2 o; o.x = pk2(sacc[tt][0], sacc[tt][1]); o.y = pk2(sacc[tt][2], sacc[tt][3]);
    *(u2*)(St + n * 136 + 32 * wave + 16 * tt + 4 * g) = o;
  }
  LDS_BARRIER();
}
DEVI void gdn_scan_stream(const KP& p, int j, int ci0, int nch, int h, int sl, const float* s0, float* sout, bf16_t* O, unsigned char* smem) {
  const int tid = get_tid(), lane = tid & 63, wave = tid >> 6, n = lane & 15, g = lane >> 4;
  bf16_t* St = (bf16_t*)smem;
  bf16_t* Vnt = St + 16 * 136;
  f32x4 sacc[2];
#pragma unroll
  for (int tt = 0; tt < 2; ++tt)
#pragma unroll
    for (int r = 0; r < 4; ++r) sacc[tt][r] = s0 ? s0[(size_t)(32 * wave + 16 * tt + 4 * g + r) * 128 + sl * 16 + n] : 0.f;
  __syncthreads();
#pragma unroll
  for (int tt = 0; tt < 2; ++tt) { u2 o; o.x = pk2(sacc[tt][0], sacc[tt][1]); o.y = pk2(sacc[tt][2], sacc[tt][3]); *(u2*)(St + n * 136 + 32 * wave + 16 * tt + 4 * g) = o; }
  ScanFrags f0, f1, f2;
#define CL(c) ((ci0 + (((c) < nch) ? (c) : nch - 1)) * 6 + h)
#define T0(c) (((ci0 + (c)) >= 256) ? TP + (ci0 + (c) - 256) * 64 : (ci0 + (c)) * 64)
  VMWAIT(0);
  scan_load(p, CL(0), wave, lane, sl, f0);
  scan_load(p, CL(1), wave, lane, sl, f1);
  LDS_BARRIER();
  for (int c = 0; c < nch; c += 3) {
    scan_load(p, CL(c + 2), wave, lane, sl, f2); scan_wait32(f0);
    scan_step(f0, sacc, St, Vnt, O, T0(c), h, sl, wave, n, g);
    if (c + 1 < nch) {
      scan_load(p, CL(c + 3), wave, lane, sl, f0); scan_wait32(f1);
      scan_step(f1, sacc, St, Vnt, O, T0(c + 1), h, sl, wave, n, g);
    }
    if (c + 2 < nch) {
      scan_load(p, CL(c + 4), wave, lane, sl, f1); scan_wait32(f2);
      scan_step(f2, sacc, St, Vnt, O, T0(c + 2), h, sl, wave, n, g);
    }
  }
  VMWAIT(0);
  scan_keep(f0); scan_keep(f1); scan_keep(f2);
#undef CL
#undef T0
#pragma unroll
  for (int tt = 0; tt < 2; ++tt)
#pragma unroll
    for (int r = 0; r < 4; ++r) sout[(size_t)(32 * wave + 16 * tt + 4 * g + r) * 128 + sl * 16 + n] = sacc[tt][r];
}

DEVI int next_item(unsigned* ctr) {
  __shared__ int s_item;
  __syncthreads();
  if (get_tid() == 0) s_item = (int)atomicAdd(ctr, 1u);
  __syncthreads();
  return s_item;
}

DEVI unsigned xcc_id() { return (unsigned)__builtin_amdgcn_s_getreg((3 << 11) | 20) & 0xFu; }
DEVI unsigned ld_relaxed(unsigned* p) { return __hip_atomic_load(p, __ATOMIC_RELAXED, __HIP_MEMORY_SCOPE_AGENT); }
DEVI void gbar_setup(unsigned* ctr, unsigned nb, unsigned* sb) {
  if (get_tid() == 0) {
    const unsigned x = xcc_id();
    __hip_atomic_fetch_add(ctr + 544 + 8 * x, 1u, __ATOMIC_RELAXED, __HIP_MEMORY_SCOPE_AGENT);
    unsigned nx, mine;
    for (;;) {
      unsigned sum = 0; nx = 0; mine = 0;
      for (unsigned j = 0; j < 16; ++j) { const unsigned c = ld_relaxed(ctr + 544 + 8 * j); sum += c; nx += c ? 1u : 0u; mine = (j == x) ? c : mine; }
      if (sum == nb) break;
      __builtin_amdgcn_s_sleep(2);
    }
    sb[0] = x; sb[1] = mine; sb[2] = nx;
  }
  __syncthreads();
}
DEVI void gbar(unsigned* ctr, unsigned* sb, unsigned& gen) {
  asm volatile("s_waitcnt vmcnt(0)" ::: "memory");
  __syncthreads();
  gen++;
  if (get_tid() == 0) {
    const unsigned x = sb[0], nloc = sb[1], nx = sb[2];
    const unsigned old = __hip_atomic_fetch_add(ctr + 704 + 8 * x, 1u, __ATOMIC_RELAXED, __HIP_MEMORY_SCOPE_AGENT);
    if (old + 1u == gen * nloc) {
      __builtin_amdgcn_fence(__ATOMIC_RELEASE, "agent");
      asm volatile("s_waitcnt vmcnt(0)" ::: "memory");
      __hip_atomic_fetch_add(ctr + 528, 1u, __ATOMIC_RELAXED, __HIP_MEMORY_SCOPE_AGENT);
    }
    for (unsigned it = 0; ld_relaxed(ctr + 528) < gen * nx; ++it) {
      if (it < 8) __builtin_amdgcn_s_sleep(4); else if (it < 24) __builtin_amdgcn_s_sleep(32); else __builtin_amdgcn_s_sleep(127);
    }
    __builtin_amdgcn_fence(__ATOMIC_ACQUIRE, "agent");
    asm volatile("s_waitcnt vmcnt(0)" ::: "memory");
  }
  __syncthreads();
}
#ifndef ONLY
#define ENAB(k) true
#else
#define ENAB(k) ((ONLY) == (k))
#endif
__global__ void __launch_bounds__(256, 2) mk_fwd(KP p) {
  __shared__ __attribute__((aligned(16))) unsigned char smem[73728];
  cg::grid_group grid = cg::this_grid();
  const int bid = blockIdx.x, nb = gridDim.x;
  const int ngw = nb * 4;
  unsigned char* ws = p.ws;
  unsigned* ctr = (unsigned*)(ws + WS_CTR);
  float* Y = p.out + O_YP;
  bf16_t* XN = (bf16_t*)(ws + WS_XN);
  bf16_t* MIX = (bf16_t*)(ws + WS_MIX);
  bf16_t* Pb = (bf16_t*)(ws + WS_P);
  bf16_t* Hb = (bf16_t*)(ws + WS_H);
  bool did = false;
  unsigned bgen = 0;
  __shared__ unsigned s_bar[4];
  gbar_setup(ctr, nb, s_bar);
  grid.sync();
  for (int ph = p.ph_lo; ph < p.ph_hi; ++ph) {
    const int layer = ph == 0 ? 0 : (ph - 1) / 9, sub = ph == 0 ? -1 : (ph - 1) % 9;
    const int kind = layer & 1, j = layer >> 1;
    if (sub == 8 && layer == 3) continue;
    if (did) gbar(ctr, s_bar, bgen);
    did = true;
    const int np = kind ? NP_SB : NP_GDN, mqoff = kind ? MQ_SB : MQ_GDN, mixp = kind ? 768 : 1024, mixoff = kind ? 512 : 768;
    if (ph == 0 && ENAB(0)) {
      const int tid = get_tid(), lane = tid & 63, gw = bid * 4 + (tid >> 6); (void)tid; (void)lane; (void)gw;
      int base = 0;
      convert_group(base, bid, nb, p.in[12], (bf16_t*)(ws + WS_WIG), 2, 1024, 3340, 3456, 3084, 116, smem);
      convert_group(base, bid, nb, p.in[13], (bf16_t*)(ws + WS_WIS), 2, 1024, 1792, 1792, 1 << 30, 0, smem);
      convert_group(base, bid, nb, p.in[14], (bf16_t*)(ws + WS_WKV), 4, 1024, 512, 512, 1 << 30, 0, smem);
      convert_group(base, bid, nb, p.in[23], (bf16_t*)(ws + WS_WOG), 2, 1024, 1024, 1024, 1 << 30, 0, smem);
      convert_group(base, bid, nb, p.in[24], (bf16_t*)(ws + WS_WOS), 2, 768, 1024, 1024, 1 << 30, 0, smem);
      convert_group(base, bid, nb, p.in[25], (bf16_t*)(ws + WS_WUP), 4, 1024, 4096, 4096, 1 << 30, 0, smem);
      convert_group(base, bid, nb, p.in[26], (bf16_t*)(ws + WS_WDN), 4, 4096, 1024, 1024, 1 << 30, 0, smem);
      for (int r = gw; r < TA; r += ngw) norm_row(r < TP ? p.in[0] + (size_t)r * DM : p.in[1] + (size_t)(r - TP) * DM, p.in[9], XN + (size_t)r * DM, lane);
      for (int i = bid * 256 + tid; i < TS * DM / 4; i += nb * 256) ((float4*)(Y + (size_t)TP * DM))[i] = ((const float4*)p.in[1])[i];
      for (int r = gw; r < 1024; r += ngw) norm_row(p.in[8] + (size_t)(r & 255) * DM, p.in[10] + (r >> 8) * DM, (bf16_t*)(ws + WS_MEMN) + (size_t)r * DM, lane);
    } else if (sub == 0 && ENAB(1)) {
      EpiArgs ea{}; ea.cb = Pb; ea.ldc = np;
      const bf16_t* wt = kind ? (const bf16_t*)(ws + WS_WIS) + (size_t)j * 1792 * 1024 : (const bf16_t*)(ws + WS_WIG) + (size_t)j * 3456 * 1024;
      gemm_phase<0>(XN, DM, wt, 1024, TA, np, ea, smem);
      if (layer == 0) {
        for (int t = bid; t < 32; t += nb) {
          const int l = t >> 3, r = t & 7;
          EpiArgs e2{}; e2.cf = (float*)(ws + WS_MEMKV) + (size_t)l * 256 * 512; e2.ldc = 512;
          gemm_tile<3>((const bf16_t*)(ws + WS_MEMN) + (size_t)l * 256 * DM, DM, (const bf16_t*)(ws + WS_WKV) + (size_t)l * 512 * DM, DM, 1024, (r >> 2) << 7, (r & 3) << 7, e2, smem);
        }
      }
    } else if (sub == 1 && ENAB(2)) {
      const int tid = get_tid(), lane = tid & 63, gw = bid * 4 + (tid >> 6); (void)tid; (void)lane; (void)gw;
      if (layer == 0) {
        const float* kv = (const float*)(ws + WS_MEMKV);
        for (int it = gw; it < 4096; it += ngw) {
          const int l = it >> 10, m = (it >> 2) & 255, hh = it & 3;
          const float kx = kv[((size_t)l * 256 + m) * 512 + hh * 64 + lane], vx = kv[((size_t)l * 256 + m) * 512 + 256 + hh * 64 + lane];
          const float ss = wave_sum(kx * kx);
          p.out[O_PMK + ((size_t)l * 256 + m) * 256 + hh * 64 + lane] = kx * rsqrtf(ss * (1.f / 64.f) + EPS) * p.in[16][l * 64 + lane];
          p.out[O_PMV + ((size_t)l * 256 + m) * 256 + hh * 64 + lane] = vx;
        }
      }
      if (kind == 0) {
        for (int it = bid; it < 256 * 6; it += nb) gdn_prep_item(p, j, it / 6, it % 6, Pb, smem);
      } else {
        bf16_t* Kb = (bf16_t*)(ws + WS_G);
        const float* kg = p.in[22] + j * 128;
        for (int t = gw; t < TA; t += ngw) {
          const bf16_t* pr = Pb + (size_t)t * np;
          const u4 ku = *(const u4*)(pr + 512 + lane * 8), vu = *(const u4*)(pr + 1024 + lane * 8);
          float kf[8] = {lo2f(ku.x), hi2f(ku.x), lo2f(ku.y), hi2f(ku.y), lo2f(ku.z), hi2f(ku.z), lo2f(ku.w), hi2f(ku.w)};
          float ss = 0.f;
#pragma unroll
          for (int e = 0; e < 8; ++e) ss += kf[e] * kf[e];
          ss += __shfl_xor(ss, 1); ss += __shfl_xor(ss, 2); ss += __shfl_xor(ss, 4); ss += __shfl_xor(ss, 8);
          const float sc = rsqrtf(ss * (1.f / 128.f) + EPS);
          const int c0 = (lane & 15) * 8;
#pragma unroll
          for (int e = 0; e < 8; ++e) kf[e] *= sc * kg[c0 + e];
          float* ok = t < TP ? p.out + O_PSK + ((size_t)j * TP + t) * 512 : p.out + O_SSK + ((size_t)j * TS + (t - TP)) * 512;
          float* ov = t < TP ? p.out + O_PSV + ((size_t)j * TP + t) * 512 : p.out + O_SSV + ((size_t)j * TS + (t - TP)) * 512;
          *(float4*)(ok + lane * 8) = make_float4(kf[0], kf[1], kf[2], kf[3]); *(float4*)(ok + lane * 8 + 4) = make_float4(kf[4], kf[5], kf[6], kf[7]);
          *(float4*)(ov + lane * 8) = make_float4(lo2f(vu.x), hi2f(vu.x), lo2f(vu.y), hi2f(vu.y)); *(float4*)(ov + lane * 8 + 4) = make_float4(lo2f(vu.z), hi2f(vu.z), lo2f(vu.w), hi2f(vu.w));
          *(u4*)(Kb + (size_t)t * 512 + lane * 8) = mk4(pk2(kf[0], kf[1]), pk2(kf[2], kf[3]), pk2(kf[4], kf[5]), pk2(kf[6], kf[7]));
        }
      }
    } else if (sub == 2 && ENAB(3)) {
      unsigned* c = ctr + layer * 4;
      if (kind == 0) {
        bf16_t* O = XN;
        if (bid < 64 && (bid & 7) < 6) {
          const int h = bid & 7, sl = bid >> 3;
          gdn_scan_stream(p, j, 0, 256, h, sl, nullptr, p.out + O_PGS + ((size_t)j * 6 + h) * 16384, O, smem);
        }
        for (;;) {
          const int it = next_item(c);
          if (it >= 48 + 544) break;
          if (it < 48) {
            const int b = it / 6, h = it % 6;
            gdn_prep_item(p, j, 256 + b, h, Pb, smem);
            asm volatile("s_waitcnt vmcnt(0)" ::: "memory");
            __syncthreads();
#pragma unroll 1
            for (int sl = 0; sl < 8; ++sl)
              gdn_scan_stream(p, j, 256 + b, 1, h, sl, p.in[3] + (((size_t)j * 8 + b) * 6 + h) * 16384, p.out + O_SGS + (((size_t)j * 8 + b) * 6 + h) * 16384, O, smem);
          } else mem_attn_item(p, layer, it - 48, Pb, np, mqoff, MIX, mixp, mixoff, smem);
        }
      } else {
        const bf16_t* Kb = (const bf16_t*)(ws + WS_G);
        bf16_t* OFAR = (bf16_t*)(ws + WS_G + (32ull << 20));
        float* CARRY = (float*)(ws + WS_G + (64ull << 20));
        const float qs = 0.08838834764831845f * LOG2E;
        for (;;) {
          const int it = next_item(c);
          if (it >= 768 + 32 + 544) break;
          if (it < 768) {
            int qb, idx, whole;
            if (it < 640) { const int pr = it / 20, r = it % 20; if (r < 8) { qb = 127 - 2 * pr; idx = r; whole = 0; } else if (r < 12) { qb = 63 - pr; idx = r - 8; whole = 1; } else { qb = 126 - 2 * pr; idx = r - 12; whole = 0; } }
            else { qb = 31 - ((it - 640) >> 2); idx = (it - 640) & 3; whole = 1; }
            const int h = whole ? idx : (idx >> 1), far = whole ? 0 : (idx & 1), near_ = (!whole && !far);
            const int nAi = whole ? 2 * qb + 2 : qb + 1, koff = near_ ? (qb + 1) * 64 : 0;
            KVSrc s; s.k = Kb + (size_t)koff * 512 + h * 128; s.v = Pb + (size_t)koff * np + 1024 + h * 128; s.kpitch = 512; s.vpitch = np; s.f32 = 0;
            bf16_t* op = far ? OFAR + (size_t)(qb * 128) * 512 + h * 128 : MIX + (size_t)(qb * 128) * mixp + h * 128;
            float* co = near_ ? CARRY + (size_t)(qb * 128) * 4 + h : nullptr;
            attn_item<128, 0>(Pb + (size_t)(qb * 128) * np + h * 128, np, 128, p.in[21] + j * 128, qs, s, nAi, qb * 128 - koff, far ? 0 : 1, s, 0, op, far ? 512 : mixp, smem, co);
          } else if (it < 800) {
            const int b = (it - 768) >> 2, h = it & 3, t0 = TP + b * 64;
            KVSrc sa; sa.k = Kb + (size_t)t0 * 512 + h * 128; sa.v = Pb + (size_t)t0 * np + 1024 + h * 128; sa.kpitch = 512; sa.vpitch = np; sa.f32 = 0;
            KVSrc sb; sb.k = p.in[4] + ((size_t)j * 8 + b) * 2048 * 512 + h * 128; sb.v = p.in[5] + ((size_t)j * 8 + b) * 2048 * 512 + h * 128; sb.kpitch = 512; sb.vpitch = 512; sb.f32 = 1;
            attn_item<128, 0>(Pb + (size_t)t0 * np + h * 128, np, 64, p.in[21] + j * 128, qs, sa, 1, 0, 1, sb, 32,
                              MIX + (size_t)t0 * mixp + h * 128, mixp, smem);
          } else mem_attn_item(p, layer, it - 800, Pb, np, mqoff, MIX, mixp, mixoff, smem);
        }
      }
    } else if (sub == 3 && kind == 1) {
      const int tid = get_tid(), lane = tid & 63, gw = bid * 4 + (tid >> 6); (void)tid; (void)lane; (void)gw;
      const bf16_t* OFAR = (const bf16_t*)(ws + WS_G + (32ull << 20));
      const float* CARRY = (const float*)(ws + WS_G + (64ull << 20));
      for (int t = TP / 2 + gw; t < TP; t += ngw) {
        const u4 a = *(const u4*)(MIX + (size_t)t * mixp + lane * 8), b = *(const u4*)(OFAR + (size_t)t * 512 + lane * 8);
        const float sc = CARRY[(size_t)t * 4 + (lane >> 4)];
        u4 o;
        o.x = pk2(lo2f(a.x) + sc * lo2f(b.x), hi2f(a.x) + sc * hi2f(b.x)); o.y = pk2(lo2f(a.y) + sc * lo2f(b.y), hi2f(a.y) + sc * hi2f(b.y));
        o.z = pk2(lo2f(a.z) + sc * lo2f(b.z), hi2f(a.z) + sc * hi2f(b.z)); o.w = pk2(lo2f(a.w) + sc * lo2f(b.w), hi2f(a.w) + sc * hi2f(b.w));
        *(u4*)(MIX + (size_t)t * mixp + lane * 8) = o;
      }
    } else if (sub == 3 && ENAB(4)) {
      const int tid = get_tid(), lane = tid & 63, gw = bid * 4 + (tid >> 6); (void)tid; (void)lane; (void)gw;
      const bf16_t* O = XN;
      const float* og = p.in[20] + j * 128;
      for (int it = gw; it < TA * 6; it += ngw) {
        const int t = it / 6, h = it % 6;
        const unsigned ou = *(const unsigned*)(O + (size_t)t * 768 + h * 128 + lane * 2);
        const unsigned zu = *(const unsigned*)(Pb + (size_t)t * np + 2304 + h * 128 + lane * 2);
        const float o0 = lo2f(ou), o1 = hi2f(ou), z0 = lo2f(zu), z1 = hi2f(zu);
        const float ss = wave_sum(o0 * o0 + o1 * o1);
        const float sc = rsqrtf(ss * (1.f / 128.f) + EPS);
        *(unsigned*)(MIX + (size_t)t * 1024 + h * 128 + lane * 2) = pk2(o0 * sc * og[lane * 2] * silu(z0), o1 * sc * og[lane * 2 + 1] * silu(z1));
      }
    } else if (sub == 4 && ENAB(5)) {
      EpiArgs ea{}; ea.yout = Y;
      if (layer == 0) { ea.res0 = p.in[0]; ea.res1 = p.in[1]; } else { ea.res0 = Y; ea.res1 = nullptr; }
      const bf16_t* wt = kind ? (const bf16_t*)(ws + WS_WOS) + (size_t)j * 1024 * 768 : (const bf16_t*)(ws + WS_WOG) + (size_t)j * 1024 * 1024;
      gemm_phase_res(MIX, mixp, wt, mixp, ea, smem);
    } else if (sub == 5) {
      const int tid = get_tid(), lane = tid & 63, gw = bid * 4 + (tid >> 6); (void)tid; (void)lane; (void)gw;
      norm_all(Y, p.in[11] + layer * DM, XN, gw, ngw, lane);
    } else if (sub == 6 && ENAB(6)) {
      EpiArgs ea{}; ea.cb = Hb; ea.ldc = DFF;
      gemm_phase_big<2>(XN, DM, (const bf16_t*)(ws + WS_WUP) + (size_t)layer * 4096 * 1024, 1024, 4096, ea, smem);
      gemm_phase_sample<2>(XN, DM, (const bf16_t*)(ws + WS_WUP) + (size_t)layer * 4096 * 1024, 1024, 4096, ea, smem);
    } else if (sub == 7 && ENAB(7)) {
      EpiArgs ea{}; ea.yout = Y; ea.res0 = Y; ea.res1 = nullptr;
      gemm_phase_res(Hb, DFF, (const bf16_t*)(ws + WS_WDN) + (size_t)layer * 1024 * 4096, 4096, ea, smem);
    } else if (sub == 8) {
      const int tid = get_tid(), lane = tid & 63, gw = bid * 4 + (tid >> 6); (void)tid; (void)lane; (void)gw;
      norm_all(Y, p.in[9] + (layer + 1) * DM, XN, gw, ngw, lane);
    }
  }
}

extern "C" void kernel_launch(void* const* d_in, const int* in_sizes, int n_in, void* d_out, int out_size, void* d_ws, size_t ws_size, hipStream_t stream) {
  static int grid_blocks = 0;
  if (!grid_blocks) {
    int dev = 0, cus = 0, per_cu = 0;
    (void)hipGetDevice(&dev);
    (void)hipDeviceGetAttribute(&cus, hipDeviceAttributeMultiprocessorCount, dev);
    (void)hipOccupancyMaxActiveBlocksPerMultiprocessor(&per_cu, mk_fwd, 256, 0);
    if (per_cu > 2) per_cu = 2;
    if (per_cu < 1) per_cu = 1;
    grid_blocks = cus * per_cu;
    if (ws_size < WS_END) fprintf(stderr, "kernel_launch: workspace too small: %zu < %zu\n", ws_size, (size_t)WS_END);
  }
  (void)hipMemsetAsync((char*)d_ws + WS_CTR, 0, 4096, stream);
  KP p{};
  for (int i = 0; i < 27; ++i) p.in[i] = (const float*)d_in[i];
  p.out = (float*)d_out; p.ws = (unsigned char*)d_ws; p.ph_lo = 0; p.ph_hi = 37;
  void* args[] = {&p};
  hipError_t e = hipLaunchCooperativeKernel((void*)mk_fwd, dim3(grid_blocks), dim3(256), args, 0, stream);
  if (e != hipSuccess) fprintf(stderr, "cooperative launch failed: %s (grid %d)\n", hipGetErrorString(e), grid_blocks);
}
```

```cpp
#include <hip/hip_runtime.h>
#include <hip/hip_cooperative_groups.h>
#include <cstdio>
#include <cstdint>
namespace cg = cooperative_groups;

typedef unsigned short bf16_t;
typedef short bf16x8 __attribute__((ext_vector_type(8)));
typedef float f32x16 __attribute__((ext_vector_type(16)));
typedef float f32x4 __attribute__((ext_vector_type(4)));
typedef unsigned u4 __attribute__((ext_vector_type(4)));
typedef unsigned u2 __attribute__((ext_vector_type(2)));
#define DEVI __device__ __forceinline__
__device__ __forceinline__ u4 mk4(unsigned a, unsigned b, unsigned c, unsigned d) { u4 r; r.x = a; r.y = b; r.z = c; r.w = d; return r; }
__device__ __forceinline__ u2 mk2(unsigned a, unsigned b) { u2 r; r.x = a; r.y = b; return r; }
#define MFMA32(a, b, c) __builtin_amdgcn_mfma_f32_32x32x16_bf16((a), (b), (c), 0, 0, 0)
#define LDS_BARRIER() do { asm volatile("s_waitcnt lgkmcnt(0)" ::: "memory"); __builtin_amdgcn_s_barrier(); } while (0)
#define GLOAD16(dst, ptr) asm volatile("global_load_dwordx4 %0, %1, off" : "=&v"(dst) : "v"(ptr) : "memory")
#define VMWAIT(n) asm volatile("s_waitcnt vmcnt(" #n ")" ::: "memory")
#define MFMA16(a, b, c) __builtin_amdgcn_mfma_f32_16x16x32_bf16((a), (b), (c), 0, 0, 0)

constexpr int DM = 1024, TP = 16384, TS = 512, TA = TP + TS, DFF = 4096;
constexpr int NP_GDN = 3456, NP_SB = 1792, MQ_GDN = 3200, MQ_SB = 1536;
constexpr int NCHUNK = 264, NITEM = NCHUNK * 6;
constexpr float EPS = 1e-6f;
constexpr int NCVT_TILES = 16 * 53 + 2 * 16 * 28 + 2 * 16 * 16 + 2 * 12 * 16 + 4 * 16 * 64 + 4 * 64 * 16;
constexpr float LOG2E = 1.4426950408889634f;
constexpr size_t O_YP = 0, O_PGC = 17301504, O_PGS = 17315328, O_PSK = 17511936, O_PSV = 34289152, O_PMK = 51066368, O_PMV = 51328512,
                 O_SGC = 51590656, O_SGS = 51701248, O_SSK = 53274112, O_SSV = 53798400;
constexpr size_t WS_CTR = 0;
constexpr size_t WS_WIG = 4096;
constexpr size_t WS_WIS = WS_WIG + 2ull * 3456 * 1024 * 2;
constexpr size_t WS_WKV = WS_WIS + 2ull * 1792 * 1024 * 2;
constexpr size_t WS_WOG = WS_WKV + 4ull * 512 * 1024 * 2;
constexpr size_t WS_WOS = WS_WOG + 2ull * 1024 * 1024 * 2;
constexpr size_t WS_WUP = WS_WOS + 2ull * 1024 * 768 * 2;
constexpr size_t WS_WDN = WS_WUP + 4ull * 4096 * 1024 * 2;
constexpr size_t WS_XN = WS_WDN + 4ull * 4096 * 1024 * 2;
constexpr size_t WS_MIX = WS_XN + (size_t)TA * 1024 * 2;
constexpr size_t WS_MEMN = WS_MIX + (size_t)TA * 1024 * 2;
constexpr size_t WS_MEMKV = WS_MEMN + 4ull * 256 * 1024 * 2;
constexpr size_t WS_BIG = WS_MEMKV + 4ull * 256 * 512 * 4;
constexpr size_t WS_P = WS_BIG;
constexpr size_t WS_G = WS_P + (size_t)TA * 3456 * 2;
constexpr size_t G_ITEM = 73728;
constexpr size_t WS_GL = WS_G + (size_t)NITEM * G_ITEM;
constexpr size_t WS_H = WS_BIG;
constexpr size_t WS_END = WS_GL + 8192;

struct KP { const float* in[27]; float* out; unsigned char* ws; int ph_lo, ph_hi; };

DEVI int get_tid() { int t = __builtin_amdgcn_workitem_id_x(); asm volatile("" : "+v"(t)); return t; }
DEVI float bf2f(bf16_t b) { return __uint_as_float(((unsigned)b) << 16); }
typedef float f32x2_t __attribute__((ext_vector_type(2)));
typedef __bf16 bf16x2_t __attribute__((ext_vector_type(2)));
DEVI unsigned pk2(float lo, float hi) { f32x2_t v = {lo, hi}; return __builtin_bit_cast(unsigned, __builtin_convertvector(v, bf16x2_t)); }
DEVI bf16_t f2bf(float f) { return (bf16_t)(pk2(f, 0.f) & 0xffffu); }
DEVI float lo2f(unsigned u) { return __uint_as_float(u << 16); }
DEVI float hi2f(unsigned u) { return __uint_as_float(u & 0xffff0000u); }
DEVI float ex2(float x) { return __builtin_amdgcn_exp2f(x); }
DEVI float lg2(float x) { return __builtin_amdgcn_logf(x); }
DEVI float wave_sum(float v) {
#pragma unroll
  for (int o = 32; o >= 1; o >>= 1) v += __shfl_xor(v, o);
  return v;
}
DEVI bf16x8 as_frag(u4 u) { return __builtin_bit_cast(bf16x8, u); }
DEVI float silu(float y) { return y / (1.f + __expf(-y)); }

struct EpiArgs { bf16_t* cb; float* cf; int ldc; const float* res0; const float* res1; float* yout; };
template <int EPI>
DEVI void gemm_tile(const bf16_t* __restrict__ A, int lda, const bf16_t* __restrict__ Bt, int ldb, int K, int m0, int n0, const EpiArgs& ea, unsigned char* smem) {
  const int tid = get_tid(), lane = tid & 63, wave = tid >> 6;
  const int wm = wave >> 1, wn = wave & 1, l31 = lane & 31, lh = lane >> 5;
  bf16_t* sA = (bf16_t*)smem;
  bf16_t* sB = sA + 2 * 128 * 72;
  f32x16 acc[2][2];
#pragma unroll
  for (int i = 0; i < 2; ++i)
#pragma unroll
    for (int j = 0; j < 2; ++j)
#pragma unroll
      for (int r = 0; r < 16; ++r) acc[i][j][r] = 0.f;
  const int lr = tid >> 3, lc = (tid & 7) * 8;
  const bf16_t* gA = A + (size_t)(m0 + lr) * lda + lc;
  const bf16_t* gB = Bt + (size_t)(n0 + lr) * ldb + lc;
  u4 ra0[4], rb0[4], ra1[4], rb1[4];
#define G_ISSUE(RA, RB, K0) { _Pragma("unroll") for (int i = 0; i < 4; ++i) { GLOAD16(RA[i], gA + (size_t)i * 32 * lda + (K0)); GLOAD16(RB[i], gB + (size_t)i * 32 * ldb + (K0)); } }
#define G_STASH(RA, RB, BUF) { _Pragma("unroll") for (int i = 0; i < 4; ++i) { *(u4*)(sA + (BUF) * 128 * 72 + (lr + i * 32) * 72 + lc) = RA[i]; *(u4*)(sB + (BUF) * 128 * 72 + (lr + i * 32) * 72 + lc) = RB[i]; } }
#define G_COMPUTE(BUF) { __builtin_amdgcn_s_setprio(1); const bf16_t* cA = sA + (BUF) * 128 * 72 + (wm * 64 + l31) * 72 + lh * 8; const bf16_t* cB = sB + (BUF) * 128 * 72 + (wn * 64 + l31) * 72 + lh * 8; \
    _Pragma("unroll") for (int ks = 0; ks < 4; ++ks) { \
      bf16x8 a0 = *(const bf16x8*)(cA + ks * 16), a1 = *(const bf16x8*)(cA + 32 * 72 + ks * 16); \
      bf16x8 b0 = *(const bf16x8*)(cB + ks * 16), b1 = *(const bf16x8*)(cB + 32 * 72 + ks * 16); \
      acc[0][0] = MFMA32(a0, b0, acc[0][0]); acc[0][1] = MFMA32(a0, b1, acc[0][1]); \
      acc[1][0] = MFMA32(a1, b0, acc[1][0]); acc[1][1] = MFMA32(a1, b1, acc[1][1]); } __builtin_amdgcn_s_setprio(0); }
  const int nk = K >> 6;
  VMWAIT(0);
  G_ISSUE(ra0, rb0, 0);
  G_ISSUE(ra1, rb1, 64);
  __syncthreads();
  VMWAIT(8);
  G_STASH(ra0, rb0, 0);
  LDS_BARRIER();
  for (int kt = 0; kt < nk; kt += 2) {
    G_ISSUE(ra0, rb0, ((kt + 2 < nk) ? kt + 2 : nk - 1) << 6);
    G_COMPUTE(0);
    VMWAIT(8);
    G_STASH(ra1, rb1, 1);
    LDS_BARRIER();
    G_ISSUE(ra1, rb1, ((kt + 3 < nk) ? kt + 3 : nk - 1) << 6);
    G_COMPUTE(1);
    VMWAIT(8);
    if (kt + 2 < nk) G_STASH(ra0, rb0, 0);
    LDS_BARRIER();
  }
  VMWAIT(0);
#pragma unroll
  for (int i = 0; i < 4; ++i) asm volatile("" :: "v"(ra0[i]), "v"(rb0[i]), "v"(ra1[i]), "v"(rb1[i]));
#undef G_ISSUE
#undef G_STASH
#undef G_COMPUTE
#pragma unroll
  for (int i = 0; i < 2; ++i)
#pragma unroll
    for (int r = 0; r < 16; ++r) {
      const int row = m0 + wm * 64 + i * 32 + (r >> 2) * 8 + lh * 4 + (r & 3);
#pragma unroll
      for (int j = 0; j < 2; ++j) {
        const int col = n0 + wn * 64 + j * 32 + l31;
        const float v = acc[i][j][r];
        if (EPI == 0) ea.cb[(size_t)row * ea.ldc + col] = f2bf(v);
        else if (EPI == 1) {
          const float* rp = ea.res1 ? (row < TP ? ea.res0 + (size_t)row * DM : ea.res1 + (size_t)(row - TP) * DM) : ea.res0 + (size_t)row * DM;
          ea.yout[(size_t)row * DM + col] = rp[col] + v;
        } else if (EPI == 4) { unsafeAtomicAdd(ea.yout + (size_t)row * DM + col, v); }
        else if (EPI == 2) { const float rl = v > 0.f ? v : 0.f; ea.cb[(size_t)row * ea.ldc + col] = f2bf(rl * rl); }
        else ea.cf[(size_t)row * ea.ldc + col] = v;
      }
    }
}
template <int EPI>
DEVI void gemm_phase(const bf16_t* A, int lda, const bf16_t* Bt, int K, int M, int N, const EpiArgs& ea, unsigned char* smem) {
  const int nM = M >> 7, nN = N >> 7, nwg = nM * nN;
  const int q = nwg >> 3, r = nwg & 7;
  for (int L = blockIdx.x; L < nwg; L += gridDim.x) {
    const int xcd = L & 7, off = L >> 3;
    const int wg = (xcd < r ? xcd * (q + 1) : r * (q + 1) + (xcd - r) * q) + off;
    const int nig = 8 * nN, gid = wg / nig, fm = gid * 8, gsz = (nM - fm) < 8 ? (nM - fm) : 8;
    const int pm = fm + ((wg % nig) % gsz), pn = (wg % nig) / gsz;
    gemm_tile<EPI>(A, lda, Bt, K, K, pm << 7, pn << 7, ea, smem);
  }
}


template <int EPI>
DEVI void gemm_tile_big(const bf16_t* __restrict__ A, int lda, const bf16_t* __restrict__ Bt, int ldb, int K, int m0, int n0, const EpiArgs& ea, unsigned char* smem) {
  const int tid = get_tid(), lane = tid & 63, wave = tid >> 6;
  const int wm = wave >> 1, wn = wave & 1, l31 = lane & 31, lh = lane >> 5;
  bf16_t* sA = (bf16_t*)smem;
  bf16_t* sB = sA + 256 * 72;
  f32x16 acc[4][2];
#pragma unroll
  for (int i = 0; i < 4; ++i)
#pragma unroll
    for (int j = 0; j < 2; ++j)
#pragma unroll
      for (int r = 0; r < 16; ++r) acc[i][j][r] = 0.f;
  const int lr = tid >> 3, lc = (tid & 7) * 8;
  const bf16_t* gA = A + (size_t)(m0 + lr) * lda + lc;
  const bf16_t* gB = Bt + (size_t)(n0 + lr) * ldb + lc;
  u4 ra[8], rb[4];
#define B_ISSUE(K0) { _Pragma("unroll") for (int i = 0; i < 8; ++i) GLOAD16(ra[i], gA + (size_t)i * 32 * lda + (K0)); _Pragma("unroll") for (int i = 0; i < 4; ++i) GLOAD16(rb[i], gB + (size_t)i * 32 * ldb + (K0)); }
#define B_STASH() { _Pragma("unroll") for (int i = 0; i < 8; ++i) *(u4*)(sA + (lr + i * 32) * 72 + lc) = ra[i]; _Pragma("unroll") for (int i = 0; i < 4; ++i) *(u4*)(sB + (lr + i * 32) * 72 + lc) = rb[i]; }
  const int nk = K >> 6;
  VMWAIT(0);
  B_ISSUE(0);
  __syncthreads();
  VMWAIT(0);
  B_STASH();
  LDS_BARRIER();
  for (int kt = 0; kt < nk; ++kt) {
    B_ISSUE(((kt + 1 < nk) ? kt + 1 : kt) << 6);
    {
      __builtin_amdgcn_s_setprio(1);
      const bf16_t* cA = sA + (wm * 128 + l31) * 72 + lh * 8;
      const bf16_t* cB = sB + (wn * 64 + l31) * 72 + lh * 8;
#pragma unroll
      for (int ks = 0; ks < 4; ++ks) {
        const bf16x8 b0 = *(const bf16x8*)(cB + ks * 16), b1 = *(const bf16x8*)(cB + 32 * 72 + ks * 16);
#pragma unroll
        for (int i = 0; i < 4; ++i) {
          const bf16x8 a = *(const bf16x8*)(cA + i * 32 * 72 + ks * 16);
          acc[i][0] = MFMA32(a, b0, acc[i][0]); acc[i][1] = MFMA32(a, b1, acc[i][1]);
        }
      }
      __builtin_amdgcn_s_setprio(0);
    }
    LDS_BARRIER();
    VMWAIT(0);
    if (kt + 1 < nk) B_STASH();
    LDS_BARRIER();
  }
#pragma unroll
  for (int i = 0; i < 8; ++i) asm volatile("" :: "v"(ra[i]));
#pragma unroll
  for (int i = 0; i < 4; ++i) asm volatile("" :: "v"(rb[i]));
#undef B_ISSUE
#undef B_STASH
#pragma unroll
  for (int i = 0; i < 4; ++i)
#pragma unroll
    for (int r = 0; r < 16; ++r) {
      const int row = m0 + wm * 128 + i * 32 + (r >> 2) * 8 + lh * 4 + (r & 3);
#pragma unroll
      for (int j = 0; j < 2; ++j) {
        const int col = n0 + wn * 64 + j * 32 + l31;
        const float v = acc[i][j][r];
        if (EPI == 0) ea.cb[(size_t)row * ea.ldc + col] = f2bf(v);
        else if (EPI == 1) { const float* rp = ea.res0 + (size_t)row * DM; ea.yout[(size_t)row * DM + col] = rp[col] + v; }
        else if (EPI == 2) { const float rl = v > 0.f ? v : 0.f; ea.cb[(size_t)row * ea.ldc + col] = f2bf(rl * rl); }
      }
      if ((r & 3) == 3) __builtin_amdgcn_sched_barrier(0);
    }
}
template <int EPI>
DEVI void gemm_phase_big(const bf16_t* A, int lda, const bf16_t* Bt, int K, int N, const EpiArgs& ea, unsigned char* smem) {
  const int nM = TP >> 8, nN = N >> 7, nwg = nM * nN;
  const int q = nwg >> 3, r = nwg & 7;
  for (int L = blockIdx.x; L < nwg; L += gridDim.x) {
    const int xcd = L & 7, off = L >> 3;
    const int wg = (xcd < r ? xcd * (q + 1) : r * (q + 1) + (xcd - r) * q) + off;
    const int nig = 8 * nN, gid = wg / nig, fm = gid * 8, gsz = (nM - fm) < 8 ? (nM - fm) : 8;
    const int pm = fm + ((wg % nig) % gsz), pn = (wg % nig) / gsz;
    gemm_tile_big<EPI>(A, lda, Bt, K, K, pm << 8, pn << 7, ea, smem);
  }
}
template <int EPI>
DEVI void gemm_phase_sample(const bf16_t* A, int lda, const bf16_t* Bt, int K, int N, const EpiArgs& ea, unsigned char* smem) {
  const int nN = N >> 7;
  for (int t = blockIdx.x; t < 4 * nN; t += gridDim.x) gemm_tile<EPI>(A, lda, Bt, K, K, TP + ((t / nN) << 7), (t % nN) << 7, ea, smem);
}

DEVI void gemm_phase_res(const bf16_t* A, int lda, const bf16_t* Bt, int K, const EpiArgs& ea, unsigned char* smem) {
  gemm_phase_big<1>(A, lda, Bt, K, 1024, ea, smem);
  const int S = (K == 4096) ? 16 : (K >> 7), klen = K / S;
  for (int it = blockIdx.x; it < 32 * S; it += gridDim.x) {
    const int tile = it / S, ks = it % S;
    gemm_tile<4>(A + (size_t)ks * klen, lda, Bt + (size_t)ks * klen, K, klen, TP + ((tile >> 3) << 7), (tile & 7) << 7, ea, smem);
  }
}

DEVI void convert_tile(const float* __restrict__ W, bf16_t* __restrict__ Wt, int K, int N, int k0, int n0, int thr, int shift, unsigned char* smem) {
  float* tile = (float*)smem;
  const int tid = get_tid();
  __syncthreads();
#pragma unroll
  for (int i = 0; i < 4; ++i) {
    const int r = (tid >> 4) + 16 * i, c = (tid & 15) * 4;
    float4 v = make_float4(0.f, 0.f, 0.f, 0.f);
    if (n0 + c < N) v = *(const float4*)(W + (size_t)(k0 + r) * N + n0 + c);
    tile[r * 65 + c] = v.x; tile[r * 65 + c + 1] = v.y; tile[r * 65 + c + 2] = v.z; tile[r * 65 + c + 3] = v.w;
  }
  __syncthreads();
  const int n = tid >> 2, kc = (tid & 3) * 16;
  if (n0 + n < N) {
    const int nn = n0 + n, nd = nn + (nn >= thr ? shift : 0);
    unsigned o[8];
#pragma unroll
    for (int e = 0; e < 8; ++e) o[e] = pk2(tile[(kc + 2 * e) * 65 + n], tile[(kc + 2 * e + 1) * 65 + n]);
    u4* dst = (u4*)(Wt + (size_t)nd * K + k0 + kc);
    dst[0] = mk4(o[0], o[1], o[2], o[3]); dst[1] = mk4(o[4], o[5], o[6], o[7]);
  }
}
DEVI void convert_group(int& base, int bid, int nb, const float* W, bf16_t* Wt, int nl, int K, int N, int NPAD, int thr, int shift, unsigned char* smem) {
  const int tk = K >> 6, tn = (N + 63) >> 6, per = tk * tn, tot = per * nl;
  int first = ((bid - base) % nb + nb) % nb;
  for (int t = first; t < tot; t += nb) {
    const int l = t / per, r = t % per;
    convert_tile(W + (size_t)l * K * N, Wt + (size_t)l * NPAD * K, K, N, (r / tn) << 6, (r % tn) << 6, thr, shift, smem);
  }
  base += tot;
}

#define CVT_TRY(W_, Wt_, nl_, K_, N_, NPAD_, thr_, sh_) { const int tk_ = (K_) >> 6, tn_ = ((N_) + 63) >> 6, per_ = tk_ * tn_, tot_ = per_ * (nl_); \
    if (t < tot_) { const int l_ = t / per_, r_ = t % per_; convert_tile((W_) + (size_t)l_ * (K_) * (N_), (Wt_) + (size_t)l_ * (NPAD_) * (K_), (K_), (N_), (r_ / tn_) << 6, (r_ % tn_) << 6, (thr_), (sh_), smem); break; } t -= tot_; }

DEVI void norm_row(const float* __restrict__ src, const float* __restrict__ gain, bf16_t* __restrict__ dst, int lane) {
  float4 v[4]; float ss = 0.f;
#pragma unroll
  for (int i = 0; i < 4; ++i) { v[i] = *(const float4*)(src + lane * 4 + 256 * i); ss += v[i].x * v[i].x + v[i].y * v[i].y + v[i].z * v[i].z + v[i].w * v[i].w; }
  ss = wave_sum(ss);
  const float sc = rsqrtf(ss * (1.f / 1024.f) + EPS);
#pragma unroll
  for (int i = 0; i < 4; ++i) {
    const float4 g = *(const float4*)(gain + lane * 4 + 256 * i);
    u2 o; o.x = pk2(v[i].x * sc * g.x, v[i].y * sc * g.y); o.y = pk2(v[i].z * sc * g.z, v[i].w * sc * g.w);
    *(u2*)(dst + lane * 4 + 256 * i) = o;
  }
}

DEVI void norm_row2(const float* __restrict__ s0, const float* __restrict__ s1, const float* __restrict__ gain, bf16_t* __restrict__ d0, bf16_t* __restrict__ d1, int lane) {
  float4 v[4], w[4]; float ss = 0.f, tt = 0.f;
#pragma unroll
  for (int i = 0; i < 4; ++i) { v[i] = *(const float4*)(s0 + lane * 4 + 256 * i); w[i] = *(const float4*)(s1 + lane * 4 + 256 * i); }
#pragma unroll
  for (int i = 0; i < 4; ++i) { ss += v[i].x * v[i].x + v[i].y * v[i].y + v[i].z * v[i].z + v[i].w * v[i].w; tt += w[i].x * w[i].x + w[i].y * w[i].y + w[i].z * w[i].z + w[i].w * w[i].w; }
#pragma unroll
  for (int o = 32; o >= 1; o >>= 1) { ss += __shfl_xor(ss, o); tt += __shfl_xor(tt, o); }
  const float sc = rsqrtf(ss * (1.f / 1024.f) + EPS), tc = rsqrtf(tt * (1.f / 1024.f) + EPS);
#pragma unroll
  for (int i = 0; i < 4; ++i) {
    const float4 g = *(const float4*)(gain + lane * 4 + 256 * i);
    u2 o; o.x = pk2(v[i].x * sc * g.x, v[i].y * sc * g.y); o.y = pk2(v[i].z * sc * g.z, v[i].w * sc * g.w);
    *(u2*)(d0 + lane * 4 + 256 * i) = o;
    u2 q; q.x = pk2(w[i].x * tc * g.x, w[i].y * tc * g.y); q.y = pk2(w[i].z * tc * g.z, w[i].w * tc * g.w);
    *(u2*)(d1 + lane * 4 + 256 * i) = q;
  }
}
DEVI void norm_all(const float* __restrict__ Y, const float* __restrict__ gain, bf16_t* __restrict__ XN, int gw, int ngw, int lane) {
  for (int r = gw; r < TA; r += ngw) norm_row(Y + (size_t)r * DM, gain, XN + (size_t)r * DM, lane);
}

struct KVSrc { const void* k; const void* v; int kpitch, vpitch, f32; };
template <int D>
DEVI void attn_load(const KVSrc& s, int r0, u4 (&kr)[D / 32], u4 (&vr)[D / 32]) {
  const int tid = get_tid();
#pragma unroll
  for (int i = 0; i < D / 32; ++i) {
    const int c = tid + 256 * i, key = c / (D / 8), dch = c % (D / 8);
    if (s.f32) {
      const float* kp = (const float*)s.k + (size_t)(r0 + key) * s.kpitch + dch * 8;
      const float* vp = (const float*)s.v + (size_t)(r0 + key) * s.vpitch + dch * 8;
      const float4 a = *(const float4*)kp, b = *(const float4*)(kp + 4), c2 = *(const float4*)vp, d2 = *(const float4*)(vp + 4);
      kr[i] = mk4(pk2(a.x, a.y), pk2(a.z, a.w), pk2(b.x, b.y), pk2(b.z, b.w));
      vr[i] = mk4(pk2(c2.x, c2.y), pk2(c2.z, c2.w), pk2(d2.x, d2.y), pk2(d2.z, d2.w));
      __builtin_amdgcn_sched_barrier(0);
    } else {
      kr[i] = *(const u4*)((const bf16_t*)s.k + (size_t)(r0 + key) * s.kpitch + dch * 8);
      vr[i] = *(const u4*)((const bf16_t*)s.v + (size_t)(r0 + key) * s.vpitch + dch * 8);
    }
  }
}
template <int D>
DEVI void attn_store(bf16_t* Ks, bf16_t* Vt, const u4 (&kr)[D / 32], const u4 (&vr)[D / 32]) {
  const int tid = get_tid();
#pragma unroll
  for (int i = 0; i < D / 32; ++i) {
    const int c = tid + 256 * i, key = c / (D / 8), dch = c % (D / 8);
    *(u4*)(Ks + key * (D + 8) + dch * 8) = kr[i];
    const int kx = key ^ ((dch & 15) << 2);
    const unsigned w[4] = {vr[i].x, vr[i].y, vr[i].z, vr[i].w};
#pragma unroll
    for (int e = 0; e < 8; ++e) Vt[(dch * 8 + e) * 72 + kx] = (bf16_t)((w[e >> 1] >> (16 * (e & 1))) & 0xffffu);
  }
}

template <int D, int MODE>
DEVI void attn_item(const bf16_t* __restrict__ qsrc, int qpitch, int nq, const float* __restrict__ qgain, float qscale,
                    const KVSrc& segA, int nA, int qposA0, int maskA, const KVSrc& segB, int nB,
                    bf16_t* __restrict__ out, int opitch, unsigned char* smem, float* __restrict__ carry_out = nullptr) {
  constexpr int KPT = D + 8, NKS = D / 16, NDB = D / 32, NCH = D / 32;
  constexpr int STAGE = 64 * KPT + D * 72;
  const int tid = get_tid(), lane = tid & 63, wave = tid >> 6, l31 = lane & 31, lh = lane >> 5;
  bf16_t* sbase = (bf16_t*)smem;
  const bool active = wave * 32 < nq;
  bf16x8 qf[NKS];
  {
    float qv[NKS][8]; float ss = 0.f;
    const bf16_t* qp = qsrc + (size_t)(wave * 32 + l31) * qpitch + lh * 8;
#pragma unroll
    for (int ks = 0; ks < NKS; ++ks) {
      u4 u = mk4(0, 0, 0, 0);
      if (active) u = *(const u4*)(qp + ks * 16);
      const unsigned w[4] = {u.x, u.y, u.z, u.w};
#pragma unroll
      for (int e = 0; e < 4; ++e) { qv[ks][2 * e] = lo2f(w[e]); qv[ks][2 * e + 1] = hi2f(w[e]); }
#pragma unroll
      for (int e = 0; e < 8; ++e) ss += qv[ks][e] * qv[ks][e];
    }
    ss += __shfl_xor(ss, 32);
    const float sc = rsqrtf(ss * (1.f / D) + EPS) * qscale;
#pragma unroll
    for (int ks = 0; ks < NKS; ++ks) {
      const float4 g0 = *(const float4*)(qgain + ks * 16 + lh * 8), g1 = *(const float4*)(qgain + ks * 16 + lh * 8 + 4);
      u4 u;
      u.x = pk2(qv[ks][0] * sc * g0.x, qv[ks][1] * sc * g0.y); u.y = pk2(qv[ks][2] * sc * g0.z, qv[ks][3] * sc * g0.w);
      u.z = pk2(qv[ks][4] * sc * g1.x, qv[ks][5] * sc * g1.y); u.w = pk2(qv[ks][6] * sc * g1.z, qv[ks][7] * sc * g1.w);
      qf[ks] = as_frag(u);
    }
  }
  f32x16 oacc[NDB];
#pragma unroll
  for (int db = 0; db < NDB; ++db)
#pragma unroll
    for (int r = 0; r < 16; ++r) oacc[db][r] = 0.f;
  float carry = 1.f, mx = -1e30f, lsum = 0.f;
  const int ntot = nA + nB;
  const int qpos = qposA0 + wave * 32 + l31;
  u4 kr[NCH], vr[NCH];
  {
    const bool inA = 0 < nA; const int tix = inA ? nA - 1 : nB - 1;
    attn_load<D>(inA ? segA : segB, tix * 64, kr, vr);
    __syncthreads();
    attn_store<D>(sbase, sbase + 64 * KPT, kr, vr);
    __syncthreads();
  }
  for (int it = 0; it < ntot; ++it) {
    const int cur = it & 1;
    if (it + 1 < ntot) {
      const bool nInA = (it + 1) < nA; const int tix = nInA ? nA - 2 - it : nB - 1 - (it + 1 - nA);
      attn_load<D>(nInA ? segA : segB, tix * 64, kr, vr);
    }
    const bool inA = it < nA;
    const int kbase = inA ? (nA - 1 - it) * 64 : 0;
    const bf16_t* Ks = sbase + cur * STAGE;
    const bf16_t* Vt = Ks + 64 * KPT;
    const bool mneed = inA && maskA && (kbase + 63 >= qposA0 + wave * 32);
    const bool skip = !active || (inA && maskA && (kbase > qposA0 + wave * 32 + 31));
    if (!skip) {
      bf16x8 pf[2][2];
      if (MODE == 0) {
        float after = carry;
#pragma unroll
        for (int rt = 1; rt >= 0; --rt) {
          f32x16 z;
#pragma unroll
          for (int r = 0; r < 16; ++r) z[r] = 0.f;
#pragma unroll
          for (int ks = 0; ks < NKS; ++ks) {
            const bf16x8 a = *(const bf16x8*)(Ks + (rt * 32 + l31) * KPT + ks * 16 + lh * 8);
            z = MFMA32(a, qf[ks], z);
          }
          float ee[16], rr[16];
#pragma unroll
          for (int i = 0; i < 16; ++i) {
            float e = ex2(z[i]);
            if (mneed) { const int key = kbase + rt * 32 + (i >> 2) * 8 + lh * 4 + (i & 3); if (key >= qpos) e = 0.f; }
            ee[i] = e; rr[i] = __builtin_amdgcn_rcpf(1.f + e);
          }
          float a_[16];
#pragma unroll
          for (int g = 3; g >= 0; --g) {
            const float s4 = (rr[g * 4] * rr[g * 4 + 1]) * (rr[g * 4 + 2] * rr[g * 4 + 3]);
            const float p4 = __shfl_xor(s4, 32);
            float c = lh == 0 ? after * p4 : after;
            after *= s4 * p4;
#pragma unroll
            for (int e = 3; e >= 0; --e) { c *= rr[g * 4 + e]; a_[g * 4 + e] = ee[g * 4 + e] * c; }
          }
#pragma unroll
          for (int s2 = 0; s2 < 2; ++s2)
            pf[rt][s2] = as_frag(mk4(pk2(a_[8 * s2 + 0], a_[8 * s2 + 1]), pk2(a_[8 * s2 + 2], a_[8 * s2 + 3]), pk2(a_[8 * s2 + 4], a_[8 * s2 + 5]), pk2(a_[8 * s2 + 6], a_[8 * s2 + 7])));
        }
        carry = after;
      } else {
        f32x16 z[2];
#pragma unroll
        for (int rt = 0; rt < 2; ++rt) {
          f32x16 zt;
#pragma unroll
          for (int r = 0; r < 16; ++r) zt[r] = 0.f;
#pragma unroll
          for (int ks = 0; ks < NKS; ++ks) {
            const bf16x8 a = *(const bf16x8*)(Ks + (rt * 32 + l31) * KPT + ks * 16 + lh * 8);
            zt = MFMA32(a, qf[ks], zt);
          }
          z[rt] = zt;
        }
        float tm = z[0][0];
#pragma unroll
        for (int rt = 0; rt < 2; ++rt)
#pragma unroll
          for (int i = 0; i < 16; ++i) tm = fmaxf(tm, z[rt][i]);
        tm = fmaxf(tm, __shfl_xor(tm, 32));
        const float nm = fmaxf(mx, tm);
        const float alpha = ex2(mx - nm);
        mx = nm;
        float ps = 0.f;
        float a_[2][16];
#pragma unroll
        for (int rt = 0; rt < 2; ++rt)
#pragma unroll
          for (int i = 0; i < 16; ++i) { a_[rt][i] = ex2(z[rt][i] - nm); ps += a_[rt][i]; }
        lsum = lsum * alpha + ps;
#pragma unroll
        for (int db = 0; db < NDB; ++db)
#pragma unroll
          for (int r = 0; r < 16; ++r) oacc[db][r] *= alpha;
#pragma unroll
        for (int rt = 0; rt < 2; ++rt)
#pragma unroll
          for (int s2 = 0; s2 < 2; ++s2)
            pf[rt][s2] = as_frag(mk4(pk2(a_[rt][8 * s2 + 0], a_[rt][8 * s2 + 1]), pk2(a_[rt][8 * s2 + 2], a_[rt][8 * s2 + 3]), pk2(a_[rt][8 * s2 + 4], a_[rt][8 * s2 + 5]), pk2(a_[rt][8 * s2 + 6], a_[rt][8 * s2 + 7])));
      }
#pragma unroll
      for (int db = 0; db < NDB; ++db) {
        const int d = db * 32 + l31, sw = ((d >> 3) & 15) << 2;
#pragma unroll
        for (int rt = 0; rt < 2; ++rt)
#pragma unroll
          for (int s = 0; s < 2; ++s) {
            const int kb0 = rt * 32 + 16 * s + 4 * lh;
            const u2 lo = *(const u2*)(Vt + d * 72 + (kb0 ^ sw));
            const u2 hi = *(const u2*)(Vt + d * 72 + ((kb0 + 8) ^ sw));
            oacc[db] = MFMA32(as_frag(mk4(lo.x, lo.y, hi.x, hi.y)), pf[rt][s], oacc[db]);
          }
      }
    }
    if (it + 1 < ntot) { bf16_t* nK = sbase + (cur ^ 1) * STAGE; attn_store<D>(nK, nK + 64 * KPT, kr, vr); }
    LDS_BARRIER();
  }
  if (active && carry_out && lh == 0) carry_out[(size_t)(wave * 32 + l31) * 4] = carry;
  if (active) {
    float inv = 1.f;
    if (MODE == 1) { const float l = lsum + __shfl_xor(lsum, 32); inv = 1.f / l; }
    bf16_t* op = out + (size_t)(wave * 32 + l31) * opitch + lh * 4;
#pragma unroll
    for (int db = 0; db < NDB; ++db)
#pragma unroll
      for (int g = 0; g < 4; ++g) {
        u2 o; o.x = pk2(oacc[db][g * 4] * inv, oacc[db][g * 4 + 1] * inv); o.y = pk2(oacc[db][g * 4 + 2] * inv, oacc[db][g * 4 + 3] * inv);
        *(u2*)(op + db * 32 + g * 8) = o;
      }
  }
}

DEVI void mem_attn_item(const KP& p, int layer, int item, const bf16_t* P, int np, int mqoff, bf16_t* mix, int mixp, int mixoff, unsigned char* smem) {
  const int h = item & 3;
  int t0, nq; const float *kk, *vv;
  if (item < 512) { t0 = (item >> 2) * 128; nq = 128; kk = p.out + O_PMK + (size_t)layer * 65536; vv = p.out + O_PMV + (size_t)layer * 65536; }
  else { const int b = (item - 512) >> 2; t0 = TP + b * 64; nq = 64; kk = p.in[6] + ((size_t)layer * 8 + b) * 65536; vv = p.in[7] + ((size_t)layer * 8 + b) * 65536; }
  KVSrc s; s.k = kk + h * 64; s.v = vv + h * 64; s.kpitch = 256; s.vpitch = 256; s.f32 = 1;
  attn_item<64, 1>(P + (size_t)t0 * np + mqoff + h * 64, np, nq, p.in[15] + layer * 64, 0.125f * LOG2E, s, 4, 0, 0, s, 0,
                   mix + (size_t)t0 * mixp + mixoff + h * 64, mixp, smem);
}

DEVI void gdn_prep_item(const KP& p, int j, int ci, int h, const bf16_t* P, unsigned char* smem) {
  constexpr int NP = NP_GDN;
  const int tid = get_tid(), lane = tid & 63, wave = tid >> 6;
  const int item = ci * 6 + h;
  const bool samp = ci >= 256;
  const int b = ci - 256;
  const int t0 = samp ? TP + b * 64 : ci * 64;
  float* stage = (float*)smem;
  float* sL = (float*)smem;
  bf16_t* qn = (bf16_t*)(smem + 33280);
  bf16_t* kn = qn + 64 * 136;
  float* sgc = (float*)(smem + 33280 + 2 * 64 * 136 * 2);
  float* sbeta = sgc + 64;
  float* segc = sbeta + 64;
  unsigned char* gi = p.ws + WS_G + (size_t)item * G_ITEM;
  bf16_t* gU = (bf16_t*)gi; bf16_t* gW = gU + 8192; bf16_t* gQD = gW + 8192; bf16_t* gKDT = gQD + 8192; bf16_t* gAI = gKDT + 8192;
  const float* convw = p.in[17] + (size_t)j * 4 * 2304;
  const float* cstate = p.in[2] + ((size_t)j * 8 + (samp ? b : 0)) * 3 * 2304;
  const bf16_t* Pc = P + (size_t)t0 * NP;
  __syncthreads();
  if (wave == 0) {
    const float braw = bf2f(Pc[(size_t)lane * NP + 3072 + h]), araw = bf2f(Pc[(size_t)lane * NP + 3078 + h]);
    const float beta = 1.f / (1.f + __expf(-braw));
    const float xx = araw + p.in[19][j * 6 + h];
    const float sp = xx > 20.f ? xx : __logf(1.f + __expf(xx));
    float g = -__expf(p.in[18][j * 6 + h]) * sp;
#pragma unroll
    for (int d = 1; d < 64; d <<= 1) { const float v = __shfl_up(g, d); if (lane >= d) g += v; }
    sgc[lane] = g; sbeta[lane] = beta; segc[lane] = __expf(g);
    if (lane == 63) ((float*)(p.ws + WS_GL))[item] = __expf(g);
  }
  if (samp || ci == 255) {
    float* dst = samp ? p.out + O_SGC + ((size_t)j * 8 + b) * 3 * 2304 : p.out + O_PGC + (size_t)j * 3 * 2304;
    for (int idx = tid; idx < 1152; idx += 256) {
      const int r = idx / 384, cc = idx % 384, ch = (cc >> 7) * 768 + h * 128 + (cc & 127);
      dst[r * 2304 + ch] = bf2f(Pc[(size_t)(61 + r) * NP + ch]);
    }
  }
  const float gcl_dummy = 0.f; (void)gcl_dummy;
#pragma unroll 1
  for (int which = 0; which < 2; ++which) {
    {
      const int c = tid & 127, th = tid >> 7, ch = which * 768 + h * 128 + c;
      const float w0 = convw[ch], w1 = convw[2304 + ch], w2 = convw[2 * 2304 + ch], w3 = convw[3 * 2304 + ch];
      float xm3, xm2, xm1;
      if (th == 1) { xm3 = bf2f(Pc[(size_t)29 * NP + ch]); xm2 = bf2f(Pc[(size_t)30 * NP + ch]); xm1 = bf2f(Pc[(size_t)31 * NP + ch]); }
      else if (samp) { xm3 = cstate[ch]; xm2 = cstate[2304 + ch]; xm1 = cstate[2 * 2304 + ch]; }
      else if (ci == 0) { xm3 = xm2 = xm1 = 0.f; }
      else { xm3 = bf2f(Pc[-(ptrdiff_t)3 * NP + ch]); xm2 = bf2f(Pc[-(ptrdiff_t)2 * NP + ch]); xm1 = bf2f(Pc[-(ptrdiff_t)NP + ch]); }
      const bf16_t* pp = Pc + (size_t)(th * 32) * NP + ch;
#pragma unroll 8
      for (int tt = 0; tt < 32; ++tt) {
        const float x0 = bf2f(pp[(size_t)tt * NP]);
        const float y = w0 * xm3 + w1 * xm2 + w2 * xm1 + w3 * x0;
        stage[(th * 32 + tt) * 129 + c] = silu(y);
        xm3 = xm2; xm2 = xm1; xm1 = x0;
      }
    }
    __syncthreads();
    {
      const int tt = tid >> 2, part = tid & 3;
      float v[32]; float ss = 0.f;
#pragma unroll
      for (int e = 0; e < 32; ++e) { v[e] = stage[tt * 129 + part * 32 + e]; ss += v[e] * v[e]; }
      ss += __shfl_xor(ss, 1); ss += __shfl_xor(ss, 2);
      float rinv = rsqrtf(ss + EPS);
      if (which == 0) rinv *= 0.08838834764831845f;
      bf16_t* dn = (which == 0 ? qn : kn) + tt * 136 + part * 32;
      const float eg = segc[tt];
#pragma unroll
      for (int e = 0; e < 32; e += 8) {
        u4 u; u.x = pk2(v[e] * rinv, v[e + 1] * rinv); u.y = pk2(v[e + 2] * rinv, v[e + 3] * rinv); u.z = pk2(v[e + 4] * rinv, v[e + 5] * rinv); u.w = pk2(v[e + 6] * rinv, v[e + 7] * rinv);
        *(u4*)(dn + e) = u;
        if (which == 0) {
          const float s2 = rinv * eg;
          u4 w; w.x = pk2(v[e] * s2, v[e + 1] * s2); w.y = pk2(v[e + 2] * s2, v[e + 3] * s2); w.z = pk2(v[e + 4] * s2, v[e + 5] * s2); w.w = pk2(v[e + 6] * s2, v[e + 7] * s2);
          *(u4*)(gQD + tt * 128 + part * 32 + e) = w;
        }
      }
    }
    __syncthreads();
  }
  {
    const int d = tid & 127, th = tid >> 7;
    const float gcl = sgc[63];
#pragma unroll
    for (int q8 = 0; q8 < 4; ++q8) {
      float f[8];
#pragma unroll
      for (int e = 0; e < 8; ++e) { const int tt = th * 32 + q8 * 8 + e; f[e] = bf2f(kn[tt * 136 + d]) * __expf(gcl - sgc[tt]); }
      *(u4*)(gKDT + d * 64 + th * 32 + q8 * 8) = mk4(pk2(f[0], f[1]), pk2(f[2], f[3]), pk2(f[4], f[5]), pk2(f[6], f[7]));
    }
  }
  {
    const int l31 = lane & 31, lh = lane >> 5, ri = wave >> 1, cj = wave & 1;
    f32x16 kk, qk;
#pragma unroll
    for (int r = 0; r < 16; ++r) { kk[r] = 0.f; qk[r] = 0.f; }
#pragma unroll
    for (int ks = 0; ks < 8; ++ks) {
      const bf16x8 ak = *(const bf16x8*)(kn + (ri * 32 + l31) * 136 + ks * 16 + lh * 8);
      const bf16x8 aq = *(const bf16x8*)(qn + (ri * 32 + l31) * 136 + ks * 16 + lh * 8);
      const bf16x8 bk = *(const bf16x8*)(kn + (cj * 32 + l31) * 136 + ks * 16 + lh * 8);
      kk = MFMA32(ak, bk, kk); qk = MFMA32(aq, bk, qk);
    }
    const int jj = cj * 32 + l31; const float gj = sgc[jj];
#pragma unroll
    for (int r = 0; r < 16; ++r) {
      const int ii = ri * 32 + (r >> 2) * 8 + lh * 4 + (r & 3);
      const float dec = ii >= jj ? __expf(sgc[ii] - gj) : 0.f;
      sL[ii * 64 + jj] = ii > jj ? sbeta[ii] * kk[r] * dec : 0.f;
      gAI[ii * 64 + jj] = f2bf(qk[r] * dec);
    }
  }
  __syncthreads();
  {
    float x[64];
    if (tid < 128) {
      const int ch = 1536 + h * 128 + tid;
      const float w0 = convw[ch], w1 = convw[2304 + ch], w2 = convw[2 * 2304 + ch], w3 = convw[3 * 2304 + ch];
      float xm3, xm2, xm1;
      if (samp) { xm3 = cstate[ch]; xm2 = cstate[2304 + ch]; xm1 = cstate[2 * 2304 + ch]; }
      else if (ci == 0) { xm3 = xm2 = xm1 = 0.f; }
      else { xm3 = bf2f(Pc[-(ptrdiff_t)3 * NP + ch]); xm2 = bf2f(Pc[-(ptrdiff_t)2 * NP + ch]); xm1 = bf2f(Pc[-(ptrdiff_t)NP + ch]); }
#pragma unroll
      for (int tt = 0; tt < 64; ++tt) {
        const float x0 = bf2f(Pc[(size_t)tt * NP + ch]);
        const float y = w0 * xm3 + w1 * xm2 + w2 * xm1 + w3 * x0;
        x[tt] = silu(y) * sbeta[tt];
        xm3 = xm2; xm2 = xm1; xm1 = x0;
        if ((tt & 7) == 7) __builtin_amdgcn_sched_barrier(0);
      }
    } else {
#pragma unroll
      for (int tt = 0; tt < 64; ++tt) { x[tt] = bf2f(kn[tt * 136 + tid - 128]) * sbeta[tt] * segc[tt]; if ((tt & 7) == 7) __builtin_amdgcn_sched_barrier(0); }
    }
#pragma unroll
    for (int i = 1; i < 64; ++i) {
      float a = x[i];
#pragma unroll
      for (int jx = 0; jx < i; ++jx) a -= sL[i * 64 + jx] * x[jx];
      x[i] = a;
      __builtin_amdgcn_sched_barrier(0);
    }
    if (tid < 128) {
#pragma unroll
      for (int t8 = 0; t8 < 8; ++t8) {
        *(u4*)(gU + tid * 64 + t8 * 8) = mk4(pk2(x[t8 * 8], x[t8 * 8 + 1]), pk2(x[t8 * 8 + 2], x[t8 * 8 + 3]), pk2(x[t8 * 8 + 4], x[t8 * 8 + 5]), pk2(x[t8 * 8 + 6], x[t8 * 8 + 7]));
        __builtin_amdgcn_sched_barrier(0);
      }
    } else {
      bf16_t* dst = gW + (tid & 127);
#pragma unroll
      for (int tt = 0; tt < 64; ++tt) { dst[tt * 128] = f2bf(x[tt]); if ((tt & 7) == 7) __builtin_amdgcn_sched_barrier(0); }
    }
  }
}

struct ScanFrags { u4 w[4], qd[4], ai[2], kdt[2][2]; u2 u; float gl; };
DEVI void scan_load(const KP& p, int item, int wave, int lane, int sl, ScanFrags& f) {
  const int n = lane & 15, g = lane >> 4;
  const unsigned char* gi = p.ws + WS_G + (size_t)item * G_ITEM;
  const bf16_t* gU = (const bf16_t*)gi; const bf16_t* gW = gU + 8192; const bf16_t* gQD = gW + 8192; const bf16_t* gKDT = gQD + 8192; const bf16_t* gAI = gKDT + 8192;
#pragma unroll
  for (int s = 0; s < 4; ++s) { GLOAD16(f.w[s], gW + (16 * wave + n) * 128 + 32 * s + 8 * g); GLOAD16(f.qd[s], gQD + (16 * wave + n) * 128 + 32 * s + 8 * g); }
#pragma unroll
  for (int s = 0; s < 2; ++s) {
    GLOAD16(f.ai[s], gAI + (16 * wave + n) * 64 + 32 * s + 8 * g);
#pragma unroll
    for (int tt = 0; tt < 2; ++tt) GLOAD16(f.kdt[tt][s], gKDT + (32 * wave + 16 * tt + n) * 64 + 32 * s + 8 * g);
  }
  const bf16_t* up = gU + (sl * 16 + n) * 64 + 16 * wave + 4 * g;
  asm volatile("global_load_dwordx2 %0, %1, off" : "=&v"(f.u) : "v"(up) : "memory");
  const float* glp = (const float*)(p.ws + WS_GL) + item;
  asm volatile("global_load_dword %0, %1, off" : "=&v"(f.gl) : "v"(glp) : "memory");
}
DEVI void scan_wait32(ScanFrags& f) {
  asm volatile("s_waitcnt vmcnt(32)"
               : "+v"(f.w[0]), "+v"(f.w[1]), "+v"(f.w[2]), "+v"(f.w[3]), "+v"(f.qd[0]), "+v"(f.qd[1]), "+v"(f.qd[2]), "+v"(f.qd[3]),
                 "+v"(f.ai[0]), "+v"(f.ai[1]), "+v"(f.kdt[0][0]), "+v"(f.kdt[0][1]), "+v"(f.kdt[1][0]), "+v"(f.kdt[1][1]),
                 "+v"(f.u), "+v"(f.gl)
               :: "memory");
}
DEVI void scan_keep(const ScanFrags& f) {
#pragma unroll
  for (int s = 0; s < 4; ++s) asm volatile("" :: "v"(f.w[s]), "v"(f.qd[s]));
#pragma unroll
  for (int s = 0; s < 2; ++s) asm volatile("" :: "v"(f.ai[s]), "v"(f.kdt[0][s]), "v"(f.kdt[1][s]));
  asm volatile("" :: "v"(f.u), "v"(f.gl));
}
DEVI void scan_step(const ScanFrags& f, f32x4 (&sacc)[2], bf16_t* St, bf16_t* Vnt, bf16_t* O, int t0, int h, int sl, int wave, int n, int g) {
  bf16x8 sf[4];
#pragma unroll
  for (int s = 0; s < 4; ++s) sf[s] = *(const bf16x8*)(St + n * 136 + 32 * s + 8 * g);
  f32x4 wsa = {0.f, 0.f, 0.f, 0.f}, oa = {0.f, 0.f, 0.f, 0.f};
#pragma unroll
  for (int s = 0; s < 4; ++s) wsa = MFMA16(as_frag(f.w[s]), sf[s], wsa);
  float vn[4];
  vn[0] = lo2f(f.u.x) - wsa[0]; vn[1] = hi2f(f.u.x) - wsa[1]; vn[2] = lo2f(f.u.y) - wsa[2]; vn[3] = hi2f(f.u.y) - wsa[3];
  { u2 o; o.x = pk2(vn[0], vn[1]); o.y = pk2(vn[2], vn[3]); *(u2*)(Vnt + n * 72 + 16 * wave + 4 * g) = o; }
#pragma unroll
  for (int s = 0; s < 4; ++s) oa = MFMA16(as_frag(f.qd[s]), sf[s], oa);
  LDS_BARRIER();
  bf16x8 vf[2];
#pragma unroll
  for (int s = 0; s < 2; ++s) vf[s] = *(const bf16x8*)(Vnt + n * 72 + 32 * s + 8 * g);
#pragma unroll
  for (int s = 0; s < 2; ++s) oa = MFMA16(as_frag(f.ai[s]), vf[s], oa);
#pragma unroll
  for (int r = 0; r < 4; ++r) O[(size_t)(t0 + 16 * wave + 4 * g + r) * 768 + h * 128 + sl * 16 + n] = f2bf(oa[r]);
#pragma unroll
  for (int tt = 0; tt < 2; ++tt) {
#pragma unroll
    for (int r = 0; r < 4; ++r) sacc[tt][r] *= f.gl;
#pragma unroll
    for (int s = 0; s < 2; ++s) sacc[tt] = MFMA16(as_frag(f.kdt[tt][s]), vf[s], sacc[tt]);
    u2 o; o.x = pk2(sacc[tt][0], sacc[tt][1]); o.y = pk2(sacc[tt][2], sacc[tt][3]);
    *(u2*)(St + n * 136 + 32 * wave + 16 * tt + 4 * g) = o;
  }
  LDS_BARRIER();
}
DEVI void gdn_scan_stream(const KP& p, int j, int ci0, int nch, int h, int sl, const float* s0, float* sout, bf16_t* O, unsigned char* smem) {
  const int tid = get_tid(), lane = tid & 63, wave = tid >> 6, n = lane & 15, g = lane >> 4;
  bf16_t* St = (bf16_t*)smem;
  bf16_t* Vnt = St + 16 * 136;
  f32x4 sacc[2];
#pragma unroll
  for (int tt = 0; tt < 2; ++tt)
#pragma unroll
    for (int r = 0; r < 4; ++r) sacc[tt][r] = s0 ? s0[(size_t)(32 * wave + 16 * tt + 4 * g + r) * 128 + sl * 16 + n] : 0.f;
  __syncthreads();
#pragma unroll
  for (int tt = 0; tt < 2; ++tt) { u2 o; o.x = pk2(sacc[tt][0], sacc[tt][1]); o.y = pk2(sacc[tt][2], sacc[tt][3]); *(u2*)(St + n * 136 + 32 * wave + 16 * tt + 4 * g) = o; }
  ScanFrags f0, f1, f2;
#define CL(c) ((ci0 + (((c) < nch) ? (c) : nch - 1)) * 6 + h)
#define T0(c) (((ci0 + (c)) >= 256) ? TP + (ci0 + (c) - 256) * 64 : (ci0 + (c)) * 64)
  VMWAIT(0);
  scan_load(p, CL(0), wave, lane, sl, f0);
  scan_load(p, CL(1), wave, lane, sl, f1);
  LDS_BARRIER();
  for (int c = 0; c < nch; c += 3) {
    scan_load(p, CL(c + 2), wave, lane, sl, f2); scan_wait32(f0);
    scan_step(f0, sacc, St, Vnt, O, T0(c), h, sl, wave, n, g);
    if (c + 1 < nch) {
      scan_load(p, CL(c + 3), wave, lane, sl, f0); scan_wait32(f1);
      scan_step(f1, sacc, St, Vnt, O, T0(c + 1), h, sl, wave, n, g);
    }
    if (c + 2 < nch) {
      scan_load(p, CL(c + 4), wave, lane, sl, f1); scan_wait32(f2);
      scan_step(f2, sacc, St, Vnt, O, T0(c + 2), h, sl, wave, n, g);
    }
  }
  VMWAIT(0);
  scan_keep(f0); scan_keep(f1); scan_keep(f2);
#undef CL
#undef T0
#pragma unroll
  for (int tt = 0; tt < 2; ++tt)
#pragma unroll
    for (int r = 0; r < 4; ++r) sout[(size_t)(32 * wave + 16 * tt + 4 * g + r) * 128 + sl * 16 + n] = sacc[tt][r];
}

DEVI int next_item(unsigned* ctr) {
  __shared__ int s_item;
  __syncthreads();
  if (get_tid() == 0) s_item = (int)atomicAdd(ctr, 1u);
  __syncthreads();
  return s_item;
}

DEVI unsigned xcc_id() { return (unsigned)__builtin_amdgcn_s_getreg((3 << 11) | 20) & 0xFu; }
DEVI unsigned ld_relaxed(unsigned* p) { return __hip_atomic_load(p, __ATOMIC_RELAXED, __HIP_MEMORY_SCOPE_AGENT); }
DEVI void gbar_setup(unsigned* ctr, unsigned nb, unsigned* sb) {
  if (get_tid() == 0) {
    const unsigned x = xcc_id();
    __hip_atomic_fetch_add(ctr + 544 + 8 * x, 1u, __ATOMIC_RELAXED, __HIP_MEMORY_SCOPE_AGENT);
    unsigned nx, mine;
    for (;;) {
      unsigned sum = 0; nx = 0; mine = 0;
      for (unsigned j = 0; j < 16; ++j) { const unsigned c = ld_relaxed(ctr + 544 + 8 * j); sum += c; nx += c ? 1u : 0u; mine = (j == x) ? c : mine; }
      if (sum == nb) break;
      __builtin_amdgcn_s_sleep(2);
    }
    sb[0] = x; sb[1] = mine; sb[2] = nx;
  }
  __syncthreads();
}
DEVI void gbar(unsigned* ctr, unsigned* sb, unsigned& gen) {
  asm volatile("s_waitcnt vmcnt(0)" ::: "memory");
  __syncthreads();
  gen++;
  if (get_tid() == 0) {
    const unsigned x = sb[0], nloc = sb[1], nx = sb[2];
    const unsigned old = __hip_atomic_fetch_add(ctr + 704 + 8 * x, 1u, __ATOMIC_RELAXED, __HIP_MEMORY_SCOPE_AGENT);
    if (old + 1u == gen * nloc) {
      __builtin_amdgcn_fence(__ATOMIC_RELEASE, "agent");
      asm volatile("s_waitcnt vmcnt(0)" ::: "memory");
      __hip_atomic_fetch_add(ctr + 528, 1u, __ATOMIC_RELAXED, __HIP_MEMORY_SCOPE_AGENT);
    }
    for (unsigned it = 0; ld_relaxed(ctr + 528) < gen * nx; ++it) {
      if (it < 8) __builtin_amdgcn_s_sleep(4); else if (it < 24) __builtin_amdgcn_s_sleep(32); else __builtin_amdgcn_s_sleep(127);
    }
    __builtin_amdgcn_fence(__ATOMIC_ACQUIRE, "agent");
    asm volatile("s_waitcnt vmcnt(0)" ::: "memory");
  }
  __syncthreads();
}
#ifndef ONLY
#define ENAB(k) true
#else
#define ENAB(k) ((ONLY) == (k))
#endif
__global__ void __launch_bounds__(256, 2) mk_fwd(KP p) {
  __shared__ __attribute__((aligned(16))) unsigned char smem[73728];
  cg::grid_group grid = cg::this_grid();
  const int bid = blockIdx.x, nb = gridDim.x;
  const int ngw = nb * 4;
  unsigned char* ws = p.ws;
  unsigned* ctr = (unsigned*)(ws + WS_CTR);
  float* Y = p.out + O_YP;
  bf16_t* XN = (bf16_t*)(ws + WS_XN);
  bf16_t* MIX = (bf16_t*)(ws + WS_MIX);
  bf16_t* Pb = (bf16_t*)(ws + WS_P);
  bf16_t* Hb = (bf16_t*)(ws + WS_H);
  bool did = false;
  unsigned bgen = 0;
  __shared__ unsigned s_bar[4];
  gbar_setup(ctr, nb, s_bar);
  grid.sync();
  for (int ph = p.ph_lo; ph < p.ph_hi; ++ph) {
    const int layer = ph == 0 ? 0 : (ph - 1) / 9, sub = ph == 0 ? -1 : (ph - 1) % 9;
    const int kind = layer & 1, j = layer >> 1;
    if (sub == 8 && layer == 3) continue;
    if (did) gbar(ctr, s_bar, bgen);
    did = true;
    const int np = kind ? NP_SB : NP_GDN, mqoff = kind ? MQ_SB : MQ_GDN, mixp = kind ? 768 : 1024, mixoff = kind ? 512 : 768;
    if (ph == 0 && ENAB(0)) {
      const int tid = get_tid(), lane = tid & 63, gw = bid * 4 + (tid >> 6); (void)tid; (void)lane; (void)gw;
      int base = 0;
      convert_group(base, bid, nb, p.in[12], (bf16_t*)(ws + WS_WIG), 1, 1024, 3340, 3456, 3084, 116, smem);
      convert_group(base, bid, nb, p.in[14], (bf16_t*)(ws + WS_WKV), 4, 1024, 512, 512, 1 << 30, 0, smem);
      for (int r = gw; r < TA; r += ngw) norm_row(r < TP ? p.in[0] + (size_t)r * DM : p.in[1] + (size_t)(r - TP) * DM, p.in[9], XN + (size_t)r * DM, lane);
      for (int i = bid * 256 + tid; i < TS * DM / 4; i += nb * 256) ((float4*)(Y + (size_t)TP * DM))[i] = ((const float4*)p.in[1])[i];
      for (int r = gw; r < 1024; r += ngw) norm_row(p.in[8] + (size_t)(r & 255) * DM, p.in[10] + (r >> 8) * DM, (bf16_t*)(ws + WS_MEMN) + (size_t)r * DM, lane);
    } else if (sub == 0 && ENAB(1)) {
      EpiArgs ea{}; ea.cb = Pb; ea.ldc = np;
      const bf16_t* wt = kind ? (const bf16_t*)(ws + WS_WIS) + (size_t)j * 1792 * 1024 : (const bf16_t*)(ws + WS_WIG) + (size_t)j * 3456 * 1024;
      gemm_phase<0>(XN, DM, wt, 1024, TA, np, ea, smem);
      if (layer == 0) {
        for (int t = bid; t < 32; t += nb) {
          const int l = t >> 3, r = t & 7;
          EpiArgs e2{}; e2.cf = (float*)(ws + WS_MEMKV) + (size_t)l * 256 * 512; e2.ldc = 512;
          gemm_tile<3>((const bf16_t*)(ws + WS_MEMN) + (size_t)l * 256 * DM, DM, (const bf16_t*)(ws + WS_WKV) + (size_t)l * 512 * DM, DM, 1024, (r >> 2) << 7, (r & 3) << 7, e2, smem);
        }
      }
    } else if (sub == 1 && ENAB(2)) {
      const int tid = get_tid(), lane = tid & 63, gw = bid * 4 + (tid >> 6); (void)tid; (void)lane; (void)gw;
      if (layer == 0) {
        const float* kv = (const float*)(ws + WS_MEMKV);
        for (int it = gw; it < 4096; it += ngw) {
          const int l = it >> 10, m = (it >> 2) & 255, hh = it & 3;
          const float kx = kv[((size_t)l * 256 + m) * 512 + hh * 64 + lane], vx = kv[((size_t)l * 256 + m) * 512 + 256 + hh * 64 + lane];
          const float ss = wave_sum(kx * kx);
          p.out[O_PMK + ((size_t)l * 256 + m) * 256 + hh * 64 + lane] = kx * rsqrtf(ss * (1.f / 64.f) + EPS) * p.in[16][l * 64 + lane];
          p.out[O_PMV + ((size_t)l * 256 + m) * 256 + hh * 64 + lane] = vx;
        }
      }
      if (kind == 0) {
        for (int it = bid; it < 256 * 6; it += nb) gdn_prep_item(p, j, it / 6, it % 6, Pb, smem);
      } else {
        bf16_t* Kb = (bf16_t*)(ws + WS_G);
        const float* kg = p.in[22] + j * 128;
        for (int t = gw; t < TA; t += ngw) {
          const bf16_t* pr = Pb + (size_t)t * np;
          const u4 ku = *(const u4*)(pr + 512 + lane * 8), vu = *(const u4*)(pr + 1024 + lane * 8);
          float kf[8] = {lo2f(ku.x), hi2f(ku.x), lo2f(ku.y), hi2f(ku.y), lo2f(ku.z), hi2f(ku.z), lo2f(ku.w), hi2f(ku.w)};
          float ss = 0.f;
#pragma unroll
          for (int e = 0; e < 8; ++e) ss += kf[e] * kf[e];
          ss += __shfl_xor(ss, 1); ss += __shfl_xor(ss, 2); ss += __shfl_xor(ss, 4); ss += __shfl_xor(ss, 8);
          const float sc = rsqrtf(ss * (1.f / 128.f) + EPS);
          const int c0 = (lane & 15) * 8;
#pragma unroll
          for (int e = 0; e < 8; ++e) kf[e] *= sc * kg[c0 + e];
          float* ok = t < TP ? p.out + O_PSK + ((size_t)j * TP + t) * 512 : p.out + O_SSK + ((size_t)j * TS + (t - TP)) * 512;
          float* ov = t < TP ? p.out + O_PSV + ((size_t)j * TP + t) * 512 : p.out + O_SSV + ((size_t)j * TS + (t - TP)) * 512;
          *(float4*)(ok + lane * 8) = make_float4(kf[0], kf[1], kf[2], kf[3]); *(float4*)(ok + lane * 8 + 4) = make_float4(kf[4], kf[5], kf[6], kf[7]);
          *(float4*)(ov + lane * 8) = make_float4(lo2f(vu.x), hi2f(vu.x), lo2f(vu.y), hi2f(vu.y)); *(float4*)(ov + lane * 8 + 4) = make_float4(lo2f(vu.z), hi2f(vu.z), lo2f(vu.w), hi2f(vu.w));
          *(u4*)(Kb + (size_t)t * 512 + lane * 8) = mk4(pk2(kf[0], kf[1]), pk2(kf[2], kf[3]), pk2(kf[4], kf[5]), pk2(kf[6], kf[7]));
        }
      }
    } else if (sub == 2 && ENAB(3)) {
      unsigned* c = ctr + layer * 4;
      if (kind == 0) {
        bf16_t* O = XN;
        if (bid < 64 && (bid & 7) < 6) {
          const int h = bid & 7, sl = bid >> 3;
          gdn_scan_stream(p, j, 0, 256, h, sl, nullptr, p.out + O_PGS + ((size_t)j * 6 + h) * 16384, O, smem);
        }
        for (;;) {
          const int it = next_item(c);
          if (it >= 48 + 544) {
            if (layer != 0 || it >= 48 + 544 + NCVT_TILES) break;
            int t = it - (48 + 544);
            do {
              CVT_TRY(p.in[12] + (size_t)1024 * 3340, (bf16_t*)(ws + WS_WIG) + (size_t)3456 * 1024, 1, 1024, 3340, 3456, 3084, 116)
              CVT_TRY(p.in[13], (bf16_t*)(ws + WS_WIS), 2, 1024, 1792, 1792, 1 << 30, 0)
              CVT_TRY(p.in[23], (bf16_t*)(ws + WS_WOG), 2, 1024, 1024, 1024, 1 << 30, 0)
              CVT_TRY(p.in[24], (bf16_t*)(ws + WS_WOS), 2, 768, 1024, 1024, 1 << 30, 0)
              CVT_TRY(p.in[25], (bf16_t*)(ws + WS_WUP), 4, 1024, 4096, 4096, 1 << 30, 0)
              CVT_TRY(p.in[26], (bf16_t*)(ws + WS_WDN), 4, 4096, 1024, 1024, 1 << 30, 0)
            } while (0);
            continue;
          }
          if (it < 48) {
            const int b = it / 6, h = it % 6;
            gdn_prep_item(p, j, 256 + b, h, Pb, smem);
            asm volatile("s_waitcnt vmcnt(0)" ::: "memory");
            __syncthreads();
#pragma unroll 1
            for (int sl = 0; sl < 8; ++sl)
              gdn_scan_stream(p, j, 256 + b, 1, h, sl, p.in[3] + (((size_t)j * 8 + b) * 6 + h) * 16384, p.out + O_SGS + (((size_t)j * 8 + b) * 6 + h) * 16384, O, smem);
          } else mem_attn_item(p, layer, it - 48, Pb, np, mqoff, MIX, mixp, mixoff, smem);
        }
      } else {
        const bf16_t* Kb = (const bf16_t*)(ws + WS_G);
        bf16_t* OFAR = (bf16_t*)(ws + WS_G + (32ull << 20));
        float* CARRY = (float*)(ws + WS_G + (64ull << 20));
        const float qs = 0.08838834764831845f * LOG2E;
        for (;;) {
          const int it = next_item(c);
          if (it >= 768 + 32 + 544) break;
          if (it < 768) {
            int qb, idx, whole;
            if (it < 640) { const int pr = it / 20, r = it % 20; if (r < 8) { qb = 127 - 2 * pr; idx = r; whole = 0; } else if (r < 12) { qb = 63 - pr; idx = r - 8; whole = 1; } else { qb = 126 - 2 * pr; idx = r - 12; whole = 0; } }
            else { qb = 31 - ((it - 640) >> 2); idx = (it - 640) & 3; whole = 1; }
            const int h = whole ? idx : (idx >> 1), far = whole ? 0 : (idx & 1), near_ = (!whole && !far);
            const int nAi = whole ? 2 * qb + 2 : qb + 1, koff = near_ ? (qb + 1) * 64 : 0;
            KVSrc s; s.k = Kb + (size_t)koff * 512 + h * 128; s.v = Pb + (size_t)koff * np + 1024 + h * 128; s.kpitch = 512; s.vpitch = np; s.f32 = 0;
            bf16_t* op = far ? OFAR + (size_t)(qb * 128) * 512 + h * 128 : MIX + (size_t)(qb * 128) * mixp + h * 128;
            float* co = near_ ? CARRY + (size_t)(qb * 128) * 4 + h : nullptr;
            attn_item<128, 0>(Pb + (size_t)(qb * 128) * np + h * 128, np, 128, p.in[21] + j * 128, qs, s, nAi, qb * 128 - koff, far ? 0 : 1, s, 0, op, far ? 512 : mixp, smem, co);
          } else if (it < 800) {
            const int b = (it - 768) >> 2, h = it & 3, t0 = TP + b * 64;
            KVSrc sa; sa.k = Kb + (size_t)t0 * 512 + h * 128; sa.v = Pb + (size_t)t0 * np + 1024 + h * 128; sa.kpitch = 512; sa.vpitch = np; sa.f32 = 0;
            KVSrc sb; sb.k = p.in[4] + ((size_t)j * 8 + b) * 2048 * 512 + h * 128; sb.v = p.in[5] + ((size_t)j * 8 + b) * 2048 * 512 + h * 128; sb.kpitch = 512; sb.vpitch = 512; sb.f32 = 1;
            attn_item<128, 0>(Pb + (size_t)t0 * np + h * 128, np, 64, p.in[21] + j * 128, qs, sa, 1, 0, 1, sb, 32,
                              MIX + (size_t)t0 * mixp + h * 128, mixp, smem);
          } else mem_attn_item(p, layer, it - 800, Pb, np, mqoff, MIX, mixp, mixoff, smem);
        }
      }
    } else if (sub == 3 && kind == 1) {
      const int tid = get_tid(), lane = tid & 63, gw = bid * 4 + (tid >> 6); (void)tid; (void)lane; (void)gw;
      const bf16_t* OFAR = (const bf16_t*)(ws + WS_G + (32ull << 20));
      const float* CARRY = (const float*)(ws + WS_G + (64ull << 20));
      for (int t = TP / 2 + gw; t < TP; t += ngw) {
        const u4 a = *(const u4*)(MIX + (size_t)t * mixp + lane * 8), b = *(const u4*)(OFAR + (size_t)t * 512 + lane * 8);
        const float sc = CARRY[(size_t)t * 4 + (lane >> 4)];
        u4 o;
        o.x = pk2(lo2f(a.x) + sc * lo2f(b.x), hi2f(a.x) + sc * hi2f(b.x)); o.y = pk2(lo2f(a.y) + sc * lo2f(b.y), hi2f(a.y) + sc * hi2f(b.y));
        o.z = pk2(lo2f(a.z) + sc * lo2f(b.z), hi2f(a.z) + sc * hi2f(b.z)); o.w = pk2(lo2f(a.w) + sc * lo2f(b.w), hi2f(a.w) + sc * hi2f(b.w));
        *(u4*)(MIX + (size_t)t * mixp + lane * 8) = o;
      }
    } else if (sub == 3 && ENAB(4)) {
      const int tid = get_tid(), lane = tid & 63, gw = bid * 4 + (tid >> 6); (void)tid; (void)lane; (void)gw;
      const bf16_t* O = XN;
      const float* og = p.in[20] + j * 128;
      for (int it = gw; it < TA * 6; it += ngw) {
        const int t = it / 6, h = it % 6;
        const unsigned ou = *(const unsigned*)(O + (size_t)t * 768 + h * 128 + lane * 2);
        const unsigned zu = *(const unsigned*)(Pb + (size_t)t * np + 2304 + h * 128 + lane * 2);
        const float o0 = lo2f(ou), o1 = hi2f(ou), z0 = lo2f(zu), z1 = hi2f(zu);
        const float ss = wave_sum(o0 * o0 + o1 * o1);
        const float sc = rsqrtf(ss * (1.f / 128.f) + EPS);
        *(unsigned*)(MIX + (size_t)t * 1024 + h * 128 + lane * 2) = pk2(o0 * sc * og[lane * 2] * silu(z0), o1 * sc * og[lane * 2 + 1] * silu(z1));
      }
    } else if (sub == 4 && ENAB(5)) {
      EpiArgs ea{}; ea.yout = Y;
      if (layer == 0) { ea.res0 = p.in[0]; ea.res1 = p.in[1]; } else { ea.res0 = Y; ea.res1 = nullptr; }
      const bf16_t* wt = kind ? (const bf16_t*)(ws + WS_WOS) + (size_t)j * 1024 * 768 : (const bf16_t*)(ws + WS_WOG) + (size_t)j * 1024 * 1024;
      gemm_phase_res(MIX, mixp, wt, mixp, ea, smem);
    } else if (sub == 5) {
      const int tid = get_tid(), lane = tid & 63, gw = bid * 4 + (tid >> 6); (void)tid; (void)lane; (void)gw;
      norm_all(Y, p.in[11] + layer * DM, XN, gw, ngw, lane);
    } else if (sub == 6 && ENAB(6)) {
      EpiArgs ea{}; ea.cb = Hb; ea.ldc = DFF;
      gemm_phase_big<2>(XN, DM, (const bf16_t*)(ws + WS_WUP) + (size_t)layer * 4096 * 1024, 1024, 4096, ea, smem);
      gemm_phase_sample<2>(XN, DM, (const bf16_t*)(ws + WS_WUP) + (size_t)layer * 4096 * 1024, 1024, 4096, ea, smem);
    } else if (sub == 7 && ENAB(7)) {
      EpiArgs ea{}; ea.yout = Y; ea.res0 = Y; ea.res1 = nullptr;
      gemm_phase_res(Hb, DFF, (const bf16_t*)(ws + WS_WDN) + (size_t)layer * 1024 * 4096, 4096, ea, smem);
    } else if (sub == 8) {
      const int tid = get_tid(), lane = tid & 63, gw = bid * 4 + (tid >> 6); (void)tid; (void)lane; (void)gw;
      norm_all(Y, p.in[9] + (layer + 1) * DM, XN, gw, ngw, lane);
    }
  }
}

extern "C" void kernel_launch(void* const* d_in, const int* in_sizes, int n_in, void* d_out, int out_size, void* d_ws, size_t ws_size, hipStream_t stream) {
  static int grid_blocks = 0;
  if (!grid_blocks) {
    int dev = 0, cus = 0, per_cu = 0;
    (void)hipGetDevice(&dev);
    (void)hipDeviceGetAttribute(&cus, hipDeviceAttributeMultiprocessorCount, dev);
    (void)hipOccupancyMaxActiveBlocksPerMultiprocessor(&per_cu, mk_fwd, 256, 0);
    if (per_cu > 2) per_cu = 2;
    if (per_cu < 1) per_cu = 1;
    grid_blocks = cus * per_cu;
    if (ws_size < WS_END) fprintf(stderr, "kernel_launch: workspace too small: %zu < %zu\n", ws_size, (size_t)WS_END);
  }
  (void)hipMemsetAsync((char*)d_ws + WS_CTR, 0, 4096, stream);
  KP p{};
  for (int i = 0; i < 27; ++i) p.in[i] = (const float*)d_in[i];
  p.out = (float*)d_out; p.ws = (unsigned char*)d_ws; p.ph_lo = 0; p.ph_hi = 37;
  void* args[] = {&p};
  hipError_t e = hipLaunchCooperativeKernel((void*)mk_fwd, dim3(grid_blocks), dim3(256), args, 0, stream);
  if (e != hipSuccess) fprintf(stderr, "cooperative launch failed: %s (grid %d)\n", hipGetErrorString(e), grid_blocks);
}
```
